# Optimizing an MI355X kernel written in HIP

```python
import math
import jax, jax.numpy as jnp
from jax import lax
import numpy as np

D_MODEL = 1024
BATCH = 4
SEQ = 4096
DEPTH = 2

CHUNK = 64
Q_BLOCK = 128
SB_HEADS = 16
SB_HEAD_DIM = D_MODEL // SB_HEADS
SB_WIDTH = SB_HEADS * SB_HEAD_DIM
CONV_WIDTH = D_MODEL
CONV_K = 3
N_BRANCH = 2
FFN_HIDDEN = -(-8 * D_MODEL // (3 * 256)) * 256
IN_WIDTH = 3 * SB_WIDTH + 3 * CONV_WIDTH + N_BRANCH * D_MODEL
EPS = 1e-6

kernel_name = "stickbreak_shortconv_griffin_adaln_block"


def rmsnorm(x, g):
    xf = x.astype(jnp.float32)
    y = xf * lax.rsqrt(jnp.mean(xf * xf, axis=-1, keepdims=True) + EPS)
    return (y * g.astype(jnp.float32)).astype(x.dtype)


def stick_breaking_attention(q, k, v):
    b, s_len, h, dh = q.shape
    qh = jnp.transpose(q, (0, 2, 1, 3)).astype(jnp.float32)
    kh = jnp.transpose(k, (0, 2, 1, 3)).astype(jnp.float32)
    vh = jnp.transpose(v, (0, 2, 1, 3)).astype(jnp.float32)
    inv_sqrt = 1.0 / math.sqrt(dh)
    outs = []
    for i in range(s_len // Q_BLOCK):
        t0 = i * Q_BLOCK
        n_keys = t0 + Q_BLOCK
        qb = qh[:, :, t0:t0 + Q_BLOCK]
        kp = kh[:, :, :n_keys]
        vp = vh[:, :, :n_keys]
        z = jnp.einsum('bhqd,bhkd->bhqk', qb, kp) * inv_sqrt
        t_idx = t0 + jnp.arange(Q_BLOCK)[:, None]
        s_idx = jnp.arange(n_keys)[None, :]
        mask = s_idx < t_idx
        log_not = jnp.where(mask, jax.nn.log_sigmoid(-z), 0.0)
        excl = lax.cumsum(log_not, axis=3, reverse=True) - log_not
        log_a = jax.nn.log_sigmoid(z) + excl
        a = jnp.where(mask, jnp.exp(log_a), 0.0)
        outs.append(jnp.einsum('bhqk,bhkd->bhqd', a, vp))
    o = jnp.concatenate(outs, axis=2)
    o = jnp.transpose(o, (0, 2, 1, 3)).reshape(b, s_len, h * dh)
    return o.astype(q.dtype)


def causal_dwconv(x, w):
    ch = x.shape[-1]
    return lax.conv_general_dilated(
        x, w[:, None, :].astype(x.dtype), window_strides=(1,),
        padding=[(CONV_K - 1, 0)], dimension_numbers=('NWC', 'WIO', 'NWC'),
        feature_group_count=ch)


def setup_inputs(seed: int = 0) -> dict:
    key = jax.random.key(seed)
    ks = jax.random.split(key, 18)
    f32 = jnp.float32

    def nrm(k, shape, fan_in):
        return jax.random.normal(k, shape, f32) * (fan_in ** -0.5)

    def gain(k, shape):
        return 1.0 + 0.02 * jax.random.normal(k, shape, f32)

    return {
        "x": jax.random.normal(ks[0], (BATCH, SEQ, D_MODEL), f32),
        "c": jax.random.normal(ks[1], (BATCH, D_MODEL), f32),
        "ada_w": nrm(ks[2], (DEPTH, D_MODEL, 6 * D_MODEL), D_MODEL),
        "ada_b": 0.02 * jax.random.normal(ks[3], (DEPTH, 6 * D_MODEL), f32),
        "ln1_g": gain(ks[4], (DEPTH, D_MODEL)),
        "w_in": nrm(ks[5], (DEPTH, D_MODEL, IN_WIDTH), D_MODEL),
        "q_norm_g": gain(ks[6], (DEPTH, SB_HEAD_DIM)),
        "k_norm_g": gain(ks[7], (DEPTH, SB_HEAD_DIM)),
        "conv_w": nrm(ks[8], (DEPTH, CONV_K, CONV_WIDTH), CONV_K),
        "w_branch_a": nrm(ks[9], (DEPTH, SB_WIDTH, D_MODEL), SB_WIDTH),
        "w_branch_b": nrm(ks[10], (DEPTH, CONV_WIDTH, D_MODEL), CONV_WIDTH),
        "w_out": nrm(ks[11], (DEPTH, D_MODEL, D_MODEL), D_MODEL),
        "ln2_g": gain(ks[12], (DEPTH, D_MODEL)),
        "w_ffn_gate": nrm(ks[13], (DEPTH, D_MODEL, FFN_HIDDEN), D_MODEL),
        "w_ffn_up": nrm(ks[14], (DEPTH, D_MODEL, FFN_HIDDEN), D_MODEL),
        "w_ffn_down": nrm(ks[15], (DEPTH, FFN_HIDDEN, D_MODEL), FFN_HIDDEN),
    }


def reference(x, c, ada_w, ada_b, ln1_g, w_in, q_norm_g, k_norm_g, conv_w,
              w_branch_a, w_branch_b, w_out, ln2_g, w_ffn_gate, w_ffn_up, w_ffn_down):
    b, s_len, d = x.shape
    split_at = np.cumsum([SB_WIDTH, SB_WIDTH, SB_WIDTH,
                          CONV_WIDTH, CONV_WIDTH, CONV_WIDTH, D_MODEL])
    c_act = jax.nn.silu(c)
    for l in range(DEPTH):
        mod = c_act @ ada_w[l] + ada_b[l]
        sh1, sc1, g1, sh2, sc2, g2 = [m[:, None, :] for m in jnp.split(mod, 6, axis=-1)]

        h = rmsnorm(x, ln1_g[l]) * (1.0 + sc1) + sh1
        p = h @ w_in[l]
        q, k, v, cb, cc, cx, ga, gb = jnp.split(p, split_at, axis=-1)
        q = rmsnorm(q.reshape(b, s_len, SB_HEADS, SB_HEAD_DIM), q_norm_g[l])
        k = rmsnorm(k.reshape(b, s_len, SB_HEADS, SB_HEAD_DIM), k_norm_g[l])
        v = v.reshape(b, s_len, SB_HEADS, SB_HEAD_DIM)
        y_a = stick_breaking_attention(q, k, v)
        y_b = cb * causal_dwconv(cc * cx, conv_w[l])
        merged = (jax.nn.sigmoid(ga) * (y_a @ w_branch_a[l])
                  + jax.nn.sigmoid(gb) * (y_b @ w_branch_b[l]))
        x = x + g1 * (merged @ w_out[l])

        h = rmsnorm(x, ln2_g[l]) * (1.0 + sc2) + sh2
        f = (jax.nn.silu(h @ w_ffn_gate[l]) * (h @ w_ffn_up[l])) @ w_ffn_down[l]
        x = x + g2 * f
    return x
```

```cpp
#include <hip/hip_runtime.h>
#include <hip/hip_cooperative_groups.h>
#include <cstdio>
#include <cstdint>
namespace cg = cooperative_groups;

#define LAS __attribute__((address_space(3)))
typedef unsigned short bf16_t;
typedef short bf16x8 __attribute__((ext_vector_type(8)));
typedef short s16x4 __attribute__((ext_vector_type(4)));
typedef float f32x4 __attribute__((ext_vector_type(4)));
typedef float f32x16 __attribute__((ext_vector_type(16)));
typedef unsigned u32x4 __attribute__((ext_vector_type(4)));
typedef unsigned u32x2 __attribute__((ext_vector_type(2)));
typedef float f32x2_t __attribute__((ext_vector_type(2)));
typedef __bf16 bf16x2_t __attribute__((ext_vector_type(2)));

constexpr int D = 1024, NB = 4, SEQ = 4096, M = NB * SEQ, NH = 16, HD = 64, FF = 2816, INW = 8192, DEPTH = 2;
constexpr float EPS = 1e-6f;
constexpr float LOG2E = 1.4426950408889634f;
constexpr float C2 = 0.125f * LOG2E;
constexpr int NWAVES = 8, NTHREADS = 512;

constexpr size_t MiB = 1u << 20;
constexpr size_t WS_CTL = 0, CTL_BYTES = 256 * 1024;
constexpr size_t WS_W = 1 * MiB;
constexpr size_t W_IN = 0, W_A = 16 * MiB, W_B = 18 * MiB, W_O = 20 * MiB, W_GU = 22 * MiB, W_D = 33 * MiB, W_LAYER = 38 * MiB + 512 * 1024;
constexpr size_t WS_ACT = 78 * MiB;
constexpr size_t REG = 32 * MiB;
constexpr size_t R_H = WS_ACT, R_A = WS_ACT + REG, R_B = WS_ACT + 2 * REG, R_C = WS_ACT + 3 * REG, R_D = WS_ACT + 4 * REG, WS_END = WS_ACT + 5 * REG;
static_assert(WS_W + 2 * W_LAYER <= WS_ACT, "weights");
static_assert((size_t)M * FF * 2 <= 3 * REG, "ffn hidden fits R_A..R_C");

__device__ __forceinline__ unsigned cvt_pk(float lo, float hi) { f32x2_t v = {lo, hi}; bf16x2_t b = __builtin_convertvector(v, bf16x2_t); return __builtin_bit_cast(unsigned, b); }
__device__ __forceinline__ float bf_lo(unsigned u) { return __uint_as_float(u << 16); }
__device__ __forceinline__ float bf_hi(unsigned u) { return __uint_as_float(u & 0xffff0000u); }
__device__ __forceinline__ float shx(float v, int o, int lane) { return __int_as_float(__builtin_amdgcn_ds_bpermute((lane ^ o) << 2, __float_as_int(v))); }
__device__ __forceinline__ float wave_sum(float v, int lane) {
#pragma unroll
    for (int o = 1; o < 64; o <<= 1) v += shx(v, o, lane);
    return v;
}
__device__ __forceinline__ int lane_id_opaque() { int l; asm volatile("v_mbcnt_lo_u32_b32 %0, -1, 0\n\tv_mbcnt_hi_u32_b32 %0, -1, %0" : "=v"(l)); return l; }
__device__ __forceinline__ float fast_exp2(float x) { return __builtin_amdgcn_exp2f(x); }
__device__ __forceinline__ float fast_log2(float x) { return __builtin_amdgcn_logf(x); }
__device__ __forceinline__ float fast_rcp(float x) { return __builtin_amdgcn_rcpf(x); }
__device__ __forceinline__ float sigmoidf_(float x) { return fast_rcp(1.0f + fast_exp2(-x * LOG2E)); }

namespace pg8 {
constexpr int BM = 256, BK = 64, HALF = 128, HTB = HALF * BK * 2, STAGE_BYTES = 8 * HTB, NXCD = 8, WGM = 8;
__host__ __device__ __forceinline__ int lds_byte(int r, int c) { const int st = (r >> 4) * 2 + (c >> 5), rr = r & 15, cc = c & 31, ob = rr * 64 + cc * 2; return st * 1024 + (ob ^ (((ob >> 9) & 1) << 5)); }
__host__ __device__ __forceinline__ void stage_rc(int b, int& R, int& C) { const int st = b / 1024, sb = b % 1024, swz = sb ^ (((sb >> 9) & 1) << 5); R = (st >> 1) * 16 + swz / 64; C = (st & 1) * 32 + (swz % 64) / 2; }

struct Unit { const char* A; const char* B; int pm, pn, kind; };

struct TileOrder {
    int nM, nN, nwg;
    __device__ __forceinline__ void init(int Mr, int N) { nM = Mr / BM; nN = N / BM; nwg = nM * nN; }
    __device__ __forceinline__ void map(int wgid, int& pm, int& pn) const {
        { const int q = nwg / NXCD, r = nwg % NXCD, xcd = wgid % NXCD, off = wgid / NXCD; wgid = (xcd < r ? xcd * (q + 1) : r * (q + 1) + (xcd - r) * q) + off; }
        const int nig = WGM * nN, gid = wgid / nig, fm = gid * WGM, gsz = (nM - fm) < WGM ? (nM - fm) : WGM;
        pm = fm + ((wgid % nig) % gsz); pn = (wgid % nig) / gsz;
    }
};
struct SchedPlain {
    TileOrder T; int G, c; const char* A; const char* B; size_t tstep;
    __device__ __forceinline__ bool next(int i, Unit& u) const {
        const long L = (long)i * G + c; if (L >= T.nwg) return false;
        T.map((int)L, u.pm, u.pn); u.A = A + (size_t)u.pm * tstep; u.B = B + (size_t)u.pn * tstep; u.kind = 0; return true;
    }
};
struct SchedBranch {
    TileOrder T; int G, c; const char* ws; const char* wl; size_t tstep;
    __device__ __forceinline__ bool next(int i, Unit& u) const {
        const long L = (long)(i >> 2) * G + c; if (L >= T.nwg) return false;
        T.map((int)L, u.pm, u.pn); const int sub = i & 3; u.kind = sub;
        const size_t oa = (sub == 1) ? R_B : ((sub == 3) ? R_A : R_H);
        const size_t ob = (sub == 0) ? (W_IN + (size_t)6144 * D * 2) : (sub == 1) ? W_A : (sub == 2) ? (W_IN + (size_t)7168 * D * 2) : W_B;
        u.A = ws + oa + (size_t)u.pm * tstep; u.B = wl + ob + (size_t)u.pn * tstep; return true;
    }
};

template <class Epi, class Sched>
__device__ __forceinline__ void gemm_phase(LAS unsigned char* lds, const int K, const Sched& S, const Epi& E, const int wid) {
    const int lane = lane_id_opaque(), tid = wid * 64 + lane, wr = wid >> 2, wc = wid & 3, fr = lane & 15, fq = lane >> 4;
    const int nt = K / BK;
    unsigned voff[2];
#pragma unroll
    for (int i = 0; i < 2; ++i) { int R, C; stage_rc(tid * 16 + i * 8192, R, C); voff[i] = (unsigned)(R * K + C) * 2u; }
    const size_t kstep = (size_t)(BK * 2);
    const size_t hstep = (size_t)HALF * K * 2;
    const unsigned ldsw = (unsigned)wid * 1024u;
    const int aoff = lds_byte(wr * 64 + fr, fq * 8), boff = lds_byte(wc * 32 + fr, fq * 8);
#define PG8_SA(b, h) (((b) * 2 + (h)) * HTB)
#define PG8_SB(b, h) ((4 + (b) * 2 + (h)) * HTB)
#define PG8_STAGE(bufoff, gbase) do { _Pragma("unroll") for (int _i = 0; _i < 2; ++_i) \
        __builtin_amdgcn_global_load_lds((const unsigned*)((const char*)(gbase) + voff[_i]), (LAS unsigned*)(lds + (bufoff) + ldsw + _i * 8192), 16, 0, 0); } while (0)
#define PG8_LDA(dst, b, h) do { _Pragma("unroll") for (int m = 0; m < 4; ++m) _Pragma("unroll") for (int k = 0; k < 2; ++k) dst[m][k] = *(const LAS bf16x8*)(lds + PG8_SA(b, h) + aoff + m * 2048 + k * 1024); } while (0)
#define PG8_LDB(dst, b, h) do { _Pragma("unroll") for (int n = 0; n < 2; ++n) _Pragma("unroll") for (int k = 0; k < 2; ++k) dst[n][k] = *(const LAS bf16x8*)(lds + PG8_SB(b, h) + boff + n * 2048 + k * 1024); } while (0)
#define PG8_MMA(ai, bj, At, Bt) do { __builtin_amdgcn_s_setprio(1); _Pragma("unroll") for (int m = 0; m < 4; ++m) _Pragma("unroll") for (int n = 0; n < 2; ++n) _Pragma("unroll") for (int k = 0; k < 2; ++k) \
        acc[ai][bj][m][n] = __builtin_amdgcn_mfma_f32_16x16x32_bf16(Bt[n][k], At[m][k], acc[ai][bj][m][n], 0, 0, 0); __builtin_amdgcn_s_setprio(0); } while (0)
#define PG8_WAIT_V(n) asm volatile("s_waitcnt vmcnt(" #n ")" ::: "memory")
#define PG8_WAIT_L(n) asm volatile("s_waitcnt lgkmcnt(" #n ")" ::: "memory")
#define PG8_BAR __builtin_amdgcn_s_barrier()
#define PG8_SCHED __builtin_amdgcn_sched_barrier(0)
    Unit cur, nxt; int ui = 0;
    if (!S.next(0, cur)) return;
    f32x4 acc[2][2][4][2];
#pragma unroll
    for (int a = 0; a < 2; ++a)
#pragma unroll
        for (int b = 0; b < 2; ++b)
#pragma unroll
            for (int m = 0; m < 4; ++m)
#pragma unroll
                for (int n = 0; n < 2; ++n) acc[a][b][m][n] = (f32x4){0.f, 0.f, 0.f, 0.f};
    bf16x8 At[4][2], B0[2][2], B1[2][2];
    const char* cA = cur.A; const char* cB = cur.B;
    PG8_STAGE(PG8_SB(0, 0), cB); PG8_STAGE(PG8_SB(0, 1), cB + hstep); PG8_STAGE(PG8_SA(0, 0), cA); PG8_STAGE(PG8_SA(0, 1), cA + hstep);
    if (wr == 1) PG8_BAR;
    PG8_WAIT_V(2); PG8_BAR;
    PG8_STAGE(PG8_SB(1, 0), cB + kstep); PG8_STAGE(PG8_SA(1, 0), cA + kstep); PG8_STAGE(PG8_SB(1, 1), cB + hstep + kstep);
    PG8_WAIT_V(6); PG8_BAR;
    for (;;) {
        const bool has_next = S.next(ui + 1, nxt);
        const char* nA = has_next ? nxt.A : cA; const char* nB = has_next ? nxt.B : cB;
        for (int t = 0; t < nt; t += 2) {
            const bool last = (t == nt - 2);
            const char* a1 = cA + (size_t)(t + 1) * kstep;
            const char* a2 = last ? nA : cA + (size_t)(t + 2) * kstep; const char* b2 = last ? nB : cB + (size_t)(t + 2) * kstep;
            const char* a3 = a2 + kstep; const char* b3 = b2 + kstep;
            PG8_LDB(B0, 0, 0); PG8_LDB(B1, 0, 1); PG8_SCHED; PG8_LDA(At, 0, 0); PG8_STAGE(PG8_SA(1, 1), a1 + hstep);
            PG8_WAIT_V(8); PG8_WAIT_L(0); PG8_BAR; PG8_MMA(0, 0, At, B0); PG8_MMA(0, 1, At, B1); PG8_BAR; PG8_SCHED;
            PG8_LDA(At, 0, 1); PG8_STAGE(PG8_SB(0, 0), b2); PG8_STAGE(PG8_SB(0, 1), b2 + hstep); PG8_STAGE(PG8_SA(0, 0), a2);
            PG8_WAIT_V(8); PG8_WAIT_L(0); PG8_BAR; PG8_MMA(1, 0, At, B0); PG8_MMA(1, 1, At, B1); PG8_BAR; PG8_SCHED;
            PG8_LDB(B0, 1, 0); PG8_LDB(B1, 1, 1); PG8_SCHED; PG8_LDA(At, 1, 0); PG8_STAGE(PG8_SA(0, 1), a2 + hstep);
            PG8_WAIT_V(8); PG8_WAIT_L(0); PG8_BAR; PG8_MMA(0, 0, At, B0); PG8_MMA(0, 1, At, B1); PG8_BAR; PG8_SCHED;
            PG8_LDA(At, 1, 1); PG8_STAGE(PG8_SB(1, 0), b3); PG8_STAGE(PG8_SB(1, 1), b3 + hstep); PG8_STAGE(PG8_SA(1, 0), a3);
            PG8_WAIT_V(8); PG8_WAIT_L(0); PG8_BAR; PG8_MMA(1, 0, At, B0); PG8_MMA(1, 1, At, B1); PG8_BAR; PG8_SCHED;
        }
        if (wr == 0) PG8_BAR;
        { const int l2 = lane_id_opaque(); E(acc, cur, wr, wc, l2 & 15, l2 >> 4); }
        if (!has_next) break;
#pragma unroll
        for (int a = 0; a < 2; ++a)
#pragma unroll
            for (int b = 0; b < 2; ++b)
#pragma unroll
                for (int m = 0; m < 4; ++m)
#pragma unroll
                    for (int n = 0; n < 2; ++n) acc[a][b][m][n] = (f32x4){0.f, 0.f, 0.f, 0.f};
        cur = nxt; cA = nA; cB = nB; ++ui;
        if (wr == 1) PG8_BAR;
    }
    PG8_WAIT_V(0);
    PG8_BAR;
#undef PG8_SA
#undef PG8_SB
#undef PG8_STAGE
#undef PG8_LDA
#undef PG8_LDB
#undef PG8_MMA
#undef PG8_WAIT_V
#undef PG8_WAIT_L
#undef PG8_BAR
#undef PG8_SCHED
}

__device__ __forceinline__ u32x4 pack8(const f32x4& a, const f32x4& b) { u32x4 w; w.x = cvt_pk(a[0], a[1]); w.y = cvt_pk(a[2], a[3]); w.z = cvt_pk(b[0], b[1]); w.w = cvt_pk(b[2], b[3]); return w; }

struct EpiRegions {
    bf16_t* base;
    __device__ __forceinline__ void operator()(const f32x4 (&acc)[2][2][4][2], const Unit& u, int wr, int wc, int fr, int fq) const {
        bf16_t* dst = base + (size_t)(u.pn >> 2) * ((size_t)M * D);
        const int col = (u.pn & 3) * 256 + wc * 64 + fq * 8, row0 = u.pm * BM + wr * 64 + fr;
#pragma unroll
        for (int ai = 0; ai < 2; ++ai)
#pragma unroll
            for (int m = 0; m < 4; ++m) { bf16_t* rp = dst + (size_t)(row0 + ai * HALF + m * 16) * D + col;
#pragma unroll
                for (int bj = 0; bj < 2; ++bj) *(u32x4*)(rp + bj * 32) = pack8(acc[ai][bj][m][0], acc[ai][bj][m][1]); }
    }
};
struct EpiQKV {
    bf16_t* q; bf16_t* k; bf16_t* vt; const float* gq; const float* gk;
    __device__ __forceinline__ void operator()(const f32x4 (&acc)[2][2][4][2], const Unit& u, int wr, int wc, int fr, int fq) const {
        const int region = u.pn >> 2, head = (u.pn & 3) * 4 + wc, row0 = u.pm * BM + wr * 64 + fr;
        if (region == 2) {
            const int b = row0 >> 12;
            bf16_t* vb = vt + ((size_t)(b * NH + head) * HD) * SEQ;
#pragma unroll
            for (int ai = 0; ai < 2; ++ai)
#pragma unroll
                for (int m = 0; m < 4; ++m) { const int s = (row0 + ai * HALF + m * 16) & (SEQ - 1);
#pragma unroll
                    for (int bj = 0; bj < 2; ++bj)
#pragma unroll
                        for (int n = 0; n < 2; ++n)
#pragma unroll
                            for (int j = 0; j < 4; ++j) { const int d = bj * 32 + fq * 8 + n * 4 + j; const unsigned w = cvt_pk(acc[ai][bj][m][n][j], 0.f);
                                vb[(size_t)d * SEQ + s] = (bf16_t)(w & 0xffffu); } }
        } else {
            const float* g = region == 0 ? gq : gk; const float sc = region == 0 ? C2 : 1.0f;
            bf16_t* dst = region == 0 ? q : k;
            f32x4 gv[2][2];
#pragma unroll
            for (int bj = 0; bj < 2; ++bj)
#pragma unroll
                for (int n = 0; n < 2; ++n) gv[bj][n] = *(const f32x4*)(g + bj * 32 + fq * 8 + n * 4) * sc;
            const int col = head * 64 + fq * 8;
#pragma unroll
            for (int ai = 0; ai < 2; ++ai)
#pragma unroll
                for (int m = 0; m < 4; ++m) {
                    float ss = 0.f;
#pragma unroll
                    for (int bj = 0; bj < 2; ++bj)
#pragma unroll
                        for (int n = 0; n < 2; ++n) { const f32x4 x = acc[ai][bj][m][n]; ss += (x[0] * x[0] + x[1] * x[1]) + (x[2] * x[2] + x[3] * x[3]); }
                    ss += shx(ss, 16, fr + 16 * fq); ss += shx(ss, 32, fr + 16 * fq);
                    const float r = 1.0f / sqrtf(ss * (1.0f / 64.0f) + EPS);
                    bf16_t* rp = dst + (size_t)(row0 + ai * HALF + m * 16) * D + col;
#pragma unroll
                    for (int bj = 0; bj < 2; ++bj) { const f32x4 a = acc[ai][bj][m][0] * r * gv[bj][0], b2 = acc[ai][bj][m][1] * r * gv[bj][1]; *(u32x4*)(rp + bj * 32) = pack8(a, b2); }
                }
        }
    }
};
struct EpiBranch {
    bf16_t* S1; bf16_t* TM;
    __device__ __forceinline__ void operator()(const f32x4 (&acc)[2][2][4][2], const Unit& u, int wr, int wc, int fr, int fq) const {
        const int col = u.pn * 256 + wc * 64 + fq * 8, row0 = u.pm * BM + wr * 64 + fr, kind = u.kind;
#pragma unroll
        for (int ai = 0; ai < 2; ++ai)
#pragma unroll
            for (int m = 0; m < 4; ++m) { const size_t off = (size_t)(row0 + ai * HALF + m * 16) * D + col;
#pragma unroll
                for (int bj = 0; bj < 2; ++bj) {
                    f32x4 a = acc[ai][bj][m][0], b = acc[ai][bj][m][1];
                    if (kind == 0 || kind == 2) {
#pragma unroll
                        for (int j = 0; j < 4; ++j) { a[j] = sigmoidf_(a[j]); b[j] = sigmoidf_(b[j]); }
                        *(u32x4*)(S1 + off + bj * 32) = pack8(a, b);
                    } else {
                        const u32x4 g = *(const u32x4*)(S1 + off + bj * 32);
                        a[0] *= bf_lo(g.x); a[1] *= bf_hi(g.x); a[2] *= bf_lo(g.y); a[3] *= bf_hi(g.y);
                        b[0] *= bf_lo(g.z); b[1] *= bf_hi(g.z); b[2] *= bf_lo(g.w); b[3] *= bf_hi(g.w);
                        if (kind == 3) { const u32x4 t = *(const u32x4*)(TM + off + bj * 32);
                            a[0] += bf_lo(t.x); a[1] += bf_hi(t.x); a[2] += bf_lo(t.y); a[3] += bf_hi(t.y);
                            b[0] += bf_lo(t.z); b[1] += bf_hi(t.z); b[2] += bf_lo(t.w); b[3] += bf_hi(t.w); }
                        *(u32x4*)(TM + off + bj * 32) = pack8(a, b);
                    }
                } }
    }
};
struct EpiResid {
    const float* xin; float* xout; const float* gmod;
    __device__ __forceinline__ void operator()(const f32x4 (&acc)[2][2][4][2], const Unit& u, int wr, int wc, int fr, int fq) const {
        const int col = u.pn * 256 + wc * 64 + fq * 8, row0 = u.pm * BM + wr * 64 + fr, b = row0 >> 12;
        f32x4 gv[2][2];
#pragma unroll
        for (int bj = 0; bj < 2; ++bj)
#pragma unroll
            for (int n = 0; n < 2; ++n) gv[bj][n] = *(const f32x4*)(gmod + b * 6144 + col + bj * 32 + n * 4);
#pragma unroll
        for (int ai = 0; ai < 2; ++ai)
#pragma unroll
            for (int m = 0; m < 4; ++m) { const size_t off = (size_t)(row0 + ai * HALF + m * 16) * D + col;
#pragma unroll
                for (int bj = 0; bj < 2; ++bj)
#pragma unroll
                    for (int n = 0; n < 2; ++n) { const f32x4 xo = *(const f32x4*)(xin + off + bj * 32 + n * 4); *(f32x4*)(xout + off + bj * 32 + n * 4) = xo + gv[bj][n] * acc[ai][bj][m][n]; } }
    }
};
struct EpiGU {
    bf16_t* f;
    __device__ __forceinline__ void operator()(const f32x4 (&acc)[2][2][4][2], const Unit& u, int wr, int wc, int fr, int fq) const {
        const int col = u.pn * 128 + wc * 32 + fq * 8, row0 = u.pm * BM + wr * 64 + fr;
#pragma unroll
        for (int ai = 0; ai < 2; ++ai)
#pragma unroll
            for (int m = 0; m < 4; ++m) {
                f32x4 o[2];
#pragma unroll
                for (int n = 0; n < 2; ++n)
#pragma unroll
                    for (int j = 0; j < 4; ++j) { const float gt = acc[ai][0][m][n][j]; o[n][j] = gt * sigmoidf_(gt) * acc[ai][1][m][n][j]; }
                *(u32x4*)(f + (size_t)(row0 + ai * HALF + m * 16) * FF + col) = pack8(o[0], o[1]);
            }
    }
};
}

#define LDS_WAIT() asm volatile("s_waitcnt lgkmcnt(0)" ::: "memory")
__device__ __forceinline__ void transpose_item(const float* W, int N, int K, int n0, bf16_t* WT, int a0, int k0, LAS float* scr, int lane) {
#pragma unroll 8
    for (int i = 0; i < 32; ++i) { const int kk = 2 * i + (lane >> 5); scr[kk * 33 + (lane & 31)] = W[(size_t)(k0 + kk) * N + n0 + (lane & 31)]; }
    LDS_WAIT(); asm volatile("" ::: "memory");
    const int c = lane & 7;
#pragma unroll
    for (int j = 0; j < 4; ++j) { const int s = (lane >> 3) + 8 * j; const int lo = 8 * ((s >> 2) & 3) + 4 * (s >> 4) + (s & 3);
        const LAS float* sp = scr + (8 * c) * 33 + lo;
        u32x4 o; o.x = cvt_pk(sp[0 * 33], sp[1 * 33]); o.y = cvt_pk(sp[2 * 33], sp[3 * 33]); o.z = cvt_pk(sp[4 * 33], sp[5 * 33]); o.w = cvt_pk(sp[6 * 33], sp[7 * 33]);
        *(u32x4*)(WT + (size_t)(a0 + s) * K + k0 + 8 * c) = o; }
    LDS_WAIT(); asm volatile("" ::: "memory");
}

struct Params { const float* in[16]; float* out; unsigned char* ws; };

__device__ __forceinline__ void phase0(const Params& p, LAS unsigned char* lds, int gw, int NGW, int wave, int lane) {
    LAS float* scr = (LAS float*)(lds + wave * 16384);
    constexpr int I_IN = 256 * 16, I_SQ = 32 * 16, I_GU = 176 * 16, I_D = 32 * 44, I_LAYER = I_IN + 3 * I_SQ + I_GU + I_D;
    constexpr int I_MOD = 2 * 32 * 24;
    for (int it = gw; it < I_MOD; it += NGW) {
        const int l = it / (32 * 24), r = it % (32 * 24), kc = r / 24, nb = r % 24;
        const float* aw = p.in[2] + (size_t)l * D * 6144 + (size_t)(kc * 32) * 6144 + nb * 256 + lane * 4;
        const float* c = p.in[1];
        f32x4 a[4];
#pragma unroll
        for (int b = 0; b < 4; ++b) a[b] = (f32x4){0.f, 0.f, 0.f, 0.f};
#pragma unroll 8
        for (int k = 0; k < 32; ++k) { const f32x4 w = *(const f32x4*)(aw + (size_t)k * 6144);
#pragma unroll
            for (int b = 0; b < 4; ++b) { const float cv = c[b * D + kc * 32 + k]; const float sv = cv * sigmoidf_(cv); a[b] += w * sv; } }
        float* mp = (float*)(p.ws + R_D) + ((size_t)(l * 32 + kc) * 4) * 6144 + nb * 256 + lane * 4;
#pragma unroll
        for (int b = 0; b < 4; ++b) *(f32x4*)(mp + (size_t)b * 6144) = a[b];
    }
    for (int it = gw; it < DEPTH * I_LAYER; it += NGW) {
        const int l = it / I_LAYER; int r = it % I_LAYER;
        unsigned char* wl = p.ws + WS_W + (size_t)l * W_LAYER;
        if (r < I_IN) { const int kb = r / 256, g = r % 256; const int pn = g >> 3, bj = (g >> 2) & 1, wc = g & 3;
            transpose_item(p.in[5] + (size_t)l * D * INW, INW, D, 256 * pn + 64 * wc + 32 * bj, (bf16_t*)(wl + W_IN), 32 * g, 64 * kb, scr, lane); continue; }
        r -= I_IN;
        if (r < 3 * I_SQ) { const int which = r / I_SQ; r %= I_SQ; const int kb = r / 32, g = r % 32; const int pn = g >> 3, bj = (g >> 2) & 1, wc = g & 3;
            const float* src = p.in[9 + which] + (size_t)l * D * D; bf16_t* dst = (bf16_t*)(wl + (which == 0 ? W_A : which == 1 ? W_B : W_O));
            transpose_item(src, D, D, 256 * pn + 64 * wc + 32 * bj, dst, 32 * g, 64 * kb, scr, lane); continue; }
        r -= 3 * I_SQ;
        if (r < I_GU) { const int kb = r / 176, g = r % 176; const int pn = g >> 3, bj = (g >> 2) & 1, wc = g & 3;
            const float* src = p.in[bj ? 14 : 13] + (size_t)l * D * FF;
            transpose_item(src, FF, D, 128 * pn + 32 * wc, (bf16_t*)(wl + W_GU), 32 * g, 64 * kb, scr, lane); continue; }
        r -= I_GU;
        { const int kb = r / 32, g = r % 32; const int pn = g >> 3, bj = (g >> 2) & 1, wc = g & 3;
            transpose_item(p.in[15] + (size_t)l * FF * D, D, FF, 256 * pn + 64 * wc + 32 * bj, (bf16_t*)(wl + W_D), 32 * g, 64 * kb, scr, lane); }
    }
}

__device__ __forceinline__ void norm_phase(const float* x, const float* g, const float* modl, int sh_off, int sc_off, bf16_t* h, int gw, int NGW) {
    const int lane = lane_id_opaque();
    for (int m = gw; m < M; m += NGW) {
        const int b = m >> 12;
        const f32x4* xr = (const f32x4*)(x + (size_t)m * D) + lane;
        f32x4 v[4]; float s = 0.f;
#pragma unroll
        for (int j = 0; j < 4; ++j) { v[j] = xr[64 * j]; s += (v[j][0] * v[j][0] + v[j][1] * v[j][1]) + (v[j][2] * v[j][2] + v[j][3] * v[j][3]); }
        const float r = 1.0f / sqrtf(wave_sum(s, lane) * (1.0f / D) + EPS);
        u32x2* o8 = (u32x2*)(h + (size_t)m * D) + lane;
#pragma unroll
        for (int j = 0; j < 4; ++j) { const int col = 4 * (64 * j + lane);
            const f32x4 gg = *(const f32x4*)(g + col), sc = *(const f32x4*)(modl + b * 6144 + sc_off + col), sh = *(const f32x4*)(modl + b * 6144 + sh_off + col);
            const f32x4 y = (v[j] * r * gg) * (sc + 1.0f) + sh;
            u32x2 w; w.x = cvt_pk(y[0], y[1]); w.y = cvt_pk(y[2], y[3]); o8[64 * j] = w; }
    }
}

__device__ __forceinline__ void conv_phase(bf16_t* cb, const bf16_t* cc, const bf16_t* cx, const float* cw, int gt0, int NT) {
    const int gt = gt0 + lane_id_opaque();
    for (int it = gt; it < (M / 16) * (D / 8); it += NT) {
        const int c8 = it & 127, run = it >> 7, t0 = run * 16, ch = c8 * 8;
        float w0[8], w1[8], w2[8];
#pragma unroll
        for (int i = 0; i < 8; ++i) { w0[i] = cw[ch + i]; w1[i] = cw[D + ch + i]; w2[i] = cw[2 * D + ch + i]; }
        float um2[8], um1[8];
#pragma unroll
        for (int i = 0; i < 8; ++i) { um2[i] = 0.f; um1[i] = 0.f; }
        if ((t0 & (SEQ - 1)) != 0) {
            const u32x4 a2 = *(const u32x4*)(cc + (size_t)(t0 - 2) * D + ch), b2 = *(const u32x4*)(cx + (size_t)(t0 - 2) * D + ch);
            const u32x4 a1 = *(const u32x4*)(cc + (size_t)(t0 - 1) * D + ch), b1 = *(const u32x4*)(cx + (size_t)(t0 - 1) * D + ch);
#pragma unroll
            for (int i = 0; i < 4; ++i) { um2[2 * i] = bf_lo(a2[i]) * bf_lo(b2[i]); um2[2 * i + 1] = bf_hi(a2[i]) * bf_hi(b2[i]);
                um1[2 * i] = bf_lo(a1[i]) * bf_lo(b1[i]); um1[2 * i + 1] = bf_hi(a1[i]) * bf_hi(b1[i]); }
        }
#pragma unroll 4
        for (int t = 0; t < 16; ++t) {
            const size_t off = (size_t)(t0 + t) * D + ch;
            const u32x4 a = *(const u32x4*)(cc + off), b = *(const u32x4*)(cx + off), e = *(const u32x4*)(cb + off);
            float u[8], y[8];
#pragma unroll
            for (int i = 0; i < 4; ++i) { u[2 * i] = bf_lo(a[i]) * bf_lo(b[i]); u[2 * i + 1] = bf_hi(a[i]) * bf_hi(b[i]); }
#pragma unroll
            for (int i = 0; i < 4; ++i) {
                y[2 * i] = bf_lo(e[i]) * (w0[2 * i] * um2[2 * i] + w1[2 * i] * um1[2 * i] + w2[2 * i] * u[2 * i]);
                y[2 * i + 1] = bf_hi(e[i]) * (w0[2 * i + 1] * um2[2 * i + 1] + w1[2 * i + 1] * um1[2 * i + 1] + w2[2 * i + 1] * u[2 * i + 1]); }
            u32x4 o; o.x = cvt_pk(y[0], y[1]); o.y = cvt_pk(y[2], y[3]); o.z = cvt_pk(y[4], y[5]); o.w = cvt_pk(y[6], y[7]);
            *(u32x4*)(cb + off) = o;
#pragma unroll
            for (int i = 0; i < 8; ++i) { um2[i] = um1[i]; um1[i] = u[i]; }
        }
    }
}

#define MFMA32(a, b, c) __builtin_amdgcn_mfma_f32_32x32x16_bf16((a), (b), (c), 0, 0, 0)
constexpr float SB_EXIT = -200.0f;
__device__ __forceinline__ void attn_task(bf16_t* QO, const bf16_t* Kp, const bf16_t* VT, int b, int h, int qblk, int lane) {
    const int n = lane & 31, hh = lane >> 5, t0 = qblk * 32;
    bf16_t* qrow = QO + (size_t)(b * SEQ + t0 + n) * D + h * HD;
    bf16x8 qf[4];
#pragma unroll
    for (int kk = 0; kk < 4; ++kk) qf[kk] = *(const bf16x8*)(qrow + kk * 16 + hh * 8);
    f32x16 o0, o1;
#pragma unroll
    for (int r = 0; r < 16; ++r) { o0[r] = 0.f; o1[r] = 0.f; }
    float carry = 0.f;
    const bf16_t* kbase = Kp + (size_t)(b * SEQ + n) * D + h * HD + hh * 8;
    const bf16_t* vbase = VT + ((size_t)(b * NH + h) * HD + n) * SEQ + 4 * hh;
    bf16x8 kf[4];
#pragma unroll
    for (int kk = 0; kk < 4; ++kk) kf[kk] = *(const bf16x8*)(kbase + (size_t)t0 * D + kk * 16);
    for (int kb = qblk; kb >= 0; --kb) {
        const int j0 = kb * 32;
        s16x4 vf[2][2][2];
#pragma unroll
        for (int mb = 0; mb < 2; ++mb)
#pragma unroll
            for (int s = 0; s < 2; ++s)
#pragma unroll
                for (int hf = 0; hf < 2; ++hf) vf[mb][s][hf] = *(const s16x4*)(vbase + (size_t)mb * 32 * SEQ + j0 + 16 * s + 8 * hf);
        f32x16 sa;
#pragma unroll
        for (int r = 0; r < 16; ++r) sa[r] = 0.f;
#pragma unroll
        for (int kk = 0; kk < 4; ++kk) sa = MFMA32(kf[kk], qf[kk], sa);
        if (kb > 0) {
#pragma unroll
            for (int kk = 0; kk < 4; ++kk) kf[kk] = *(const bf16x8*)(kbase + (size_t)(j0 - 32) * D + kk * 16);
        }
        float lb[16], la[16];
        const bool diag = (kb == qblk);
#pragma unroll
        for (int r = 0; r < 16; ++r) {
            const float z = sa[r];
            const float e = fast_exp2(-fabsf(z));
            const float sp = fmaxf(z, 0.f) + fast_log2(1.0f + e);
            float l = -sp;
            if (diag) { const int ki = (r & 3) + 8 * (r >> 2) + 4 * hh; if (ki >= n) l = 0.f; }
            lb[r] = l; la[r] = z - sp;
        }
        float g[4], pg[4];
#pragma unroll
        for (int q = 0; q < 4; ++q) g[q] = (lb[4 * q] + lb[4 * q + 1]) + (lb[4 * q + 2] + lb[4 * q + 3]);
#pragma unroll
        for (int q = 0; q < 4; ++q) pg[q] = shx(g[q], 32, lane);
        float so = 0.f, sp_e = 0.f;
        float a[16];
#pragma unroll
        for (int q = 3; q >= 0; --q) {
            const float base = carry + so + sp_e + (hh == 0 ? pg[q] : 0.f);
            const float e3 = base, e2 = e3 + lb[4 * q + 3], e1 = e2 + lb[4 * q + 2], e0 = e1 + lb[4 * q + 1];
            a[4 * q + 3] = fast_exp2(la[4 * q + 3] + e3); a[4 * q + 2] = fast_exp2(la[4 * q + 2] + e2);
            a[4 * q + 1] = fast_exp2(la[4 * q + 1] + e1); a[4 * q + 0] = fast_exp2(la[4 * q + 0] + e0);
            so += g[q]; sp_e += pg[q];
        }
        carry += so + sp_e;
        if (diag) {
#pragma unroll
            for (int r = 0; r < 16; ++r) { const int ki = (r & 3) + 8 * (r >> 2) + 4 * hh; if (ki >= n) a[r] = 0.f; }
        }
#pragma unroll
        for (int s = 0; s < 2; ++s) {
            u32x4 pw; pw.x = cvt_pk(a[8 * s + 0], a[8 * s + 1]); pw.y = cvt_pk(a[8 * s + 2], a[8 * s + 3]); pw.z = cvt_pk(a[8 * s + 4], a[8 * s + 5]); pw.w = cvt_pk(a[8 * s + 6], a[8 * s + 7]);
            const bf16x8 pf = __builtin_bit_cast(bf16x8, pw);
            const bf16x8 v0 = __builtin_shufflevector(vf[0][s][0], vf[0][s][1], 0, 1, 2, 3, 4, 5, 6, 7);
            const bf16x8 v1 = __builtin_shufflevector(vf[1][s][0], vf[1][s][1], 0, 1, 2, 3, 4, 5, 6, 7);
            o0 = MFMA32(v0, pf, o0); o1 = MFMA32(v1, pf, o1);
        }
        if (!__any(carry > SB_EXIT)) break;
    }
#pragma unroll
    for (int q = 0; q < 4; ++q) {
        u32x2 w0, w1; w0.x = cvt_pk(o0[4 * q], o0[4 * q + 1]); w0.y = cvt_pk(o0[4 * q + 2], o0[4 * q + 3]); w1.x = cvt_pk(o1[4 * q], o1[4 * q + 1]); w1.y = cvt_pk(o1[4 * q + 2], o1[4 * q + 3]);
        *(u32x2*)(qrow + 8 * q + 4 * hh) = w0; *(u32x2*)(qrow + 32 + 8 * q + 4 * hh) = w1;
    }
}
__device__ __forceinline__ void attn_phase(bf16_t* QO, const bf16_t* Kp, const bf16_t* VT, int gw, int NGW) {
    const int lane = lane_id_opaque();
    constexpr int NQB = SEQ / 32, NTASK = NB * NH * NQB;
    int i = 0;
    for (int tau = gw; tau < NTASK; tau += NGW, ++i) {
        const int bh = tau / NQB, qr = tau % NQB, qblk = (i & 1) ? (NQB - 1 - qr) : qr;
        attn_task(QO, Kp, VT, bh / NH, bh % NH, qblk, lane);
    }
}

constexpr int LDS_BYTES = 131072 + 1024;
__global__ void __launch_bounds__(NTHREADS, 2) fwd_kernel(Params p) {
    extern __shared__ __attribute__((aligned(16))) unsigned char lds_raw[];
    LAS unsigned char* lds = (LAS unsigned char*)lds_raw;
    cg::grid_group grid = cg::this_grid();
#define GRID_SYNC() do { asm volatile("s_waitcnt vmcnt(0)" ::: "memory"); grid.sync(); __builtin_amdgcn_fence(__ATOMIC_ACQUIRE, "agent"); asm volatile("s_waitcnt vmcnt(0)" ::: "memory"); } while (0)
    const int tid0 = threadIdx.x, wave = __builtin_amdgcn_readfirstlane(tid0 >> 6);
    const int G = gridDim.x, bx = blockIdx.x;
    const int gw = bx * NWAVES + wave, NGW = G * NWAVES, NT = G * NTHREADS;
    unsigned char* ws = p.ws;
    float* mod = (float*)(ws + WS_CTL);
    bf16_t* Rh = (bf16_t*)(ws + R_H); bf16_t* Ra = (bf16_t*)(ws + R_A); bf16_t* Rb = (bf16_t*)(ws + R_B); bf16_t* Rc = (bf16_t*)(ws + R_C); bf16_t* Rd = (bf16_t*)(ws + R_D);

    phase0(p, lds, gw, NGW, wave, lane_id_opaque());
    GRID_SYNC();
    {
        const int gt = bx * NTHREADS + wave * 64 + lane_id_opaque();
        for (int it = gt; it < 2 * 4 * 1536; it += NT) {
            const int l = it / 6144, r = it % 6144, b = r / 1536, n4 = r % 1536;
            f32x4 a = *(const f32x4*)(p.in[3] + l * 6144 + n4 * 4);
            const float* mp = (const float*)(ws + R_D) + ((size_t)(l * 32) * 4 + b) * 6144 + n4 * 4;
#pragma unroll 8
            for (int kc = 0; kc < 32; ++kc) a += *(const f32x4*)(mp + (size_t)kc * 4 * 6144);
            *(f32x4*)(mod + (size_t)(l * 4 + b) * 6144 + n4 * 4) = a;
        }
    }
    GRID_SYNC();

#pragma unroll 1
    for (int l = 0; l < DEPTH; ++l) {
        const float* modl = mod + (size_t)l * 4 * 6144;
        const unsigned char* wl = ws + WS_W + (size_t)l * W_LAYER;
        const float* xin = (l == 0) ? p.in[0] : p.out;
        norm_phase(xin, p.in[4] + l * D, modl, 0, 1024, Rh, gw, NGW);
        GRID_SYNC();
        { pg8::SchedPlain S; S.T.init(M, 3072); S.G = G; S.c = bx; S.A = (const char*)Rh; S.B = (const char*)(wl + W_IN) + (size_t)3072 * D * 2; S.tstep = (size_t)256 * D * 2;
          pg8::EpiRegions E{Ra};
          pg8::gemm_phase(lds, D, S, E, wave); }
        GRID_SYNC();
        conv_phase(Ra, Rb, Rc, p.in[8] + (size_t)l * 3 * D, bx * NTHREADS + wave * 64, NT);
        GRID_SYNC();
        { pg8::SchedPlain S; S.T.init(M, 3072); S.G = G; S.c = bx; S.A = (const char*)Rh; S.B = (const char*)(wl + W_IN); S.tstep = (size_t)256 * D * 2;
          pg8::EpiQKV E{Rb, Rc, Rd, p.in[6] + l * HD, p.in[7] + l * HD};
          pg8::gemm_phase(lds, D, S, E, wave); }
        GRID_SYNC();
        attn_phase(Rb, Rc, Rd, gw, NGW);
        GRID_SYNC();
        { pg8::SchedBranch S; S.T.init(M, D); S.G = G; S.c = bx; S.ws = (const char*)ws; S.wl = (const char*)wl; S.tstep = (size_t)256 * D * 2;
          pg8::EpiBranch E{Rd, Rc};
          pg8::gemm_phase(lds, D, S, E, wave); }
        GRID_SYNC();
        { pg8::SchedPlain S; S.T.init(M, D); S.G = G; S.c = bx; S.A = (const char*)Rc; S.B = (const char*)(wl + W_O); S.tstep = (size_t)256 * D * 2;
          pg8::EpiResid E{xin, p.out, modl + 2048};
          pg8::gemm_phase(lds, D, S, E, wave); }
        GRID_SYNC();
        norm_phase(p.out, p.in[12] + l * D, modl, 3072, 4096, Rh, gw, NGW);
        GRID_SYNC();
        { pg8::SchedPlain S; S.T.init(M, 2 * FF); S.G = G; S.c = bx; S.A = (const char*)Rh; S.B = (const char*)(wl + W_GU); S.tstep = (size_t)256 * D * 2;
          pg8::EpiGU E{Ra};
          pg8::gemm_phase(lds, D, S, E, wave); }
        GRID_SYNC();
        { pg8::SchedPlain S; S.T.init(M, D); S.G = G; S.c = bx; S.A = (const char*)Ra; S.B = (const char*)(wl + W_D); S.tstep = (size_t)256 * FF * 2;
          pg8::EpiResid E{p.out, p.out, modl + 5120};
          pg8::gemm_phase(lds, FF, S, E, wave); }
        if (l + 1 < DEPTH) GRID_SYNC();
    }
}

extern "C" void kernel_launch(void* const* d_in, const int* in_sizes, int n_in, void* d_out, int out_size, void* d_ws, size_t ws_size, hipStream_t stream) {
    static int grid_blocks = 0;
    if (grid_blocks == 0) {
        if (n_in != 16 || out_size != M * D || ws_size < WS_END) { fprintf(stderr, "kernel_launch: unexpected shapes (n_in %d out %d ws %zu need %zu)\n", n_in, out_size, ws_size, (size_t)WS_END); grid_blocks = -1; return; }
        int dev = 0, cus = 0, per_cu = 0;
        hipGetDevice(&dev);
        hipDeviceGetAttribute(&cus, hipDeviceAttributeMultiprocessorCount, dev);
        hipFuncSetAttribute((const void*)fwd_kernel, hipFuncAttributeMaxDynamicSharedMemorySize, LDS_BYTES);
        hipOccupancyMaxActiveBlocksPerMultiprocessor(&per_cu, (const void*)fwd_kernel, NTHREADS, LDS_BYTES);
        (void)hipGetLastError();
        if (per_cu < 1) { fprintf(stderr, "kernel_launch: occupancy query says %d blocks per CU\n", per_cu); per_cu = 1; }
        grid_blocks = cus;
    }
    if (grid_blocks < 0) return;
    Params p{};
    for (int i = 0; i < 16; ++i) p.in[i] = (const float*)d_in[i];
    p.out = (float*)d_out; p.ws = (unsigned char*)d_ws;
    void* args[] = {&p};
    hipError_t e = hipLaunchCooperativeKernel((const void*)fwd_kernel, dim3(grid_blocks), dim3(NTHREADS), args, LDS_BYTES, stream);
    if (e != hipSuccess) fprintf(stderr, "cooperative launch failed: %s (grid %d)\n", hipGetErrorString(e), grid_blocks);
}
```

```cpp
#include <hip/hip_runtime.h>
#include <hip/hip_cooperative_groups.h>
#include <cstdio>
#include <cstdint>
namespace cg = cooperative_groups;
#ifndef PROBE_SYNCS
#define PROBE_SYNCS 0
#endif
#ifndef PROBE_NOEXIT
#define PROBE_NOEXIT 0
#endif
#ifndef PROBE_DUPGEMM
#define PROBE_DUPGEMM 0
#endif

#define LAS __attribute__((address_space(3)))
typedef unsigned short bf16_t;
typedef short bf16x8 __attribute__((ext_vector_type(8)));
typedef short s16x4 __attribute__((ext_vector_type(4)));
typedef float f32x4 __attribute__((ext_vector_type(4)));
typedef float f32x16 __attribute__((ext_vector_type(16)));
typedef unsigned u32x4 __attribute__((ext_vector_type(4)));
typedef unsigned u32x2 __attribute__((ext_vector_type(2)));
typedef float f32x2_t __attribute__((ext_vector_type(2)));
typedef __bf16 bf16x2_t __attribute__((ext_vector_type(2)));

constexpr int D = 1024, NB = 4, SEQ = 4096, M = NB * SEQ, NH = 16, HD = 64, FF = 2816, INW = 8192, DEPTH = 2;
constexpr float EPS = 1e-6f;
constexpr float LOG2E = 1.4426950408889634f;
constexpr float C2 = 0.125f * LOG2E;
constexpr int NWAVES = 8, NTHREADS = 512;

constexpr size_t MiB = 1u << 20;
constexpr size_t WS_CTL = 0, CTL_BYTES = 256 * 1024;
constexpr size_t WS_W = 1 * MiB;
constexpr size_t W_IN = 0, W_A = 16 * MiB, W_B = 18 * MiB, W_O = 20 * MiB, W_GU = 22 * MiB, W_D = 33 * MiB, W_LAYER = 38 * MiB + 512 * 1024;
constexpr size_t WS_ACT = 78 * MiB;
constexpr size_t REG = 32 * MiB;
constexpr size_t R_H = WS_ACT, R_A = WS_ACT + REG, R_B = WS_ACT + 2 * REG, R_C = WS_ACT + 3 * REG, R_D = WS_ACT + 4 * REG, WS_END = WS_ACT + 5 * REG;
static_assert(WS_W + 2 * W_LAYER <= WS_ACT, "weights");
static_assert((size_t)M * FF * 2 <= 3 * REG, "ffn hidden fits R_A..R_C");

__device__ __forceinline__ unsigned cvt_pk(float lo, float hi) { f32x2_t v = {lo, hi}; bf16x2_t b = __builtin_convertvector(v, bf16x2_t); return __builtin_bit_cast(unsigned, b); }
__device__ __forceinline__ float bf_lo(unsigned u) { return __uint_as_float(u << 16); }
__device__ __forceinline__ float bf_hi(unsigned u) { return __uint_as_float(u & 0xffff0000u); }
__device__ __forceinline__ float shx(float v, int o, int lane) { return __int_as_float(__builtin_amdgcn_ds_bpermute((lane ^ o) << 2, __float_as_int(v))); }
__device__ __forceinline__ float wave_sum(float v, int lane) {
#pragma unroll
    for (int o = 1; o < 64; o <<= 1) v += shx(v, o, lane);
    return v;
}
__device__ __forceinline__ int lane_id_opaque() { int l; asm volatile("v_mbcnt_lo_u32_b32 %0, -1, 0\n\tv_mbcnt_hi_u32_b32 %0, -1, %0" : "=v"(l)); return l; }
__device__ __forceinline__ float fast_exp2(float x) { return __builtin_amdgcn_exp2f(x); }
__device__ __forceinline__ float fast_log2(float x) { return __builtin_amdgcn_logf(x); }
__device__ __forceinline__ float fast_rcp(float x) { return __builtin_amdgcn_rcpf(x); }
__device__ __forceinline__ float sigmoidf_(float x) { return fast_rcp(1.0f + fast_exp2(-x * LOG2E)); }

namespace pg8 {
constexpr int BM = 256, BK = 64, HALF = 128, HTB = HALF * BK * 2, STAGE_BYTES = 8 * HTB, NXCD = 8, WGM = 8;
__host__ __device__ __forceinline__ int lds_byte(int r, int c) { const int st = (r >> 4) * 2 + (c >> 5), rr = r & 15, cc = c & 31, ob = rr * 64 + cc * 2; return st * 1024 + (ob ^ (((ob >> 9) & 1) << 5)); }
__host__ __device__ __forceinline__ void stage_rc(int b, int& R, int& C) { const int st = b / 1024, sb = b % 1024, swz = sb ^ (((sb >> 9) & 1) << 5); R = (st >> 1) * 16 + swz / 64; C = (st & 1) * 32 + (swz % 64) / 2; }

struct Unit { const char* A; const char* B; int pm, pn, kind; };

struct TileOrder {
    int nM, nN, nwg;
    __device__ __forceinline__ void init(int Mr, int N) { nM = Mr / BM; nN = N / BM; nwg = nM * nN; }
    __device__ __forceinline__ void map(int wgid, int& pm, int& pn) const {
        { const int q = nwg / NXCD, r = nwg % NXCD, xcd = wgid % NXCD, off = wgid / NXCD; wgid = (xcd < r ? xcd * (q + 1) : r * (q + 1) + (xcd - r) * q) + off; }
        const int nig = WGM * nN, gid = wgid / nig, fm = gid * WGM, gsz = (nM - fm) < WGM ? (nM - fm) : WGM;
        pm = fm + ((wgid % nig) % gsz); pn = (wgid % nig) / gsz;
    }
};
struct SchedPlain {
    TileOrder T; int G, c; const char* A; const char* B; size_t tstep;
    __device__ __forceinline__ bool next(int i, Unit& u) const {
        const long L = (long)i * G + c; if (L >= T.nwg) return false;
        T.map((int)L, u.pm, u.pn); u.A = A + (size_t)u.pm * tstep; u.B = B + (size_t)u.pn * tstep; u.kind = 0; return true;
    }
};
struct SchedBranch {
    TileOrder T; int G, c; const char* ws; const char* wl; size_t tstep;
    __device__ __forceinline__ bool next(int i, Unit& u) const {
        const long L = (long)(i >> 2) * G + c; if (L >= T.nwg) return false;
        T.map((int)L, u.pm, u.pn); const int sub = i & 3; u.kind = sub;
        const size_t oa = (sub == 1) ? R_B : ((sub == 3) ? R_A : R_H);
        const size_t ob = (sub == 0) ? (W_IN + (size_t)6144 * D * 2) : (sub == 1) ? W_A : (sub == 2) ? (W_IN + (size_t)7168 * D * 2) : W_B;
        u.A = ws + oa + (size_t)u.pm * tstep; u.B = wl + ob + (size_t)u.pn * tstep; return true;
    }
};

template <class Epi, class Sched>
__device__ __forceinline__ void gemm_phase(LAS unsigned char* lds, const int K, const Sched& S, const Epi& E, const int wid) {
    const int lane = lane_id_opaque(), tid = wid * 64 + lane, wr = wid >> 2, wc = wid & 3, fr = lane & 15, fq = lane >> 4;
    const int nt = K / BK;
    unsigned voff[2];
#pragma unroll
    for (int i = 0; i < 2; ++i) { int R, C; stage_rc(tid * 16 + i * 8192, R, C); voff[i] = (unsigned)(R * K + C) * 2u; }
    const size_t kstep = (size_t)(BK * 2);
    const size_t hstep = (size_t)HALF * K * 2;
    const unsigned ldsw = (unsigned)wid * 1024u;
    const int aoff = lds_byte(wr * 64 + fr, fq * 8), boff = lds_byte(wc * 32 + fr, fq * 8);
#define PG8_SA(b, h) (((b) * 2 + (h)) * HTB)
#define PG8_SB(b, h) ((4 + (b) * 2 + (h)) * HTB)
#define PG8_STAGE(bufoff, gbase) do { _Pragma("unroll") for (int _i = 0; _i < 2; ++_i) \
        __builtin_amdgcn_global_load_lds((const unsigned*)((const char*)(gbase) + voff[_i]), (LAS unsigned*)(lds + (bufoff) + ldsw + _i * 8192), 16, 0, 0); } while (0)
#define PG8_LDA(dst, b, h) do { _Pragma("unroll") for (int m = 0; m < 4; ++m) _Pragma("unroll") for (int k = 0; k < 2; ++k) dst[m][k] = *(const LAS bf16x8*)(lds + PG8_SA(b, h) + aoff + m * 2048 + k * 1024); } while (0)
#define PG8_LDB(dst, b, h) do { _Pragma("unroll") for (int n = 0; n < 2; ++n) _Pragma("unroll") for (int k = 0; k < 2; ++k) dst[n][k] = *(const LAS bf16x8*)(lds + PG8_SB(b, h) + boff + n * 2048 + k * 1024); } while (0)
#define PG8_MMA(ai, bj, At, Bt) do { __builtin_amdgcn_s_setprio(1); _Pragma("unroll") for (int m = 0; m < 4; ++m) _Pragma("unroll") for (int n = 0; n < 2; ++n) _Pragma("unroll") for (int k = 0; k < 2; ++k) \
        acc[ai][bj][m][n] = __builtin_amdgcn_mfma_f32_16x16x32_bf16(Bt[n][k], At[m][k], acc[ai][bj][m][n], 0, 0, 0); __builtin_amdgcn_s_setprio(0); } while (0)
#define PG8_WAIT_V(n) asm volatile("s_waitcnt vmcnt(" #n ")" ::: "memory")
#define PG8_WAIT_L(n) asm volatile("s_waitcnt lgkmcnt(" #n ")" ::: "memory")
#define PG8_BAR __builtin_amdgcn_s_barrier()
#define PG8_SCHED __builtin_amdgcn_sched_barrier(0)
    Unit cur, nxt; int ui = 0;
    if (!S.next(0, cur)) return;
    f32x4 acc[2][2][4][2];
#pragma unroll
    for (int a = 0; a < 2; ++a)
#pragma unroll
        for (int b = 0; b < 2; ++b)
#pragma unroll
            for (int m = 0; m < 4; ++m)
#pragma unroll
                for (int n = 0; n < 2; ++n) acc[a][b][m][n] = (f32x4){0.f, 0.f, 0.f, 0.f};
    bf16x8 At[4][2], B0[2][2], B1[2][2];
    const char* cA = cur.A; const char* cB = cur.B;
    PG8_STAGE(PG8_SB(0, 0), cB); PG8_STAGE(PG8_SB(0, 1), cB + hstep); PG8_STAGE(PG8_SA(0, 0), cA); PG8_STAGE(PG8_SA(0, 1), cA + hstep);
    if (wr == 1) PG8_BAR;
    PG8_WAIT_V(2); PG8_BAR;
    PG8_STAGE(PG8_SB(1, 0), cB + kstep); PG8_STAGE(PG8_SA(1, 0), cA + kstep); PG8_STAGE(PG8_SB(1, 1), cB + hstep + kstep);
    PG8_WAIT_V(6); PG8_BAR;
    for (;;) {
        const bool has_next = S.next(ui + 1, nxt);
        const char* nA = has_next ? nxt.A : cA; const char* nB = has_next ? nxt.B : cB;
        for (int t = 0; t < nt; t += 2) {
            const bool last = (t == nt - 2);
            const char* a1 = cA + (size_t)(t + 1) * kstep;
            const char* a2 = last ? nA : cA + (size_t)(t + 2) * kstep; const char* b2 = last ? nB : cB + (size_t)(t + 2) * kstep;
            const char* a3 = a2 + kstep; const char* b3 = b2 + kstep;
            PG8_LDB(B0, 0, 0); PG8_LDB(B1, 0, 1); PG8_SCHED; PG8_LDA(At, 0, 0); PG8_STAGE(PG8_SA(1, 1), a1 + hstep);
            PG8_WAIT_V(8); PG8_WAIT_L(0); PG8_BAR; PG8_MMA(0, 0, At, B0); PG8_MMA(0, 1, At, B1); PG8_BAR; PG8_SCHED;
            PG8_LDA(At, 0, 1); PG8_STAGE(PG8_SB(0, 0), b2); PG8_STAGE(PG8_SB(0, 1), b2 + hstep); PG8_STAGE(PG8_SA(0, 0), a2);
            PG8_WAIT_V(8); PG8_WAIT_L(0); PG8_BAR; PG8_MMA(1, 0, At, B0); PG8_MMA(1, 1, At, B1); PG8_BAR; PG8_SCHED;
            PG8_LDB(B0, 1, 0); PG8_LDB(B1, 1, 1); PG8_SCHED; PG8_LDA(At, 1, 0); PG8_STAGE(PG8_SA(0, 1), a2 + hstep);
            PG8_WAIT_V(8); PG8_WAIT_L(0); PG8_BAR; PG8_MMA(0, 0, At, B0); PG8_MMA(0, 1, At, B1); PG8_BAR; PG8_SCHED;
            PG8_LDA(At, 1, 1); PG8_STAGE(PG8_SB(1, 0), b3); PG8_STAGE(PG8_SB(1, 1), b3 + hstep); PG8_STAGE(PG8_SA(1, 0), a3);
            PG8_WAIT_V(8); PG8_WAIT_L(0); PG8_BAR; PG8_MMA(1, 0, At, B0); PG8_MMA(1, 1, At, B1); PG8_BAR; PG8_SCHED;
        }
        if (wr == 0) PG8_BAR;
        { const int l2 = lane_id_opaque(); E(acc, cur, wr, wc, l2 & 15, l2 >> 4); }
        if (!has_next) break;
#pragma unroll
        for (int a = 0; a < 2; ++a)
#pragma unroll
            for (int b = 0; b < 2; ++b)
#pragma unroll
                for (int m = 0; m < 4; ++m)
#pragma unroll
                    for (int n = 0; n < 2; ++n) acc[a][b][m][n] = (f32x4){0.f, 0.f, 0.f, 0.f};
        cur = nxt; cA = nA; cB = nB; ++ui;
        if (wr == 1) PG8_BAR;
    }
    PG8_WAIT_V(0);
    PG8_BAR;
#undef PG8_SA
#undef PG8_SB
#undef PG8_STAGE
#undef PG8_LDA
#undef PG8_LDB
#undef PG8_MMA
#undef PG8_WAIT_V
#undef PG8_WAIT_L
#undef PG8_BAR
#undef PG8_SCHED
}

__device__ __forceinline__ u32x4 pack8(const f32x4& a, const f32x4& b) { u32x4 w; w.x = cvt_pk(a[0], a[1]); w.y = cvt_pk(a[2], a[3]); w.z = cvt_pk(b[0], b[1]); w.w = cvt_pk(b[2], b[3]); return w; }

struct EpiRegions {
    bf16_t* base;
    __device__ __forceinline__ void operator()(const f32x4 (&acc)[2][2][4][2], const Unit& u, int wr, int wc, int fr, int fq) const {
        bf16_t* dst = base + (size_t)(u.pn >> 2) * ((size_t)M * D);
        const int col = (u.pn & 3) * 256 + wc * 64 + fq * 8, row0 = u.pm * BM + wr * 64 + fr;
#pragma unroll
        for (int ai = 0; ai < 2; ++ai)
#pragma unroll
            for (int m = 0; m < 4; ++m) { bf16_t* rp = dst + (size_t)(row0 + ai * HALF + m * 16) * D + col;
#pragma unroll
                for (int bj = 0; bj < 2; ++bj) *(u32x4*)(rp + bj * 32) = pack8(acc[ai][bj][m][0], acc[ai][bj][m][1]); }
    }
};
struct EpiQKV {
    bf16_t* q; bf16_t* k; bf16_t* vt; const float* gq; const float* gk;
    __device__ __forceinline__ void operator()(const f32x4 (&acc)[2][2][4][2], const Unit& u, int wr, int wc, int fr, int fq) const {
        const int region = u.pn >> 2, head = (u.pn & 3) * 4 + wc, row0 = u.pm * BM + wr * 64 + fr;
        if (region == 2) {
            const int b = row0 >> 12;
            bf16_t* vb = vt + ((size_t)(b * NH + head) * HD) * SEQ;
#pragma unroll
            for (int ai = 0; ai < 2; ++ai)
#pragma unroll
                for (int m = 0; m < 4; ++m) { const int s = (row0 + ai * HALF + m * 16) & (SEQ - 1);
#pragma unroll
                    for (int bj = 0; bj < 2; ++bj)
#pragma unroll
                        for (int n = 0; n < 2; ++n)
#pragma unroll
                            for (int j = 0; j < 4; ++j) { const int d = bj * 32 + fq * 8 + n * 4 + j; const unsigned w = cvt_pk(acc[ai][bj][m][n][j], 0.f);
                                vb[(size_t)d * SEQ + s] = (bf16_t)(w & 0xffffu); } }
        } else {
            const float* g = region == 0 ? gq : gk; const float sc = region == 0 ? C2 : 1.0f;
            bf16_t* dst = region == 0 ? q : k;
            f32x4 gv[2][2];
#pragma unroll
            for (int bj = 0; bj < 2; ++bj)
#pragma unroll
                for (int n = 0; n < 2; ++n) gv[bj][n] = *(const f32x4*)(g + bj * 32 + fq * 8 + n * 4) * sc;
            const int col = head * 64 + fq * 8;
#pragma unroll
            for (int ai = 0; ai < 2; ++ai)
#pragma unroll
                for (int m = 0; m < 4; ++m) {
                    float ss = 0.f;
#pragma unroll
                    for (int bj = 0; bj < 2; ++bj)
#pragma unroll
                        for (int n = 0; n < 2; ++n) { const f32x4 x = acc[ai][bj][m][n]; ss += (x[0] * x[0] + x[1] * x[1]) + (x[2] * x[2] + x[3] * x[3]); }
                    ss += shx(ss, 16, fr + 16 * fq); ss += shx(ss, 32, fr + 16 * fq);
                    const float r = 1.0f / sqrtf(ss * (1.0f / 64.0f) + EPS);
                    bf16_t* rp = dst + (size_t)(row0 + ai * HALF + m * 16) * D + col;
#pragma unroll
                    for (int bj = 0; bj < 2; ++bj) { const f32x4 a = acc[ai][bj][m][0] * r * gv[bj][0], b2 = acc[ai][bj][m][1] * r * gv[bj][1]; *(u32x4*)(rp + bj * 32) = pack8(a, b2); }
                }
        }
    }
};
struct EpiBranch {
    bf16_t* S1; bf16_t* TM;
    __device__ __forceinline__ void operator()(const f32x4 (&acc)[2][2][4][2], const Unit& u, int wr, int wc, int fr, int fq) const {
        const int col = u.pn * 256 + wc * 64 + fq * 8, row0 = u.pm * BM + wr * 64 + fr, kind = u.kind;
#pragma unroll
        for (int ai = 0; ai < 2; ++ai)
#pragma unroll
            for (int m = 0; m < 4; ++m) { const size_t off = (size_t)(row0 + ai * HALF + m * 16) * D + col;
#pragma unroll
                for (int bj = 0; bj < 2; ++bj) {
                    f32x4 a = acc[ai][bj][m][0], b = acc[ai][bj][m][1];
                    if (kind == 0 || kind == 2) {
#pragma unroll
                        for (int j = 0; j < 4; ++j) { a[j] = sigmoidf_(a[j]); b[j] = sigmoidf_(b[j]); }
                        *(u32x4*)(S1 + off + bj * 32) = pack8(a, b);
                    } else {
                        const u32x4 g = *(const u32x4*)(S1 + off + bj * 32);
                        a[0] *= bf_lo(g.x); a[1] *= bf_hi(g.x); a[2] *= bf_lo(g.y); a[3] *= bf_hi(g.y);
                        b[0] *= bf_lo(g.z); b[1] *= bf_hi(g.z); b[2] *= bf_lo(g.w); b[3] *= bf_hi(g.w);
                        if (kind == 3) { const u32x4 t = *(const u32x4*)(TM + off + bj * 32);
                            a[0] += bf_lo(t.x); a[1] += bf_hi(t.x); a[2] += bf_lo(t.y); a[3] += bf_hi(t.y);
                            b[0] += bf_lo(t.z); b[1] += bf_hi(t.z); b[2] += bf_lo(t.w); b[3] += bf_hi(t.w); }
                        *(u32x4*)(TM + off + bj * 32) = pack8(a, b);
                    }
                } }
    }
};
struct EpiResid {
    const float* xin; float* xout; const float* gmod;
    __device__ __forceinline__ void operator()(const f32x4 (&acc)[2][2][4][2], const Unit& u, int wr, int wc, int fr, int fq) const {
        const int col = u.pn * 256 + wc * 64 + fq * 8, row0 = u.pm * BM + wr * 64 + fr, b = row0 >> 12;
        f32x4 gv[2][2];
#pragma unroll
        for (int bj = 0; bj < 2; ++bj)
#pragma unroll
            for (int n = 0; n < 2; ++n) gv[bj][n] = *(const f32x4*)(gmod + b * 6144 + col + bj * 32 + n * 4);
#pragma unroll
        for (int ai = 0; ai < 2; ++ai)
#pragma unroll
            for (int m = 0; m < 4; ++m) { const size_t off = (size_t)(row0 + ai * HALF + m * 16) * D + col;
#pragma unroll
                for (int bj = 0; bj < 2; ++bj)
#pragma unroll
                    for (int n = 0; n < 2; ++n) { const f32x4 xo = *(const f32x4*)(xin + off + bj * 32 + n * 4); *(f32x4*)(xout + off + bj * 32 + n * 4) = xo + gv[bj][n] * acc[ai][bj][m][n]; } }
    }
};
struct EpiGU {
    bf16_t* f;
    __device__ __forceinline__ void operator()(const f32x4 (&acc)[2][2][4][2], const Unit& u, int wr, int wc, int fr, int fq) const {
        const int col = u.pn * 128 + wc * 32 + fq * 8, row0 = u.pm * BM + wr * 64 + fr;
#pragma unroll
        for (int ai = 0; ai < 2; ++ai)
#pragma unroll
            for (int m = 0; m < 4; ++m) {
                f32x4 o[2];
#pragma unroll
                for (int n = 0; n < 2; ++n)
#pragma unroll
                    for (int j = 0; j < 4; ++j) { const float gt = acc[ai][0][m][n][j]; o[n][j] = gt * sigmoidf_(gt) * acc[ai][1][m][n][j]; }
                *(u32x4*)(f + (size_t)(row0 + ai * HALF + m * 16) * FF + col) = pack8(o[0], o[1]);
            }
    }
};
}

#define LDS_WAIT() asm volatile("s_waitcnt lgkmcnt(0)" ::: "memory")
__device__ __forceinline__ void transpose_item(const float* W, int N, int K, int n0, bf16_t* WT, int a0, int k0, LAS float* scr, int lane) {
#pragma unroll 8
    for (int i = 0; i < 32; ++i) { const int kk = 2 * i + (lane >> 5); scr[kk * 33 + (lane & 31)] = W[(size_t)(k0 + kk) * N + n0 + (lane & 31)]; }
    LDS_WAIT(); asm volatile("" ::: "memory");
    const int c = lane & 7;
#pragma unroll
    for (int j = 0; j < 4; ++j) { const int s = (lane >> 3) + 8 * j; const int lo = 8 * ((s >> 2) & 3) + 4 * (s >> 4) + (s & 3);
        const LAS float* sp = scr + (8 * c) * 33 + lo;
        u32x4 o; o.x = cvt_pk(sp[0 * 33], sp[1 * 33]); o.y = cvt_pk(sp[2 * 33], sp[3 * 33]); o.z = cvt_pk(sp[4 * 33], sp[5 * 33]); o.w = cvt_pk(sp[6 * 33], sp[7 * 33]);
        *(u32x4*)(WT + (size_t)(a0 + s) * K + k0 + 8 * c) = o; }
    LDS_WAIT(); asm volatile("" ::: "memory");
}

struct Params { const float* in[16]; float* out; unsigned char* ws; };

__device__ __forceinline__ void phase0(const Params& p, LAS unsigned char* lds, int gw, int NGW, int wave, int lane) {
    LAS float* scr = (LAS float*)(lds + wave * 16384);
    constexpr int I_IN = 256 * 16, I_SQ = 32 * 16, I_GU = 176 * 16, I_D = 32 * 44, I_LAYER = I_IN + 3 * I_SQ + I_GU + I_D;
    constexpr int I_MOD = 2 * 32 * 24;
    for (int it = gw; it < I_MOD; it += NGW) {
        const int l = it / (32 * 24), r = it % (32 * 24), kc = r / 24, nb = r % 24;
        const float* aw = p.in[2] + (size_t)l * D * 6144 + (size_t)(kc * 32) * 6144 + nb * 256 + lane * 4;
        const float* c = p.in[1];
        f32x4 a[4];
#pragma unroll
        for (int b = 0; b < 4; ++b) a[b] = (f32x4){0.f, 0.f, 0.f, 0.f};
#pragma unroll 8
        for (int k = 0; k < 32; ++k) { const f32x4 w = *(const f32x4*)(aw + (size_t)k * 6144);
#pragma unroll
            for (int b = 0; b < 4; ++b) { const float cv = c[b * D + kc * 32 + k]; const float sv = cv * sigmoidf_(cv); a[b] += w * sv; } }
        float* mp = (float*)(p.ws + R_D) + ((size_t)(l * 32 + kc) * 4) * 6144 + nb * 256 + lane * 4;
#pragma unroll
        for (int b = 0; b < 4; ++b) *(f32x4*)(mp + (size_t)b * 6144) = a[b];
    }
    for (int it = gw; it < DEPTH * I_LAYER; it += NGW) {
        const int l = it / I_LAYER; int r = it % I_LAYER;
        unsigned char* wl = p.ws + WS_W + (size_t)l * W_LAYER;
        if (r < I_IN) { const int kb = r / 256, g = r % 256; const int pn = g >> 3, bj = (g >> 2) & 1, wc = g & 3;
            transpose_item(p.in[5] + (size_t)l * D * INW, INW, D, 256 * pn + 64 * wc + 32 * bj, (bf16_t*)(wl + W_IN), 32 * g, 64 * kb, scr, lane); continue; }
        r -= I_IN;
        if (r < 3 * I_SQ) { const int which = r / I_SQ; r %= I_SQ; const int kb = r / 32, g = r % 32; const int pn = g >> 3, bj = (g >> 2) & 1, wc = g & 3;
            const float* src = p.in[9 + which] + (size_t)l * D * D; bf16_t* dst = (bf16_t*)(wl + (which == 0 ? W_A : which == 1 ? W_B : W_O));
            transpose_item(src, D, D, 256 * pn + 64 * wc + 32 * bj, dst, 32 * g, 64 * kb, scr, lane); continue; }
        r -= 3 * I_SQ;
        if (r < I_GU) { const int kb = r / 176, g = r % 176; const int pn = g >> 3, bj = (g >> 2) & 1, wc = g & 3;
            const float* src = p.in[bj ? 14 : 13] + (size_t)l * D * FF;
            transpose_item(src, FF, D, 128 * pn + 32 * wc, (bf16_t*)(wl + W_GU), 32 * g, 64 * kb, scr, lane); continue; }
        r -= I_GU;
        { const int kb = r / 32, g = r % 32; const int pn = g >> 3, bj = (g >> 2) & 1, wc = g & 3;
            transpose_item(p.in[15] + (size_t)l * FF * D, D, FF, 256 * pn + 64 * wc + 32 * bj, (bf16_t*)(wl + W_D), 32 * g, 64 * kb, scr, lane); }
    }
}

__device__ __forceinline__ void norm_phase(const float* x, const float* g, const float* modl, int sh_off, int sc_off, bf16_t* h, int gw, int NGW) {
    const int lane = lane_id_opaque();
    for (int m = gw; m < M; m += NGW) {
        const int b = m >> 12;
        const f32x4* xr = (const f32x4*)(x + (size_t)m * D) + lane;
        f32x4 v[4]; float s = 0.f;
#pragma unroll
        for (int j = 0; j < 4; ++j) { v[j] = xr[64 * j]; s += (v[j][0] * v[j][0] + v[j][1] * v[j][1]) + (v[j][2] * v[j][2] + v[j][3] * v[j][3]); }
        const float r = 1.0f / sqrtf(wave_sum(s, lane) * (1.0f / D) + EPS);
        u32x2* o8 = (u32x2*)(h + (size_t)m * D) + lane;
#pragma unroll
        for (int j = 0; j < 4; ++j) { const int col = 4 * (64 * j + lane);
            const f32x4 gg = *(const f32x4*)(g + col), sc = *(const f32x4*)(modl + b * 6144 + sc_off + col), sh = *(const f32x4*)(modl + b * 6144 + sh_off + col);
            const f32x4 y = (v[j] * r * gg) * (sc + 1.0f) + sh;
            u32x2 w; w.x = cvt_pk(y[0], y[1]); w.y = cvt_pk(y[2], y[3]); o8[64 * j] = w; }
    }
}

__device__ __forceinline__ void conv_phase(bf16_t* cb, const bf16_t* cc, const bf16_t* cx, const float* cw, int gt0, int NT) {
    const int gt = gt0 + lane_id_opaque();
    for (int it = gt; it < (M / 16) * (D / 8); it += NT) {
        const int c8 = it & 127, run = it >> 7, t0 = run * 16, ch = c8 * 8;
        float w0[8], w1[8], w2[8];
#pragma unroll
        for (int i = 0; i < 8; ++i) { w0[i] = cw[ch + i]; w1[i] = cw[D + ch + i]; w2[i] = cw[2 * D + ch + i]; }
        float um2[8], um1[8];
#pragma unroll
        for (int i = 0; i < 8; ++i) { um2[i] = 0.f; um1[i] = 0.f; }
        if ((t0 & (SEQ - 1)) != 0) {
            const u32x4 a2 = *(const u32x4*)(cc + (size_t)(t0 - 2) * D + ch), b2 = *(const u32x4*)(cx + (size_t)(t0 - 2) * D + ch);
            const u32x4 a1 = *(const u32x4*)(cc + (size_t)(t0 - 1) * D + ch), b1 = *(const u32x4*)(cx + (size_t)(t0 - 1) * D + ch);
#pragma unroll
            for (int i = 0; i < 4; ++i) { um2[2 * i] = bf_lo(a2[i]) * bf_lo(b2[i]); um2[2 * i + 1] = bf_hi(a2[i]) * bf_hi(b2[i]);
                um1[2 * i] = bf_lo(a1[i]) * bf_lo(b1[i]); um1[2 * i + 1] = bf_hi(a1[i]) * bf_hi(b1[i]); }
        }
#pragma unroll 4
        for (int t = 0; t < 16; ++t) {
            const size_t off = (size_t)(t0 + t) * D + ch;
            const u32x4 a = *(const u32x4*)(cc + off), b = *(const u32x4*)(cx + off), e = *(const u32x4*)(cb + off);
            float u[8], y[8];
#pragma unroll
            for (int i = 0; i < 4; ++i) { u[2 * i] = bf_lo(a[i]) * bf_lo(b[i]); u[2 * i + 1] = bf_hi(a[i]) * bf_hi(b[i]); }
#pragma unroll
            for (int i = 0; i < 4; ++i) {
                y[2 * i] = bf_lo(e[i]) * (w0[2 * i] * um2[2 * i] + w1[2 * i] * um1[2 * i] + w2[2 * i] * u[2 * i]);
                y[2 * i + 1] = bf_hi(e[i]) * (w0[2 * i + 1] * um2[2 * i + 1] + w1[2 * i + 1] * um1[2 * i + 1] + w2[2 * i + 1] * u[2 * i + 1]); }
            u32x4 o; o.x = cvt_pk(y[0], y[1]); o.y = cvt_pk(y[2], y[3]); o.z = cvt_pk(y[4], y[5]); o.w = cvt_pk(y[6], y[7]);
            *(u32x4*)(cb + off) = o;
#pragma unroll
            for (int i = 0; i < 8; ++i) { um2[i] = um1[i]; um1[i] = u[i]; }
        }
    }
}

#define MFMA32(a, b, c) __builtin_amdgcn_mfma_f32_32x32x16_bf16((a), (b), (c), 0, 0, 0)
constexpr float SB_EXIT = PROBE_NOEXIT ? -3.0e38f : -200.0f;
__device__ __forceinline__ void attn_task(bf16_t* QO, const bf16_t* Kp, const bf16_t* VT, int b, int h, int qblk, int lane) {
    const int n = lane & 31, hh = lane >> 5, t0 = qblk * 32;
    bf16_t* qrow = QO + (size_t)(b * SEQ + t0 + n) * D + h * HD;
    bf16x8 qf[4];
#pragma unroll
    for (int kk = 0; kk < 4; ++kk) qf[kk] = *(const bf16x8*)(qrow + kk * 16 + hh * 8);
    f32x16 o0, o1;
#pragma unroll
    for (int r = 0; r < 16; ++r) { o0[r] = 0.f; o1[r] = 0.f; }
    float carry = 0.f;
    const bf16_t* kbase = Kp + (size_t)(b * SEQ + n) * D + h * HD + hh * 8;
    const bf16_t* vbase = VT + ((size_t)(b * NH + h) * HD + n) * SEQ + 4 * hh;
    bf16x8 kf[4];
#pragma unroll
    for (int kk = 0; kk < 4; ++kk) kf[kk] = *(const bf16x8*)(kbase + (size_t)t0 * D + kk * 16);
    for (int kb = qblk; kb >= 0; --kb) {
        const int j0 = kb * 32;
        s16x4 vf[2][2][2];
#pragma unroll
        for (int mb = 0; mb < 2; ++mb)
#pragma unroll
            for (int s = 0; s < 2; ++s)
#pragma unroll
                for (int hf = 0; hf < 2; ++hf) vf[mb][s][hf] = *(const s16x4*)(vbase + (size_t)mb * 32 * SEQ + j0 + 16 * s + 8 * hf);
        f32x16 sa;
#pragma unroll
        for (int r = 0; r < 16; ++r) sa[r] = 0.f;
#pragma unroll
        for (int kk = 0; kk < 4; ++kk) sa = MFMA32(kf[kk], qf[kk], sa);
        if (kb > 0) {
#pragma unroll
            for (int kk = 0; kk < 4; ++kk) kf[kk] = *(const bf16x8*)(kbase + (size_t)(j0 - 32) * D + kk * 16);
        }
        float lb[16], la[16];
        const bool diag = (kb == qblk);
#pragma unroll
        for (int r = 0; r < 16; ++r) {
            const float z = sa[r];
            const float e = fast_exp2(-fabsf(z));
            const float sp = fmaxf(z, 0.f) + fast_log2(1.0f + e);
            float l = -sp;
            if (diag) { const int ki = (r & 3) + 8 * (r >> 2) + 4 * hh; if (ki >= n) l = 0.f; }
            lb[r] = l; la[r] = z - sp;
        }
        float g[4], pg[4];
#pragma unroll
        for (int q = 0; q < 4; ++q) g[q] = (lb[4 * q] + lb[4 * q + 1]) + (lb[4 * q + 2] + lb[4 * q + 3]);
#pragma unroll
        for (int q = 0; q < 4; ++q) pg[q] = shx(g[q], 32, lane);
        float so = 0.f, sp_e = 0.f;
        float a[16];
#pragma unroll
        for (int q = 3; q >= 0; --q) {
            const float base = carry + so + sp_e + (hh == 0 ? pg[q] : 0.f);
            const float e3 = base, e2 = e3 + lb[4 * q + 3], e1 = e2 + lb[4 * q + 2], e0 = e1 + lb[4 * q + 1];
            a[4 * q + 3] = fast_exp2(la[4 * q + 3] + e3); a[4 * q + 2] = fast_exp2(la[4 * q + 2] + e2);
            a[4 * q + 1] = fast_exp2(la[4 * q + 1] + e1); a[4 * q + 0] = fast_exp2(la[4 * q + 0] + e0);
            so += g[q]; sp_e += pg[q];
        }
        carry += so + sp_e;
        if (diag) {
#pragma unroll
            for (int r = 0; r < 16; ++r) { const int ki = (r & 3) + 8 * (r >> 2) + 4 * hh; if (ki >= n) a[r] = 0.f; }
        }
#pragma unroll
        for (int s = 0; s < 2; ++s) {
            u32x4 pw; pw.x = cvt_pk(a[8 * s + 0], a[8 * s + 1]); pw.y = cvt_pk(a[8 * s + 2], a[8 * s + 3]); pw.z = cvt_pk(a[8 * s + 4], a[8 * s + 5]); pw.w = cvt_pk(a[8 * s + 6], a[8 * s + 7]);
            const bf16x8 pf = __builtin_bit_cast(bf16x8, pw);
            const bf16x8 v0 = __builtin_shufflevector(vf[0][s][0], vf[0][s][1], 0, 1, 2, 3, 4, 5, 6, 7);
            const bf16x8 v1 = __builtin_shufflevector(vf[1][s][0], vf[1][s][1], 0, 1, 2, 3, 4, 5, 6, 7);
            o0 = MFMA32(v0, pf, o0); o1 = MFMA32(v1, pf, o1);
        }
        if (!__any(carry > SB_EXIT)) break;
    }
#pragma unroll
    for (int q = 0; q < 4; ++q) {
        u32x2 w0, w1; w0.x = cvt_pk(o0[4 * q], o0[4 * q + 1]); w0.y = cvt_pk(o0[4 * q + 2], o0[4 * q + 3]); w1.x = cvt_pk(o1[4 * q], o1[4 * q + 1]); w1.y = cvt_pk(o1[4 * q + 2], o1[4 * q + 3]);
        *(u32x2*)(qrow + 8 * q + 4 * hh) = w0; *(u32x2*)(qrow + 32 + 8 * q + 4 * hh) = w1;
    }
}
__device__ __forceinline__ void attn_phase(bf16_t* QO, const bf16_t* Kp, const bf16_t* VT, int gw, int NGW) {
    const int lane = lane_id_opaque();
    constexpr int NQB = SEQ / 32, NTASK = NB * NH * NQB;
    int i = 0;
    for (int tau = gw; tau < NTASK; tau += NGW, ++i) {
        const int bh = tau / NQB, qr = tau % NQB, qblk = (i & 1) ? (NQB - 1 - qr) : qr;
        attn_task(QO, Kp, VT, bh / NH, bh % NH, qblk, lane);
    }
}


#define XB_TMO      128
#define XB_XCNT(j)  (256  + 64 * (j))
#define XB_XSUB(j)  (1280 + 64 * (j))
#define XB_XGEN(j)  (2304 + 64 * (j))
#define XB_TOP      3328
#define XB_TOPGEN   3392
#define XCD_BAR_WORDS 3456
#define XB_SPIN_CAP (1u << 18)
__device__ __forceinline__ unsigned xb_ld(unsigned* p)              { return __hip_atomic_load(p, __ATOMIC_RELAXED, __HIP_MEMORY_SCOPE_AGENT); }
__device__ __forceinline__ unsigned xb_add(unsigned* p, unsigned v) { return __hip_atomic_fetch_add(p, v, __ATOMIC_RELAXED, __HIP_MEMORY_SCOPE_AGENT); }
__device__ __forceinline__ unsigned xb_xcc_id() { return (unsigned)__builtin_amdgcn_s_getreg((3 << 11) | 20) & 0xFu; }
#define XB_SPIN(cond, bar) do { unsigned _sp = 0; while (cond) { __builtin_amdgcn_s_sleep(1); \
    if ((++_sp & 255u) == 0u) { if (xb_ld(&(bar)[XB_TMO])) break; if (_sp > XB_SPIN_CAP) { atomicAdd(&(bar)[XB_TMO], 1u); break; } } } } while (0)
struct XcdBarrier { unsigned* bar; unsigned x; volatile LAS unsigned* st; };
__device__ __forceinline__ XcdBarrier xcd_barrier_post(unsigned* bar, volatile LAS unsigned* st, int tid) {
    XcdBarrier b; b.bar = bar; b.x = xb_xcc_id(); b.st = st;
    if (tid == 0) (void)xb_add(&bar[XB_XCNT(b.x)], 1u);
    return b;
}
__device__ __forceinline__ void xcd_barrier_complete(unsigned* bar, unsigned x, unsigned& nloc, unsigned& nx) {
    const unsigned G = gridDim.x * gridDim.y * gridDim.z;
    unsigned sum, cnt, mine, sp = 0u;
    for (;;) {
        sum = 0u; cnt = 0u; mine = 0u;
#pragma unroll
        for (unsigned j = 0; j < 16; ++j) { const unsigned c = xb_ld(&bar[XB_XCNT(j)]); sum += c; cnt += (c > 0u) ? 1u : 0u; mine = (j == x) ? c : mine; }
        if (sum == G) break;
        __builtin_amdgcn_s_sleep(1);
        if ((++sp & 255u) == 0u) { if (xb_ld(&bar[XB_TMO])) break; if (sp > XB_SPIN_CAP) { atomicAdd(&bar[XB_TMO], 1u); break; } }
    }
    nloc = mine > 0u ? mine : 1u; nx = cnt > 0u ? cnt : 1u;
}
__device__ __forceinline__ void xcd_barrier(const XcdBarrier& b, bool leader) {
    asm volatile("s_waitcnt vmcnt(0)" ::: "memory");
    __syncthreads();
    if (leader) {
        unsigned* bar = b.bar;
        __builtin_amdgcn_s_waitcnt(0);
        unsigned nloc = b.st[0], nx = b.st[1];
        if (nloc == 0u) { xcd_barrier_complete(bar, b.x, nloc, nx); b.st[0] = nloc; b.st[1] = nx; }
        const unsigned old = xb_add(&bar[XB_XSUB(b.x)], 1u);
        const unsigned gen = old / nloc;
        if (old + 1u == (gen + 1u) * nloc) {
            __builtin_amdgcn_fence(__ATOMIC_RELEASE, "agent");
            asm volatile("s_waitcnt vmcnt(0)" ::: "memory");
            const unsigned og = xb_add(&bar[XB_TOP], 1u);
            const unsigned tg = og / nx;
            if (og + 1u == (tg + 1u) * nx) xb_add(&bar[XB_TOPGEN], 1u);
            else XB_SPIN(xb_ld(&bar[XB_TOPGEN]) == tg, bar);
            __builtin_amdgcn_fence(__ATOMIC_ACQUIRE, "agent");
            xb_add(&bar[XB_XGEN(b.x)], 1u);
            asm volatile("s_waitcnt vmcnt(0)" ::: "memory");
        } else {
            XB_SPIN(xb_ld(&bar[XB_XGEN(b.x)]) == gen, bar);
            __builtin_amdgcn_fence(__ATOMIC_ACQUIRE, "agent");
            asm volatile("s_waitcnt vmcnt(0)" ::: "memory");
        }
    }
    __syncthreads();
}

constexpr int LDS_BYTES = 131072 + 1024;
__global__ void __launch_bounds__(NTHREADS, 2) fwd_kernel(Params p) {
    extern __shared__ __attribute__((aligned(16))) unsigned char lds_raw[];
    LAS unsigned char* lds = (LAS unsigned char*)lds_raw;
    cg::grid_group grid = cg::this_grid();
#define CG_SYNC() do { asm volatile("s_waitcnt vmcnt(0)" ::: "memory"); grid.sync(); __builtin_amdgcn_fence(__ATOMIC_ACQUIRE, "agent"); asm volatile("s_waitcnt vmcnt(0)" ::: "memory"); } while (0)
#define GRID_SYNC() xcd_barrier(xb, leader)
    const int tid0 = threadIdx.x, wave = __builtin_amdgcn_readfirstlane(tid0 >> 6);
    const int G = gridDim.x, bx = blockIdx.x;
    const int gw = bx * NWAVES + wave, NGW = G * NWAVES, NT = G * NTHREADS;
    unsigned char* ws = p.ws;
    float* mod = (float*)(ws + WS_CTL);
    bf16_t* Rh = (bf16_t*)(ws + R_H); bf16_t* Ra = (bf16_t*)(ws + R_A); bf16_t* Rb = (bf16_t*)(ws + R_B); bf16_t* Rc = (bf16_t*)(ws + R_C); bf16_t* Rd = (bf16_t*)(ws + R_D);

    unsigned* barw = (unsigned*)(ws + WS_CTL + 200 * 1024);
    volatile LAS unsigned* bst = (volatile LAS unsigned*)(lds + 131072);
    const bool leader = (wave == 0) && (lane_id_opaque() == 0);
    if (leader) { bst[0] = 0u; bst[1] = 0u; }
    if (bx == 0) { const int t = wave * 64 + lane_id_opaque(); for (int i = t; i < XCD_BAR_WORDS; i += NTHREADS) barw[i] = 0u; }
    phase0(p, lds, gw, NGW, wave, lane_id_opaque());
    CG_SYNC();
    const XcdBarrier xb = xcd_barrier_post(barw, bst, leader ? 0 : 1);
#pragma unroll 1
    for (int i = 0; i < PROBE_SYNCS; ++i) GRID_SYNC();
    {
        const int gt = bx * NTHREADS + wave * 64 + lane_id_opaque();
        for (int it = gt; it < 2 * 4 * 1536; it += NT) {
            const int l = it / 6144, r = it % 6144, b = r / 1536, n4 = r % 1536;
            f32x4 a = *(const f32x4*)(p.in[3] + l * 6144 + n4 * 4);
            const float* mp = (const float*)(ws + R_D) + ((size_t)(l * 32) * 4 + b) * 6144 + n4 * 4;
#pragma unroll 8
            for (int kc = 0; kc < 32; ++kc) a += *(const f32x4*)(mp + (size_t)kc * 4 * 6144);
            *(f32x4*)(mod + (size_t)(l * 4 + b) * 6144 + n4 * 4) = a;
        }
    }
    GRID_SYNC();

#pragma unroll 1
    for (int l = 0; l < DEPTH; ++l) {
        const float* modl = mod + (size_t)l * 4 * 6144;
        const unsigned char* wl = ws + WS_W + (size_t)l * W_LAYER;
        const float* xin = (l == 0) ? p.in[0] : p.out;
        norm_phase(xin, p.in[4] + l * D, modl, 0, 1024, Rh, gw, NGW);
        GRID_SYNC();
        { pg8::SchedPlain S; S.T.init(M, 3072); S.G = G; S.c = bx; S.A = (const char*)Rh; S.B = (const char*)(wl + W_IN) + (size_t)3072 * D * 2; S.tstep = (size_t)256 * D * 2;
          pg8::EpiRegions E{Ra};
          pg8::gemm_phase(lds, D, S, E, wave);
          if (PROBE_DUPGEMM) pg8::gemm_phase(lds, D, S, E, wave); }
        GRID_SYNC();
        conv_phase(Ra, Rb, Rc, p.in[8] + (size_t)l * 3 * D, bx * NTHREADS + wave * 64, NT);
        GRID_SYNC();
        { pg8::SchedPlain S; S.T.init(M, 3072); S.G = G; S.c = bx; S.A = (const char*)Rh; S.B = (const char*)(wl + W_IN); S.tstep = (size_t)256 * D * 2;
          pg8::EpiQKV E{Rb, Rc, Rd, p.in[6] + l * HD, p.in[7] + l * HD};
          pg8::gemm_phase(lds, D, S, E, wave); }
        GRID_SYNC();
        attn_phase(Rb, Rc, Rd, gw, NGW);
        GRID_SYNC();
        { pg8::SchedBranch S; S.T.init(M, D); S.G = G; S.c = bx; S.ws = (const char*)ws; S.wl = (const char*)wl; S.tstep = (size_t)256 * D * 2;
          pg8::EpiBranch E{Rd, Rc};
          pg8::gemm_phase(lds, D, S, E, wave); }
        GRID_SYNC();
        { pg8::SchedPlain S; S.T.init(M, D); S.G = G; S.c = bx; S.A = (const char*)Rc; S.B = (const char*)(wl + W_O); S.tstep = (size_t)256 * D * 2;
          pg8::EpiResid E{xin, p.out, modl + 2048};
          pg8::gemm_phase(lds, D, S, E, wave); }
        GRID_SYNC();
        norm_phase(p.out, p.in[12] + l * D, modl, 3072, 4096, Rh, gw, NGW);
        GRID_SYNC();
        { pg8::SchedPlain S; S.T.init(M, 2 * FF); S.G = G; S.c = bx; S.A = (const char*)Rh; S.B = (const char*)(wl + W_GU); S.tstep = (size_t)256 * D * 2;
          pg8::EpiGU E{Ra};
          pg8::gemm_phase(lds, D, S, E, wave);
          if (PROBE_DUPGEMM) pg8::gemm_phase(lds, D, S, E, wave); }
        GRID_SYNC();
        { pg8::SchedPlain S; S.T.init(M, D); S.G = G; S.c = bx; S.A = (const char*)Ra; S.B = (const char*)(wl + W_D); S.tstep = (size_t)256 * FF * 2;
          pg8::EpiResid E{p.out, p.out, modl + 5120};
          pg8::gemm_phase(lds, FF, S, E, wave); }
        if (l + 1 < DEPTH) GRID_SYNC();
    }
}

extern "C" void kernel_launch(void* const* d_in, const int* in_sizes, int n_in, void* d_out, int out_size, void* d_ws, size_t ws_size, hipStream_t stream) {
    static int grid_blocks = 0;
    if (grid_blocks == 0) {
        if (n_in != 16 || out_size != M * D || ws_size < WS_END) { fprintf(stderr, "kernel_launch: unexpected shapes (n_in %d out %d ws %zu need %zu)\n", n_in, out_size, ws_size, (size_t)WS_END); grid_blocks = -1; return; }
        int dev = 0, cus = 0, per_cu = 0;
        hipGetDevice(&dev);
        hipDeviceGetAttribute(&cus, hipDeviceAttributeMultiprocessorCount, dev);
        hipFuncSetAttribute((const void*)fwd_kernel, hipFuncAttributeMaxDynamicSharedMemorySize, LDS_BYTES);
        hipOccupancyMaxActiveBlocksPerMultiprocessor(&per_cu, (const void*)fwd_kernel, NTHREADS, LDS_BYTES);
        (void)hipGetLastError();
        if (per_cu < 1) { fprintf(stderr, "kernel_launch: occupancy query says %d blocks per CU\n", per_cu); per_cu = 1; }
        grid_blocks = cus;
    }
    if (grid_blocks < 0) return;
    Params p{};
    for (int i = 0; i < 16; ++i) p.in[i] = (const float*)d_in[i];
    p.out = (float*)d_out; p.ws = (unsigned char*)d_ws;
    void* args[] = {&p};
    hipError_t e = hipLaunchCooperativeKernel((const void*)fwd_kernel, dim3(grid_blocks), dim3(NTHREADS), args, LDS_BYTES, stream);
    if (e != hipSuccess) fprintf(stderr, "cooperative launch failed: %s (grid %d)\n", hipGetErrorString(e), grid_blocks);
}
```

```cpp
#include <hip/hip_runtime.h>
#include <hip/hip_cooperative_groups.h>
#include <cstdio>
#include <cstdint>
namespace cg = cooperative_groups;
#ifndef PROBE_SYNCS
#define PROBE_SYNCS 0
#endif
#ifndef PROBE_DUPP0
#define PROBE_DUPP0 0
#endif
#ifndef PROBE_DUP46
#define PROBE_DUP46 0
#endif
#ifndef PROBE_DUPNORM
#define PROBE_DUPNORM 0
#endif
#ifndef PROBE_NOEXIT
#define PROBE_NOEXIT 0
#endif
#ifndef PROBE_DUPGEMM
#define PROBE_DUPGEMM 0
#endif

#define LAS __attribute__((address_space(3)))
typedef unsigned short bf16_t;
typedef short bf16x8 __attribute__((ext_vector_type(8)));
typedef short s16x4 __attribute__((ext_vector_type(4)));
typedef float f32x4 __attribute__((ext_vector_type(4)));
typedef float f32x16 __attribute__((ext_vector_type(16)));
typedef unsigned u32x4 __attribute__((ext_vector_type(4)));
typedef unsigned u32x2 __attribute__((ext_vector_type(2)));
typedef float f32x2_t __attribute__((ext_vector_type(2)));
typedef __bf16 bf16x2_t __attribute__((ext_vector_type(2)));

constexpr int D = 1024, NB = 4, SEQ = 4096, M = NB * SEQ, NH = 16, HD = 64, FF = 2816, INW = 8192, DEPTH = 2;
constexpr float EPS = 1e-6f;
constexpr float LOG2E = 1.4426950408889634f;
constexpr float C2 = 0.125f * LOG2E;
constexpr int NWAVES = 8, NTHREADS = 512;

constexpr size_t MiB = 1u << 20;
constexpr size_t WS_CTL = 0, CTL_BYTES = 256 * 1024;
constexpr size_t WS_W = 1 * MiB;
constexpr size_t W_IN = 0, W_A = 16 * MiB, W_B = 18 * MiB, W_O = 20 * MiB, W_GU = 22 * MiB, W_D = 33 * MiB, W_LAYER = 38 * MiB + 512 * 1024;
constexpr size_t WS_ACT = 78 * MiB;
constexpr size_t REG = 32 * MiB;
constexpr size_t R_H = WS_ACT, R_A = WS_ACT + REG, R_B = WS_ACT + 2 * REG, R_C = WS_ACT + 3 * REG, R_D = WS_ACT + 4 * REG, WS_END = WS_ACT + 5 * REG;
static_assert(WS_W + 2 * W_LAYER <= WS_ACT, "weights");
static_assert((size_t)M * FF * 2 <= 3 * REG, "ffn hidden fits R_A..R_C");

__device__ __forceinline__ unsigned cvt_pk(float lo, float hi) { f32x2_t v = {lo, hi}; bf16x2_t b = __builtin_convertvector(v, bf16x2_t); return __builtin_bit_cast(unsigned, b); }
__device__ __forceinline__ float bf_lo(unsigned u) { return __uint_as_float(u << 16); }
__device__ __forceinline__ float bf_hi(unsigned u) { return __uint_as_float(u & 0xffff0000u); }
__device__ __forceinline__ float shx(float v, int o, int lane) { return __int_as_float(__builtin_amdgcn_ds_bpermute((lane ^ o) << 2, __float_as_int(v))); }
__device__ __forceinline__ float wave_sum(float v, int lane) {
#pragma unroll
    for (int o = 1; o < 64; o <<= 1) v += shx(v, o, lane);
    return v;
}
__device__ __forceinline__ int lane_id_opaque() { int l; asm volatile("v_mbcnt_lo_u32_b32 %0, -1, 0\n\tv_mbcnt_hi_u32_b32 %0, -1, %0" : "=v"(l)); return l; }
__device__ __forceinline__ float fast_exp2(float x) { return __builtin_amdgcn_exp2f(x); }
__device__ __forceinline__ float fast_log2(float x) { return __builtin_amdgcn_logf(x); }
__device__ __forceinline__ float fast_rcp(float x) { return __builtin_amdgcn_rcpf(x); }
__device__ __forceinline__ float sigmoidf_(float x) { return fast_rcp(1.0f + fast_exp2(-x * LOG2E)); }

namespace pg8 {
constexpr int BM = 256, BK = 64, HALF = 128, HTB = HALF * BK * 2, STAGE_BYTES = 8 * HTB, NXCD = 8, WGM = 8;
__host__ __device__ __forceinline__ int lds_byte(int r, int c) { const int st = (r >> 4) * 2 + (c >> 5), rr = r & 15, cc = c & 31, ob = rr * 64 + cc * 2; return st * 1024 + (ob ^ (((ob >> 9) & 1) << 5)); }
__host__ __device__ __forceinline__ void stage_rc(int b, int& R, int& C) { const int st = b / 1024, sb = b % 1024, swz = sb ^ (((sb >> 9) & 1) << 5); R = (st >> 1) * 16 + swz / 64; C = (st & 1) * 32 + (swz % 64) / 2; }

struct Unit { const char* A; const char* B; int pm, pn, kind; };

struct TileOrder {
    int nM, nN, nwg;
    __device__ __forceinline__ void init(int Mr, int N) { nM = Mr / BM; nN = N / BM; nwg = nM * nN; }
    __device__ __forceinline__ void map(int wgid, int& pm, int& pn) const {
        { const int q = nwg / NXCD, r = nwg % NXCD, xcd = wgid % NXCD, off = wgid / NXCD; wgid = (xcd < r ? xcd * (q + 1) : r * (q + 1) + (xcd - r) * q) + off; }
        const int nig = WGM * nN, gid = wgid / nig, fm = gid * WGM, gsz = (nM - fm) < WGM ? (nM - fm) : WGM;
        pm = fm + ((wgid % nig) % gsz); pn = (wgid % nig) / gsz;
    }
};
struct SchedPlain {
    TileOrder T; int G, c; const char* A; const char* B; size_t tstep;
    __device__ __forceinline__ bool next(int i, Unit& u) const {
        const long L = (long)i * G + c; if (L >= T.nwg) return false;
        T.map((int)L, u.pm, u.pn); u.A = A + (size_t)u.pm * tstep; u.B = B + (size_t)u.pn * tstep; u.kind = 0; return true;
    }
};
struct SchedBranch {
    TileOrder T; int G, c; const char* ws; const char* wl; size_t tstep;
    __device__ __forceinline__ bool next(int i, Unit& u) const {
        const long L = (long)(i >> 2) * G + c; if (L >= T.nwg) return false;
        T.map((int)L, u.pm, u.pn); const int sub = i & 3; u.kind = sub;
        const size_t oa = (sub == 1) ? R_B : ((sub == 3) ? R_A : R_H);
        const size_t ob = (sub == 0) ? (W_IN + (size_t)6144 * D * 2) : (sub == 1) ? W_A : (sub == 2) ? (W_IN + (size_t)7168 * D * 2) : W_B;
        u.A = ws + oa + (size_t)u.pm * tstep; u.B = wl + ob + (size_t)u.pn * tstep; return true;
    }
};

template <class Epi, class Sched>
__device__ __forceinline__ void gemm_phase(LAS unsigned char* lds, const int K, const Sched& S, const Epi& E, const int wid) {
    const int lane = lane_id_opaque(), tid = wid * 64 + lane, wr = wid >> 2, wc = wid & 3, fr = lane & 15, fq = lane >> 4;
    const int nt = K / BK;
    unsigned voff[2];
#pragma unroll
    for (int i = 0; i < 2; ++i) { int R, C; stage_rc(tid * 16 + i * 8192, R, C); voff[i] = (unsigned)(R * K + C) * 2u; }
    const size_t kstep = (size_t)(BK * 2);
    const size_t hstep = (size_t)HALF * K * 2;
    const unsigned ldsw = (unsigned)wid * 1024u;
    const int aoff = lds_byte(wr * 64 + fr, fq * 8), boff = lds_byte(wc * 32 + fr, fq * 8);
#define PG8_SA(b, h) (((b) * 2 + (h)) * HTB)
#define PG8_SB(b, h) ((4 + (b) * 2 + (h)) * HTB)
#define PG8_STAGE(bufoff, gbase) do { _Pragma("unroll") for (int _i = 0; _i < 2; ++_i) \
        __builtin_amdgcn_global_load_lds((const unsigned*)((const char*)(gbase) + voff[_i]), (LAS unsigned*)(lds + (bufoff) + ldsw + _i * 8192), 16, 0, 0); } while (0)
#define PG8_LDA(dst, b, h) do { _Pragma("unroll") for (int m = 0; m < 4; ++m) _Pragma("unroll") for (int k = 0; k < 2; ++k) dst[m][k] = *(const LAS bf16x8*)(lds + PG8_SA(b, h) + aoff + m * 2048 + k * 1024); } while (0)
#define PG8_LDB(dst, b, h) do { _Pragma("unroll") for (int n = 0; n < 2; ++n) _Pragma("unroll") for (int k = 0; k < 2; ++k) dst[n][k] = *(const LAS bf16x8*)(lds + PG8_SB(b, h) + boff + n * 2048 + k * 1024); } while (0)
#define PG8_MMA(ai, bj, At, Bt) do { __builtin_amdgcn_s_setprio(1); _Pragma("unroll") for (int m = 0; m < 4; ++m) _Pragma("unroll") for (int n = 0; n < 2; ++n) _Pragma("unroll") for (int k = 0; k < 2; ++k) \
        acc[ai][bj][m][n] = __builtin_amdgcn_mfma_f32_16x16x32_bf16(Bt[n][k], At[m][k], acc[ai][bj][m][n], 0, 0, 0); __builtin_amdgcn_s_setprio(0); } while (0)
#define PG8_WAIT_V(n) asm volatile("s_waitcnt vmcnt(" #n ")" ::: "memory")
#define PG8_WAIT_L(n) asm volatile("s_waitcnt lgkmcnt(" #n ")" ::: "memory")
#define PG8_BAR __builtin_amdgcn_s_barrier()
#define PG8_SCHED __builtin_amdgcn_sched_barrier(0)
    Unit cur, nxt; int ui = 0;
    if (!S.next(0, cur)) return;
    f32x4 acc[2][2][4][2];
#pragma unroll
    for (int a = 0; a < 2; ++a)
#pragma unroll
        for (int b = 0; b < 2; ++b)
#pragma unroll
            for (int m = 0; m < 4; ++m)
#pragma unroll
                for (int n = 0; n < 2; ++n) acc[a][b][m][n] = (f32x4){0.f, 0.f, 0.f, 0.f};
    bf16x8 At[4][2], B0[2][2], B1[2][2];
    const char* cA = cur.A; const char* cB = cur.B;
    PG8_STAGE(PG8_SB(0, 0), cB); PG8_STAGE(PG8_SB(0, 1), cB + hstep); PG8_STAGE(PG8_SA(0, 0), cA); PG8_STAGE(PG8_SA(0, 1), cA + hstep);
    if (wr == 1) PG8_BAR;
    PG8_WAIT_V(2); PG8_BAR;
    PG8_STAGE(PG8_SB(1, 0), cB + kstep); PG8_STAGE(PG8_SA(1, 0), cA + kstep); PG8_STAGE(PG8_SB(1, 1), cB + hstep + kstep);
    PG8_WAIT_V(6); PG8_BAR;
    for (;;) {
        const bool has_next = S.next(ui + 1, nxt);
        const char* nA = has_next ? nxt.A : cA; const char* nB = has_next ? nxt.B : cB;
        for (int t = 0; t < nt; t += 2) {
            const bool last = (t == nt - 2);
            const char* a1 = cA + (size_t)(t + 1) * kstep;
            const char* a2 = last ? nA : cA + (size_t)(t + 2) * kstep; const char* b2 = last ? nB : cB + (size_t)(t + 2) * kstep;
            const char* a3 = a2 + kstep; const char* b3 = b2 + kstep;
            PG8_LDB(B0, 0, 0); PG8_LDB(B1, 0, 1); PG8_SCHED; PG8_LDA(At, 0, 0); PG8_STAGE(PG8_SA(1, 1), a1 + hstep);
            PG8_WAIT_V(8); PG8_WAIT_L(0); PG8_BAR; PG8_MMA(0, 0, At, B0); PG8_MMA(0, 1, At, B1); PG8_BAR; PG8_SCHED;
            PG8_LDA(At, 0, 1); PG8_STAGE(PG8_SB(0, 0), b2); PG8_STAGE(PG8_SB(0, 1), b2 + hstep); PG8_STAGE(PG8_SA(0, 0), a2);
            PG8_WAIT_V(8); PG8_WAIT_L(0); PG8_BAR; PG8_MMA(1, 0, At, B0); PG8_MMA(1, 1, At, B1); PG8_BAR; PG8_SCHED;
            PG8_LDB(B0, 1, 0); PG8_LDB(B1, 1, 1); PG8_SCHED; PG8_LDA(At, 1, 0); PG8_STAGE(PG8_SA(0, 1), a2 + hstep);
            PG8_WAIT_V(8); PG8_WAIT_L(0); PG8_BAR; PG8_MMA(0, 0, At, B0); PG8_MMA(0, 1, At, B1); PG8_BAR; PG8_SCHED;
            PG8_LDA(At, 1, 1); PG8_STAGE(PG8_SB(1, 0), b3); PG8_STAGE(PG8_SB(1, 1), b3 + hstep); PG8_STAGE(PG8_SA(1, 0), a3);
            PG8_WAIT_V(8); PG8_WAIT_L(0); PG8_BAR; PG8_MMA(1, 0, At, B0); PG8_MMA(1, 1, At, B1); PG8_BAR; PG8_SCHED;
        }
        if (wr == 0) PG8_BAR;
        { const int l2 = lane_id_opaque(); E(acc, cur, wr, wc, l2 & 15, l2 >> 4); }
        if (!has_next) break;
#pragma unroll
        for (int a = 0; a < 2; ++a)
#pragma unroll
            for (int b = 0; b < 2; ++b)
#pragma unroll
                for (int m = 0; m < 4; ++m)
#pragma unroll
                    for (int n = 0; n < 2; ++n) acc[a][b][m][n] = (f32x4){0.f, 0.f, 0.f, 0.f};
        cur = nxt; cA = nA; cB = nB; ++ui;
        if (wr == 1) PG8_BAR;
    }
    PG8_WAIT_V(0);
    PG8_BAR;
#undef PG8_SA
#undef PG8_SB
#undef PG8_STAGE
#undef PG8_LDA
#undef PG8_LDB
#undef PG8_MMA
#undef PG8_WAIT_V
#undef PG8_WAIT_L
#undef PG8_BAR
#undef PG8_SCHED
}

__device__ __forceinline__ u32x4 pack8(const f32x4& a, const f32x4& b) { u32x4 w; w.x = cvt_pk(a[0], a[1]); w.y = cvt_pk(a[2], a[3]); w.z = cvt_pk(b[0], b[1]); w.w = cvt_pk(b[2], b[3]); return w; }

struct EpiRegions {
    bf16_t* base;
    __device__ __forceinline__ void operator()(const f32x4 (&acc)[2][2][4][2], const Unit& u, int wr, int wc, int fr, int fq) const {
        bf16_t* dst = base + (size_t)(u.pn >> 2) * ((size_t)M * D);
        const int col = (u.pn & 3) * 256 + wc * 64 + fq * 8, row0 = u.pm * BM + wr * 64 + fr;
#pragma unroll
        for (int ai = 0; ai < 2; ++ai)
#pragma unroll
            for (int m = 0; m < 4; ++m) { bf16_t* rp = dst + (size_t)(row0 + ai * HALF + m * 16) * D + col;
#pragma unroll
                for (int bj = 0; bj < 2; ++bj) *(u32x4*)(rp + bj * 32) = pack8(acc[ai][bj][m][0], acc[ai][bj][m][1]); }
    }
};
struct EpiQKV {
    bf16_t* q; bf16_t* k; bf16_t* vt; const float* gq; const float* gk;
    __device__ __forceinline__ void operator()(const f32x4 (&acc)[2][2][4][2], const Unit& u, int wr, int wc, int fr, int fq) const {
        const int region = u.pn >> 2, head = (u.pn & 3) * 4 + wc, row0 = u.pm * BM + wr * 64 + fr;
        if (region == 2) {
            const int b = row0 >> 12;
            bf16_t* vb = vt + ((size_t)(b * NH + head) * HD) * SEQ;
#pragma unroll
            for (int ai = 0; ai < 2; ++ai)
#pragma unroll
                for (int m = 0; m < 4; ++m) { const int s = (row0 + ai * HALF + m * 16) & (SEQ - 1);
#pragma unroll
                    for (int bj = 0; bj < 2; ++bj)
#pragma unroll
                        for (int n = 0; n < 2; ++n)
#pragma unroll
                            for (int j = 0; j < 4; ++j) { const int d = bj * 32 + fq * 8 + n * 4 + j; const unsigned w = cvt_pk(acc[ai][bj][m][n][j], 0.f);
                                vb[(size_t)d * SEQ + s] = (bf16_t)(w & 0xffffu); } }
        } else {
            const float* g = region == 0 ? gq : gk; const float sc = region == 0 ? C2 : 1.0f;
            bf16_t* dst = region == 0 ? q : k;
            f32x4 gv[2][2];
#pragma unroll
            for (int bj = 0; bj < 2; ++bj)
#pragma unroll
                for (int n = 0; n < 2; ++n) gv[bj][n] = *(const f32x4*)(g + bj * 32 + fq * 8 + n * 4) * sc;
            const int col = head * 64 + fq * 8;
#pragma unroll
            for (int ai = 0; ai < 2; ++ai)
#pragma unroll
                for (int m = 0; m < 4; ++m) {
                    float ss = 0.f;
#pragma unroll
                    for (int bj = 0; bj < 2; ++bj)
#pragma unroll
                        for (int n = 0; n < 2; ++n) { const f32x4 x = acc[ai][bj][m][n]; ss += (x[0] * x[0] + x[1] * x[1]) + (x[2] * x[2] + x[3] * x[3]); }
                    ss += shx(ss, 16, fr + 16 * fq); ss += shx(ss, 32, fr + 16 * fq);
                    const float r = 1.0f / sqrtf(ss * (1.0f / 64.0f) + EPS);
                    bf16_t* rp = dst + (size_t)(row0 + ai * HALF + m * 16) * D + col;
#pragma unroll
                    for (int bj = 0; bj < 2; ++bj) { const f32x4 a = acc[ai][bj][m][0] * r * gv[bj][0], b2 = acc[ai][bj][m][1] * r * gv[bj][1]; *(u32x4*)(rp + bj * 32) = pack8(a, b2); }
                }
        }
    }
};
struct EpiBranch {
    bf16_t* S1; bf16_t* TM;
    __device__ __forceinline__ void operator()(const f32x4 (&acc)[2][2][4][2], const Unit& u, int wr, int wc, int fr, int fq) const {
        const int col = u.pn * 256 + wc * 64 + fq * 8, row0 = u.pm * BM + wr * 64 + fr, kind = u.kind;
#pragma unroll
        for (int ai = 0; ai < 2; ++ai)
#pragma unroll
            for (int m = 0; m < 4; ++m) { const size_t off = (size_t)(row0 + ai * HALF + m * 16) * D + col;
#pragma unroll
                for (int bj = 0; bj < 2; ++bj) {
                    f32x4 a = acc[ai][bj][m][0], b = acc[ai][bj][m][1];
                    if (kind == 0 || kind == 2) {
#pragma unroll
                        for (int j = 0; j < 4; ++j) { a[j] = sigmoidf_(a[j]); b[j] = sigmoidf_(b[j]); }
                        *(u32x4*)(S1 + off + bj * 32) = pack8(a, b);
                    } else {
                        const u32x4 g = *(const u32x4*)(S1 + off + bj * 32);
                        a[0] *= bf_lo(g.x); a[1] *= bf_hi(g.x); a[2] *= bf_lo(g.y); a[3] *= bf_hi(g.y);
                        b[0] *= bf_lo(g.z); b[1] *= bf_hi(g.z); b[2] *= bf_lo(g.w); b[3] *= bf_hi(g.w);
                        if (kind == 3) { const u32x4 t = *(const u32x4*)(TM + off + bj * 32);
                            a[0] += bf_lo(t.x); a[1] += bf_hi(t.x); a[2] += bf_lo(t.y); a[3] += bf_hi(t.y);
                            b[0] += bf_lo(t.z); b[1] += bf_hi(t.z); b[2] += bf_lo(t.w); b[3] += bf_hi(t.w); }
                        *(u32x4*)(TM + off + bj * 32) = pack8(a, b);
                    }
                } }
    }
};
struct EpiResid {
    const float* xin; float* xout; const float* gmod;
    __device__ __forceinline__ void operator()(const f32x4 (&acc)[2][2][4][2], const Unit& u, int wr, int wc, int fr, int fq) const {
        const int col = u.pn * 256 + wc * 64 + fq * 8, row0 = u.pm * BM + wr * 64 + fr, b = row0 >> 12;
        f32x4 gv[2][2];
#pragma unroll
        for (int bj = 0; bj < 2; ++bj)
#pragma unroll
            for (int n = 0; n < 2; ++n) gv[bj][n] = *(const f32x4*)(gmod + b * 6144 + col + bj * 32 + n * 4);
#pragma unroll
        for (int ai = 0; ai < 2; ++ai)
#pragma unroll
            for (int m = 0; m < 4; ++m) { const size_t off = (size_t)(row0 + ai * HALF + m * 16) * D + col;
#pragma unroll
                for (int bj = 0; bj < 2; ++bj)
#pragma unroll
                    for (int n = 0; n < 2; ++n) { const f32x4 xo = *(const f32x4*)(xin + off + bj * 32 + n * 4); *(f32x4*)(xout + off + bj * 32 + n * 4) = xo + gv[bj][n] * acc[ai][bj][m][n]; } }
    }
};
struct EpiGU {
    bf16_t* f;
    __device__ __forceinline__ void operator()(const f32x4 (&acc)[2][2][4][2], const Unit& u, int wr, int wc, int fr, int fq) const {
        const int col = u.pn * 128 + wc * 32 + fq * 8, row0 = u.pm * BM + wr * 64 + fr;
#pragma unroll
        for (int ai = 0; ai < 2; ++ai)
#pragma unroll
            for (int m = 0; m < 4; ++m) {
                f32x4 o[2];
#pragma unroll
                for (int n = 0; n < 2; ++n)
#pragma unroll
                    for (int j = 0; j < 4; ++j) { const float gt = acc[ai][0][m][n][j]; o[n][j] = gt * sigmoidf_(gt) * acc[ai][1][m][n][j]; }
                *(u32x4*)(f + (size_t)(row0 + ai * HALF + m * 16) * FF + col) = pack8(o[0], o[1]);
            }
    }
};
}

#define LDS_WAIT() asm volatile("s_waitcnt lgkmcnt(0)" ::: "memory")
__device__ __forceinline__ void transpose_item(const float* W, int N, int K, int n0, bf16_t* WT, int a0, int k0, LAS float* scr, int lane) {
#pragma unroll 8
    for (int i = 0; i < 32; ++i) { const int kk = 2 * i + (lane >> 5); scr[kk * 33 + (lane & 31)] = W[(size_t)(k0 + kk) * N + n0 + (lane & 31)]; }
    LDS_WAIT(); asm volatile("" ::: "memory");
    const int c = lane & 7;
#pragma unroll
    for (int j = 0; j < 4; ++j) { const int s = (lane >> 3) + 8 * j; const int lo = 8 * ((s >> 2) & 3) + 4 * (s >> 4) + (s & 3);
        const LAS float* sp = scr + (8 * c) * 33 + lo;
        u32x4 o; o.x = cvt_pk(sp[0 * 33], sp[1 * 33]); o.y = cvt_pk(sp[2 * 33], sp[3 * 33]); o.z = cvt_pk(sp[4 * 33], sp[5 * 33]); o.w = cvt_pk(sp[6 * 33], sp[7 * 33]);
        *(u32x4*)(WT + (size_t)(a0 + s) * K + k0 + 8 * c) = o; }
    LDS_WAIT(); asm volatile("" ::: "memory");
}

struct Params { const float* in[16]; float* out; unsigned char* ws; };

__device__ __forceinline__ void phase0(const Params& p, LAS unsigned char* lds, int gw, int NGW, int wave, int lane) {
    LAS float* scr = (LAS float*)(lds + wave * 16384);
    constexpr int I_IN = 256 * 16, I_SQ = 32 * 16, I_GU = 176 * 16, I_D = 32 * 44, I_LAYER = I_IN + 3 * I_SQ + I_GU + I_D;
    constexpr int I_MOD = 2 * 32 * 24;
    for (int it = gw; it < I_MOD; it += NGW) {
        const int l = it / (32 * 24), r = it % (32 * 24), kc = r / 24, nb = r % 24;
        const float* aw = p.in[2] + (size_t)l * D * 6144 + (size_t)(kc * 32) * 6144 + nb * 256 + lane * 4;
        const float* c = p.in[1];
        f32x4 a[4];
#pragma unroll
        for (int b = 0; b < 4; ++b) a[b] = (f32x4){0.f, 0.f, 0.f, 0.f};
#pragma unroll 8
        for (int k = 0; k < 32; ++k) { const f32x4 w = *(const f32x4*)(aw + (size_t)k * 6144);
#pragma unroll
            for (int b = 0; b < 4; ++b) { const float cv = c[b * D + kc * 32 + k]; const float sv = cv * sigmoidf_(cv); a[b] += w * sv; } }
        float* mp = (float*)(p.ws + R_D) + ((size_t)(l * 32 + kc) * 4) * 6144 + nb * 256 + lane * 4;
#pragma unroll
        for (int b = 0; b < 4; ++b) *(f32x4*)(mp + (size_t)b * 6144) = a[b];
    }
    for (int it = gw; it < DEPTH * I_LAYER; it += NGW) {
        const int l = it / I_LAYER; int r = it % I_LAYER;
        unsigned char* wl = p.ws + WS_W + (size_t)l * W_LAYER;
        if (r < I_IN) { const int kb = r / 256, g = r % 256; const int pn = g >> 3, bj = (g >> 2) & 1, wc = g & 3;
            transpose_item(p.in[5] + (size_t)l * D * INW, INW, D, 256 * pn + 64 * wc + 32 * bj, (bf16_t*)(wl + W_IN), 32 * g, 64 * kb, scr, lane); continue; }
        r -= I_IN;
        if (r < 3 * I_SQ) { const int which = r / I_SQ; r %= I_SQ; const int kb = r / 32, g = r % 32; const int pn = g >> 3, bj = (g >> 2) & 1, wc = g & 3;
            const float* src = p.in[9 + which] + (size_t)l * D * D; bf16_t* dst = (bf16_t*)(wl + (which == 0 ? W_A : which == 1 ? W_B : W_O));
            transpose_item(src, D, D, 256 * pn + 64 * wc + 32 * bj, dst, 32 * g, 64 * kb, scr, lane); continue; }
        r -= 3 * I_SQ;
        if (r < I_GU) { const int kb = r / 176, g = r % 176; const int pn = g >> 3, bj = (g >> 2) & 1, wc = g & 3;
            const float* src = p.in[bj ? 14 : 13] + (size_t)l * D * FF;
            transpose_item(src, FF, D, 128 * pn + 32 * wc, (bf16_t*)(wl + W_GU), 32 * g, 64 * kb, scr, lane); continue; }
        r -= I_GU;
        { const int kb = r / 32, g = r % 32; const int pn = g >> 3, bj = (g >> 2) & 1, wc = g & 3;
            transpose_item(p.in[15] + (size_t)l * FF * D, D, FF, 256 * pn + 64 * wc + 32 * bj, (bf16_t*)(wl + W_D), 32 * g, 64 * kb, scr, lane); }
    }
}

__device__ __forceinline__ void norm_phase(const float* x, const float* g, const float* modl, int sh_off, int sc_off, bf16_t* h, int gw, int NGW) {
    const int lane = lane_id_opaque();
    for (int m = gw; m < M; m += NGW) {
        const int b = m >> 12;
        const f32x4* xr = (const f32x4*)(x + (size_t)m * D) + lane;
        f32x4 v[4]; float s = 0.f;
#pragma unroll
        for (int j = 0; j < 4; ++j) { v[j] = xr[64 * j]; s += (v[j][0] * v[j][0] + v[j][1] * v[j][1]) + (v[j][2] * v[j][2] + v[j][3] * v[j][3]); }
        const float r = 1.0f / sqrtf(wave_sum(s, lane) * (1.0f / D) + EPS);
        u32x2* o8 = (u32x2*)(h + (size_t)m * D) + lane;
#pragma unroll
        for (int j = 0; j < 4; ++j) { const int col = 4 * (64 * j + lane);
            const f32x4 gg = *(const f32x4*)(g + col), sc = *(const f32x4*)(modl + b * 6144 + sc_off + col), sh = *(const f32x4*)(modl + b * 6144 + sh_off + col);
            const f32x4 y = (v[j] * r * gg) * (sc + 1.0f) + sh;
            u32x2 w; w.x = cvt_pk(y[0], y[1]); w.y = cvt_pk(y[2], y[3]); o8[64 * j] = w; }
    }
}

__device__ __forceinline__ void conv_phase(bf16_t* cb, const bf16_t* cc, const bf16_t* cx, const float* cw, int gt0, int NT) {
    const int gt = gt0 + lane_id_opaque();
    for (int it = gt; it < (M / 16) * (D / 8); it += NT) {
        const int c8 = it & 127, run = it >> 7, t0 = run * 16, ch = c8 * 8;
        float w0[8], w1[8], w2[8];
#pragma unroll
        for (int i = 0; i < 8; ++i) { w0[i] = cw[ch + i]; w1[i] = cw[D + ch + i]; w2[i] = cw[2 * D + ch + i]; }
        float um2[8], um1[8];
#pragma unroll
        for (int i = 0; i < 8; ++i) { um2[i] = 0.f; um1[i] = 0.f; }
        if ((t0 & (SEQ - 1)) != 0) {
            const u32x4 a2 = *(const u32x4*)(cc + (size_t)(t0 - 2) * D + ch), b2 = *(const u32x4*)(cx + (size_t)(t0 - 2) * D + ch);
            const u32x4 a1 = *(const u32x4*)(cc + (size_t)(t0 - 1) * D + ch), b1 = *(const u32x4*)(cx + (size_t)(t0 - 1) * D + ch);
#pragma unroll
            for (int i = 0; i < 4; ++i) { um2[2 * i] = bf_lo(a2[i]) * bf_lo(b2[i]); um2[2 * i + 1] = bf_hi(a2[i]) * bf_hi(b2[i]);
                um1[2 * i] = bf_lo(a1[i]) * bf_lo(b1[i]); um1[2 * i + 1] = bf_hi(a1[i]) * bf_hi(b1[i]); }
        }
#pragma unroll 4
        for (int t = 0; t < 16; ++t) {
            const size_t off = (size_t)(t0 + t) * D + ch;
            const u32x4 a = *(const u32x4*)(cc + off), b = *(const u32x4*)(cx + off), e = *(const u32x4*)(cb + off);
            float u[8], y[8];
#pragma unroll
            for (int i = 0; i < 4; ++i) { u[2 * i] = bf_lo(a[i]) * bf_lo(b[i]); u[2 * i + 1] = bf_hi(a[i]) * bf_hi(b[i]); }
#pragma unroll
            for (int i = 0; i < 4; ++i) {
                y[2 * i] = bf_lo(e[i]) * (w0[2 * i] * um2[2 * i] + w1[2 * i] * um1[2 * i] + w2[2 * i] * u[2 * i]);
                y[2 * i + 1] = bf_hi(e[i]) * (w0[2 * i + 1] * um2[2 * i + 1] + w1[2 * i + 1] * um1[2 * i + 1] + w2[2 * i + 1] * u[2 * i + 1]); }
            u32x4 o; o.x = cvt_pk(y[0], y[1]); o.y = cvt_pk(y[2], y[3]); o.z = cvt_pk(y[4], y[5]); o.w = cvt_pk(y[6], y[7]);
            *(u32x4*)(cb + off) = o;
#pragma unroll
            for (int i = 0; i < 8; ++i) { um2[i] = um1[i]; um1[i] = u[i]; }
        }
    }
}

#define MFMA32(a, b, c) __builtin_amdgcn_mfma_f32_32x32x16_bf16((a), (b), (c), 0, 0, 0)
constexpr float SB_EXIT = PROBE_NOEXIT ? -1.0f : 1.0e-37f;
__device__ __forceinline__ float vmin_(float a, float b) { float r; asm("v_min_f32_e32 %0, %1, %2" : "=v"(r) : "v"(a), "v"(b)); return r; }
struct AttnState { f32x16 o0, o1; float P; bf16x8 kf[4]; };
template <bool DIAG>
__device__ __forceinline__ void attn_step(AttnState& st, const bf16x8 (&qf)[4], const bf16_t* kbase, const bf16_t* vbase, int j0, bool more, int n, int hh, int lane) {
    s16x4 vf[2][2][2];
#pragma unroll
    for (int mb = 0; mb < 2; ++mb)
#pragma unroll
        for (int s = 0; s < 2; ++s)
#pragma unroll
            for (int hf = 0; hf < 2; ++hf) vf[mb][s][hf] = *(const s16x4*)(vbase + (size_t)mb * 32 * SEQ + j0 + 16 * s + 8 * hf);
    f32x16 sa;
#pragma unroll
    for (int r = 0; r < 16; ++r) sa[r] = 0.f;
#pragma unroll
    for (int kk = 0; kk < 4; ++kk) sa = MFMA32(st.kf[kk], qf[kk], sa);
    if (more) {
#pragma unroll
        for (int kk = 0; kk < 4; ++kk) st.kf[kk] = *(const bf16x8*)(kbase + (size_t)(j0 - 32) * D + kk * 16);
    }
    float om[16], be[16];
#pragma unroll
    for (int r = 0; r < 16; ++r) {
        const float e = fast_exp2(vmin_(sa[r], 80.0f));
        float o = fast_rcp(1.0f + e), b = e * o;
        if (DIAG) { const int ki = (r & 3) + 8 * (r >> 2) + 4 * hh; if (ki >= n) { o = 1.0f; b = 0.f; } }
        om[r] = o; be[r] = b;
    }
    float g[4], pg[4];
#pragma unroll
    for (int q = 0; q < 4; ++q) g[q] = (om[4 * q] * om[4 * q + 1]) * (om[4 * q + 2] * om[4 * q + 3]);
#pragma unroll
    for (int q = 0; q < 4; ++q) pg[q] = shx(g[q], 32, lane);
    float run = st.P;
    float a[16];
#pragma unroll
    for (int q = 3; q >= 0; --q) {
        const float c3 = (hh == 0) ? run * pg[q] : run;
        const float c2 = c3 * om[4 * q + 3], c1 = c2 * om[4 * q + 2], c0 = c1 * om[4 * q + 1];
        a[4 * q + 3] = be[4 * q + 3] * c3; a[4 * q + 2] = be[4 * q + 2] * c2; a[4 * q + 1] = be[4 * q + 1] * c1; a[4 * q] = be[4 * q] * c0;
        run *= g[q] * pg[q];
    }
    st.P = run;
#pragma unroll
    for (int s = 0; s < 2; ++s) {
        u32x4 pw; pw.x = cvt_pk(a[8 * s + 0], a[8 * s + 1]); pw.y = cvt_pk(a[8 * s + 2], a[8 * s + 3]); pw.z = cvt_pk(a[8 * s + 4], a[8 * s + 5]); pw.w = cvt_pk(a[8 * s + 6], a[8 * s + 7]);
        const bf16x8 pf = __builtin_bit_cast(bf16x8, pw);
        const bf16x8 v0 = __builtin_shufflevector(vf[0][s][0], vf[0][s][1], 0, 1, 2, 3, 4, 5, 6, 7);
        const bf16x8 v1 = __builtin_shufflevector(vf[1][s][0], vf[1][s][1], 0, 1, 2, 3, 4, 5, 6, 7);
        st.o0 = MFMA32(v0, pf, st.o0); st.o1 = MFMA32(v1, pf, st.o1);
    }
}
__device__ __forceinline__ void attn_task(bf16_t* QO, const bf16_t* Kp, const bf16_t* VT, int b, int h, int qblk, int lane) {
    const int n = lane & 31, hh = lane >> 5, t0 = qblk * 32;
    bf16_t* qrow = QO + (size_t)(b * SEQ + t0 + n) * D + h * HD;
    bf16x8 qf[4];
#pragma unroll
    for (int kk = 0; kk < 4; ++kk) qf[kk] = *(const bf16x8*)(qrow + kk * 16 + hh * 8);
    AttnState st;
#pragma unroll
    for (int r = 0; r < 16; ++r) { st.o0[r] = 0.f; st.o1[r] = 0.f; }
    st.P = 1.0f;
    const bf16_t* kbase = Kp + (size_t)(b * SEQ + n) * D + h * HD + hh * 8;
    const bf16_t* vbase = VT + ((size_t)(b * NH + h) * HD + n) * SEQ + 4 * hh;
#pragma unroll
    for (int kk = 0; kk < 4; ++kk) st.kf[kk] = *(const bf16x8*)(kbase + (size_t)t0 * D + kk * 16);
    attn_step<true>(st, qf, kbase, vbase, t0, qblk > 0, n, hh, lane);
    for (int kb = qblk - 1; kb >= 0; --kb) {
        if (!__any(st.P > SB_EXIT)) break;
        attn_step<false>(st, qf, kbase, vbase, kb * 32, kb > 0, n, hh, lane);
    }
#pragma unroll
    for (int q = 0; q < 4; ++q) {
        u32x2 w0, w1; w0.x = cvt_pk(st.o0[4 * q], st.o0[4 * q + 1]); w0.y = cvt_pk(st.o0[4 * q + 2], st.o0[4 * q + 3]); w1.x = cvt_pk(st.o1[4 * q], st.o1[4 * q + 1]); w1.y = cvt_pk(st.o1[4 * q + 2], st.o1[4 * q + 3]);
        *(u32x2*)(qrow + 8 * q + 4 * hh) = w0; *(u32x2*)(qrow + 32 + 8 * q + 4 * hh) = w1;
    }
}
__device__ __forceinline__ void attn_phase(bf16_t* QO, const bf16_t* Kp, const bf16_t* VT, int gw, int NGW) {
    const int lane = lane_id_opaque();
    constexpr int NQB = SEQ / 32, NTASK = NB * NH * NQB;
    int i = 0;
    for (int tau = gw; tau < NTASK; tau += NGW, ++i) {
        const int bh = tau / NQB, qr = tau % NQB, qblk = (i & 1) ? (NQB - 1 - qr) : qr;
        attn_task(QO, Kp, VT, bh / NH, bh % NH, qblk, lane);
    }
}


#define XB_TMO      128
#define XB_XCNT(j)  (256  + 64 * (j))
#define XB_XSUB(j)  (1280 + 64 * (j))
#define XB_XGEN(j)  (2304 + 64 * (j))
#define XB_TOP      3328
#define XB_TOPGEN   3392
#define XCD_BAR_WORDS 3456
#define XB_SPIN_CAP (1u << 18)
__device__ __forceinline__ unsigned xb_ld(unsigned* p)              { return __hip_atomic_load(p, __ATOMIC_RELAXED, __HIP_MEMORY_SCOPE_AGENT); }
__device__ __forceinline__ unsigned xb_add(unsigned* p, unsigned v) { return __hip_atomic_fetch_add(p, v, __ATOMIC_RELAXED, __HIP_MEMORY_SCOPE_AGENT); }
__device__ __forceinline__ unsigned xb_xcc_id() { return (unsigned)__builtin_amdgcn_s_getreg((3 << 11) | 20) & 0xFu; }
#define XB_SPIN(cond, bar) do { unsigned _sp = 0; while (cond) { __builtin_amdgcn_s_sleep(1); \
    if ((++_sp & 255u) == 0u) { if (xb_ld(&(bar)[XB_TMO])) break; if (_sp > XB_SPIN_CAP) { atomicAdd(&(bar)[XB_TMO], 1u); break; } } } } while (0)
struct XcdBarrier { unsigned* bar; unsigned x; volatile LAS unsigned* st; };
__device__ __forceinline__ XcdBarrier xcd_barrier_post(unsigned* bar, volatile LAS unsigned* st, int tid) {
    XcdBarrier b; b.bar = bar; b.x = xb_xcc_id(); b.st = st;
    if (tid == 0) (void)xb_add(&bar[XB_XCNT(b.x)], 1u);
    return b;
}
__device__ __forceinline__ void xcd_barrier_complete(unsigned* bar, unsigned x, unsigned& nloc, unsigned& nx) {
    const unsigned G = gridDim.x * gridDim.y * gridDim.z;
    unsigned sum, cnt, mine, sp = 0u;
    for (;;) {
        sum = 0u; cnt = 0u; mine = 0u;
#pragma unroll
        for (unsigned j = 0; j < 16; ++j) { const unsigned c = xb_ld(&bar[XB_XCNT(j)]); sum += c; cnt += (c > 0u) ? 1u : 0u; mine = (j == x) ? c : mine; }
        if (sum == G) break;
        __builtin_amdgcn_s_sleep(1);
        if ((++sp & 255u) == 0u) { if (xb_ld(&bar[XB_TMO])) break; if (sp > XB_SPIN_CAP) { atomicAdd(&bar[XB_TMO], 1u); break; } }
    }
    nloc = mine > 0u ? mine : 1u; nx = cnt > 0u ? cnt : 1u;
}
__device__ __forceinline__ void xcd_barrier(const XcdBarrier& b, bool leader) {
    asm volatile("s_waitcnt vmcnt(0)" ::: "memory");
    __syncthreads();
    if (leader) {
        unsigned* bar = b.bar;
        __builtin_amdgcn_s_waitcnt(0);
        unsigned nloc = b.st[0], nx = b.st[1];
        if (nloc == 0u) { xcd_barrier_complete(bar, b.x, nloc, nx); b.st[0] = nloc; b.st[1] = nx; }
        const unsigned old = xb_add(&bar[XB_XSUB(b.x)], 1u);
        const unsigned gen = old / nloc;
        if (old + 1u == (gen + 1u) * nloc) {
            __builtin_amdgcn_fence(__ATOMIC_RELEASE, "agent");
            asm volatile("s_waitcnt vmcnt(0)" ::: "memory");
            const unsigned og = xb_add(&bar[XB_TOP], 1u);
            const unsigned tg = og / nx;
            if (og + 1u == (tg + 1u) * nx) xb_add(&bar[XB_TOPGEN], 1u);
            else XB_SPIN(xb_ld(&bar[XB_TOPGEN]) == tg, bar);
            __builtin_amdgcn_fence(__ATOMIC_ACQUIRE, "agent");
            xb_add(&bar[XB_XGEN(b.x)], 1u);
            asm volatile("s_waitcnt vmcnt(0)" ::: "memory");
        } else {
            XB_SPIN(xb_ld(&bar[XB_XGEN(b.x)]) == gen, bar);
            __builtin_amdgcn_fence(__ATOMIC_ACQUIRE, "agent");
            asm volatile("s_waitcnt vmcnt(0)" ::: "memory");
        }
    }
    __syncthreads();
}

constexpr int LDS_BYTES = 131072 + 1024;
__global__ void __launch_bounds__(NTHREADS, 2) fwd_kernel(Params p) {
    extern __shared__ __attribute__((aligned(16))) unsigned char lds_raw[];
    LAS unsigned char* lds = (LAS unsigned char*)lds_raw;
    cg::grid_group grid = cg::this_grid();
#define CG_SYNC() do { asm volatile("s_waitcnt vmcnt(0)" ::: "memory"); grid.sync(); if (wave == 0) { __builtin_amdgcn_fence(__ATOMIC_ACQUIRE, "agent"); asm volatile("s_waitcnt vmcnt(0)" ::: "memory"); } __syncthreads(); } while (0)
#define GRID_SYNC() xcd_barrier(xb, leader)
    const int tid0 = threadIdx.x, wave = __builtin_amdgcn_readfirstlane(tid0 >> 6);
    const int G = gridDim.x, bx = blockIdx.x;
    const int gw = bx * NWAVES + wave, NGW = G * NWAVES, NT = G * NTHREADS;
    unsigned char* ws = p.ws;
    float* mod = (float*)(ws + WS_CTL);
    bf16_t* Rh = (bf16_t*)(ws + R_H); bf16_t* Ra = (bf16_t*)(ws + R_A); bf16_t* Rb = (bf16_t*)(ws + R_B); bf16_t* Rc = (bf16_t*)(ws + R_C); bf16_t* Rd = (bf16_t*)(ws + R_D);

    unsigned* barw = (unsigned*)(ws + WS_CTL + 200 * 1024);
    volatile LAS unsigned* bst = (volatile LAS unsigned*)(lds + 131072);
    const bool leader = (wave == 0) && (lane_id_opaque() == 0);
    if (leader) { bst[0] = 0u; bst[1] = 0u; }
    if (bx == 0) { const int t = wave * 64 + lane_id_opaque(); for (int i = t; i < XCD_BAR_WORDS; i += NTHREADS) barw[i] = 0u; }
    phase0(p, lds, gw, NGW, wave, lane_id_opaque());
    if (PROBE_DUPP0) phase0(p, lds, gw, NGW, wave, lane_id_opaque());
    CG_SYNC();
    const XcdBarrier xb = xcd_barrier_post(barw, bst, leader ? 0 : 1);
#pragma unroll 1
    for (int i = 0; i < PROBE_SYNCS; ++i) GRID_SYNC();
    {
        const int gt = bx * NTHREADS + wave * 64 + lane_id_opaque();
        for (int it = gt; it < 2 * 4 * 1536; it += NT) {
            const int l = it / 6144, r = it % 6144, b = r / 1536, n4 = r % 1536;
            f32x4 a = *(const f32x4*)(p.in[3] + l * 6144 + n4 * 4);
            const float* mp = (const float*)(ws + R_D) + ((size_t)(l * 32) * 4 + b) * 6144 + n4 * 4;
#pragma unroll 8
            for (int kc = 0; kc < 32; ++kc) a += *(const f32x4*)(mp + (size_t)kc * 4 * 6144);
            *(f32x4*)(mod + (size_t)(l * 4 + b) * 6144 + n4 * 4) = a;
        }
    }
    GRID_SYNC();

#pragma unroll 1
    for (int l = 0; l < DEPTH; ++l) {
        const float* modl = mod + (size_t)l * 4 * 6144;
        const unsigned char* wl = ws + WS_W + (size_t)l * W_LAYER;
        const float* xin = (l == 0) ? p.in[0] : p.out;
        norm_phase(xin, p.in[4] + l * D, modl, 0, 1024, Rh, gw, NGW);
        if (PROBE_DUPNORM) norm_phase(xin, p.in[4] + l * D, modl, 0, 1024, Rh, gw, NGW);
        GRID_SYNC();
        { pg8::SchedPlain S; S.T.init(M, 3072); S.G = G; S.c = bx; S.A = (const char*)Rh; S.B = (const char*)(wl + W_IN) + (size_t)3072 * D * 2; S.tstep = (size_t)256 * D * 2;
          pg8::EpiRegions E{Ra};
          pg8::gemm_phase(lds, D, S, E, wave);
          if (PROBE_DUPGEMM) pg8::gemm_phase(lds, D, S, E, wave); }
        GRID_SYNC();
        conv_phase(Ra, Rb, Rc, p.in[8] + (size_t)l * 3 * D, bx * NTHREADS + wave * 64, NT);
        GRID_SYNC();
        { pg8::SchedPlain S; S.T.init(M, 3072); S.G = G; S.c = bx; S.A = (const char*)Rh; S.B = (const char*)(wl + W_IN); S.tstep = (size_t)256 * D * 2;
          pg8::EpiQKV E{Rb, Rc, Rd, p.in[6] + l * HD, p.in[7] + l * HD};
          pg8::gemm_phase(lds, D, S, E, wave);
          if (PROBE_DUP46 & 1) pg8::gemm_phase(lds, D, S, E, wave); }
        GRID_SYNC();
        attn_phase(Rb, Rc, Rd, gw, NGW);
        GRID_SYNC();
        { pg8::SchedBranch S; S.T.init(M, D); S.G = G; S.c = bx; S.ws = (const char*)ws; S.wl = (const char*)wl; S.tstep = (size_t)256 * D * 2;
          pg8::EpiBranch E{Rd, Rc};
          pg8::gemm_phase(lds, D, S, E, wave);
          if (PROBE_DUP46 & 2) pg8::gemm_phase(lds, D, S, E, wave); }
        GRID_SYNC();
        { pg8::SchedPlain S; S.T.init(M, D); S.G = G; S.c = bx; S.A = (const char*)Rc; S.B = (const char*)(wl + W_O); S.tstep = (size_t)256 * D * 2;
          pg8::EpiResid E{xin, p.out, modl + 2048};
          pg8::gemm_phase(lds, D, S, E, wave); }
        GRID_SYNC();
        norm_phase(p.out, p.in[12] + l * D, modl, 3072, 4096, Rh, gw, NGW);
        if (PROBE_DUPNORM) norm_phase(p.out, p.in[12] + l * D, modl, 3072, 4096, Rh, gw, NGW);
        GRID_SYNC();
        { pg8::SchedPlain S; S.T.init(M, 2 * FF); S.G = G; S.c = bx; S.A = (const char*)Rh; S.B = (const char*)(wl + W_GU); S.tstep = (size_t)256 * D * 2;
          pg8::EpiGU E{Ra};
          pg8::gemm_phase(lds, D, S, E, wave);
          if (PROBE_DUPGEMM) pg8::gemm_phase(lds, D, S, E, wave); }
        GRID_SYNC();
        { pg8::SchedPlain S; S.T.init(M, D); S.G = G; S.c = bx; S.A = (const char*)Ra; S.B = (const char*)(wl + W_D); S.tstep = (size_t)256 * FF * 2;
          pg8::EpiResid E{p.out, p.out, modl + 5120};
          pg8::gemm_phase(lds, FF, S, E, wave); }
        if (l + 1 < DEPTH) GRID_SYNC();
    }
}

extern "C" void kernel_launch(void* const* d_in, const int* in_sizes, int n_in, void* d_out, int out_size, void* d_ws, size_t ws_size, hipStream_t stream) {
    static int grid_blocks = 0;
    if (grid_blocks == 0) {
        if (n_in != 16 || out_size != M * D || ws_size < WS_END) { fprintf(stderr, "kernel_launch: unexpected shapes (n_in %d out %d ws %zu need %zu)\n", n_in, out_size, ws_size, (size_t)WS_END); grid_blocks = -1; return; }
        int dev = 0, cus = 0, per_cu = 0;
        hipGetDevice(&dev);
        hipDeviceGetAttribute(&cus, hipDeviceAttributeMultiprocessorCount, dev);
        hipFuncSetAttribute((const void*)fwd_kernel, hipFuncAttributeMaxDynamicSharedMemorySize, LDS_BYTES);
        hipOccupancyMaxActiveBlocksPerMultiprocessor(&per_cu, (const void*)fwd_kernel, NTHREADS, LDS_BYTES);
        (void)hipGetLastError();
        if (per_cu < 1) { fprintf(stderr, "kernel_launch: occupancy query says %d blocks per CU\n", per_cu); per_cu = 1; }
        grid_blocks = cus;
    }
    if (grid_blocks < 0) return;
    Params p{};
    for (int i = 0; i < 16; ++i) p.in[i] = (const float*)d_in[i];
    p.out = (float*)d_out; p.ws = (unsigned char*)d_ws;
    void* args[] = {&p};
    hipError_t e = hipLaunchCooperativeKernel((const void*)fwd_kernel, dim3(grid_blocks), dim3(NTHREADS), args, LDS_BYTES, stream);
    if (e != hipSuccess) fprintf(stderr, "cooperative launch failed: %s (grid %d)\n", hipGetErrorString(e), grid_blocks);
}
```

```cpp
#include <hip/hip_runtime.h>
#include <hip/hip_cooperative_groups.h>
#include <cstdio>
#include <cstdint>
namespace cg = cooperative_groups;

#define LAS __attribute__((address_space(3)))
typedef unsigned short bf16_t;
typedef short bf16x8 __attribute__((ext_vector_type(8)));
typedef short s16x4 __attribute__((ext_vector_type(4)));
typedef float f32x4 __attribute__((ext_vector_type(4)));
typedef float f32x16 __attribute__((ext_vector_type(16)));
typedef unsigned u32x4 __attribute__((ext_vector_type(4)));
typedef unsigned u32x2 __attribute__((ext_vector_type(2)));
typedef float f32x2_t __attribute__((ext_vector_type(2)));
typedef __bf16 bf16x2_t __attribute__((ext_vector_type(2)));

constexpr int D = 1024, NB = 4, SEQ = 4096, M = NB * SEQ, NH = 16, HD = 64, FF = 2816, INW = 8192, DEPTH = 2;
constexpr float EPS = 1e-6f;
constexpr float LOG2E = 1.4426950408889634f;
constexpr float C2 = 0.125f * LOG2E;
constexpr int NWAVES = 8, NTHREADS = 512;

constexpr size_t MiB = 1u << 20;
constexpr size_t WS_CTL = 0, CTL_BYTES = 256 * 1024;
constexpr size_t WS_W = 1 * MiB;
constexpr size_t W_IN = 0, W_A = 16 * MiB, W_B = 18 * MiB, W_O = 20 * MiB, W_GU = 22 * MiB, W_D = 33 * MiB, W_LAYER = 38 * MiB + 512 * 1024;
constexpr size_t WS_ACT = 40 * MiB;
constexpr size_t REG = 32 * MiB;
constexpr size_t R_H = WS_ACT, R_Q = WS_ACT + REG, R_K = WS_ACT + 2 * REG, R_V = WS_ACT + 3 * REG, R_CB = WS_ACT + 4 * REG, R_CC = WS_ACT + 5 * REG, R_CX = WS_ACT + 6 * REG, WS_END = WS_ACT + 7 * REG;
static_assert(WS_W + W_LAYER <= WS_ACT, "weights");
static_assert((size_t)M * FF * 2 <= 3 * REG, "ffn hidden fits R_Q..R_V");
static_assert(WS_END <= 279028736, "workspace >= sum of the inputs' bytes");

__device__ __forceinline__ unsigned cvt_pk(float lo, float hi) { f32x2_t v = {lo, hi}; bf16x2_t b = __builtin_convertvector(v, bf16x2_t); return __builtin_bit_cast(unsigned, b); }
__device__ __forceinline__ float bf_lo(unsigned u) { return __uint_as_float(u << 16); }
__device__ __forceinline__ float bf_hi(unsigned u) { return __uint_as_float(u & 0xffff0000u); }
__device__ __forceinline__ float shx(float v, int o, int lane) { return __int_as_float(__builtin_amdgcn_ds_bpermute((lane ^ o) << 2, __float_as_int(v))); }
__device__ __forceinline__ float wave_sum(float v, int lane) {
#pragma unroll
    for (int o = 1; o < 64; o <<= 1) v += shx(v, o, lane);
    return v;
}
__device__ __forceinline__ int lane_id_opaque() { int l; asm volatile("v_mbcnt_lo_u32_b32 %0, -1, 0\n\tv_mbcnt_hi_u32_b32 %0, -1, %0" : "=v"(l)); return l; }
__device__ __forceinline__ float fast_exp2(float x) { return __builtin_amdgcn_exp2f(x); }
__device__ __forceinline__ float fast_log2(float x) { return __builtin_amdgcn_logf(x); }
__device__ __forceinline__ float fast_rcp(float x) { return __builtin_amdgcn_rcpf(x); }
__device__ __forceinline__ float sigmoidf_(float x) { return fast_rcp(1.0f + fast_exp2(-x * LOG2E)); }

namespace pg8 {
constexpr int BM = 256, BK = 64, HALF = 128, HTB = HALF * BK * 2, STAGE_BYTES = 8 * HTB, NXCD = 8, WGM = 8;
__host__ __device__ __forceinline__ int lds_byte(int r, int c) { const int st = (r >> 4) * 2 + (c >> 5), rr = r & 15, cc = c & 31, ob = rr * 64 + cc * 2; return st * 1024 + (ob ^ (((ob >> 9) & 1) << 5)); }
__host__ __device__ __forceinline__ void stage_rc(int b, int& R, int& C) { const int st = b / 1024, sb = b % 1024, swz = sb ^ (((sb >> 9) & 1) << 5); R = (st >> 1) * 16 + swz / 64; C = (st & 1) * 32 + (swz % 64) / 2; }

struct Unit { const char* A; const char* B; int pm, pn, kind; };

struct TileOrder {
    int nM, nN, nwg;
    __device__ __forceinline__ void init(int Mr, int N) { nM = Mr / BM; nN = N / BM; nwg = nM * nN; }
    __device__ __forceinline__ void map(int wgid, int& pm, int& pn) const {
        { const int q = nwg / NXCD, r = nwg % NXCD, xcd = wgid % NXCD, off = wgid / NXCD; wgid = (xcd < r ? xcd * (q + 1) : r * (q + 1) + (xcd - r) * q) + off; }
        const int nig = WGM * nN, gid = wgid / nig, fm = gid * WGM, gsz = (nM - fm) < WGM ? (nM - fm) : WGM;
        pm = fm + ((wgid % nig) % gsz); pn = (wgid % nig) / gsz;
    }
};
struct SchedPlain {
    TileOrder T; int G, c; const char* A; const char* B; size_t tstep;
    __device__ __forceinline__ bool next(int i, Unit& u) const {
        const long L = (long)i * G + c; if (L >= T.nwg) return false;
        T.map((int)L, u.pm, u.pn); u.A = A + (size_t)u.pm * tstep; u.B = B + (size_t)u.pn * tstep; u.kind = 0; return true;
    }
};
struct SchedBranch {
    TileOrder T; int G, c; const char* ws; const char* wl; size_t tstep;
    __device__ __forceinline__ bool next(int i, Unit& u) const {
        const long L = (long)(i >> 2) * G + c; if (L >= T.nwg) return false;
        T.map((int)L, u.pm, u.pn); const int sub = i & 3; u.kind = sub;
        const size_t oa = (sub == 1) ? R_Q : ((sub == 3) ? R_CB : R_H);
        const size_t ob = (sub == 0) ? (W_IN + (size_t)6144 * D * 2) : (sub == 1) ? W_A : (sub == 2) ? (W_IN + (size_t)7168 * D * 2) : W_B;
        u.A = ws + oa + (size_t)u.pm * tstep; u.B = wl + ob + (size_t)u.pn * tstep; return true;
    }
};

template <class Epi, class Sched>
__device__ __forceinline__ void gemm_phase(LAS unsigned char* lds, const int K, const Sched& S, const Epi& E, const int wid) {
    const int lane = lane_id_opaque(), tid = wid * 64 + lane, wr = wid >> 2, wc = wid & 3, fr = lane & 15, fq = lane >> 4;
    const int nt = K / BK;
    unsigned voff[2];
#pragma unroll
    for (int i = 0; i < 2; ++i) { int R, C; stage_rc(tid * 16 + i * 8192, R, C); voff[i] = (unsigned)(R * K + C) * 2u; }
    const size_t kstep = (size_t)(BK * 2);
    const size_t hstep = (size_t)HALF * K * 2;
    const unsigned ldsw = (unsigned)wid * 1024u;
    const int aoff = lds_byte(wr * 64 + fr, fq * 8), boff = lds_byte(wc * 32 + fr, fq * 8);
#define PG8_SA(b, h) (((b) * 2 + (h)) * HTB)
#define PG8_SB(b, h) ((4 + (b) * 2 + (h)) * HTB)
#define PG8_STAGE(bufoff, gbase) do { _Pragma("unroll") for (int _i = 0; _i < 2; ++_i) \
        __builtin_amdgcn_global_load_lds((const unsigned*)((const char*)(gbase) + voff[_i]), (LAS unsigned*)(lds + (bufoff) + ldsw + _i * 8192), 16, 0, 0); } while (0)
#define PG8_LDA(dst, b, h) do { _Pragma("unroll") for (int m = 0; m < 4; ++m) _Pragma("unroll") for (int k = 0; k < 2; ++k) dst[m][k] = *(const LAS bf16x8*)(lds + PG8_SA(b, h) + aoff + m * 2048 + k * 1024); } while (0)
#define PG8_LDB(dst, b, h) do { _Pragma("unroll") for (int n = 0; n < 2; ++n) _Pragma("unroll") for (int k = 0; k < 2; ++k) dst[n][k] = *(const LAS bf16x8*)(lds + PG8_SB(b, h) + boff + n * 2048 + k * 1024); } while (0)
#define PG8_MMA(ai, bj, At, Bt) do { __builtin_amdgcn_s_setprio(1); _Pragma("unroll") for (int m = 0; m < 4; ++m) _Pragma("unroll") for (int n = 0; n < 2; ++n) _Pragma("unroll") for (int k = 0; k < 2; ++k) \
        acc[ai][bj][m][n] = __builtin_amdgcn_mfma_f32_16x16x32_bf16(Bt[n][k], At[m][k], acc[ai][bj][m][n], 0, 0, 0); __builtin_amdgcn_s_setprio(0); } while (0)
#define PG8_WAIT_V(n) asm volatile("s_waitcnt vmcnt(" #n ")" ::: "memory")
#define PG8_WAIT_L(n) asm volatile("s_waitcnt lgkmcnt(" #n ")" ::: "memory")
#define PG8_BAR __builtin_amdgcn_s_barrier()
#define PG8_SCHED __builtin_amdgcn_sched_barrier(0)
    Unit cur, nxt; int ui = 0;
    if (!S.next(0, cur)) return;
    f32x4 acc[2][2][4][2];
#pragma unroll
    for (int a = 0; a < 2; ++a)
#pragma unroll
        for (int b = 0; b < 2; ++b)
#pragma unroll
            for (int m = 0; m < 4; ++m)
#pragma unroll
                for (int n = 0; n < 2; ++n) acc[a][b][m][n] = (f32x4){0.f, 0.f, 0.f, 0.f};
    bf16x8 At[4][2], B0[2][2], B1[2][2];
    const char* cA = cur.A; const char* cB = cur.B;
    PG8_STAGE(PG8_SB(0, 0), cB); PG8_STAGE(PG8_SB(0, 1), cB + hstep); PG8_STAGE(PG8_SA(0, 0), cA); PG8_STAGE(PG8_SA(0, 1), cA + hstep);
    if (wr == 1) PG8_BAR;
    PG8_WAIT_V(2); PG8_BAR;
    PG8_STAGE(PG8_SB(1, 0), cB + kstep); PG8_STAGE(PG8_SA(1, 0), cA + kstep); PG8_STAGE(PG8_SB(1, 1), cB + hstep + kstep);
    PG8_WAIT_V(6); PG8_BAR;
    for (;;) {
        const bool has_next = S.next(ui + 1, nxt);
        const char* nA = has_next ? nxt.A : cA; const char* nB = has_next ? nxt.B : cB;
        for (int t = 0; t < nt; t += 2) {
            const bool last = (t == nt - 2);
            const char* a1 = cA + (size_t)(t + 1) * kstep;
            const char* a2 = last ? nA : cA + (size_t)(t + 2) * kstep; const char* b2 = last ? nB : cB + (size_t)(t + 2) * kstep;
            const char* a3 = a2 + kstep; const char* b3 = b2 + kstep;
            PG8_LDB(B0, 0, 0); PG8_LDB(B1, 0, 1); PG8_SCHED; PG8_LDA(At, 0, 0); PG8_STAGE(PG8_SA(1, 1), a1 + hstep);
            PG8_WAIT_V(8); PG8_WAIT_L(0); PG8_BAR; PG8_MMA(0, 0, At, B0); PG8_MMA(0, 1, At, B1); PG8_BAR; PG8_SCHED;
            PG8_LDA(At, 0, 1); PG8_STAGE(PG8_SB(0, 0), b2); PG8_STAGE(PG8_SB(0, 1), b2 + hstep); PG8_STAGE(PG8_SA(0, 0), a2);
            PG8_WAIT_V(8); PG8_WAIT_L(0); PG8_BAR; PG8_MMA(1, 0, At, B0); PG8_MMA(1, 1, At, B1); PG8_BAR; PG8_SCHED;
            PG8_LDB(B0, 1, 0); PG8_LDB(B1, 1, 1); PG8_SCHED; PG8_LDA(At, 1, 0); PG8_STAGE(PG8_SA(0, 1), a2 + hstep);
            PG8_WAIT_V(8); PG8_WAIT_L(0); PG8_BAR; PG8_MMA(0, 0, At, B0); PG8_MMA(0, 1, At, B1); PG8_BAR; PG8_SCHED;
            PG8_LDA(At, 1, 1); PG8_STAGE(PG8_SB(1, 0), b3); PG8_STAGE(PG8_SB(1, 1), b3 + hstep); PG8_STAGE(PG8_SA(1, 0), a3);
            PG8_WAIT_V(8); PG8_WAIT_L(0); PG8_BAR; PG8_MMA(1, 0, At, B0); PG8_MMA(1, 1, At, B1); PG8_BAR; PG8_SCHED;
        }
        if (wr == 0) PG8_BAR;
        { const int l2 = lane_id_opaque(); E(acc, cur, wr, wc, l2 & 15, l2 >> 4); }
        if (!has_next) break;
#pragma unroll
        for (int a = 0; a < 2; ++a)
#pragma unroll
            for (int b = 0; b < 2; ++b)
#pragma unroll
                for (int m = 0; m < 4; ++m)
#pragma unroll
                    for (int n = 0; n < 2; ++n) acc[a][b][m][n] = (f32x4){0.f, 0.f, 0.f, 0.f};
        cur = nxt; cA = nA; cB = nB; ++ui;
        if (wr == 1) PG8_BAR;
    }
    PG8_WAIT_V(0);
    PG8_BAR;
#undef PG8_SA
#undef PG8_SB
#undef PG8_STAGE
#undef PG8_LDA
#undef PG8_LDB
#undef PG8_MMA
#undef PG8_WAIT_V
#undef PG8_WAIT_L
#undef PG8_BAR
#undef PG8_SCHED
}

__device__ __forceinline__ u32x4 pack8(const f32x4& a, const f32x4& b) { u32x4 w; w.x = cvt_pk(a[0], a[1]); w.y = cvt_pk(a[2], a[3]); w.z = cvt_pk(b[0], b[1]); w.w = cvt_pk(b[2], b[3]); return w; }

struct EpiRegions {
    bf16_t* base;
    __device__ __forceinline__ void operator()(const f32x4 (&acc)[2][2][4][2], const Unit& u, int wr, int wc, int fr, int fq) const {
        bf16_t* dst = base + (size_t)(u.pn >> 2) * ((size_t)M * D);
        const int col = (u.pn & 3) * 256 + wc * 64 + fq * 8, row0 = u.pm * BM + wr * 64 + fr;
#pragma unroll
        for (int ai = 0; ai < 2; ++ai)
#pragma unroll
            for (int m = 0; m < 4; ++m) { bf16_t* rp = dst + (size_t)(row0 + ai * HALF + m * 16) * D + col;
#pragma unroll
                for (int bj = 0; bj < 2; ++bj) *(u32x4*)(rp + bj * 32) = pack8(acc[ai][bj][m][0], acc[ai][bj][m][1]); }
    }
};
struct EpiQKV {
    bf16_t* base; const float* gq; const float* gk;
    __device__ __forceinline__ void operator()(const f32x4 (&acc)[2][2][4][2], const Unit& u, int wr, int wc, int fr, int fq) const {
        const int region = u.pn >> 2, head = (u.pn & 3) * 4 + wc, row0 = u.pm * BM + wr * 64 + fr;
        if (region == 2) {
            const int b = row0 >> 12;
            bf16_t* vb = base + (size_t)2 * M * D + ((size_t)(b * NH + head) * HD) * SEQ;
#pragma unroll
            for (int ai = 0; ai < 2; ++ai)
#pragma unroll
                for (int m = 0; m < 4; ++m) { const int s = (row0 + ai * HALF + m * 16) & (SEQ - 1);
#pragma unroll
                    for (int bj = 0; bj < 2; ++bj)
#pragma unroll
                        for (int n = 0; n < 2; ++n)
#pragma unroll
                            for (int j = 0; j < 4; ++j) { const int d = bj * 32 + fq * 8 + n * 4 + j; const unsigned w = cvt_pk(acc[ai][bj][m][n][j], 0.f);
                                vb[(size_t)d * SEQ + s] = (bf16_t)(w & 0xffffu); } }
        } else if (region >= 3) {
            bf16_t* dst = base + (size_t)region * ((size_t)M * D);
            const int col = (u.pn & 3) * 256 + wc * 64 + fq * 8;
#pragma unroll
            for (int ai = 0; ai < 2; ++ai)
#pragma unroll
                for (int m = 0; m < 4; ++m) { bf16_t* rp = dst + (size_t)(row0 + ai * HALF + m * 16) * D + col;
#pragma unroll
                    for (int bj = 0; bj < 2; ++bj) *(u32x4*)(rp + bj * 32) = pack8(acc[ai][bj][m][0], acc[ai][bj][m][1]); }
        } else {
            const float* g = region == 0 ? gq : gk; const float sc = region == 0 ? C2 : 1.0f;
            bf16_t* dst = base + (size_t)region * ((size_t)M * D);
            f32x4 gv[2][2];
#pragma unroll
            for (int bj = 0; bj < 2; ++bj)
#pragma unroll
                for (int n = 0; n < 2; ++n) gv[bj][n] = *(const f32x4*)(g + bj * 32 + fq * 8 + n * 4) * sc;
            const int col = head * 64 + fq * 8;
#pragma unroll
            for (int ai = 0; ai < 2; ++ai)
#pragma unroll
                for (int m = 0; m < 4; ++m) {
                    float ss = 0.f;
#pragma unroll
                    for (int bj = 0; bj < 2; ++bj)
#pragma unroll
                        for (int n = 0; n < 2; ++n) { const f32x4 x = acc[ai][bj][m][n]; ss += (x[0] * x[0] + x[1] * x[1]) + (x[2] * x[2] + x[3] * x[3]); }
                    ss += shx(ss, 16, fr + 16 * fq); ss += shx(ss, 32, fr + 16 * fq);
                    const float r = 1.0f / sqrtf(ss * (1.0f / 64.0f) + EPS);
                    bf16_t* rp = dst + (size_t)(row0 + ai * HALF + m * 16) * D + col;
#pragma unroll
                    for (int bj = 0; bj < 2; ++bj) { const f32x4 a = acc[ai][bj][m][0] * r * gv[bj][0], b2 = acc[ai][bj][m][1] * r * gv[bj][1]; *(u32x4*)(rp + bj * 32) = pack8(a, b2); }
                }
        }
    }
};
struct EpiBranch {
    bf16_t* S1; bf16_t* TM;
    __device__ __forceinline__ void operator()(const f32x4 (&acc)[2][2][4][2], const Unit& u, int wr, int wc, int fr, int fq) const {
        const int col = u.pn * 256 + wc * 64 + fq * 8, row0 = u.pm * BM + wr * 64 + fr, kind = u.kind;
#pragma unroll
        for (int ai = 0; ai < 2; ++ai)
#pragma unroll
            for (int m = 0; m < 4; ++m) { const size_t off = (size_t)(row0 + ai * HALF + m * 16) * D + col;
#pragma unroll
                for (int bj = 0; bj < 2; ++bj) {
                    f32x4 a = acc[ai][bj][m][0], b = acc[ai][bj][m][1];
                    if (kind == 0 || kind == 2) {
#pragma unroll
                        for (int j = 0; j < 4; ++j) { a[j] = sigmoidf_(a[j]); b[j] = sigmoidf_(b[j]); }
                        *(u32x4*)(S1 + off + bj * 32) = pack8(a, b);
                    } else {
                        const u32x4 g = *(const u32x4*)(S1 + off + bj * 32);
                        a[0] *= bf_lo(g.x); a[1] *= bf_hi(g.x); a[2] *= bf_lo(g.y); a[3] *= bf_hi(g.y);
                        b[0] *= bf_lo(g.z); b[1] *= bf_hi(g.z); b[2] *= bf_lo(g.w); b[3] *= bf_hi(g.w);
                        if (kind == 3) { const u32x4 t = *(const u32x4*)(TM + off + bj * 32);
                            a[0] += bf_lo(t.x); a[1] += bf_hi(t.x); a[2] += bf_lo(t.y); a[3] += bf_hi(t.y);
                            b[0] += bf_lo(t.z); b[1] += bf_hi(t.z); b[2] += bf_lo(t.w); b[3] += bf_hi(t.w); }
                        *(u32x4*)(TM + off + bj * 32) = pack8(a, b);
                    }
                } }
    }
};
struct EpiResid {
    const float* xin; float* xout; const float* gmod;
    __device__ __forceinline__ void operator()(const f32x4 (&acc)[2][2][4][2], const Unit& u, int wr, int wc, int fr, int fq) const {
        const int col = u.pn * 256 + wc * 64 + fq * 8, row0 = u.pm * BM + wr * 64 + fr, b = row0 >> 12;
        f32x4 gv[2][2];
#pragma unroll
        for (int bj = 0; bj < 2; ++bj)
#pragma unroll
            for (int n = 0; n < 2; ++n) gv[bj][n] = *(const f32x4*)(gmod + b * 6144 + col + bj * 32 + n * 4);
#pragma unroll
        for (int ai = 0; ai < 2; ++ai)
#pragma unroll
            for (int m = 0; m < 4; ++m) { const size_t off = (size_t)(row0 + ai * HALF + m * 16) * D + col;
#pragma unroll
                for (int bj = 0; bj < 2; ++bj)
#pragma unroll
                    for (int n = 0; n < 2; ++n) { const f32x4 xo = *(const f32x4*)(xin + off + bj * 32 + n * 4); *(f32x4*)(xout + off + bj * 32 + n * 4) = xo + gv[bj][n] * acc[ai][bj][m][n]; } }
    }
};
struct EpiGU {
    bf16_t* f;
    __device__ __forceinline__ void operator()(const f32x4 (&acc)[2][2][4][2], const Unit& u, int wr, int wc, int fr, int fq) const {
        const int col = u.pn * 128 + wc * 32 + fq * 8, row0 = u.pm * BM + wr * 64 + fr;
#pragma unroll
        for (int ai = 0; ai < 2; ++ai)
#pragma unroll
            for (int m = 0; m < 4; ++m) {
                f32x4 o[2];
#pragma unroll
                for (int n = 0; n < 2; ++n)
#pragma unroll
                    for (int j = 0; j < 4; ++j) { const float gt = acc[ai][0][m][n][j]; o[n][j] = gt * sigmoidf_(gt) * acc[ai][1][m][n][j]; }
                *(u32x4*)(f + (size_t)(row0 + ai * HALF + m * 16) * FF + col) = pack8(o[0], o[1]);
            }
    }
};
}

#define LDS_WAIT() asm volatile("s_waitcnt lgkmcnt(0)" ::: "memory")
__device__ __forceinline__ void transpose_item(const float* W, int N, int K, int n0, bf16_t* WT, int a0, int k0, LAS float* scr, int lane) {
#pragma unroll 8
    for (int i = 0; i < 32; ++i) { const int kk = 2 * i + (lane >> 5); scr[kk * 33 + (lane & 31)] = W[(size_t)(k0 + kk) * N + n0 + (lane & 31)]; }
    LDS_WAIT(); asm volatile("" ::: "memory");
    const int c = lane & 7;
#pragma unroll
    for (int j = 0; j < 4; ++j) { const int s = (lane >> 3) + 8 * j; const int lo = 8 * ((s >> 2) & 3) + 4 * (s >> 4) + (s & 3);
        const LAS float* sp = scr + (8 * c) * 33 + lo;
        u32x4 o; o.x = cvt_pk(sp[0 * 33], sp[1 * 33]); o.y = cvt_pk(sp[2 * 33], sp[3 * 33]); o.z = cvt_pk(sp[4 * 33], sp[5 * 33]); o.w = cvt_pk(sp[6 * 33], sp[7 * 33]);
        *(u32x4*)(WT + (size_t)(a0 + s) * K + k0 + 8 * c) = o; }
    LDS_WAIT(); asm volatile("" ::: "memory");
}

struct Params { const float* in[16]; float* out; unsigned char* ws; };

__device__ __forceinline__ void phase0(const Params& p, LAS unsigned char* lds, int gw, int NGW, int wave, int lane, const int l, const bool with_mod) {
    LAS float* scr = (LAS float*)(lds + wave * 16384);
    constexpr int I_IN = 256 * 16, I_SQ = 32 * 16, I_GU = 176 * 16, I_D = 32 * 44, I_LAYER = I_IN + 3 * I_SQ + I_GU + I_D;
    constexpr int I_MOD = 2 * 32 * 24;
    for (int it = gw; it < (with_mod ? I_MOD : 0); it += NGW) {
        const int l = it / (32 * 24), r = it % (32 * 24), kc = r / 24, nb = r % 24;
        const float* aw = p.in[2] + (size_t)l * D * 6144 + (size_t)(kc * 32) * 6144 + nb * 256 + lane * 4;
        const float* c = p.in[1];
        f32x4 a[4];
#pragma unroll
        for (int b = 0; b < 4; ++b) a[b] = (f32x4){0.f, 0.f, 0.f, 0.f};
#pragma unroll 8
        for (int k = 0; k < 32; ++k) { const f32x4 w = *(const f32x4*)(aw + (size_t)k * 6144);
#pragma unroll
            for (int b = 0; b < 4; ++b) { const float cv = c[b * D + kc * 32 + k]; const float sv = cv * sigmoidf_(cv); a[b] += w * sv; } }
        float* mp = (float*)(p.ws + R_CX) + ((size_t)(l * 32 + kc) * 4) * 6144 + nb * 256 + lane * 4;
#pragma unroll
        for (int b = 0; b < 4; ++b) *(f32x4*)(mp + (size_t)b * 6144) = a[b];
    }
    for (int it = gw; it < I_LAYER; it += NGW) {
        int r = it;
        unsigned char* wl = p.ws + WS_W;
        if (r < I_IN) { const int kb = r / 256, g = r % 256; const int pn = g >> 3, bj = (g >> 2) & 1, wc = g & 3;
            transpose_item(p.in[5] + (size_t)l * D * INW, INW, D, 256 * pn + 64 * wc + 32 * bj, (bf16_t*)(wl + W_IN), 32 * g, 64 * kb, scr, lane); continue; }
        r -= I_IN;
        if (r < 3 * I_SQ) { const int which = r / I_SQ; r %= I_SQ; const int kb = r / 32, g = r % 32; const int pn = g >> 3, bj = (g >> 2) & 1, wc = g & 3;
            const float* src = p.in[9 + which] + (size_t)l * D * D; bf16_t* dst = (bf16_t*)(wl + (which == 0 ? W_A : which == 1 ? W_B : W_O));
            transpose_item(src, D, D, 256 * pn + 64 * wc + 32 * bj, dst, 32 * g, 64 * kb, scr, lane); continue; }
        r -= 3 * I_SQ;
        if (r < I_GU) { const int kb = r / 176, g = r % 176; const int pn = g >> 3, bj = (g >> 2) & 1, wc = g & 3;
            const float* src = p.in[bj ? 14 : 13] + (size_t)l * D * FF;
            transpose_item(src, FF, D, 128 * pn + 32 * wc, (bf16_t*)(wl + W_GU), 32 * g, 64 * kb, scr, lane); continue; }
        r -= I_GU;
        { const int kb = r / 32, g = r % 32; const int pn = g >> 3, bj = (g >> 2) & 1, wc = g & 3;
            transpose_item(p.in[15] + (size_t)l * FF * D, D, FF, 256 * pn + 64 * wc + 32 * bj, (bf16_t*)(wl + W_D), 32 * g, 64 * kb, scr, lane); }
    }
}

__device__ __forceinline__ void norm_phase(const float* x, const float* g, const float* modl, int sh_off, int sc_off, bf16_t* h, int gw, int NGW) {
    const int lane = lane_id_opaque();
    for (int m = gw; m < M; m += NGW) {
        const int b = m >> 12;
        const f32x4* xr = (const f32x4*)(x + (size_t)m * D) + lane;
        f32x4 v[4]; float s = 0.f;
#pragma unroll
        for (int j = 0; j < 4; ++j) { v[j] = xr[64 * j]; s += (v[j][0] * v[j][0] + v[j][1] * v[j][1]) + (v[j][2] * v[j][2] + v[j][3] * v[j][3]); }
        const float r = 1.0f / sqrtf(wave_sum(s, lane) * (1.0f / D) + EPS);
        u32x2* o8 = (u32x2*)(h + (size_t)m * D) + lane;
#pragma unroll
        for (int j = 0; j < 4; ++j) { const int col = 4 * (64 * j + lane);
            const f32x4 gg = *(const f32x4*)(g + col), sc = *(const f32x4*)(modl + b * 6144 + sc_off + col), sh = *(const f32x4*)(modl + b * 6144 + sh_off + col);
            const f32x4 y = (v[j] * r * gg) * (sc + 1.0f) + sh;
            u32x2 w; w.x = cvt_pk(y[0], y[1]); w.y = cvt_pk(y[2], y[3]); o8[64 * j] = w; }
    }
}

__device__ __forceinline__ void conv_phase(bf16_t* cb, const bf16_t* cc, const bf16_t* cx, const float* cw, int gt0, int NT) {
    const int gt = gt0 + lane_id_opaque();
    for (int it = gt; it < (M / 16) * (D / 8); it += NT) {
        const int c8 = it & 127, run = it >> 7, t0 = run * 16, ch = c8 * 8;
        float w0[8], w1[8], w2[8];
#pragma unroll
        for (int i = 0; i < 8; ++i) { w0[i] = cw[ch + i]; w1[i] = cw[D + ch + i]; w2[i] = cw[2 * D + ch + i]; }
        float um2[8], um1[8];
#pragma unroll
        for (int i = 0; i < 8; ++i) { um2[i] = 0.f; um1[i] = 0.f; }
        if ((t0 & (SEQ - 1)) != 0) {
            const u32x4 a2 = *(const u32x4*)(cc + (size_t)(t0 - 2) * D + ch), b2 = *(const u32x4*)(cx + (size_t)(t0 - 2) * D + ch);
            const u32x4 a1 = *(const u32x4*)(cc + (size_t)(t0 - 1) * D + ch), b1 = *(const u32x4*)(cx + (size_t)(t0 - 1) * D + ch);
#pragma unroll
            for (int i = 0; i < 4; ++i) { um2[2 * i] = bf_lo(a2[i]) * bf_lo(b2[i]); um2[2 * i + 1] = bf_hi(a2[i]) * bf_hi(b2[i]);
                um1[2 * i] = bf_lo(a1[i]) * bf_lo(b1[i]); um1[2 * i + 1] = bf_hi(a1[i]) * bf_hi(b1[i]); }
        }
#pragma unroll 4
        for (int t = 0; t < 16; ++t) {
            const size_t off = (size_t)(t0 + t) * D + ch;
            const u32x4 a = *(const u32x4*)(cc + off), b = *(const u32x4*)(cx + off), e = *(const u32x4*)(cb + off);
            float u[8], y[8];
#pragma unroll
            for (int i = 0; i < 4; ++i) { u[2 * i] = bf_lo(a[i]) * bf_lo(b[i]); u[2 * i + 1] = bf_hi(a[i]) * bf_hi(b[i]); }
#pragma unroll
            for (int i = 0; i < 4; ++i) {
                y[2 * i] = bf_lo(e[i]) * (w0[2 * i] * um2[2 * i] + w1[2 * i] * um1[2 * i] + w2[2 * i] * u[2 * i]);
                y[2 * i + 1] = bf_hi(e[i]) * (w0[2 * i + 1] * um2[2 * i + 1] + w1[2 * i + 1] * um1[2 * i + 1] + w2[2 * i + 1] * u[2 * i + 1]); }
            u32x4 o; o.x = cvt_pk(y[0], y[1]); o.y = cvt_pk(y[2], y[3]); o.z = cvt_pk(y[4], y[5]); o.w = cvt_pk(y[6], y[7]);
            *(u32x4*)(cb + off) = o;
#pragma unroll
            for (int i = 0; i < 8; ++i) { um2[i] = um1[i]; um1[i] = u[i]; }
        }
    }
}

#define MFMA32(a, b, c) __builtin_amdgcn_mfma_f32_32x32x16_bf16((a), (b), (c), 0, 0, 0)
constexpr float SB_EXIT = 1.0e-37f;
__device__ __forceinline__ float vmin_(float a, float b) { float r; asm("v_min_f32_e32 %0, %1, %2" : "=v"(r) : "v"(a), "v"(b)); return r; }
struct AttnState { f32x16 o0, o1; float P; bf16x8 kf[4]; };
template <bool DIAG>
__device__ __forceinline__ void attn_step(AttnState& st, const bf16x8 (&qf)[4], const bf16_t* kbase, const bf16_t* vbase, int j0, bool more, int n, int hh, int lane) {
    s16x4 vf[2][2][2];
#pragma unroll
    for (int mb = 0; mb < 2; ++mb)
#pragma unroll
        for (int s = 0; s < 2; ++s)
#pragma unroll
            for (int hf = 0; hf < 2; ++hf) vf[mb][s][hf] = *(const s16x4*)(vbase + (size_t)mb * 32 * SEQ + j0 + 16 * s + 8 * hf);
    f32x16 sa;
#pragma unroll
    for (int r = 0; r < 16; ++r) sa[r] = 0.f;
#pragma unroll
    for (int kk = 0; kk < 4; ++kk) sa = MFMA32(st.kf[kk], qf[kk], sa);
    if (more) {
#pragma unroll
        for (int kk = 0; kk < 4; ++kk) st.kf[kk] = *(const bf16x8*)(kbase + (size_t)(j0 - 32) * D + kk * 16);
    }
    float om[16], be[16];
#pragma unroll
    for (int r = 0; r < 16; ++r) {
        const float e = fast_exp2(vmin_(sa[r], 80.0f));
        float o = fast_rcp(1.0f + e), b = e * o;
        if (DIAG) { const int ki = (r & 3) + 8 * (r >> 2) + 4 * hh; if (ki >= n) { o = 1.0f; b = 0.f; } }
        om[r] = o; be[r] = b;
    }
    float g[4], pg[4];
#pragma unroll
    for (int q = 0; q < 4; ++q) g[q] = (om[4 * q] * om[4 * q + 1]) * (om[4 * q + 2] * om[4 * q + 3]);
#pragma unroll
    for (int q = 0; q < 4; ++q) pg[q] = shx(g[q], 32, lane);
    float run = st.P;
    float a[16];
#pragma unroll
    for (int q = 3; q >= 0; --q) {
        const float c3 = (hh == 0) ? run * pg[q] : run;
        const float c2 = c3 * om[4 * q + 3], c1 = c2 * om[4 * q + 2], c0 = c1 * om[4 * q + 1];
        a[4 * q + 3] = be[4 * q + 3] * c3; a[4 * q + 2] = be[4 * q + 2] * c2; a[4 * q + 1] = be[4 * q + 1] * c1; a[4 * q] = be[4 * q] * c0;
        run *= g[q] * pg[q];
    }
    st.P = run;
#pragma unroll
    for (int s = 0; s < 2; ++s) {
        u32x4 pw; pw.x = cvt_pk(a[8 * s + 0], a[8 * s + 1]); pw.y = cvt_pk(a[8 * s + 2], a[8 * s + 3]); pw.z = cvt_pk(a[8 * s + 4], a[8 * s + 5]); pw.w = cvt_pk(a[8 * s + 6], a[8 * s + 7]);
        const bf16x8 pf = __builtin_bit_cast(bf16x8, pw);
        const bf16x8 v0 = __builtin_shufflevector(vf[0][s][0], vf[0][s][1], 0, 1, 2, 3, 4, 5, 6, 7);
        const bf16x8 v1 = __builtin_shufflevector(vf[1][s][0], vf[1][s][1], 0, 1, 2, 3, 4, 5, 6, 7);
        st.o0 = MFMA32(v0, pf, st.o0); st.o1 = MFMA32(v1, pf, st.o1);
    }
}
__device__ __forceinline__ void attn_task(bf16_t* QO, const bf16_t* Kp, const bf16_t* VT, int b, int h, int qblk, int lane) {
    const int n = lane & 31, hh = lane >> 5, t0 = qblk * 32;
    bf16_t* qrow = QO + (size_t)(b * SEQ + t0 + n) * D + h * HD;
    bf16x8 qf[4];
#pragma unroll
    for (int kk = 0; kk < 4; ++kk) qf[kk] = *(const bf16x8*)(qrow + kk * 16 + hh * 8);
    AttnState st;
#pragma unroll
    for (int r = 0; r < 16; ++r) { st.o0[r] = 0.f; st.o1[r] = 0.f; }
    st.P = 1.0f;
    const bf16_t* kbase = Kp + (size_t)(b * SEQ + n) * D + h * HD + hh * 8;
    const bf16_t* vbase = VT + ((size_t)(b * NH + h) * HD + n) * SEQ + 4 * hh;
#pragma unroll
    for (int kk = 0; kk < 4; ++kk) st.kf[kk] = *(const bf16x8*)(kbase + (size_t)t0 * D + kk * 16);
    attn_step<true>(st, qf, kbase, vbase, t0, qblk > 0, n, hh, lane);
    for (int kb = qblk - 1; kb >= 0; --kb) {
        if (!__any(st.P > SB_EXIT)) break;
        attn_step<false>(st, qf, kbase, vbase, kb * 32, kb > 0, n, hh, lane);
    }
#pragma unroll
    for (int q = 0; q < 4; ++q) {
        u32x2 w0, w1; w0.x = cvt_pk(st.o0[4 * q], st.o0[4 * q + 1]); w0.y = cvt_pk(st.o0[4 * q + 2], st.o0[4 * q + 3]); w1.x = cvt_pk(st.o1[4 * q], st.o1[4 * q + 1]); w1.y = cvt_pk(st.o1[4 * q + 2], st.o1[4 * q + 3]);
        *(u32x2*)(qrow + 8 * q + 4 * hh) = w0; *(u32x2*)(qrow + 32 + 8 * q + 4 * hh) = w1;
    }
}
__device__ __forceinline__ void attn_phase(bf16_t* QO, const bf16_t* Kp, const bf16_t* VT, int gw, int NGW) {
    const int lane = lane_id_opaque();
    constexpr int NQB = SEQ / 32, NTASK = NB * NH * NQB;
    int i = 0;
    for (int tau = gw; tau < NTASK; tau += NGW, ++i) {
        const int bh = tau / NQB, qr = tau % NQB, qblk = (i & 1) ? (NQB - 1 - qr) : qr;
        attn_task(QO, Kp, VT, bh / NH, bh % NH, qblk, lane);
    }
}


__device__ __forceinline__ void mixer_phase(bf16_t* QO, const bf16_t* Kp, const bf16_t* VT, bf16_t* cb, const bf16_t* cc, const bf16_t* cx, const float* cw, int gw, int NGW, int wave, int gt0, int NT) {
    if (wave & 1) { conv_phase(cb, cc, cx, cw, gt0, NT); attn_phase(QO, Kp, VT, gw, NGW); }
    else          { attn_phase(QO, Kp, VT, gw, NGW); conv_phase(cb, cc, cx, cw, gt0, NT); }
}

#define XB_TMO      128
#define XB_XCNT(j)  (256  + 64 * (j))
#define XB_XSUB(j)  (1280 + 64 * (j))
#define XB_XGEN(j)  (2304 + 64 * (j))
#define XB_TOP      3328
#define XB_TOPGEN   3392
#define XCD_BAR_WORDS 3456
#define XB_SPIN_CAP (1u << 18)
__device__ __forceinline__ unsigned xb_ld(unsigned* p)              { return __hip_atomic_load(p, __ATOMIC_RELAXED, __HIP_MEMORY_SCOPE_AGENT); }
__device__ __forceinline__ unsigned xb_add(unsigned* p, unsigned v) { return __hip_atomic_fetch_add(p, v, __ATOMIC_RELAXED, __HIP_MEMORY_SCOPE_AGENT); }
__device__ __forceinline__ unsigned xb_xcc_id() { return (unsigned)__builtin_amdgcn_s_getreg((3 << 11) | 20) & 0xFu; }
#define XB_SPIN(cond, bar) do { unsigned _sp = 0; while (cond) { __builtin_amdgcn_s_sleep(1); \
    if ((++_sp & 255u) == 0u) { if (xb_ld(&(bar)[XB_TMO])) break; if (_sp > XB_SPIN_CAP) { atomicAdd(&(bar)[XB_TMO], 1u); break; } } } } while (0)
struct XcdBarrier { unsigned* bar; unsigned x; volatile LAS unsigned* st; };
__device__ __forceinline__ XcdBarrier xcd_barrier_post(unsigned* bar, volatile LAS unsigned* st, int tid) {
    XcdBarrier b; b.bar = bar; b.x = xb_xcc_id(); b.st = st;
    if (tid == 0) (void)xb_add(&bar[XB_XCNT(b.x)], 1u);
    return b;
}
__device__ __forceinline__ void xcd_barrier_complete(unsigned* bar, unsigned x, unsigned& nloc, unsigned& nx) {
    const unsigned G = gridDim.x * gridDim.y * gridDim.z;
    unsigned sum, cnt, mine, sp = 0u;
    for (;;) {
        sum = 0u; cnt = 0u; mine = 0u;
#pragma unroll
        for (unsigned j = 0; j < 16; ++j) { const unsigned c = xb_ld(&bar[XB_XCNT(j)]); sum += c; cnt += (c > 0u) ? 1u : 0u; mine = (j == x) ? c : mine; }
        if (sum == G) break;
        __builtin_amdgcn_s_sleep(1);
        if ((++sp & 255u) == 0u) { if (xb_ld(&bar[XB_TMO])) break; if (sp > XB_SPIN_CAP) { atomicAdd(&bar[XB_TMO], 1u); break; } }
    }
    nloc = mine > 0u ? mine : 1u; nx = cnt > 0u ? cnt : 1u;
}
__device__ __forceinline__ void xcd_barrier(const XcdBarrier& b, bool leader) {
    asm volatile("s_waitcnt vmcnt(0)" ::: "memory");
    __syncthreads();
    if (leader) {
        unsigned* bar = b.bar;
        __builtin_amdgcn_s_waitcnt(0);
        unsigned nloc = b.st[0], nx = b.st[1];
        if (nloc == 0u) { xcd_barrier_complete(bar, b.x, nloc, nx); b.st[0] = nloc; b.st[1] = nx; }
        const unsigned old = xb_add(&bar[XB_XSUB(b.x)], 1u);
        const unsigned gen = old / nloc;
        if (old + 1u == (gen + 1u) * nloc) {
            __builtin_amdgcn_fence(__ATOMIC_RELEASE, "agent");
            asm volatile("s_waitcnt vmcnt(0)" ::: "memory");
            const unsigned og = xb_add(&bar[XB_TOP], 1u);
            const unsigned tg = og / nx;
            if (og + 1u == (tg + 1u) * nx) xb_add(&bar[XB_TOPGEN], 1u);
            else XB_SPIN(xb_ld(&bar[XB_TOPGEN]) == tg, bar);
            __builtin_amdgcn_fence(__ATOMIC_ACQUIRE, "agent");
            xb_add(&bar[XB_XGEN(b.x)], 1u);
            asm volatile("s_waitcnt vmcnt(0)" ::: "memory");
        } else {
            XB_SPIN(xb_ld(&bar[XB_XGEN(b.x)]) == gen, bar);
            __builtin_amdgcn_fence(__ATOMIC_ACQUIRE, "agent");
            asm volatile("s_waitcnt vmcnt(0)" ::: "memory");
        }
    }
    __syncthreads();
}

constexpr int LDS_BYTES = 131072 + 1024;
__global__ void __launch_bounds__(NTHREADS, 2) fwd_kernel(Params p) {
    extern __shared__ __attribute__((aligned(16))) unsigned char lds_raw[];
    LAS unsigned char* lds = (LAS unsigned char*)lds_raw;
    cg::grid_group grid = cg::this_grid();
#define CG_SYNC() do { asm volatile("s_waitcnt vmcnt(0)" ::: "memory"); grid.sync(); if (wave == 0) { __builtin_amdgcn_fence(__ATOMIC_ACQUIRE, "agent"); asm volatile("s_waitcnt vmcnt(0)" ::: "memory"); } __syncthreads(); } while (0)
#define GRID_SYNC() xcd_barrier(xb, leader)
    const int tid0 = threadIdx.x, wave = __builtin_amdgcn_readfirstlane(tid0 >> 6);
    const int G = gridDim.x, bx = blockIdx.x;
    const int gw = bx * NWAVES + wave, NGW = G * NWAVES, NT = G * NTHREADS;
    unsigned char* ws = p.ws;
    float* mod = (float*)(ws + WS_CTL);
    bf16_t* Rh = (bf16_t*)(ws + R_H); bf16_t* Rq = (bf16_t*)(ws + R_Q); bf16_t* Rk = (bf16_t*)(ws + R_K); bf16_t* Rv = (bf16_t*)(ws + R_V);
    bf16_t* Rcb = (bf16_t*)(ws + R_CB); bf16_t* Rcc = (bf16_t*)(ws + R_CC); bf16_t* Rcx = (bf16_t*)(ws + R_CX);
    const unsigned char* wl = ws + WS_W;

    unsigned* barw = (unsigned*)(ws + WS_CTL + 200 * 1024);
    volatile LAS unsigned* bst = (volatile LAS unsigned*)(lds + 131072);
    const bool leader = (wave == 0) && (lane_id_opaque() == 0);
    if (leader) { bst[0] = 0u; bst[1] = 0u; }
    if (bx == 0) { const int t = wave * 64 + lane_id_opaque(); for (int i = t; i < XCD_BAR_WORDS; i += NTHREADS) barw[i] = 0u; }
    phase0(p, lds, gw, NGW, wave, lane_id_opaque(), 0, true);
    CG_SYNC();
    const XcdBarrier xb = xcd_barrier_post(barw, bst, leader ? 0 : 1);
    {
        const int gt = bx * NTHREADS + wave * 64 + lane_id_opaque();
        for (int it = gt; it < 2 * 4 * 1536; it += NT) {
            const int l = it / 6144, r = it % 6144, b = r / 1536, n4 = r % 1536;
            f32x4 a = *(const f32x4*)(p.in[3] + l * 6144 + n4 * 4);
            const float* mp = (const float*)(ws + R_CX) + ((size_t)(l * 32) * 4 + b) * 6144 + n4 * 4;
#pragma unroll 8
            for (int kc = 0; kc < 32; ++kc) a += *(const f32x4*)(mp + (size_t)kc * 4 * 6144);
            *(f32x4*)(mod + (size_t)(l * 4 + b) * 6144 + n4 * 4) = a;
        }
    }
    GRID_SYNC();
    norm_phase(p.in[0], p.in[4], mod, 0, 1024, Rh, gw, NGW);
    GRID_SYNC();

#pragma unroll 1
    for (int l = 0; l < DEPTH; ++l) {
        const float* modl = mod + (size_t)l * 4 * 6144;
        const float* xin = (l == 0) ? p.in[0] : p.out;
        { pg8::SchedPlain S; S.T.init(M, 6144); S.G = G; S.c = bx; S.A = (const char*)Rh; S.B = (const char*)(wl + W_IN); S.tstep = (size_t)256 * D * 2;
          pg8::EpiQKV E{Rq, p.in[6] + l * HD, p.in[7] + l * HD};
          pg8::gemm_phase(lds, D, S, E, wave); }
        GRID_SYNC();
        mixer_phase(Rq, Rk, Rv, Rcb, Rcc, Rcx, p.in[8] + (size_t)l * 3 * D, gw, NGW, wave, bx * NTHREADS + wave * 64, NT);
        GRID_SYNC();
        { pg8::SchedBranch S; S.T.init(M, D); S.G = G; S.c = bx; S.ws = (const char*)ws; S.wl = (const char*)wl; S.tstep = (size_t)256 * D * 2;
          pg8::EpiBranch E{Rv, Rk};
          pg8::gemm_phase(lds, D, S, E, wave); }
        GRID_SYNC();
        { pg8::SchedPlain S; S.T.init(M, D); S.G = G; S.c = bx; S.A = (const char*)Rk; S.B = (const char*)(wl + W_O); S.tstep = (size_t)256 * D * 2;
          pg8::EpiResid E{xin, p.out, modl + 2048};
          pg8::gemm_phase(lds, D, S, E, wave); }
        GRID_SYNC();
        norm_phase(p.out, p.in[12] + l * D, modl, 3072, 4096, Rh, gw, NGW);
        GRID_SYNC();
        { pg8::SchedPlain S; S.T.init(M, 2 * FF); S.G = G; S.c = bx; S.A = (const char*)Rh; S.B = (const char*)(wl + W_GU); S.tstep = (size_t)256 * D * 2;
          pg8::EpiGU E{Rq};
          pg8::gemm_phase(lds, D, S, E, wave); }
        GRID_SYNC();
        { pg8::SchedPlain S; S.T.init(M, D); S.G = G; S.c = bx; S.A = (const char*)Rq; S.B = (const char*)(wl + W_D); S.tstep = (size_t)256 * FF * 2;
          pg8::EpiResid E{p.out, p.out, modl + 5120};
          pg8::gemm_phase(lds, FF, S, E, wave); }
        if (l + 1 < DEPTH) {
            GRID_SYNC();
            phase0(p, lds, gw, NGW, wave, lane_id_opaque(), l + 1, false);
            norm_phase(p.out, p.in[4] + (l + 1) * D, mod + (size_t)(l + 1) * 4 * 6144, 0, 1024, Rh, gw, NGW);
            GRID_SYNC();
        }
    }
}

extern "C" void kernel_launch(void* const* d_in, const int* in_sizes, int n_in, void* d_out, int out_size, void* d_ws, size_t ws_size, hipStream_t stream) {
    static int grid_blocks = 0;
    if (grid_blocks == 0) {
        if (n_in != 16 || out_size != M * D || ws_size < WS_END) { fprintf(stderr, "kernel_launch: unexpected shapes (n_in %d out %d ws %zu need %zu)\n", n_in, out_size, ws_size, (size_t)WS_END); grid_blocks = -1; return; }
        int dev = 0, cus = 0, per_cu = 0;
        hipGetDevice(&dev);
        hipDeviceGetAttribute(&cus, hipDeviceAttributeMultiprocessorCount, dev);
        hipFuncSetAttribute((const void*)fwd_kernel, hipFuncAttributeMaxDynamicSharedMemorySize, LDS_BYTES);
        hipOccupancyMaxActiveBlocksPerMultiprocessor(&per_cu, (const void*)fwd_kernel, NTHREADS, LDS_BYTES);
        (void)hipGetLastError();
        if (per_cu < 1) { fprintf(stderr, "kernel_launch: occupancy query says %d blocks per CU\n", per_cu); per_cu = 1; }
        grid_blocks = cus;
    }
    if (grid_blocks < 0) return;
    Params p{};
    for (int i = 0; i < 16; ++i) p.in[i] = (const float*)d_in[i];
    p.out = (float*)d_out; p.ws = (unsigned char*)d_ws;
    void* args[] = {&p};
    hipError_t e = hipLaunchCooperativeKernel((const void*)fwd_kernel, dim3(grid_blocks), dim3(NTHREADS), args, LDS_BYTES, stream);
    if (e != hipSuccess) fprintf(stderr, "cooperative launch failed: %s (grid %d)\n", hipGetErrorString(e), grid_blocks);
}
```

```cpp
#include <hip/hip_runtime.h>
#include <hip/hip_cooperative_groups.h>
#include <cstdio>
#include <cstdint>
namespace cg = cooperative_groups;
#ifndef PROBE_MASK
#define PROBE_MASK 0
#endif

#define LAS __attribute__((address_space(3)))
typedef unsigned short bf16_t;
typedef short bf16x8 __attribute__((ext_vector_type(8)));
typedef short s16x4 __attribute__((ext_vector_type(4)));
typedef float f32x4 __attribute__((ext_vector_type(4)));
typedef float f32x16 __attribute__((ext_vector_type(16)));
typedef unsigned u32x4 __attribute__((ext_vector_type(4)));
typedef unsigned u32x2 __attribute__((ext_vector_type(2)));
typedef float f32x2_t __attribute__((ext_vector_type(2)));
typedef __bf16 bf16x2_t __attribute__((ext_vector_type(2)));

constexpr int D = 1024, NB = 4, SEQ = 4096, M = NB * SEQ, NH = 16, HD = 64, FF = 2816, INW = 8192, DEPTH = 2;
constexpr float EPS = 1e-6f;
constexpr float LOG2E = 1.4426950408889634f;
constexpr float C2 = 0.125f * LOG2E;
constexpr int NWAVES = 8, NTHREADS = 512;

constexpr size_t MiB = 1u << 20;
constexpr size_t WS_CTL = 0, CTL_BYTES = 256 * 1024;
constexpr size_t WS_W = 1 * MiB;
constexpr size_t W_IN = 0, W_A = 16 * MiB, W_B = 18 * MiB, W_O = 20 * MiB, W_GU = 22 * MiB, W_D = 33 * MiB, W_LAYER = 38 * MiB + 512 * 1024;
constexpr size_t WS_ACT = 40 * MiB;
constexpr size_t REG = 32 * MiB;
constexpr size_t R_H = WS_ACT, R_Q = WS_ACT + REG, R_K = WS_ACT + 2 * REG, R_V = WS_ACT + 3 * REG, R_CB = WS_ACT + 4 * REG, R_CC = WS_ACT + 5 * REG, R_CX = WS_ACT + 6 * REG, WS_END = WS_ACT + 7 * REG;
static_assert(WS_W + W_LAYER <= WS_ACT, "weights");
static_assert((size_t)M * FF * 2 <= 3 * REG, "ffn hidden fits R_Q..R_V");
static_assert(WS_END <= 279028736, "workspace >= sum of the inputs' bytes");

__device__ __forceinline__ unsigned cvt_pk(float lo, float hi) { f32x2_t v = {lo, hi}; bf16x2_t b = __builtin_convertvector(v, bf16x2_t); return __builtin_bit_cast(unsigned, b); }
__device__ __forceinline__ float bf_lo(unsigned u) { return __uint_as_float(u << 16); }
__device__ __forceinline__ float bf_hi(unsigned u) { return __uint_as_float(u & 0xffff0000u); }
__device__ __forceinline__ float shx(float v, int o, int lane) { return __int_as_float(__builtin_amdgcn_ds_bpermute((lane ^ o) << 2, __float_as_int(v))); }
__device__ __forceinline__ float wave_sum(float v, int lane) {
#pragma unroll
    for (int o = 1; o < 64; o <<= 1) v += shx(v, o, lane);
    return v;
}
__device__ __forceinline__ int lane_id_opaque() { int l; asm volatile("v_mbcnt_lo_u32_b32 %0, -1, 0\n\tv_mbcnt_hi_u32_b32 %0, -1, %0" : "=v"(l)); return l; }
__device__ __forceinline__ float fast_exp2(float x) { return __builtin_amdgcn_exp2f(x); }
__device__ __forceinline__ float fast_log2(float x) { return __builtin_amdgcn_logf(x); }
__device__ __forceinline__ float fast_rcp(float x) { return __builtin_amdgcn_rcpf(x); }
__device__ __forceinline__ float sigmoidf_(float x) { return fast_rcp(1.0f + fast_exp2(-x * LOG2E)); }

namespace pg8 {
constexpr int BM = 256, BK = 64, HALF = 128, HTB = HALF * BK * 2, STAGE_BYTES = 8 * HTB, NXCD = 8, WGM = 8;
__host__ __device__ __forceinline__ int lds_byte(int r, int c) { const int st = (r >> 4) * 2 + (c >> 5), rr = r & 15, cc = c & 31, ob = rr * 64 + cc * 2; return st * 1024 + (ob ^ (((ob >> 9) & 1) << 5)); }
__host__ __device__ __forceinline__ void stage_rc(int b, int& R, int& C) { const int st = b / 1024, sb = b % 1024, swz = sb ^ (((sb >> 9) & 1) << 5); R = (st >> 1) * 16 + swz / 64; C = (st & 1) * 32 + (swz % 64) / 2; }

struct Unit { const char* A; const char* B; int pm, pn, kind; };

struct TileOrder {
    int nM, nN, nwg;
    __device__ __forceinline__ void init(int Mr, int N) { nM = Mr / BM; nN = N / BM; nwg = nM * nN; }
    __device__ __forceinline__ void map(int wgid, int& pm, int& pn) const {
        { const int q = nwg / NXCD, r = nwg % NXCD, xcd = wgid % NXCD, off = wgid / NXCD; wgid = (xcd < r ? xcd * (q + 1) : r * (q + 1) + (xcd - r) * q) + off; }
        const int nig = WGM * nN, gid = wgid / nig, fm = gid * WGM, gsz = (nM - fm) < WGM ? (nM - fm) : WGM;
        pm = fm + ((wgid % nig) % gsz); pn = (wgid % nig) / gsz;
    }
};
struct SchedPlain {
    TileOrder T; int G, c; const char* A; const char* B; size_t tstep;
    __device__ __forceinline__ bool next(int i, Unit& u) const {
        const long L = (long)i * G + c; if (L >= T.nwg) return false;
        T.map((int)L, u.pm, u.pn); u.A = A + (size_t)u.pm * tstep; u.B = B + (size_t)u.pn * tstep; u.kind = 0; return true;
    }
};
struct SchedBranch {
    TileOrder T; int G, c; const char* ws; const char* wl; size_t tstep;
    __device__ __forceinline__ bool next(int i, Unit& u) const {
        const long L = (long)(i >> 2) * G + c; if (L >= T.nwg) return false;
        T.map((int)L, u.pm, u.pn); const int sub = i & 3; u.kind = sub;
        const size_t oa = (sub == 1) ? R_Q : ((sub == 3) ? R_CB : R_H);
        const size_t ob = (sub == 0) ? (W_IN + (size_t)6144 * D * 2) : (sub == 1) ? W_A : (sub == 2) ? (W_IN + (size_t)7168 * D * 2) : W_B;
        u.A = ws + oa + (size_t)u.pm * tstep; u.B = wl + ob + (size_t)u.pn * tstep; return true;
    }
};

template <class Epi, class Sched>
__device__ __forceinline__ void gemm_phase(LAS unsigned char* lds, const int K, const Sched& S, const Epi& E, const int wid) {
    const int lane = lane_id_opaque(), tid = wid * 64 + lane, wr = wid >> 2, wc = wid & 3, fr = lane & 15, fq = lane >> 4;
    const int nt = K / BK;
    unsigned voff[2];
#pragma unroll
    for (int i = 0; i < 2; ++i) { int R, C; stage_rc(tid * 16 + i * 8192, R, C); voff[i] = (unsigned)(R * K + C) * 2u; }
    const size_t kstep = (size_t)(BK * 2);
    const size_t hstep = (size_t)HALF * K * 2;
    const unsigned ldsw = (unsigned)wid * 1024u;
    const int aoff = lds_byte(wr * 64 + fr, fq * 8), boff = lds_byte(wc * 32 + fr, fq * 8);
#define PG8_SA(b, h) (((b) * 2 + (h)) * HTB)
#define PG8_SB(b, h) ((4 + (b) * 2 + (h)) * HTB)
#define PG8_STAGE(bufoff, gbase) do { _Pragma("unroll") for (int _i = 0; _i < 2; ++_i) \
        __builtin_amdgcn_global_load_lds((const unsigned*)((const char*)(gbase) + voff[_i]), (LAS unsigned*)(lds + (bufoff) + ldsw + _i * 8192), 16, 0, 0); } while (0)
#define PG8_LDA(dst, b, h) do { _Pragma("unroll") for (int m = 0; m < 4; ++m) _Pragma("unroll") for (int k = 0; k < 2; ++k) dst[m][k] = *(const LAS bf16x8*)(lds + PG8_SA(b, h) + aoff + m * 2048 + k * 1024); } while (0)
#define PG8_LDB(dst, b, h) do { _Pragma("unroll") for (int n = 0; n < 2; ++n) _Pragma("unroll") for (int k = 0; k < 2; ++k) dst[n][k] = *(const LAS bf16x8*)(lds + PG8_SB(b, h) + boff + n * 2048 + k * 1024); } while (0)
#define PG8_MMA(ai, bj, At, Bt) do { __builtin_amdgcn_s_setprio(1); _Pragma("unroll") for (int m = 0; m < 4; ++m) _Pragma("unroll") for (int n = 0; n < 2; ++n) _Pragma("unroll") for (int k = 0; k < 2; ++k) \
        acc[ai][bj][m][n] = __builtin_amdgcn_mfma_f32_16x16x32_bf16(Bt[n][k], At[m][k], acc[ai][bj][m][n], 0, 0, 0); __builtin_amdgcn_s_setprio(0); } while (0)
#define PG8_WAIT_V(n) asm volatile("s_waitcnt vmcnt(" #n ")" ::: "memory")
#define PG8_WAIT_L(n) asm volatile("s_waitcnt lgkmcnt(" #n ")" ::: "memory")
#define PG8_BAR __builtin_amdgcn_s_barrier()
#define PG8_SCHED __builtin_amdgcn_sched_barrier(0)
    Unit cur, nxt; int ui = 0;
    if (!S.next(0, cur)) return;
    f32x4 acc[2][2][4][2];
#pragma unroll
    for (int a = 0; a < 2; ++a)
#pragma unroll
        for (int b = 0; b < 2; ++b)
#pragma unroll
            for (int m = 0; m < 4; ++m)
#pragma unroll
                for (int n = 0; n < 2; ++n) acc[a][b][m][n] = (f32x4){0.f, 0.f, 0.f, 0.f};
    bf16x8 At[4][2], B0[2][2], B1[2][2];
    const char* cA = cur.A; const char* cB = cur.B;
    PG8_STAGE(PG8_SB(0, 0), cB); PG8_STAGE(PG8_SB(0, 1), cB + hstep); PG8_STAGE(PG8_SA(0, 0), cA); PG8_STAGE(PG8_SA(0, 1), cA + hstep);
    if (wr == 1) PG8_BAR;
    PG8_WAIT_V(2); PG8_BAR;
    PG8_STAGE(PG8_SB(1, 0), cB + kstep); PG8_STAGE(PG8_SA(1, 0), cA + kstep); PG8_STAGE(PG8_SB(1, 1), cB + hstep + kstep);
    PG8_WAIT_V(6); PG8_BAR;
    for (;;) {
        const bool has_next = S.next(ui + 1, nxt);
        const char* nA = has_next ? nxt.A : cA; const char* nB = has_next ? nxt.B : cB;
        for (int t = 0; t < nt; t += 2) {
            const bool last = (t == nt - 2);
            const char* a1 = cA + (size_t)(t + 1) * kstep;
            const char* a2 = last ? nA : cA + (size_t)(t + 2) * kstep; const char* b2 = last ? nB : cB + (size_t)(t + 2) * kstep;
            const char* a3 = a2 + kstep; const char* b3 = b2 + kstep;
            PG8_LDB(B0, 0, 0); PG8_LDB(B1, 0, 1); PG8_SCHED; PG8_LDA(At, 0, 0); PG8_STAGE(PG8_SA(1, 1), a1 + hstep);
            PG8_WAIT_V(8); PG8_WAIT_L(0); PG8_BAR; PG8_MMA(0, 0, At, B0); PG8_MMA(0, 1, At, B1); PG8_BAR; PG8_SCHED;
            PG8_LDA(At, 0, 1); PG8_STAGE(PG8_SB(0, 0), b2); PG8_STAGE(PG8_SB(0, 1), b2 + hstep); PG8_STAGE(PG8_SA(0, 0), a2);
            PG8_WAIT_V(8); PG8_WAIT_L(0); PG8_BAR; PG8_MMA(1, 0, At, B0); PG8_MMA(1, 1, At, B1); PG8_BAR; PG8_SCHED;
            PG8_LDB(B0, 1, 0); PG8_LDB(B1, 1, 1); PG8_SCHED; PG8_LDA(At, 1, 0); PG8_STAGE(PG8_SA(0, 1), a2 + hstep);
            PG8_WAIT_V(8); PG8_WAIT_L(0); PG8_BAR; PG8_MMA(0, 0, At, B0); PG8_MMA(0, 1, At, B1); PG8_BAR; PG8_SCHED;
            PG8_LDA(At, 1, 1); PG8_STAGE(PG8_SB(1, 0), b3); PG8_STAGE(PG8_SB(1, 1), b3 + hstep); PG8_STAGE(PG8_SA(1, 0), a3);
            PG8_WAIT_V(8); PG8_WAIT_L(0); PG8_BAR; PG8_MMA(1, 0, At, B0); PG8_MMA(1, 1, At, B1); PG8_BAR; PG8_SCHED;
        }
        if (wr == 0) PG8_BAR;
        { const int l2 = lane_id_opaque(); E(acc, cur, wr, wc, l2 & 15, l2 >> 4); }
        if (!has_next) break;
#pragma unroll
        for (int a = 0; a < 2; ++a)
#pragma unroll
            for (int b = 0; b < 2; ++b)
#pragma unroll
                for (int m = 0; m < 4; ++m)
#pragma unroll
                    for (int n = 0; n < 2; ++n) acc[a][b][m][n] = (f32x4){0.f, 0.f, 0.f, 0.f};
        cur = nxt; cA = nA; cB = nB; ++ui;
        if (wr == 1) PG8_BAR;
    }
    PG8_WAIT_V(0);
    PG8_BAR;
#undef PG8_SA
#undef PG8_SB
#undef PG8_STAGE
#undef PG8_LDA
#undef PG8_LDB
#undef PG8_MMA
#undef PG8_WAIT_V
#undef PG8_WAIT_L
#undef PG8_BAR
#undef PG8_SCHED
}

__device__ __forceinline__ u32x4 pack8(const f32x4& a, const f32x4& b) { u32x4 w; w.x = cvt_pk(a[0], a[1]); w.y = cvt_pk(a[2], a[3]); w.z = cvt_pk(b[0], b[1]); w.w = cvt_pk(b[2], b[3]); return w; }

struct EpiRegions {
    bf16_t* base;
    __device__ __forceinline__ void operator()(const f32x4 (&acc)[2][2][4][2], const Unit& u, int wr, int wc, int fr, int fq) const {
        bf16_t* dst = base + (size_t)(u.pn >> 2) * ((size_t)M * D);
        const int col = (u.pn & 3) * 256 + wc * 64 + fq * 8, row0 = u.pm * BM + wr * 64 + fr;
#pragma unroll
        for (int ai = 0; ai < 2; ++ai)
#pragma unroll
            for (int m = 0; m < 4; ++m) { bf16_t* rp = dst + (size_t)(row0 + ai * HALF + m * 16) * D + col;
#pragma unroll
                for (int bj = 0; bj < 2; ++bj) *(u32x4*)(rp + bj * 32) = pack8(acc[ai][bj][m][0], acc[ai][bj][m][1]); }
    }
};
struct EpiQKV {
    bf16_t* base; const float* gq; const float* gk;
    __device__ __forceinline__ void operator()(const f32x4 (&acc)[2][2][4][2], const Unit& u, int wr, int wc, int fr, int fq) const {
        const int region = u.pn >> 2, head = (u.pn & 3) * 4 + wc, row0 = u.pm * BM + wr * 64 + fr;
        if (region == 2) {
            const int b = row0 >> 12;
            bf16_t* vb = base + (size_t)2 * M * D + ((size_t)(b * NH + head) * HD) * SEQ;
#pragma unroll
            for (int ai = 0; ai < 2; ++ai)
#pragma unroll
                for (int m = 0; m < 4; ++m) { const int s = (row0 + ai * HALF + m * 16) & (SEQ - 1);
#pragma unroll
                    for (int bj = 0; bj < 2; ++bj)
#pragma unroll
                        for (int n = 0; n < 2; ++n)
#pragma unroll
                            for (int j = 0; j < 4; ++j) { const int d = bj * 32 + fq * 8 + n * 4 + j; const unsigned w = cvt_pk(acc[ai][bj][m][n][j], 0.f);
                                vb[(size_t)d * SEQ + s] = (bf16_t)(w & 0xffffu); } }
        } else if (region >= 3) {
            bf16_t* dst = base + (size_t)region * ((size_t)M * D);
            const int col = (u.pn & 3) * 256 + wc * 64 + fq * 8;
#pragma unroll
            for (int ai = 0; ai < 2; ++ai)
#pragma unroll
                for (int m = 0; m < 4; ++m) { bf16_t* rp = dst + (size_t)(row0 + ai * HALF + m * 16) * D + col;
#pragma unroll
                    for (int bj = 0; bj < 2; ++bj) *(u32x4*)(rp + bj * 32) = pack8(acc[ai][bj][m][0], acc[ai][bj][m][1]); }
        } else {
            const float* g = region == 0 ? gq : gk; const float sc = region == 0 ? C2 : 1.0f;
            bf16_t* dst = base + (size_t)region * ((size_t)M * D);
            f32x4 gv[2][2];
#pragma unroll
            for (int bj = 0; bj < 2; ++bj)
#pragma unroll
                for (int n = 0; n < 2; ++n) gv[bj][n] = *(const f32x4*)(g + bj * 32 + fq * 8 + n * 4) * sc;
            const int col = head * 64 + fq * 8;
#pragma unroll
            for (int ai = 0; ai < 2; ++ai)
#pragma unroll
                for (int m = 0; m < 4; ++m) {
                    float ss = 0.f;
#pragma unroll
                    for (int bj = 0; bj < 2; ++bj)
#pragma unroll
                        for (int n = 0; n < 2; ++n) { const f32x4 x = acc[ai][bj][m][n]; ss += (x[0] * x[0] + x[1] * x[1]) + (x[2] * x[2] + x[3] * x[3]); }
                    ss += shx(ss, 16, fr + 16 * fq); ss += shx(ss, 32, fr + 16 * fq);
                    const float r = 1.0f / sqrtf(ss * (1.0f / 64.0f) + EPS);
                    bf16_t* rp = dst + (size_t)(row0 + ai * HALF + m * 16) * D + col;
#pragma unroll
                    for (int bj = 0; bj < 2; ++bj) { const f32x4 a = acc[ai][bj][m][0] * r * gv[bj][0], b2 = acc[ai][bj][m][1] * r * gv[bj][1]; *(u32x4*)(rp + bj * 32) = pack8(a, b2); }
                }
        }
    }
};
struct EpiBranch {
    bf16_t* S1; bf16_t* TM;
    __device__ __forceinline__ void operator()(const f32x4 (&acc)[2][2][4][2], const Unit& u, int wr, int wc, int fr, int fq) const {
        const int col = u.pn * 256 + wc * 64 + fq * 8, row0 = u.pm * BM + wr * 64 + fr, kind = u.kind;
#pragma unroll
        for (int ai = 0; ai < 2; ++ai) {
            if (kind == 0 || kind == 2) {
#pragma unroll
                for (int m = 0; m < 4; ++m) { const size_t off = (size_t)(row0 + ai * HALF + m * 16) * D + col;
#pragma unroll
                    for (int bj = 0; bj < 2; ++bj) { f32x4 a = acc[ai][bj][m][0], b = acc[ai][bj][m][1];
#pragma unroll
                        for (int j = 0; j < 4; ++j) { a[j] = sigmoidf_(a[j]); b[j] = sigmoidf_(b[j]); }
                        *(u32x4*)(S1 + off + bj * 32) = pack8(a, b); } }
            } else {
#pragma unroll
              for (int mh = 0; mh < 2; ++mh) {
                u32x4 g[2][2], t[2][2];
#pragma unroll
                for (int m2 = 0; m2 < 2; ++m2) { const int m = 2 * mh + m2; const size_t off = (size_t)(row0 + ai * HALF + m * 16) * D + col;
#pragma unroll
                    for (int bj = 0; bj < 2; ++bj) { g[m2][bj] = *(const u32x4*)(S1 + off + bj * 32); if (kind == 3) t[m2][bj] = *(const u32x4*)(TM + off + bj * 32); else t[m2][bj] = (u32x4){0u, 0u, 0u, 0u}; } }
#pragma unroll
                for (int m2 = 0; m2 < 2; ++m2) { const int m = 2 * mh + m2; const size_t off = (size_t)(row0 + ai * HALF + m * 16) * D + col;
#pragma unroll
                    for (int bj = 0; bj < 2; ++bj) { f32x4 a = acc[ai][bj][m][0], b = acc[ai][bj][m][1]; const u32x4 gg = g[m2][bj], tt = t[m2][bj];
                        a[0] = a[0] * bf_lo(gg.x) + bf_lo(tt.x); a[1] = a[1] * bf_hi(gg.x) + bf_hi(tt.x); a[2] = a[2] * bf_lo(gg.y) + bf_lo(tt.y); a[3] = a[3] * bf_hi(gg.y) + bf_hi(tt.y);
                        b[0] = b[0] * bf_lo(gg.z) + bf_lo(tt.z); b[1] = b[1] * bf_hi(gg.z) + bf_hi(tt.z); b[2] = b[2] * bf_lo(gg.w) + bf_lo(tt.w); b[3] = b[3] * bf_hi(gg.w) + bf_hi(tt.w);
                        *(u32x4*)(TM + off + bj * 32) = pack8(a, b); } }
              }
            }
        }
    }
};
struct EpiResid {
    const float* xin; float* xout; const float* gmod;
    __device__ __forceinline__ void operator()(const f32x4 (&acc)[2][2][4][2], const Unit& u, int wr, int wc, int fr, int fq) const {
        const int col = u.pn * 256 + wc * 64 + fq * 8, row0 = u.pm * BM + wr * 64 + fr, b = row0 >> 12;
        f32x4 gv[2][2];
#pragma unroll
        for (int bj = 0; bj < 2; ++bj)
#pragma unroll
            for (int n = 0; n < 2; ++n) gv[bj][n] = *(const f32x4*)(gmod + b * 6144 + col + bj * 32 + n * 4);
#pragma unroll
        for (int ai = 0; ai < 2; ++ai)
#pragma unroll
          for (int mh = 0; mh < 2; ++mh) {
            f32x4 xo[2][2][2];
#pragma unroll
            for (int m2 = 0; m2 < 2; ++m2) { const size_t off = (size_t)(row0 + ai * HALF + (2 * mh + m2) * 16) * D + col;
#pragma unroll
                for (int bj = 0; bj < 2; ++bj)
#pragma unroll
                    for (int n = 0; n < 2; ++n) xo[m2][bj][n] = *(const f32x4*)(xin + off + bj * 32 + n * 4); }
#pragma unroll
            for (int m2 = 0; m2 < 2; ++m2) { const size_t off = (size_t)(row0 + ai * HALF + (2 * mh + m2) * 16) * D + col;
#pragma unroll
                for (int bj = 0; bj < 2; ++bj)
#pragma unroll
                    for (int n = 0; n < 2; ++n) *(f32x4*)(xout + off + bj * 32 + n * 4) = xo[m2][bj][n] + gv[bj][n] * acc[ai][bj][2 * mh + m2][n]; }
          }
    }
};
struct EpiGU {
    bf16_t* f;
    __device__ __forceinline__ void operator()(const f32x4 (&acc)[2][2][4][2], const Unit& u, int wr, int wc, int fr, int fq) const {
        const int col = u.pn * 128 + wc * 32 + fq * 8, row0 = u.pm * BM + wr * 64 + fr;
#pragma unroll
        for (int ai = 0; ai < 2; ++ai)
#pragma unroll
            for (int m = 0; m < 4; ++m) {
                f32x4 o[2];
#pragma unroll
                for (int n = 0; n < 2; ++n)
#pragma unroll
                    for (int j = 0; j < 4; ++j) { const float gt = acc[ai][0][m][n][j]; o[n][j] = gt * sigmoidf_(gt) * acc[ai][1][m][n][j]; }
                *(u32x4*)(f + (size_t)(row0 + ai * HALF + m * 16) * FF + col) = pack8(o[0], o[1]);
            }
    }
};
}

#define LDS_WAIT() asm volatile("s_waitcnt lgkmcnt(0)" ::: "memory")
__device__ __forceinline__ void transpose_item(const float* W, int N, int K, int n0, bf16_t* WT, int a0, int k0, LAS float* scr, int lane) {
    {
        const int kr = lane >> 3, c4 = (lane & 7) * 4;
        f32x4 t[8];
#pragma unroll
        for (int i = 0; i < 8; ++i) t[i] = *(const f32x4*)(W + (size_t)(k0 + 8 * i + kr) * N + n0 + c4);
#pragma unroll
        for (int i = 0; i < 8; ++i) { LAS float* d = scr + (8 * i + kr) * 33 + c4; d[0] = t[i][0]; d[1] = t[i][1]; d[2] = t[i][2]; d[3] = t[i][3]; }
    }
    LDS_WAIT(); asm volatile("" ::: "memory");
    const int c = lane & 7;
#pragma unroll
    for (int j = 0; j < 4; ++j) { const int s = (lane >> 3) + 8 * j; const int lo = 8 * ((s >> 2) & 3) + 4 * (s >> 4) + (s & 3);
        const LAS float* sp = scr + (8 * c) * 33 + lo;
        u32x4 o; o.x = cvt_pk(sp[0 * 33], sp[1 * 33]); o.y = cvt_pk(sp[2 * 33], sp[3 * 33]); o.z = cvt_pk(sp[4 * 33], sp[5 * 33]); o.w = cvt_pk(sp[6 * 33], sp[7 * 33]);
        *(u32x4*)(WT + (size_t)(a0 + s) * K + k0 + 8 * c) = o; }
    LDS_WAIT(); asm volatile("" ::: "memory");
}

struct Params { const float* in[16]; float* out; unsigned char* ws; };

__device__ __forceinline__ void phase0(const Params& p, LAS unsigned char* lds, int gw, int NGW, int wave, int lane, const int l, const bool with_mod) {
    LAS float* scr = (LAS float*)(lds + wave * 16384);
    constexpr int I_IN = 256 * 16, I_SQ = 32 * 16, I_GU = 176 * 16, I_D = 32 * 44, I_LAYER = I_IN + 3 * I_SQ + I_GU + I_D;
    constexpr int I_MOD = 2 * 32 * 24;
    for (int it = gw; it < (with_mod ? I_MOD : 0); it += NGW) {
        const int l = it / (32 * 24), r = it % (32 * 24), kc = r / 24, nb = r % 24;
        const float* aw = p.in[2] + (size_t)l * D * 6144 + (size_t)(kc * 32) * 6144 + nb * 256 + lane * 4;
        const float* c = p.in[1];
        f32x4 a[4];
#pragma unroll
        for (int b = 0; b < 4; ++b) a[b] = (f32x4){0.f, 0.f, 0.f, 0.f};
#pragma unroll 8
        for (int k = 0; k < 32; ++k) { const f32x4 w = *(const f32x4*)(aw + (size_t)k * 6144);
#pragma unroll
            for (int b = 0; b < 4; ++b) { const float cv = c[b * D + kc * 32 + k]; const float sv = cv * sigmoidf_(cv); a[b] += w * sv; } }
        float* mp = (float*)(p.ws + R_CX) + ((size_t)(l * 32 + kc) * 4) * 6144 + nb * 256 + lane * 4;
#pragma unroll
        for (int b = 0; b < 4; ++b) *(f32x4*)(mp + (size_t)b * 6144) = a[b];
    }
    for (int it = gw; it < I_LAYER; it += NGW) {
        int r = it;
        unsigned char* wl = p.ws + WS_W;
        if (r < I_IN) { const int kb = r / 256, g = r % 256; const int pn = g >> 3, bj = (g >> 2) & 1, wc = g & 3;
            transpose_item(p.in[5] + (size_t)l * D * INW, INW, D, 256 * pn + 64 * wc + 32 * bj, (bf16_t*)(wl + W_IN), 32 * g, 64 * kb, scr, lane); continue; }
        r -= I_IN;
        if (r < 3 * I_SQ) { const int which = r / I_SQ; r %= I_SQ; const int kb = r / 32, g = r % 32; const int pn = g >> 3, bj = (g >> 2) & 1, wc = g & 3;
            const float* src = p.in[9 + which] + (size_t)l * D * D; bf16_t* dst = (bf16_t*)(wl + (which == 0 ? W_A : which == 1 ? W_B : W_O));
            transpose_item(src, D, D, 256 * pn + 64 * wc + 32 * bj, dst, 32 * g, 64 * kb, scr, lane); continue; }
        r -= 3 * I_SQ;
        if (r < I_GU) { const int kb = r / 176, g = r % 176; const int pn = g >> 3, bj = (g >> 2) & 1, wc = g & 3;
            const float* src = p.in[bj ? 14 : 13] + (size_t)l * D * FF;
            transpose_item(src, FF, D, 128 * pn + 32 * wc, (bf16_t*)(wl + W_GU), 32 * g, 64 * kb, scr, lane); continue; }
        r -= I_GU;
        { const int kb = r / 32, g = r % 32; const int pn = g >> 3, bj = (g >> 2) & 1, wc = g & 3;
            transpose_item(p.in[15] + (size_t)l * FF * D, D, FF, 256 * pn + 64 * wc + 32 * bj, (bf16_t*)(wl + W_D), 32 * g, 64 * kb, scr, lane); }
    }
}

__device__ __forceinline__ void norm_phase(const float* x, const float* g, const float* modl, int sh_off, int sc_off, bf16_t* h, int gw, int NGW) {
    const int lane = lane_id_opaque();
    for (int q = gw; q < M / 4; q += NGW) {
        const int m0 = 4 * q, b = m0 >> 12;
        f32x4 v[4][4];
#pragma unroll
        for (int r = 0; r < 4; ++r) { const f32x4* xr = (const f32x4*)(x + (size_t)(m0 + r) * D) + lane;
#pragma unroll
            for (int j = 0; j < 4; ++j) v[r][j] = xr[64 * j]; }
        float rs[4];
#pragma unroll
        for (int r = 0; r < 4; ++r) { float s = 0.f;
#pragma unroll
            for (int j = 0; j < 4; ++j) s += (v[r][j][0] * v[r][j][0] + v[r][j][1] * v[r][j][1]) + (v[r][j][2] * v[r][j][2] + v[r][j][3] * v[r][j][3]);
            rs[r] = s; }
#pragma unroll
        for (int o = 1; o < 64; o <<= 1) {
#pragma unroll
            for (int r = 0; r < 4; ++r) rs[r] += shx(rs[r], o, lane); }
#pragma unroll
        for (int r = 0; r < 4; ++r) rs[r] = 1.0f / sqrtf(rs[r] * (1.0f / D) + EPS);
#pragma unroll
        for (int j = 0; j < 4; ++j) { const int col = 4 * (64 * j + lane);
            const f32x4 gg = *(const f32x4*)(g + col), sc = *(const f32x4*)(modl + b * 6144 + sc_off + col) + 1.0f, sh = *(const f32x4*)(modl + b * 6144 + sh_off + col);
#pragma unroll
            for (int r = 0; r < 4; ++r) { const f32x4 y = (v[r][j] * rs[r] * gg) * sc + sh;
                u32x2 w; w.x = cvt_pk(y[0], y[1]); w.y = cvt_pk(y[2], y[3]); *((u32x2*)(h + (size_t)(m0 + r) * D) + lane + 64 * j) = w; } }
    }
}

__device__ __forceinline__ void conv_phase(bf16_t* cb, const bf16_t* cc, const bf16_t* cx, const float* cw, int gt0, int NT) {
    const int gt = gt0 + lane_id_opaque();
    for (int it = gt; it < (M / 16) * (D / 8); it += NT) {
        const int c8 = it & 127, run = it >> 7, t0 = run * 16, ch = c8 * 8;
        float w0[8], w1[8], w2[8];
#pragma unroll
        for (int i = 0; i < 8; ++i) { w0[i] = cw[ch + i]; w1[i] = cw[D + ch + i]; w2[i] = cw[2 * D + ch + i]; }
        float um2[8], um1[8];
#pragma unroll
        for (int i = 0; i < 8; ++i) { um2[i] = 0.f; um1[i] = 0.f; }
        if ((t0 & (SEQ - 1)) != 0) {
            const u32x4 a2 = *(const u32x4*)(cc + (size_t)(t0 - 2) * D + ch), b2 = *(const u32x4*)(cx + (size_t)(t0 - 2) * D + ch);
            const u32x4 a1 = *(const u32x4*)(cc + (size_t)(t0 - 1) * D + ch), b1 = *(const u32x4*)(cx + (size_t)(t0 - 1) * D + ch);
#pragma unroll
            for (int i = 0; i < 4; ++i) { um2[2 * i] = bf_lo(a2[i]) * bf_lo(b2[i]); um2[2 * i + 1] = bf_hi(a2[i]) * bf_hi(b2[i]);
                um1[2 * i] = bf_lo(a1[i]) * bf_lo(b1[i]); um1[2 * i + 1] = bf_hi(a1[i]) * bf_hi(b1[i]); }
        }
#pragma unroll 4
        for (int t = 0; t < 16; ++t) {
            const size_t off = (size_t)(t0 + t) * D + ch;
            const u32x4 a = *(const u32x4*)(cc + off), b = *(const u32x4*)(cx + off), e = *(const u32x4*)(cb + off);
            float u[8], y[8];
#pragma unroll
            for (int i = 0; i < 4; ++i) { u[2 * i] = bf_lo(a[i]) * bf_lo(b[i]); u[2 * i + 1] = bf_hi(a[i]) * bf_hi(b[i]); }
#pragma unroll
            for (int i = 0; i < 4; ++i) {
                y[2 * i] = bf_lo(e[i]) * (w0[2 * i] * um2[2 * i] + w1[2 * i] * um1[2 * i] + w2[2 * i] * u[2 * i]);
                y[2 * i + 1] = bf_hi(e[i]) * (w0[2 * i + 1] * um2[2 * i + 1] + w1[2 * i + 1] * um1[2 * i + 1] + w2[2 * i + 1] * u[2 * i + 1]); }
            u32x4 o; o.x = cvt_pk(y[0], y[1]); o.y = cvt_pk(y[2], y[3]); o.z = cvt_pk(y[4], y[5]); o.w = cvt_pk(y[6], y[7]);
            *(u32x4*)(cb + off) = o;
#pragma unroll
            for (int i = 0; i < 8; ++i) { um2[i] = um1[i]; um1[i] = u[i]; }
        }
    }
}

#define MFMA32(a, b, c) __builtin_amdgcn_mfma_f32_32x32x16_bf16((a), (b), (c), 0, 0, 0)
constexpr float SB_EXIT = 1.0e-20f;
__device__ __forceinline__ float clamp_z(float z) { return __builtin_amdgcn_fmed3f(z, -126.0f, 80.0f); }
struct AttnState { f32x16 o0, o1; float P; bf16x8 kf[4]; };
template <bool DIAG>
__device__ __forceinline__ void attn_step(AttnState& st, const bf16x8 (&qf)[4], const bf16_t* kbase, const bf16_t* vbase, int j0, bool more, int n, int hh, int lane) {
    s16x4 vf[2][2][2];
#pragma unroll
    for (int mb = 0; mb < 2; ++mb)
#pragma unroll
        for (int s = 0; s < 2; ++s)
#pragma unroll
            for (int hf = 0; hf < 2; ++hf) vf[mb][s][hf] = *(const s16x4*)(vbase + (size_t)mb * 32 * SEQ + j0 + 16 * s + 8 * hf);
    f32x16 sa;
#pragma unroll
    for (int r = 0; r < 16; ++r) sa[r] = 0.f;
#pragma unroll
    for (int kk = 0; kk < 4; ++kk) sa = MFMA32(st.kf[kk], qf[kk], sa);
    if (more) {
#pragma unroll
        for (int kk = 0; kk < 4; ++kk) st.kf[kk] = *(const bf16x8*)(kbase + (size_t)(j0 - 32) * D + kk * 16);
    }
    float om[16], be[16];
#pragma unroll
    for (int r = 0; r < 16; ++r) {
        const float e = fast_exp2(clamp_z(sa[r]));
        float o = fast_rcp(1.0f + e), b = e * o;
        if (DIAG) { const int ki = (r & 3) + 8 * (r >> 2) + 4 * hh; if (ki >= n) { o = 1.0f; b = 0.f; } }
        om[r] = o; be[r] = b;
    }
    float g[4], pg[4];
#pragma unroll
    for (int q = 0; q < 4; ++q) g[q] = (om[4 * q] * om[4 * q + 1]) * (om[4 * q + 2] * om[4 * q + 3]);
#pragma unroll
    for (int q = 0; q < 4; ++q) pg[q] = shx(g[q], 32, lane);
    float run = st.P;
    float a[16];
#pragma unroll
    for (int q = 3; q >= 0; --q) {
        const float c3 = (hh == 0) ? run * pg[q] : run;
        const float c2 = c3 * om[4 * q + 3], c1 = c2 * om[4 * q + 2], c0 = c1 * om[4 * q + 1];
        a[4 * q + 3] = be[4 * q + 3] * c3; a[4 * q + 2] = be[4 * q + 2] * c2; a[4 * q + 1] = be[4 * q + 1] * c1; a[4 * q] = be[4 * q] * c0;
        run *= g[q] * pg[q];
    }
    st.P = run;
#pragma unroll
    for (int s = 0; s < 2; ++s) {
        u32x4 pw; pw.x = cvt_pk(a[8 * s + 0], a[8 * s + 1]); pw.y = cvt_pk(a[8 * s + 2], a[8 * s + 3]); pw.z = cvt_pk(a[8 * s + 4], a[8 * s + 5]); pw.w = cvt_pk(a[8 * s + 6], a[8 * s + 7]);
        const bf16x8 pf = __builtin_bit_cast(bf16x8, pw);
        const bf16x8 v0 = __builtin_shufflevector(vf[0][s][0], vf[0][s][1], 0, 1, 2, 3, 4, 5, 6, 7);
        const bf16x8 v1 = __builtin_shufflevector(vf[1][s][0], vf[1][s][1], 0, 1, 2, 3, 4, 5, 6, 7);
        st.o0 = MFMA32(v0, pf, st.o0); st.o1 = MFMA32(v1, pf, st.o1);
    }
}
__device__ __forceinline__ void attn_task(bf16_t* QO, const bf16_t* Kp, const bf16_t* VT, int b, int h, int qblk, int lane) {
    const int n = lane & 31, hh = lane >> 5, t0 = qblk * 32;
    bf16_t* qrow = QO + (size_t)(b * SEQ + t0 + n) * D + h * HD;
    bf16x8 qf[4];
#pragma unroll
    for (int kk = 0; kk < 4; ++kk) qf[kk] = *(const bf16x8*)(qrow + kk * 16 + hh * 8);
    AttnState st;
#pragma unroll
    for (int r = 0; r < 16; ++r) { st.o0[r] = 0.f; st.o1[r] = 0.f; }
    st.P = 1.0f;
    const bf16_t* kbase = Kp + (size_t)(b * SEQ + n) * D + h * HD + hh * 8;
    const bf16_t* vbase = VT + ((size_t)(b * NH + h) * HD + n) * SEQ + 4 * hh;
#pragma unroll
    for (int kk = 0; kk < 4; ++kk) st.kf[kk] = *(const bf16x8*)(kbase + (size_t)t0 * D + kk * 16);
    attn_step<true>(st, qf, kbase, vbase, t0, qblk > 0, n, hh, lane);
    for (int kb = qblk - 1; kb >= 0; --kb) {
        if (!__any(st.P > SB_EXIT)) break;
        attn_step<false>(st, qf, kbase, vbase, kb * 32, kb > 0, n, hh, lane);
    }
#pragma unroll
    for (int q = 0; q < 4; ++q) {
        u32x2 w0, w1; w0.x = cvt_pk(st.o0[4 * q], st.o0[4 * q + 1]); w0.y = cvt_pk(st.o0[4 * q + 2], st.o0[4 * q + 3]); w1.x = cvt_pk(st.o1[4 * q], st.o1[4 * q + 1]); w1.y = cvt_pk(st.o1[4 * q + 2], st.o1[4 * q + 3]);
        *(u32x2*)(qrow + 8 * q + 4 * hh) = w0; *(u32x2*)(qrow + 32 + 8 * q + 4 * hh) = w1;
    }
}
__device__ __forceinline__ void attn_phase(bf16_t* QO, const bf16_t* Kp, const bf16_t* VT, int G, int bx, int wave) {
    const int lane = lane_id_opaque();
    constexpr int NQB = SEQ / 32, NTASK = NB * NH * NQB;
    if (G == 256) {
#pragma unroll 1
        for (int i = 0; i < 4; ++i) { const int bh = 2 * (wave * 4 + i) + (bx & 1); attn_task(QO, Kp, VT, bh / NH, bh % NH, bx >> 1, lane); }
    } else {
        int i = 0;
        for (int tau = bx * NWAVES + wave; tau < NTASK; tau += G * NWAVES, ++i) {
            const int bh = tau / NQB, qr = tau % NQB, qblk = (i & 1) ? (NQB - 1 - qr) : qr;
            attn_task(QO, Kp, VT, bh / NH, bh % NH, qblk, lane);
        }
    }
}
__device__ __forceinline__ void mixer_phase(bf16_t* QO, const bf16_t* Kp, const bf16_t* VT, bf16_t* cb, const bf16_t* cc, const bf16_t* cx, const float* cw, int G, int bx, int wave, int gt0, int NT) {
    if (wave & 4) { conv_phase(cb, cc, cx, cw, gt0, NT); attn_phase(QO, Kp, VT, G, bx, wave); }
    else          { attn_phase(QO, Kp, VT, G, bx, wave); conv_phase(cb, cc, cx, cw, gt0, NT); }
}

#define XB_TMO      128
#define XB_XCNT(j)  (256  + 64 * (j))
#define XB_XSUB(j)  (1280 + 64 * (j))
#define XB_XGEN(j)  (2304 + 64 * (j))
#define XB_TOP      3328
#define XB_TOPGEN   3392
#define XCD_BAR_WORDS 3456
#define XB_SPIN_CAP (1u << 18)
__device__ __forceinline__ unsigned xb_ld(unsigned* p)              { return __hip_atomic_load(p, __ATOMIC_RELAXED, __HIP_MEMORY_SCOPE_AGENT); }
__device__ __forceinline__ unsigned xb_add(unsigned* p, unsigned v) { return __hip_atomic_fetch_add(p, v, __ATOMIC_RELAXED, __HIP_MEMORY_SCOPE_AGENT); }
__device__ __forceinline__ unsigned xb_xcc_id() { return (unsigned)__builtin_amdgcn_s_getreg((3 << 11) | 20) & 0xFu; }
#define XB_SPIN(cond, bar) do { unsigned _sp = 0; while (cond) { __builtin_amdgcn_s_sleep(1); \
    if ((++_sp & 255u) == 0u) { if (xb_ld(&(bar)[XB_TMO])) break; if (_sp > XB_SPIN_CAP) { atomicAdd(&(bar)[XB_TMO], 1u); break; } } } } while (0)
struct XcdBarrier { unsigned* bar; unsigned x; volatile LAS unsigned* st; };
__device__ __forceinline__ XcdBarrier xcd_barrier_post(unsigned* bar, volatile LAS unsigned* st, int tid) {
    XcdBarrier b; b.bar = bar; b.x = xb_xcc_id(); b.st = st;
    if (tid == 0) (void)xb_add(&bar[XB_XCNT(b.x)], 1u);
    return b;
}
__device__ __forceinline__ void xcd_barrier_complete(unsigned* bar, unsigned x, unsigned& nloc, unsigned& nx) {
    const unsigned G = gridDim.x * gridDim.y * gridDim.z;
    unsigned sum, cnt, mine, sp = 0u;
    for (;;) {
        sum = 0u; cnt = 0u; mine = 0u;
#pragma unroll
        for (unsigned j = 0; j < 16; ++j) { const unsigned c = xb_ld(&bar[XB_XCNT(j)]); sum += c; cnt += (c > 0u) ? 1u : 0u; mine = (j == x) ? c : mine; }
        if (sum == G) break;
        __builtin_amdgcn_s_sleep(1);
        if ((++sp & 255u) == 0u) { if (xb_ld(&bar[XB_TMO])) break; if (sp > XB_SPIN_CAP) { atomicAdd(&bar[XB_TMO], 1u); break; } }
    }
    nloc = mine > 0u ? mine : 1u; nx = cnt > 0u ? cnt : 1u;
}
__device__ __forceinline__ void xcd_barrier(const XcdBarrier& b, bool leader) {
    asm volatile("s_waitcnt vmcnt(0)" ::: "memory");
    __syncthreads();
    if (leader) {
        unsigned* bar = b.bar;
        __builtin_amdgcn_s_waitcnt(0);
        unsigned nloc = b.st[0], nx = b.st[1];
        if (nloc == 0u) { xcd_barrier_complete(bar, b.x, nloc, nx); b.st[0] = nloc; b.st[1] = nx; }
        const unsigned old = xb_add(&bar[XB_XSUB(b.x)], 1u);
        const unsigned gen = old / nloc;
        if (old + 1u == (gen + 1u) * nloc) {
            __builtin_amdgcn_fence(__ATOMIC_RELEASE, "agent");
            asm volatile("s_waitcnt vmcnt(0)" ::: "memory");
            const unsigned og = xb_add(&bar[XB_TOP], 1u);
            const unsigned tg = og / nx;
            if (og + 1u == (tg + 1u) * nx) xb_add(&bar[XB_TOPGEN], 1u);
            else XB_SPIN(xb_ld(&bar[XB_TOPGEN]) == tg, bar);
            __builtin_amdgcn_fence(__ATOMIC_ACQUIRE, "agent");
            xb_add(&bar[XB_XGEN(b.x)], 1u);
            asm volatile("s_waitcnt vmcnt(0)" ::: "memory");
        } else {
            XB_SPIN(xb_ld(&bar[XB_XGEN(b.x)]) == gen, bar);
            __builtin_amdgcn_fence(__ATOMIC_ACQUIRE, "agent");
            asm volatile("s_waitcnt vmcnt(0)" ::: "memory");
        }
    }
    __syncthreads();
}

#define XB_DONE XCD_BAR_WORDS
__device__ unsigned g_bar[XCD_BAR_WORDS + 64];

constexpr int LDS_BYTES = 131072 + 1024;
__global__ void __launch_bounds__(NTHREADS, 2) fwd_kernel(Params p) {
    extern __shared__ __attribute__((aligned(16))) unsigned char lds_raw[];
    LAS unsigned char* lds = (LAS unsigned char*)lds_raw;
    cg::grid_group grid = cg::this_grid();
#define CG_SYNC() do { asm volatile("s_waitcnt vmcnt(0)" ::: "memory"); grid.sync(); if (wave == 0) { __builtin_amdgcn_fence(__ATOMIC_ACQUIRE, "agent"); asm volatile("s_waitcnt vmcnt(0)" ::: "memory"); } __syncthreads(); } while (0)
#define GRID_SYNC_() xcd_barrier(xb, leader)
    unsigned long long pr_acc = 0, pr_t0 = 0;
#define TIC() do { if (PROBE_MASK) pr_t0 = __builtin_amdgcn_s_memrealtime(); } while (0)
#define TOC(bit) do { if (PROBE_MASK & (bit)) pr_acc += __builtin_amdgcn_s_memrealtime() - pr_t0; } while (0)
#define GRID_SYNC() do { TIC(); GRID_SYNC_(); TOC(2 | sync_kind); } while (0)
    int sync_kind = 128;
    const int tid0 = threadIdx.x, wave = __builtin_amdgcn_readfirstlane(tid0 >> 6);
    const int G = gridDim.x, bx = blockIdx.x;
    const int gw = bx * NWAVES + wave, NGW = G * NWAVES, NT = G * NTHREADS;
    unsigned char* ws = p.ws;
    float* mod = (float*)(ws + WS_CTL);
    bf16_t* Rh = (bf16_t*)(ws + R_H); bf16_t* Rq = (bf16_t*)(ws + R_Q); bf16_t* Rk = (bf16_t*)(ws + R_K); bf16_t* Rv = (bf16_t*)(ws + R_V);
    bf16_t* Rcb = (bf16_t*)(ws + R_CB); bf16_t* Rcc = (bf16_t*)(ws + R_CC); bf16_t* Rcx = (bf16_t*)(ws + R_CX);
    const unsigned char* wl = ws + WS_W;

    unsigned* barw = g_bar;
    volatile LAS unsigned* bst = (volatile LAS unsigned*)(lds + 131072);
    const bool leader = (wave == 0) && (lane_id_opaque() == 0);
    if (leader) { bst[0] = 0u; bst[1] = 0u; bst[2] = 0u; }
    const XcdBarrier xb = xcd_barrier_post(barw, bst, leader ? 0 : 1);
    if (G == 0x7fffffff) CG_SYNC();
    TIC();
    phase0(p, lds, gw, NGW, wave, lane_id_opaque(), 0, true);
    TOC(16);
    GRID_SYNC();
    TIC();
    {
        const int gt = bx * NTHREADS + wave * 64 + lane_id_opaque();
        for (int it = gt; it < 2 * 4 * 1536; it += NT) {
            const int l = it / 6144, r = it % 6144, b = r / 1536, n4 = r % 1536;
            f32x4 a = *(const f32x4*)(p.in[3] + l * 6144 + n4 * 4);
            const float* mp = (const float*)(ws + R_CX) + ((size_t)(l * 32) * 4 + b) * 6144 + n4 * 4;
#pragma unroll 8
            for (int kc = 0; kc < 32; ++kc) a += *(const f32x4*)(mp + (size_t)kc * 4 * 6144);
            *(f32x4*)(mod + (size_t)(l * 4 + b) * 6144 + n4 * 4) = a;
        }
    }
    TOC(16);
    GRID_SYNC();
    TIC(); norm_phase(p.in[0], p.in[4], mod, 0, 1024, Rh, gw, NGW); TOC(8); sync_kind = 128;
    GRID_SYNC();

#pragma unroll 1
    for (int l = 0; l < DEPTH; ++l) {
        const float* modl = mod + (size_t)l * 4 * 6144;
        const float* xin = (l == 0) ? p.in[0] : p.out;
        { pg8::SchedPlain S; S.T.init(M, 6144); S.G = G; S.c = bx; S.A = (const char*)Rh; S.B = (const char*)(wl + W_IN); S.tstep = (size_t)256 * D * 2;
          pg8::EpiQKV E{Rq, p.in[6] + l * HD, p.in[7] + l * HD};
          TIC(); pg8::gemm_phase(lds, D, S, E, wave); TOC(1); sync_kind = 32; }
        GRID_SYNC();
        TIC(); mixer_phase(Rq, Rk, Rv, Rcb, Rcc, Rcx, p.in[8] + (size_t)l * 3 * D, G, bx, wave, bx * NTHREADS + wave * 64, NT); TOC(4); sync_kind = 64;
        GRID_SYNC();
        { pg8::SchedBranch S; S.T.init(M, D); S.G = G; S.c = bx; S.ws = (const char*)ws; S.wl = (const char*)wl; S.tstep = (size_t)256 * D * 2;
          pg8::EpiBranch E{Rv, Rk};
          TIC(); pg8::gemm_phase(lds, D, S, E, wave); TOC(1); sync_kind = 32; }
        GRID_SYNC();
        { pg8::SchedPlain S; S.T.init(M, D); S.G = G; S.c = bx; S.A = (const char*)Rk; S.B = (const char*)(wl + W_O); S.tstep = (size_t)256 * D * 2;
          pg8::EpiResid E{xin, p.out, modl + 2048};
          TIC(); pg8::gemm_phase(lds, D, S, E, wave); TOC(1); sync_kind = 32; }
        GRID_SYNC();
        TIC(); norm_phase(p.out, p.in[12] + l * D, modl, 3072, 4096, Rh, gw, NGW); TOC(8); sync_kind = 128;
        GRID_SYNC();
        { pg8::SchedPlain S; S.T.init(M, 2 * FF); S.G = G; S.c = bx; S.A = (const char*)Rh; S.B = (const char*)(wl + W_GU); S.tstep = (size_t)256 * D * 2;
          pg8::EpiGU E{Rq};
          TIC(); pg8::gemm_phase(lds, D, S, E, wave); TOC(1); sync_kind = 32; }
        GRID_SYNC();
        { pg8::SchedPlain S; S.T.init(M, D); S.G = G; S.c = bx; S.A = (const char*)Rq; S.B = (const char*)(wl + W_D); S.tstep = (size_t)256 * FF * 2;
          pg8::EpiResid E{p.out, p.out, modl + 5120};
          TIC(); pg8::gemm_phase(lds, FF, S, E, wave); TOC(1); sync_kind = 32; }
        if (l + 1 < DEPTH) {
            GRID_SYNC();
            TIC();
            phase0(p, lds, gw, NGW, wave, lane_id_opaque(), l + 1, false);
            norm_phase(p.out, p.in[4] + (l + 1) * D, mod + (size_t)(l + 1) * 4 * 6144, 0, 1024, Rh, gw, NGW);
            TOC(8); sync_kind = 128;
            GRID_SYNC();
        }
    }
    asm volatile("s_waitcnt vmcnt(0)" ::: "memory");
    if (leader) { const unsigned old = xb_add(&barw[XB_DONE], 1u); bst[2] = (old + 1u == (unsigned)G) ? 1u : 0u; }
    __syncthreads();
    if (bst[2]) { const int t = wave * 64 + lane_id_opaque(); for (int i = t; i < XCD_BAR_WORDS + 64; i += NTHREADS) __hip_atomic_store(&barw[i], 0u, __ATOMIC_RELAXED, __HIP_MEMORY_SCOPE_AGENT); }
    if (PROBE_MASK && bx == 0 && leader) { const unsigned long long t = __builtin_amdgcn_s_memrealtime(); while (__builtin_amdgcn_s_memrealtime() - t < pr_acc) __builtin_amdgcn_s_sleep(8); }
}

extern "C" void kernel_launch(void* const* d_in, const int* in_sizes, int n_in, void* d_out, int out_size, void* d_ws, size_t ws_size, hipStream_t stream) {
    static int grid_blocks = 0;
    if (grid_blocks == 0) {
        if (n_in != 16 || out_size != M * D || ws_size < WS_END) { fprintf(stderr, "kernel_launch: unexpected shapes (n_in %d out %d ws %zu need %zu)\n", n_in, out_size, ws_size, (size_t)WS_END); grid_blocks = -1; return; }
        int dev = 0, cus = 0, per_cu = 0;
        hipGetDevice(&dev);
        hipDeviceGetAttribute(&cus, hipDeviceAttributeMultiprocessorCount, dev);
        hipFuncSetAttribute((const void*)fwd_kernel, hipFuncAttributeMaxDynamicSharedMemorySize, LDS_BYTES);
        hipOccupancyMaxActiveBlocksPerMultiprocessor(&per_cu, (const void*)fwd_kernel, NTHREADS, LDS_BYTES);
        (void)hipGetLastError();
        if (per_cu < 1) { fprintf(stderr, "kernel_launch: occupancy query says %d blocks per CU\n", per_cu); per_cu = 1; }
        grid_blocks = cus;
    }
    if (grid_blocks < 0) return;
    Params p{};
    for (int i = 0; i < 16; ++i) p.in[i] = (const float*)d_in[i];
    p.out = (float*)d_out; p.ws = (unsigned char*)d_ws;
    void* args[] = {&p};
    hipError_t e = hipLaunchCooperativeKernel((const void*)fwd_kernel, dim3(grid_blocks), dim3(NTHREADS), args, LDS_BYTES, stream);
    if (e != hipSuccess) fprintf(stderr, "cooperative launch failed: %s (grid %d)\n", hipGetErrorString(e), grid_blocks);
}
```

```cpp
#include <hip/hip_runtime.h>
#include <hip/hip_cooperative_groups.h>
#include <cstdio>
#include <cstdint>
namespace cg = cooperative_groups;
#ifndef PROBE_MASK
#define PROBE_MASK 0
#endif

#define LAS __attribute__((address_space(3)))
typedef unsigned short bf16_t;
typedef short bf16x8 __attribute__((ext_vector_type(8)));
typedef short s16x4 __attribute__((ext_vector_type(4)));
typedef float f32x4 __attribute__((ext_vector_type(4)));
typedef float f32x16 __attribute__((ext_vector_type(16)));
typedef unsigned u32x4 __attribute__((ext_vector_type(4)));
typedef unsigned u32x2 __attribute__((ext_vector_type(2)));
typedef float f32x2_t __attribute__((ext_vector_type(2)));
typedef __bf16 bf16x2_t __attribute__((ext_vector_type(2)));

constexpr int D = 1024, NB = 4, SEQ = 4096, M = NB * SEQ, NH = 16, HD = 64, FF = 2816, INW = 8192, DEPTH = 2;
constexpr float EPS = 1e-6f;
constexpr float LOG2E = 1.4426950408889634f;
constexpr float C2 = 0.125f * LOG2E;
constexpr int NWAVES = 8, NTHREADS = 512;

constexpr size_t MiB = 1u << 20;
constexpr size_t WS_CTL = 0, CTL_BYTES = 256 * 1024;
constexpr size_t WS_W = 1 * MiB;
constexpr size_t W_IN = 0, W_A = 16 * MiB, W_B = 18 * MiB, W_O = 20 * MiB, W_GU = 22 * MiB, W_D = 33 * MiB, W_LAYER = 38 * MiB + 512 * 1024;
constexpr size_t WS_ACT = 40 * MiB;
constexpr size_t REG = 32 * MiB;
constexpr size_t R_H = WS_ACT, R_Q = WS_ACT + REG, R_K = WS_ACT + 2 * REG, R_V = WS_ACT + 3 * REG, R_CB = WS_ACT + 4 * REG, R_CC = WS_ACT + 5 * REG, R_CX = WS_ACT + 6 * REG, WS_END = WS_ACT + 7 * REG;
static_assert(WS_W + W_LAYER <= WS_ACT, "weights");
static_assert((size_t)M * FF * 2 <= 3 * REG, "ffn hidden fits R_Q..R_V");
static_assert(WS_END <= 279028736, "workspace >= sum of the inputs' bytes");

__device__ __forceinline__ unsigned cvt_pk(float lo, float hi) { f32x2_t v = {lo, hi}; bf16x2_t b = __builtin_convertvector(v, bf16x2_t); return __builtin_bit_cast(unsigned, b); }
__device__ __forceinline__ float bf_lo(unsigned u) { return __uint_as_float(u << 16); }
__device__ __forceinline__ float bf_hi(unsigned u) { return __uint_as_float(u & 0xffff0000u); }
__device__ __forceinline__ float shx(float v, int o, int lane) { return __int_as_float(__builtin_amdgcn_ds_bpermute((lane ^ o) << 2, __float_as_int(v))); }
__device__ __forceinline__ float wave_sum(float v, int lane) {
#pragma unroll
    for (int o = 1; o < 64; o <<= 1) v += shx(v, o, lane);
    return v;
}
__device__ __forceinline__ int lane_id_opaque() { int l; asm volatile("v_mbcnt_lo_u32_b32 %0, -1, 0\n\tv_mbcnt_hi_u32_b32 %0, -1, %0" : "=v"(l)); return l; }
__device__ __forceinline__ float fast_exp2(float x) { return __builtin_amdgcn_exp2f(x); }
__device__ __forceinline__ float fast_log2(float x) { return __builtin_amdgcn_logf(x); }
__device__ __forceinline__ float fast_rcp(float x) { return __builtin_amdgcn_rcpf(x); }
__device__ __forceinline__ float sigmoidf_(float x) { return fast_rcp(1.0f + fast_exp2(-x * LOG2E)); }

namespace pg8 {
constexpr int BM = 256, BK = 64, HALF = 128, HTB = HALF * BK * 2, STAGE_BYTES = 8 * HTB, NXCD = 8, WGM = 8;
__host__ __device__ __forceinline__ int lds_byte(int r, int c) { const int st = (r >> 4) * 2 + (c >> 5), rr = r & 15, cc = c & 31, ob = rr * 64 + cc * 2; return st * 1024 + (ob ^ (((ob >> 9) & 1) << 5)); }
__host__ __device__ __forceinline__ void stage_rc(int b, int& R, int& C) { const int st = b / 1024, sb = b % 1024, swz = sb ^ (((sb >> 9) & 1) << 5); R = (st >> 1) * 16 + swz / 64; C = (st & 1) * 32 + (swz % 64) / 2; }

struct Unit { const char* A; const char* B; int pm, pn, kind; };

struct TileOrder {
    int nM, nN, nwg;
    __device__ __forceinline__ void init(int Mr, int N) { nM = Mr / BM; nN = N / BM; nwg = nM * nN; }
    __device__ __forceinline__ void map(int wgid, int& pm, int& pn) const {
        { const int q = nwg / NXCD, r = nwg % NXCD, xcd = wgid % NXCD, off = wgid / NXCD; wgid = (xcd < r ? xcd * (q + 1) : r * (q + 1) + (xcd - r) * q) + off; }
        const int nig = WGM * nN, gid = wgid / nig, fm = gid * WGM, gsz = (nM - fm) < WGM ? (nM - fm) : WGM;
        pm = fm + ((wgid % nig) % gsz); pn = (wgid % nig) / gsz;
    }
};
struct SchedPlain {
    TileOrder T; int G, c; const char* A; const char* B; size_t tstep;
    __device__ __forceinline__ bool next(int i, Unit& u) const {
        const long L = (long)i * G + c; if (L >= T.nwg) return false;
        T.map((int)L, u.pm, u.pn); u.A = A + (size_t)u.pm * tstep; u.B = B + (size_t)u.pn * tstep; u.kind = 0; return true;
    }
};
struct SchedBranch {
    TileOrder T; int G, c; const char* ws; const char* wl; size_t tstep;
    __device__ __forceinline__ bool next(int i, Unit& u) const {
        const long L = (long)(i >> 2) * G + c; if (L >= T.nwg) return false;
        T.map((int)L, u.pm, u.pn); const int sub = i & 3; u.kind = sub;
        const size_t oa = (sub == 1) ? R_Q : ((sub == 3) ? R_CB : R_H);
        const size_t ob = (sub == 0) ? (W_IN + (size_t)6144 * D * 2) : (sub == 1) ? W_A : (sub == 2) ? (W_IN + (size_t)7168 * D * 2) : W_B;
        u.A = ws + oa + (size_t)u.pm * tstep; u.B = wl + ob + (size_t)u.pn * tstep; return true;
    }
};

template <class Epi, class Sched>
__device__ __forceinline__ void gemm_phase(LAS unsigned char* lds, const int K, const Sched& S, const Epi& E, const int wid) {
    const int lane = lane_id_opaque(), tid = wid * 64 + lane, wr = wid >> 2, wc = wid & 3, fr = lane & 15, fq = lane >> 4;
    const int nt = K / BK;
    unsigned voff[2];
#pragma unroll
    for (int i = 0; i < 2; ++i) { int R, C; stage_rc(tid * 16 + i * 8192, R, C); voff[i] = (unsigned)(R * K + C) * 2u; }
    const size_t kstep = (size_t)(BK * 2);
    const size_t hstep = (size_t)HALF * K * 2;
    const unsigned ldsw = (unsigned)wid * 1024u;
    const int aoff = lds_byte(wr * 64 + fr, fq * 8), boff = lds_byte(wc * 32 + fr, fq * 8);
#define PG8_SA(b, h) (((b) * 2 + (h)) * HTB)
#define PG8_SB(b, h) ((4 + (b) * 2 + (h)) * HTB)
#define PG8_STAGE(bufoff, gbase) do { _Pragma("unroll") for (int _i = 0; _i < 2; ++_i) \
        __builtin_amdgcn_global_load_lds((const unsigned*)((const char*)(gbase) + voff[_i]), (LAS unsigned*)(lds + (bufoff) + ldsw + _i * 8192), 16, 0, 0); } while (0)
#define PG8_LDA(dst, b, h) do { _Pragma("unroll") for (int m = 0; m < 4; ++m) _Pragma("unroll") for (int k = 0; k < 2; ++k) dst[m][k] = *(const LAS bf16x8*)(lds + PG8_SA(b, h) + aoff + m * 2048 + k * 1024); } while (0)
#define PG8_LDB(dst, b, h) do { _Pragma("unroll") for (int n = 0; n < 2; ++n) _Pragma("unroll") for (int k = 0; k < 2; ++k) dst[n][k] = *(const LAS bf16x8*)(lds + PG8_SB(b, h) + boff + n * 2048 + k * 1024); } while (0)
#define PG8_MMA(ai, bj, At, Bt) do { __builtin_amdgcn_s_setprio(1); _Pragma("unroll") for (int m = 0; m < 4; ++m) _Pragma("unroll") for (int n = 0; n < 2; ++n) _Pragma("unroll") for (int k = 0; k < 2; ++k) \
        acc[ai][bj][m][n] = __builtin_amdgcn_mfma_f32_16x16x32_bf16(Bt[n][k], At[m][k], acc[ai][bj][m][n], 0, 0, 0); __builtin_amdgcn_s_setprio(0); } while (0)
#define PG8_WAIT_V(n) asm volatile("s_waitcnt vmcnt(" #n ")" ::: "memory")
#define PG8_WAIT_L(n) asm volatile("s_waitcnt lgkmcnt(" #n ")" ::: "memory")
#define PG8_BAR __builtin_amdgcn_s_barrier()
#define PG8_SCHED __builtin_amdgcn_sched_barrier(0)
    Unit cur, nxt; int ui = 0;
    if (!S.next(0, cur)) return;
    f32x4 acc[2][2][4][2];
#pragma unroll
    for (int a = 0; a < 2; ++a)
#pragma unroll
        for (int b = 0; b < 2; ++b)
#pragma unroll
            for (int m = 0; m < 4; ++m)
#pragma unroll
                for (int n = 0; n < 2; ++n) acc[a][b][m][n] = (f32x4){0.f, 0.f, 0.f, 0.f};
    bf16x8 At[4][2], B0[2][2], B1[2][2];
    const char* cA = cur.A; const char* cB = cur.B;
    PG8_STAGE(PG8_SB(0, 0), cB); PG8_STAGE(PG8_SB(0, 1), cB + hstep); PG8_STAGE(PG8_SA(0, 0), cA); PG8_STAGE(PG8_SA(0, 1), cA + hstep);
    if (wr == 1) PG8_BAR;
    PG8_WAIT_V(2); PG8_BAR;
    PG8_STAGE(PG8_SB(1, 0), cB + kstep); PG8_STAGE(PG8_SA(1, 0), cA + kstep); PG8_STAGE(PG8_SB(1, 1), cB + hstep + kstep);
    PG8_WAIT_V(6); PG8_BAR;
    for (;;) {
        const bool has_next = S.next(ui + 1, nxt);
        const char* nA = has_next ? nxt.A : cA; const char* nB = has_next ? nxt.B : cB;
        for (int t = 0; t < nt; t += 2) {
            const bool last = (t == nt - 2);
            const char* a1 = cA + (size_t)(t + 1) * kstep;
            const char* a2 = last ? nA : cA + (size_t)(t + 2) * kstep; const char* b2 = last ? nB : cB + (size_t)(t + 2) * kstep;
            const char* a3 = a2 + kstep; const char* b3 = b2 + kstep;
            PG8_LDB(B0, 0, 0); PG8_LDB(B1, 0, 1); PG8_SCHED; PG8_LDA(At, 0, 0); PG8_STAGE(PG8_SA(1, 1), a1 + hstep);
            PG8_WAIT_V(8); PG8_WAIT_L(0); PG8_BAR; PG8_MMA(0, 0, At, B0); PG8_MMA(0, 1, At, B1); PG8_BAR; PG8_SCHED;
            PG8_LDA(At, 0, 1); PG8_STAGE(PG8_SB(0, 0), b2); PG8_STAGE(PG8_SB(0, 1), b2 + hstep); PG8_STAGE(PG8_SA(0, 0), a2);
            PG8_WAIT_V(8); PG8_WAIT_L(0); PG8_BAR; PG8_MMA(1, 0, At, B0); PG8_MMA(1, 1, At, B1); PG8_BAR; PG8_SCHED;
            PG8_LDB(B0, 1, 0); PG8_LDB(B1, 1, 1); PG8_SCHED; PG8_LDA(At, 1, 0); PG8_STAGE(PG8_SA(0, 1), a2 + hstep);
            PG8_WAIT_V(8); PG8_WAIT_L(0); PG8_BAR; PG8_MMA(0, 0, At, B0); PG8_MMA(0, 1, At, B1); PG8_BAR; PG8_SCHED;
            PG8_LDA(At, 1, 1); PG8_STAGE(PG8_SB(1, 0), b3); PG8_STAGE(PG8_SB(1, 1), b3 + hstep); PG8_STAGE(PG8_SA(1, 0), a3);
            PG8_WAIT_V(8); PG8_WAIT_L(0); PG8_BAR; PG8_MMA(1, 0, At, B0); PG8_MMA(1, 1, At, B1); PG8_BAR; PG8_SCHED;
        }
        if (wr == 0) PG8_BAR;
        { const int l2 = lane_id_opaque(); E(acc, cur, wr, wc, l2 & 15, l2 >> 4); }
        if (!has_next) break;
#pragma unroll
        for (int a = 0; a < 2; ++a)
#pragma unroll
            for (int b = 0; b < 2; ++b)
#pragma unroll
                for (int m = 0; m < 4; ++m)
#pragma unroll
                    for (int n = 0; n < 2; ++n) acc[a][b][m][n] = (f32x4){0.f, 0.f, 0.f, 0.f};
        cur = nxt; cA = nA; cB = nB; ++ui;
        if (wr == 1) PG8_BAR;
    }
    PG8_WAIT_V(0);
    PG8_BAR;
#undef PG8_SA
#undef PG8_SB
#undef PG8_STAGE
#undef PG8_LDA
#undef PG8_LDB
#undef PG8_MMA
#undef PG8_WAIT_V
#undef PG8_WAIT_L
#undef PG8_BAR
#undef PG8_SCHED
}

__device__ __forceinline__ u32x4 pack8(const f32x4& a, const f32x4& b) { u32x4 w; w.x = cvt_pk(a[0], a[1]); w.y = cvt_pk(a[2], a[3]); w.z = cvt_pk(b[0], b[1]); w.w = cvt_pk(b[2], b[3]); return w; }

struct EpiRegions {
    bf16_t* base;
    __device__ __forceinline__ void operator()(const f32x4 (&acc)[2][2][4][2], const Unit& u, int wr, int wc, int fr, int fq) const {
        bf16_t* dst = base + (size_t)(u.pn >> 2) * ((size_t)M * D);
        const int col = (u.pn & 3) * 256 + wc * 64 + fq * 8, row0 = u.pm * BM + wr * 64 + fr;
#pragma unroll
        for (int ai = 0; ai < 2; ++ai)
#pragma unroll
            for (int m = 0; m < 4; ++m) { bf16_t* rp = dst + (size_t)(row0 + ai * HALF + m * 16) * D + col;
#pragma unroll
                for (int bj = 0; bj < 2; ++bj) *(u32x4*)(rp + bj * 32) = pack8(acc[ai][bj][m][0], acc[ai][bj][m][1]); }
    }
};
struct EpiQKV {
    bf16_t* base; const float* gq; const float* gk;
    __device__ __forceinline__ void operator()(const f32x4 (&acc)[2][2][4][2], const Unit& u, int wr, int wc, int fr, int fq) const {
        const int region = u.pn >> 2, head = (u.pn & 3) * 4 + wc, row0 = u.pm * BM + wr * 64 + fr;
        if (region == 2) {
            const int b = row0 >> 12;
            bf16_t* vb = base + (size_t)2 * M * D + ((size_t)(b * NH + head) * HD) * SEQ;
#pragma unroll
            for (int ai = 0; ai < 2; ++ai)
#pragma unroll
                for (int m = 0; m < 4; ++m) { const int s0 = (row0 + ai * HALF + m * 16) & (SEQ - 1), q = (s0 >> 2) & 3;
                    const int s = (s0 & ~12) | ((((q & 1) << 1) | (q >> 1)) << 2);
#pragma unroll
                    for (int bj = 0; bj < 2; ++bj)
#pragma unroll
                        for (int n = 0; n < 2; ++n)
#pragma unroll
                            for (int j = 0; j < 4; ++j) { const int d = bj * 32 + fq * 8 + n * 4 + j; const unsigned w = cvt_pk(acc[ai][bj][m][n][j], 0.f);
                                vb[(size_t)d * SEQ + s] = (bf16_t)(w & 0xffffu); } }
        } else if (region >= 3) {
            bf16_t* dst = base + (size_t)region * ((size_t)M * D);
            const int col = (u.pn & 3) * 256 + wc * 64 + fq * 8;
#pragma unroll
            for (int ai = 0; ai < 2; ++ai)
#pragma unroll
                for (int m = 0; m < 4; ++m) { bf16_t* rp = dst + (size_t)(row0 + ai * HALF + m * 16) * D + col;
#pragma unroll
                    for (int bj = 0; bj < 2; ++bj) *(u32x4*)(rp + bj * 32) = pack8(acc[ai][bj][m][0], acc[ai][bj][m][1]); }
        } else {
            const float* g = region == 0 ? gq : gk; const float sc = region == 0 ? C2 : 1.0f;
            bf16_t* dst = base + (size_t)region * ((size_t)M * D);
            f32x4 gv[2][2];
#pragma unroll
            for (int bj = 0; bj < 2; ++bj)
#pragma unroll
                for (int n = 0; n < 2; ++n) gv[bj][n] = *(const f32x4*)(g + bj * 32 + fq * 8 + n * 4) * sc;
            const int col = head * 64 + fq * 8;
#pragma unroll
            for (int ai = 0; ai < 2; ++ai)
#pragma unroll
                for (int m = 0; m < 4; ++m) {
                    float ss = 0.f;
#pragma unroll
                    for (int bj = 0; bj < 2; ++bj)
#pragma unroll
                        for (int n = 0; n < 2; ++n) { const f32x4 x = acc[ai][bj][m][n]; ss += (x[0] * x[0] + x[1] * x[1]) + (x[2] * x[2] + x[3] * x[3]); }
                    ss += shx(ss, 16, fr + 16 * fq); ss += shx(ss, 32, fr + 16 * fq);
                    const float r = 1.0f / sqrtf(ss * (1.0f / 64.0f) + EPS);
                    bf16_t* rp = dst + (size_t)(row0 + ai * HALF + m * 16) * D + col;
#pragma unroll
                    for (int bj = 0; bj < 2; ++bj) { const f32x4 a = acc[ai][bj][m][0] * r * gv[bj][0], b2 = acc[ai][bj][m][1] * r * gv[bj][1]; *(u32x4*)(rp + bj * 32) = pack8(a, b2); }
                }
        }
    }
};
struct EpiBranch {
    bf16_t* S1; bf16_t* TM;
    __device__ __forceinline__ void operator()(const f32x4 (&acc)[2][2][4][2], const Unit& u, int wr, int wc, int fr, int fq) const {
        const int col = u.pn * 256 + wc * 64 + fq * 8, row0 = u.pm * BM + wr * 64 + fr, kind = u.kind;
#pragma unroll
        for (int ai = 0; ai < 2; ++ai) {
            if (kind == 0 || kind == 2) {
#pragma unroll
                for (int m = 0; m < 4; ++m) { const size_t off = (size_t)(row0 + ai * HALF + m * 16) * D + col;
#pragma unroll
                    for (int bj = 0; bj < 2; ++bj) { f32x4 a = acc[ai][bj][m][0], b = acc[ai][bj][m][1];
#pragma unroll
                        for (int j = 0; j < 4; ++j) { a[j] = sigmoidf_(a[j]); b[j] = sigmoidf_(b[j]); }
                        *(u32x4*)(S1 + off + bj * 32) = pack8(a, b); } }
            } else {
#pragma unroll
              for (int mh = 0; mh < 2; ++mh) {
                u32x4 g[2][2], t[2][2];
#pragma unroll
                for (int m2 = 0; m2 < 2; ++m2) { const int m = 2 * mh + m2; const size_t off = (size_t)(row0 + ai * HALF + m * 16) * D + col;
#pragma unroll
                    for (int bj = 0; bj < 2; ++bj) { g[m2][bj] = *(const u32x4*)(S1 + off + bj * 32); if (kind == 3) t[m2][bj] = *(const u32x4*)(TM + off + bj * 32); else t[m2][bj] = (u32x4){0u, 0u, 0u, 0u}; } }
#pragma unroll
                for (int m2 = 0; m2 < 2; ++m2) { const int m = 2 * mh + m2; const size_t off = (size_t)(row0 + ai * HALF + m * 16) * D + col;
#pragma unroll
                    for (int bj = 0; bj < 2; ++bj) { f32x4 a = acc[ai][bj][m][0], b = acc[ai][bj][m][1]; const u32x4 gg = g[m2][bj], tt = t[m2][bj];
                        a[0] = a[0] * bf_lo(gg.x) + bf_lo(tt.x); a[1] = a[1] * bf_hi(gg.x) + bf_hi(tt.x); a[2] = a[2] * bf_lo(gg.y) + bf_lo(tt.y); a[3] = a[3] * bf_hi(gg.y) + bf_hi(tt.y);
                        b[0] = b[0] * bf_lo(gg.z) + bf_lo(tt.z); b[1] = b[1] * bf_hi(gg.z) + bf_hi(tt.z); b[2] = b[2] * bf_lo(gg.w) + bf_lo(tt.w); b[3] = b[3] * bf_hi(gg.w) + bf_hi(tt.w);
                        *(u32x4*)(TM + off + bj * 32) = pack8(a, b); } }
              }
            }
        }
    }
};
struct EpiResid {
    const float* xin; float* xout; const float* gmod;
    __device__ __forceinline__ void operator()(const f32x4 (&acc)[2][2][4][2], const Unit& u, int wr, int wc, int fr, int fq) const {
        const int col = u.pn * 256 + wc * 64 + fq * 8, row0 = u.pm * BM + wr * 64 + fr, b = row0 >> 12;
        f32x4 gv[2][2];
#pragma unroll
        for (int bj = 0; bj < 2; ++bj)
#pragma unroll
            for (int n = 0; n < 2; ++n) gv[bj][n] = *(const f32x4*)(gmod + b * 6144 + col + bj * 32 + n * 4);
#pragma unroll
        for (int ai = 0; ai < 2; ++ai)
#pragma unroll
          for (int mh = 0; mh < 2; ++mh) {
            f32x4 xo[2][2][2];
#pragma unroll
            for (int m2 = 0; m2 < 2; ++m2) { const size_t off = (size_t)(row0 + ai * HALF + (2 * mh + m2) * 16) * D + col;
#pragma unroll
                for (int bj = 0; bj < 2; ++bj)
#pragma unroll
                    for (int n = 0; n < 2; ++n) xo[m2][bj][n] = *(const f32x4*)(xin + off + bj * 32 + n * 4); }
#pragma unroll
            for (int m2 = 0; m2 < 2; ++m2) { const size_t off = (size_t)(row0 + ai * HALF + (2 * mh + m2) * 16) * D + col;
#pragma unroll
                for (int bj = 0; bj < 2; ++bj)
#pragma unroll
                    for (int n = 0; n < 2; ++n) *(f32x4*)(xout + off + bj * 32 + n * 4) = xo[m2][bj][n] + gv[bj][n] * acc[ai][bj][2 * mh + m2][n]; }
          }
    }
};
struct EpiGU {
    bf16_t* f;
    __device__ __forceinline__ void operator()(const f32x4 (&acc)[2][2][4][2], const Unit& u, int wr, int wc, int fr, int fq) const {
        const int col = u.pn * 128 + wc * 32 + fq * 8, row0 = u.pm * BM + wr * 64 + fr;
#pragma unroll
        for (int ai = 0; ai < 2; ++ai)
#pragma unroll
            for (int m = 0; m < 4; ++m) {
                f32x4 o[2];
#pragma unroll
                for (int n = 0; n < 2; ++n)
#pragma unroll
                    for (int j = 0; j < 4; ++j) { const float gt = acc[ai][0][m][n][j]; o[n][j] = gt * sigmoidf_(gt) * acc[ai][1][m][n][j]; }
                *(u32x4*)(f + (size_t)(row0 + ai * HALF + m * 16) * FF + col) = pack8(o[0], o[1]);
            }
    }
};
}

#define LDS_WAIT() asm volatile("s_waitcnt lgkmcnt(0)" ::: "memory")
__device__ __forceinline__ void transpose_item(const float* W, int N, int K, int n0, bf16_t* WT, int a0, int k0, LAS float* scr, int lane) {
    {
        const int kr = lane >> 3, c4 = (lane & 7) * 4;
        f32x4 t[8];
#pragma unroll
        for (int i = 0; i < 8; ++i) t[i] = *(const f32x4*)(W + (size_t)(k0 + 8 * i + kr) * N + n0 + c4);
#pragma unroll
        for (int i = 0; i < 8; ++i) { LAS float* d = scr + (8 * i + kr) * 33 + c4; d[0] = t[i][0]; d[1] = t[i][1]; d[2] = t[i][2]; d[3] = t[i][3]; }
    }
    LDS_WAIT(); asm volatile("" ::: "memory");
    const int c = lane & 7;
#pragma unroll
    for (int j = 0; j < 4; ++j) { const int s = (lane >> 3) + 8 * j; const int lo = 8 * ((s >> 2) & 3) + 4 * (s >> 4) + (s & 3);
        const LAS float* sp = scr + (8 * c) * 33 + lo;
        u32x4 o; o.x = cvt_pk(sp[0 * 33], sp[1 * 33]); o.y = cvt_pk(sp[2 * 33], sp[3 * 33]); o.z = cvt_pk(sp[4 * 33], sp[5 * 33]); o.w = cvt_pk(sp[6 * 33], sp[7 * 33]);
        *(u32x4*)(WT + (size_t)(a0 + s) * K + k0 + 8 * c) = o; }
    LDS_WAIT(); asm volatile("" ::: "memory");
}

struct Params { const float* in[16]; float* out; unsigned char* ws; };

__device__ __forceinline__ void phase0(const Params& p, LAS unsigned char* lds, int gw, int NGW, int wave, int lane, const int l, const bool with_mod) {
    LAS float* scr = (LAS float*)(lds + wave * 16384);
    constexpr int I_IN = 256 * 16, I_SQ = 32 * 16, I_GU = 176 * 16, I_D = 32 * 44, I_LAYER = I_IN + 3 * I_SQ + I_GU + I_D;
    constexpr int I_MOD = 2 * 32 * 24;
    for (int it = gw; it < (with_mod ? I_MOD : 0); it += NGW) {
        const int l = it / (32 * 24), r = it % (32 * 24), kc = r / 24, nb = r % 24;
        const float* aw = p.in[2] + (size_t)l * D * 6144 + (size_t)(kc * 32) * 6144 + nb * 256 + lane * 4;
        const float* c = p.in[1];
        f32x4 a[4];
#pragma unroll
        for (int b = 0; b < 4; ++b) a[b] = (f32x4){0.f, 0.f, 0.f, 0.f};
#pragma unroll 8
        for (int k = 0; k < 32; ++k) { const f32x4 w = *(const f32x4*)(aw + (size_t)k * 6144);
#pragma unroll
            for (int b = 0; b < 4; ++b) { const float cv = c[b * D + kc * 32 + k]; const float sv = cv * sigmoidf_(cv); a[b] += w * sv; } }
        float* mp = (float*)(p.ws + R_CX) + ((size_t)(l * 32 + kc) * 4) * 6144 + nb * 256 + lane * 4;
#pragma unroll
        for (int b = 0; b < 4; ++b) *(f32x4*)(mp + (size_t)b * 6144) = a[b];
    }
    for (int it = gw; it < I_LAYER; it += NGW) {
        int r = it;
        unsigned char* wl = p.ws + WS_W;
        if (r < I_IN) { const int kb = r / 256, g = r % 256; const int pn = g >> 3, bj = (g >> 2) & 1, wc = g & 3;
            transpose_item(p.in[5] + (size_t)l * D * INW, INW, D, 256 * pn + 64 * wc + 32 * bj, (bf16_t*)(wl + W_IN), 32 * g, 64 * kb, scr, lane); continue; }
        r -= I_IN;
        if (r < 3 * I_SQ) { const int which = r / I_SQ; r %= I_SQ; const int kb = r / 32, g = r % 32; const int pn = g >> 3, bj = (g >> 2) & 1, wc = g & 3;
            const float* src = p.in[9 + which] + (size_t)l * D * D; bf16_t* dst = (bf16_t*)(wl + (which == 0 ? W_A : which == 1 ? W_B : W_O));
            transpose_item(src, D, D, 256 * pn + 64 * wc + 32 * bj, dst, 32 * g, 64 * kb, scr, lane); continue; }
        r -= 3 * I_SQ;
        if (r < I_GU) { const int kb = r / 176, g = r % 176; const int pn = g >> 3, bj = (g >> 2) & 1, wc = g & 3;
            const float* src = p.in[bj ? 14 : 13] + (size_t)l * D * FF;
            transpose_item(src, FF, D, 128 * pn + 32 * wc, (bf16_t*)(wl + W_GU), 32 * g, 64 * kb, scr, lane); continue; }
        r -= I_GU;
        { const int kb = r / 32, g = r % 32; const int pn = g >> 3, bj = (g >> 2) & 1, wc = g & 3;
            transpose_item(p.in[15] + (size_t)l * FF * D, D, FF, 256 * pn + 64 * wc + 32 * bj, (bf16_t*)(wl + W_D), 32 * g, 64 * kb, scr, lane); }
    }
}

__device__ __forceinline__ void norm_phase(const float* x, const float* g, const float* modl, int sh_off, int sc_off, bf16_t* h, int gw, int NGW) {
    const int lane = lane_id_opaque();
    for (int q = gw; q < M / 4; q += NGW) {
        const int m0 = 4 * q, b = m0 >> 12;
        f32x4 v[4][4];
#pragma unroll
        for (int r = 0; r < 4; ++r) { const f32x4* xr = (const f32x4*)(x + (size_t)(m0 + r) * D) + lane;
#pragma unroll
            for (int j = 0; j < 4; ++j) v[r][j] = xr[64 * j]; }
        float rs[4];
#pragma unroll
        for (int r = 0; r < 4; ++r) { float s = 0.f;
#pragma unroll
            for (int j = 0; j < 4; ++j) s += (v[r][j][0] * v[r][j][0] + v[r][j][1] * v[r][j][1]) + (v[r][j][2] * v[r][j][2] + v[r][j][3] * v[r][j][3]);
            rs[r] = s; }
#pragma unroll
        for (int o = 1; o < 64; o <<= 1) {
#pragma unroll
            for (int r = 0; r < 4; ++r) rs[r] += shx(rs[r], o, lane); }
#pragma unroll
        for (int r = 0; r < 4; ++r) rs[r] = 1.0f / sqrtf(rs[r] * (1.0f / D) + EPS);
#pragma unroll
        for (int j = 0; j < 4; ++j) { const int col = 4 * (64 * j + lane);
            const f32x4 gg = *(const f32x4*)(g + col), sc = *(const f32x4*)(modl + b * 6144 + sc_off + col) + 1.0f, sh = *(const f32x4*)(modl + b * 6144 + sh_off + col);
#pragma unroll
            for (int r = 0; r < 4; ++r) { const f32x4 y = (v[r][j] * rs[r] * gg) * sc + sh;
                u32x2 w; w.x = cvt_pk(y[0], y[1]); w.y = cvt_pk(y[2], y[3]); *((u32x2*)(h + (size_t)(m0 + r) * D) + lane + 64 * j) = w; } }
    }
}

__device__ __forceinline__ void conv_phase(bf16_t* cb, const bf16_t* cc, const bf16_t* cx, const float* cw, int gt0, int NT) {
    const int gt = gt0 + lane_id_opaque();
    for (int it = gt; it < (M / 16) * (D / 8); it += NT) {
        const int c8 = it & 127, run = it >> 7, t0 = run * 16, ch = c8 * 8;
        float w0[8], w1[8], w2[8];
#pragma unroll
        for (int i = 0; i < 8; ++i) { w0[i] = cw[ch + i]; w1[i] = cw[D + ch + i]; w2[i] = cw[2 * D + ch + i]; }
        float um2[8], um1[8];
#pragma unroll
        for (int i = 0; i < 8; ++i) { um2[i] = 0.f; um1[i] = 0.f; }
        if ((t0 & (SEQ - 1)) != 0) {
            const u32x4 a2 = *(const u32x4*)(cc + (size_t)(t0 - 2) * D + ch), b2 = *(const u32x4*)(cx + (size_t)(t0 - 2) * D + ch);
            const u32x4 a1 = *(const u32x4*)(cc + (size_t)(t0 - 1) * D + ch), b1 = *(const u32x4*)(cx + (size_t)(t0 - 1) * D + ch);
#pragma unroll
            for (int i = 0; i < 4; ++i) { um2[2 * i] = bf_lo(a2[i]) * bf_lo(b2[i]); um2[2 * i + 1] = bf_hi(a2[i]) * bf_hi(b2[i]);
                um1[2 * i] = bf_lo(a1[i]) * bf_lo(b1[i]); um1[2 * i + 1] = bf_hi(a1[i]) * bf_hi(b1[i]); }
        }
#pragma unroll 4
        for (int t = 0; t < 16; ++t) {
            const size_t off = (size_t)(t0 + t) * D + ch;
            const u32x4 a = *(const u32x4*)(cc + off), b = *(const u32x4*)(cx + off), e = *(const u32x4*)(cb + off);
            float u[8], y[8];
#pragma unroll
            for (int i = 0; i < 4; ++i) { u[2 * i] = bf_lo(a[i]) * bf_lo(b[i]); u[2 * i + 1] = bf_hi(a[i]) * bf_hi(b[i]); }
#pragma unroll
            for (int i = 0; i < 4; ++i) {
                y[2 * i] = bf_lo(e[i]) * (w0[2 * i] * um2[2 * i] + w1[2 * i] * um1[2 * i] + w2[2 * i] * u[2 * i]);
                y[2 * i + 1] = bf_hi(e[i]) * (w0[2 * i + 1] * um2[2 * i + 1] + w1[2 * i + 1] * um1[2 * i + 1] + w2[2 * i + 1] * u[2 * i + 1]); }
            u32x4 o; o.x = cvt_pk(y[0], y[1]); o.y = cvt_pk(y[2], y[3]); o.z = cvt_pk(y[4], y[5]); o.w = cvt_pk(y[6], y[7]);
            *(u32x4*)(cb + off) = o;
#pragma unroll
            for (int i = 0; i < 8; ++i) { um2[i] = um1[i]; um1[i] = u[i]; }
        }
    }
}

#define MFMA32(a, b, c) __builtin_amdgcn_mfma_f32_32x32x16_bf16((a), (b), (c), 0, 0, 0)
constexpr float SB_EXIT = 1.0e-20f;
__device__ __forceinline__ float clamp_z(float z) { return __builtin_amdgcn_fmed3f(z, -126.0f, 80.0f); }
struct AttnState { f32x16 o0, o1; float P; bf16x8 kf[4]; };
template <bool DIAG>
__device__ __forceinline__ void attn_step(AttnState& st, const bf16x8 (&qf)[4], const bf16_t* kbase, const bf16_t* vbase, int j0, bool more, int n, int hh, int lane) {
    bf16x8 vf[2][2];
#pragma unroll
    for (int mb = 0; mb < 2; ++mb)
#pragma unroll
        for (int s = 0; s < 2; ++s) vf[mb][s] = *(const bf16x8*)(vbase + (size_t)mb * 32 * SEQ + j0 + 16 * s);
    f32x16 sa;
#pragma unroll
    for (int r = 0; r < 16; ++r) sa[r] = 0.f;
#pragma unroll
    for (int kk = 0; kk < 4; ++kk) sa = MFMA32(st.kf[kk], qf[kk], sa);
    if (more) {
#pragma unroll
        for (int kk = 0; kk < 4; ++kk) st.kf[kk] = *(const bf16x8*)(kbase + (size_t)(j0 - 32) * D + kk * 16);
    }
    float om[16], be[16];
#pragma unroll
    for (int r = 0; r < 16; ++r) {
        const float e = fast_exp2(clamp_z(sa[r]));
        float o = fast_rcp(1.0f + e), b = e * o;
        if (DIAG) { const int ki = (r & 3) + 8 * (r >> 2) + 4 * hh; if (ki >= n) { o = 1.0f; b = 0.f; } }
        om[r] = o; be[r] = b;
    }
    float g[4], pg[4];
#pragma unroll
    for (int q = 0; q < 4; ++q) g[q] = (om[4 * q] * om[4 * q + 1]) * (om[4 * q + 2] * om[4 * q + 3]);
#pragma unroll
    for (int q = 0; q < 4; ++q) pg[q] = shx(g[q], 32, lane);
    float run = st.P;
    float a[16];
#pragma unroll
    for (int q = 3; q >= 0; --q) {
        const float c3 = (hh == 0) ? run * pg[q] : run;
        const float c2 = c3 * om[4 * q + 3], c1 = c2 * om[4 * q + 2], c0 = c1 * om[4 * q + 1];
        a[4 * q + 3] = be[4 * q + 3] * c3; a[4 * q + 2] = be[4 * q + 2] * c2; a[4 * q + 1] = be[4 * q + 1] * c1; a[4 * q] = be[4 * q] * c0;
        run *= g[q] * pg[q];
    }
    st.P = run;
#pragma unroll
    for (int s = 0; s < 2; ++s) {
        u32x4 pw; pw.x = cvt_pk(a[8 * s + 0], a[8 * s + 1]); pw.y = cvt_pk(a[8 * s + 2], a[8 * s + 3]); pw.z = cvt_pk(a[8 * s + 4], a[8 * s + 5]); pw.w = cvt_pk(a[8 * s + 6], a[8 * s + 7]);
        const bf16x8 pf = __builtin_bit_cast(bf16x8, pw);
        st.o0 = MFMA32(vf[0][s], pf, st.o0); st.o1 = MFMA32(vf[1][s], pf, st.o1);
    }
}
__device__ __forceinline__ void attn_task(bf16_t* QO, const bf16_t* Kp, const bf16_t* VT, int b, int h, int qblk, int lane) {
    const int n = lane & 31, hh = lane >> 5, t0 = qblk * 32;
    bf16_t* qrow = QO + (size_t)(b * SEQ + t0 + n) * D + h * HD;
    bf16x8 qf[4];
#pragma unroll
    for (int kk = 0; kk < 4; ++kk) qf[kk] = *(const bf16x8*)(qrow + kk * 16 + hh * 8);
    AttnState st;
#pragma unroll
    for (int r = 0; r < 16; ++r) { st.o0[r] = 0.f; st.o1[r] = 0.f; }
    st.P = 1.0f;
    const bf16_t* kbase = Kp + (size_t)(b * SEQ + n) * D + h * HD + hh * 8;
    const bf16_t* vbase = VT + ((size_t)(b * NH + h) * HD + n) * SEQ + 8 * hh;
#pragma unroll
    for (int kk = 0; kk < 4; ++kk) st.kf[kk] = *(const bf16x8*)(kbase + (size_t)t0 * D + kk * 16);
    attn_step<true>(st, qf, kbase, vbase, t0, qblk > 0, n, hh, lane);
    for (int kb = qblk - 1; kb >= 0; --kb) {
        if (!__any(st.P > SB_EXIT)) break;
        attn_step<false>(st, qf, kbase, vbase, kb * 32, kb > 0, n, hh, lane);
    }
#pragma unroll
    for (int q = 0; q < 4; ++q) {
        u32x2 w0, w1; w0.x = cvt_pk(st.o0[4 * q], st.o0[4 * q + 1]); w0.y = cvt_pk(st.o0[4 * q + 2], st.o0[4 * q + 3]); w1.x = cvt_pk(st.o1[4 * q], st.o1[4 * q + 1]); w1.y = cvt_pk(st.o1[4 * q + 2], st.o1[4 * q + 3]);
        *(u32x2*)(qrow + 8 * q + 4 * hh) = w0; *(u32x2*)(qrow + 32 + 8 * q + 4 * hh) = w1;
    }
}
__device__ __forceinline__ void attn_phase(bf16_t* QO, const bf16_t* Kp, const bf16_t* VT, int G, int bx, int wave) {
    const int lane = lane_id_opaque();
    constexpr int NQB = SEQ / 32, NTASK = NB * NH * NQB;
    if (G == 256) {
#pragma unroll 1
        for (int i = 0; i < 4; ++i) { const int bh = 2 * (wave * 4 + i) + (bx & 1); attn_task(QO, Kp, VT, bh / NH, bh % NH, bx >> 1, lane); }
    } else {
        int i = 0;
        for (int tau = bx * NWAVES + wave; tau < NTASK; tau += G * NWAVES, ++i) {
            const int bh = tau / NQB, qr = tau % NQB, qblk = (i & 1) ? (NQB - 1 - qr) : qr;
            attn_task(QO, Kp, VT, bh / NH, bh % NH, qblk, lane);
        }
    }
}
__device__ __forceinline__ void mixer_phase(bf16_t* QO, const bf16_t* Kp, const bf16_t* VT, bf16_t* cb, const bf16_t* cc, const bf16_t* cx, const float* cw, int G, int bx, int wave, int gt0, int NT) {
    if (wave & 4) { conv_phase(cb, cc, cx, cw, gt0, NT); attn_phase(QO, Kp, VT, G, bx, wave); }
    else          { attn_phase(QO, Kp, VT, G, bx, wave); conv_phase(cb, cc, cx, cw, gt0, NT); }
}

#define XB_TMO      128
#define XB_XCNT(j)  (256  + 64 * (j))
#define XB_XSUB(j)  (1280 + 64 * (j))
#define XB_XGEN(j)  (2304 + 64 * (j))
#define XB_TOP      3328
#define XB_TOPGEN   3392
#define XCD_BAR_WORDS 3456
#define XB_SPIN_CAP (1u << 18)
__device__ __forceinline__ unsigned xb_ld(unsigned* p)              { return __hip_atomic_load(p, __ATOMIC_RELAXED, __HIP_MEMORY_SCOPE_AGENT); }
__device__ __forceinline__ unsigned xb_add(unsigned* p, unsigned v) { return __hip_atomic_fetch_add(p, v, __ATOMIC_RELAXED, __HIP_MEMORY_SCOPE_AGENT); }
__device__ __forceinline__ unsigned xb_xcc_id() { return (unsigned)__builtin_amdgcn_s_getreg((3 << 11) | 20) & 0xFu; }
#define XB_SPIN(cond, bar) do { unsigned _sp = 0; while (cond) { __builtin_amdgcn_s_sleep(1); \
    if ((++_sp & 255u) == 0u) { if (xb_ld(&(bar)[XB_TMO])) break; if (_sp > XB_SPIN_CAP) { atomicAdd(&(bar)[XB_TMO], 1u); break; } } } } while (0)
struct XcdBarrier { unsigned* bar; unsigned x; volatile LAS unsigned* st; };
__device__ __forceinline__ XcdBarrier xcd_barrier_post(unsigned* bar, volatile LAS unsigned* st, int tid) {
    XcdBarrier b; b.bar = bar; b.x = xb_xcc_id(); b.st = st;
    if (tid == 0) (void)xb_add(&bar[XB_XCNT(b.x)], 1u);
    return b;
}
__device__ __forceinline__ void xcd_barrier_complete(unsigned* bar, unsigned x, unsigned& nloc, unsigned& nx) {
    const unsigned G = gridDim.x * gridDim.y * gridDim.z;
    unsigned sum, cnt, mine, sp = 0u;
    for (;;) {
        sum = 0u; cnt = 0u; mine = 0u;
#pragma unroll
        for (unsigned j = 0; j < 16; ++j) { const unsigned c = xb_ld(&bar[XB_XCNT(j)]); sum += c; cnt += (c > 0u) ? 1u : 0u; mine = (j == x) ? c : mine; }
        if (sum == G) break;
        __builtin_amdgcn_s_sleep(1);
        if ((++sp & 255u) == 0u) { if (xb_ld(&bar[XB_TMO])) break; if (sp > XB_SPIN_CAP) { atomicAdd(&bar[XB_TMO], 1u); break; } }
    }
    nloc = mine > 0u ? mine : 1u; nx = cnt > 0u ? cnt : 1u;
}
__device__ __forceinline__ void xcd_barrier(const XcdBarrier& b, bool leader) {
    asm volatile("s_waitcnt vmcnt(0)" ::: "memory");
    __syncthreads();
    if (leader) {
        unsigned* bar = b.bar;
        __builtin_amdgcn_s_waitcnt(0);
        unsigned nloc = b.st[0], nx = b.st[1];
        if (nloc == 0u) { xcd_barrier_complete(bar, b.x, nloc, nx); b.st[0] = nloc; b.st[1] = nx; }
        const unsigned old = xb_add(&bar[XB_XSUB(b.x)], 1u);
        const unsigned gen = old / nloc;
        if (old + 1u == (gen + 1u) * nloc) {
            __builtin_amdgcn_fence(__ATOMIC_RELEASE, "agent");
            asm volatile("s_waitcnt vmcnt(0)" ::: "memory");
            const unsigned og = xb_add(&bar[XB_TOP], 1u);
            const unsigned tg = og / nx;
            if (og + 1u == (tg + 1u) * nx) xb_add(&bar[XB_TOPGEN], 1u);
            else XB_SPIN(xb_ld(&bar[XB_TOPGEN]) == tg, bar);
            __builtin_amdgcn_fence(__ATOMIC_ACQUIRE, "agent");
            xb_add(&bar[XB_XGEN(b.x)], 1u);
            asm volatile("s_waitcnt vmcnt(0)" ::: "memory");
        } else {
            XB_SPIN(xb_ld(&bar[XB_XGEN(b.x)]) == gen, bar);
            __builtin_amdgcn_fence(__ATOMIC_ACQUIRE, "agent");
            asm volatile("s_waitcnt vmcnt(0)" ::: "memory");
        }
    }
    __syncthreads();
}

#define XB_DONE XCD_BAR_WORDS
__device__ unsigned g_bar[XCD_BAR_WORDS + 64];

constexpr int LDS_BYTES = 131072 + 1024;
__global__ void __launch_bounds__(NTHREADS, 2) fwd_kernel(Params p) {
    extern __shared__ __attribute__((aligned(16))) unsigned char lds_raw[];
    LAS unsigned char* lds = (LAS unsigned char*)lds_raw;
    cg::grid_group grid = cg::this_grid();
#define CG_SYNC() do { asm volatile("s_waitcnt vmcnt(0)" ::: "memory"); grid.sync(); if (wave == 0) { __builtin_amdgcn_fence(__ATOMIC_ACQUIRE, "agent"); asm volatile("s_waitcnt vmcnt(0)" ::: "memory"); } __syncthreads(); } while (0)
#define GRID_SYNC_() xcd_barrier(xb, leader)
    unsigned long long pr_acc = 0, pr_t0 = 0;
#define TIC() do { if (PROBE_MASK) pr_t0 = __builtin_amdgcn_s_memrealtime(); } while (0)
#define TOC(bit) do { if (PROBE_MASK & (bit)) pr_acc += __builtin_amdgcn_s_memrealtime() - pr_t0; } while (0)
#define GRID_SYNC() do { TIC(); GRID_SYNC_(); TOC(2 | sync_kind); } while (0)
    int sync_kind = 128;
    const int tid0 = threadIdx.x, wave = __builtin_amdgcn_readfirstlane(tid0 >> 6);
    const int G = gridDim.x, bx = blockIdx.x;
    const int gw = bx * NWAVES + wave, NGW = G * NWAVES, NT = G * NTHREADS;
    unsigned char* ws = p.ws;
    float* mod = (float*)(ws + WS_CTL);
    bf16_t* Rh = (bf16_t*)(ws + R_H); bf16_t* Rq = (bf16_t*)(ws + R_Q); bf16_t* Rk = (bf16_t*)(ws + R_K); bf16_t* Rv = (bf16_t*)(ws + R_V);
    bf16_t* Rcb = (bf16_t*)(ws + R_CB); bf16_t* Rcc = (bf16_t*)(ws + R_CC); bf16_t* Rcx = (bf16_t*)(ws + R_CX);
    const unsigned char* wl = ws + WS_W;

    unsigned* barw = g_bar;
    volatile LAS unsigned* bst = (volatile LAS unsigned*)(lds + 131072);
    const bool leader = (wave == 0) && (lane_id_opaque() == 0);
    if (leader) { bst[0] = 0u; bst[1] = 0u; bst[2] = 0u; }
    const XcdBarrier xb = xcd_barrier_post(barw, bst, leader ? 0 : 1);
    if (G == 0x7fffffff) CG_SYNC();
    TIC();
    phase0(p, lds, gw, NGW, wave, lane_id_opaque(), 0, true);
    TOC(16);
    GRID_SYNC();
    TIC();
    {
        const int gt = bx * NTHREADS + wave * 64 + lane_id_opaque();
        for (int it = gt; it < 2 * 4 * 1536; it += NT) {
            const int l = it / 6144, r = it % 6144, b = r / 1536, n4 = r % 1536;
            f32x4 a = *(const f32x4*)(p.in[3] + l * 6144 + n4 * 4);
            const float* mp = (const float*)(ws + R_CX) + ((size_t)(l * 32) * 4 + b) * 6144 + n4 * 4;
#pragma unroll 8
            for (int kc = 0; kc < 32; ++kc) a += *(const f32x4*)(mp + (size_t)kc * 4 * 6144);
            *(f32x4*)(mod + (size_t)(l * 4 + b) * 6144 + n4 * 4) = a;
        }
    }
    TOC(16);
    GRID_SYNC();
    TIC(); norm_phase(p.in[0], p.in[4], mod, 0, 1024, Rh, gw, NGW); TOC(8); sync_kind = 128;
    GRID_SYNC();

#pragma unroll 1
    for (int l = 0; l < DEPTH; ++l) {
        const float* modl = mod + (size_t)l * 4 * 6144;
        const float* xin = (l == 0) ? p.in[0] : p.out;
        { pg8::SchedPlain S; S.T.init(M, 6144); S.G = G; S.c = bx; S.A = (const char*)Rh; S.B = (const char*)(wl + W_IN); S.tstep = (size_t)256 * D * 2;
          pg8::EpiQKV E{Rq, p.in[6] + l * HD, p.in[7] + l * HD};
          TIC(); pg8::gemm_phase(lds, D, S, E, wave); TOC(1); sync_kind = 32; }
        GRID_SYNC();
        TIC(); mixer_phase(Rq, Rk, Rv, Rcb, Rcc, Rcx, p.in[8] + (size_t)l * 3 * D, G, bx, wave, bx * NTHREADS + wave * 64, NT); TOC(4); sync_kind = 64;
        GRID_SYNC();
        { pg8::SchedBranch S; S.T.init(M, D); S.G = G; S.c = bx; S.ws = (const char*)ws; S.wl = (const char*)wl; S.tstep = (size_t)256 * D * 2;
          pg8::EpiBranch E{Rv, Rk};
          TIC(); pg8::gemm_phase(lds, D, S, E, wave); TOC(1); sync_kind = 32; }
        GRID_SYNC();
        { pg8::SchedPlain S; S.T.init(M, D); S.G = G; S.c = bx; S.A = (const char*)Rk; S.B = (const char*)(wl + W_O); S.tstep = (size_t)256 * D * 2;
          pg8::EpiResid E{xin, p.out, modl + 2048};
          TIC(); pg8::gemm_phase(lds, D, S, E, wave); TOC(1); sync_kind = 32; }
        GRID_SYNC();
        TIC(); norm_phase(p.out, p.in[12] + l * D, modl, 3072, 4096, Rh, gw, NGW); TOC(8); sync_kind = 128;
        GRID_SYNC();
        { pg8::SchedPlain S; S.T.init(M, 2 * FF); S.G = G; S.c = bx; S.A = (const char*)Rh; S.B = (const char*)(wl + W_GU); S.tstep = (size_t)256 * D * 2;
          pg8::EpiGU E{Rq};
          TIC(); pg8::gemm_phase(lds, D, S, E, wave); TOC(1); sync_kind = 32; }
        GRID_SYNC();
        { pg8::SchedPlain S; S.T.init(M, D); S.G = G; S.c = bx; S.A = (const char*)Rq; S.B = (const char*)(wl + W_D); S.tstep = (size_t)256 * FF * 2;
          pg8::EpiResid E{p.out, p.out, modl + 5120};
          TIC(); pg8::gemm_phase(lds, FF, S, E, wave); TOC(1); sync_kind = 32; }
        if (l + 1 < DEPTH) {
            GRID_SYNC();
            TIC();
            phase0(p, lds, gw, NGW, wave, lane_id_opaque(), l + 1, false);
            norm_phase(p.out, p.in[4] + (l + 1) * D, mod + (size_t)(l + 1) * 4 * 6144, 0, 1024, Rh, gw, NGW);
            TOC(8); sync_kind = 128;
            GRID_SYNC();
        }
    }
    asm volatile("s_waitcnt vmcnt(0)" ::: "memory");
    if (leader) { const unsigned old = xb_add(&barw[XB_DONE], 1u); bst[2] = (old + 1u == (unsigned)G) ? 1u : 0u; }
    __syncthreads();
    if (bst[2]) { const int t = wave * 64 + lane_id_opaque(); for (int i = t; i < XCD_BAR_WORDS + 64; i += NTHREADS) __hip_atomic_store(&barw[i], 0u, __ATOMIC_RELAXED, __HIP_MEMORY_SCOPE_AGENT); }
    if (PROBE_MASK && bx == 0 && leader) { const unsigned long long t = __builtin_amdgcn_s_memrealtime(); while (__builtin_amdgcn_s_memrealtime() - t < pr_acc) __builtin_amdgcn_s_sleep(8); }
}

extern "C" void kernel_launch(void* const* d_in, const int* in_sizes, int n_in, void* d_out, int out_size, void* d_ws, size_t ws_size, hipStream_t stream) {
    static int grid_blocks = 0;
    if (grid_blocks == 0) {
        if (n_in != 16 || out_size != M * D || ws_size < WS_END) { fprintf(stderr, "kernel_launch: unexpected shapes (n_in %d out %d ws %zu need %zu)\n", n_in, out_size, ws_size, (size_t)WS_END); grid_blocks = -1; return; }
        int dev = 0, cus = 0, per_cu = 0;
        hipGetDevice(&dev);
        hipDeviceGetAttribute(&cus, hipDeviceAttributeMultiprocessorCount, dev);
        hipFuncSetAttribute((const void*)fwd_kernel, hipFuncAttributeMaxDynamicSharedMemorySize, LDS_BYTES);
        hipOccupancyMaxActiveBlocksPerMultiprocessor(&per_cu, (const void*)fwd_kernel, NTHREADS, LDS_BYTES);
        (void)hipGetLastError();
        if (per_cu < 1) { fprintf(stderr, "kernel_launch: occupancy query says %d blocks per CU\n", per_cu); per_cu = 1; }
        grid_blocks = cus;
    }
    if (grid_blocks < 0) return;
    Params p{};
    for (int i = 0; i < 16; ++i) p.in[i] = (const float*)d_in[i];
    p.out = (float*)d_out; p.ws = (unsigned char*)d_ws;
    void* args[] = {&p};
    hipError_t e = hipLaunchCooperativeKernel((const void*)fwd_kernel, dim3(grid_blocks), dim3(NTHREADS), args, LDS_BYTES, stream);
    if (e != hipSuccess) fprintf(stderr, "cooperative launch failed: %s (grid %d)\n", hipGetErrorString(e), grid_blocks);
}
```

```cpp
#include <hip/hip_runtime.h>
#include <hip/hip_cooperative_groups.h>
#include <cstdio>
#include <cstdint>
namespace cg = cooperative_groups;
#ifndef PROBE_MASK
#define PROBE_MASK 0
#endif

#define LAS __attribute__((address_space(3)))
typedef unsigned short bf16_t;
typedef short bf16x8 __attribute__((ext_vector_type(8)));
typedef short s16x4 __attribute__((ext_vector_type(4)));
typedef float f32x4 __attribute__((ext_vector_type(4)));
typedef float f32x16 __attribute__((ext_vector_type(16)));
typedef unsigned u32x4 __attribute__((ext_vector_type(4)));
typedef unsigned u32x2 __attribute__((ext_vector_type(2)));
typedef float f32x2_t __attribute__((ext_vector_type(2)));
typedef __bf16 bf16x2_t __attribute__((ext_vector_type(2)));

constexpr int D = 1024, NB = 4, SEQ = 4096, M = NB * SEQ, NH = 16, HD = 64, FF = 2816, INW = 8192, DEPTH = 2;
constexpr float EPS = 1e-6f;
constexpr float LOG2E = 1.4426950408889634f;
constexpr float C2 = 0.125f * LOG2E;
constexpr int NWAVES = 8, NTHREADS = 512;

constexpr size_t MiB = 1u << 20;
constexpr size_t WS_CTL = 0, CTL_BYTES = 256 * 1024;
constexpr size_t WS_W = 1 * MiB;
constexpr size_t W_IN = 0, W_A = 16 * MiB, W_B = 18 * MiB, W_O = 20 * MiB, W_GU = 22 * MiB, W_D = 33 * MiB, W_LAYER = 38 * MiB + 512 * 1024;
constexpr size_t WS_ACT = 40 * MiB;
constexpr size_t REG = 32 * MiB;
constexpr size_t R_H = WS_ACT, R_Q = WS_ACT + REG, R_K = WS_ACT + 2 * REG, R_V = WS_ACT + 3 * REG, R_CB = WS_ACT + 4 * REG, R_CC = WS_ACT + 5 * REG, R_CX = WS_ACT + 6 * REG, WS_END = WS_ACT + 7 * REG;
static_assert(WS_W + W_LAYER <= WS_ACT, "weights");
static_assert((size_t)M * FF * 2 <= 3 * REG, "ffn hidden fits R_Q..R_V");
static_assert(WS_END <= 279028736, "workspace >= sum of the inputs' bytes");

__device__ __forceinline__ unsigned cvt_pk(float lo, float hi) { f32x2_t v = {lo, hi}; bf16x2_t b = __builtin_convertvector(v, bf16x2_t); return __builtin_bit_cast(unsigned, b); }
__device__ __forceinline__ float bf_lo(unsigned u) { return __uint_as_float(u << 16); }
__device__ __forceinline__ float bf_hi(unsigned u) { return __uint_as_float(u & 0xffff0000u); }
__device__ __forceinline__ float shx(float v, int o, int lane) { return __int_as_float(__builtin_amdgcn_ds_bpermute((lane ^ o) << 2, __float_as_int(v))); }
__device__ __forceinline__ float wave_sum(float v, int lane) {
#pragma unroll
    for (int o = 1; o < 64; o <<= 1) v += shx(v, o, lane);
    return v;
}
__device__ __forceinline__ int lane_id_opaque() { int l; asm volatile("v_mbcnt_lo_u32_b32 %0, -1, 0\n\tv_mbcnt_hi_u32_b32 %0, -1, %0" : "=v"(l)); return l; }
__device__ __forceinline__ float fast_exp2(float x) { return __builtin_amdgcn_exp2f(x); }
__device__ __forceinline__ float fast_log2(float x) { return __builtin_amdgcn_logf(x); }
__device__ __forceinline__ float fast_rcp(float x) { return __builtin_amdgcn_rcpf(x); }
__device__ __forceinline__ float sigmoidf_(float x) { return fast_rcp(1.0f + fast_exp2(-x * LOG2E)); }

namespace pg8 {
constexpr int BM = 256, BK = 64, HALF = 128, HTB = HALF * BK * 2, STAGE_BYTES = 8 * HTB, NXCD = 8, WGM = 8;
__host__ __device__ __forceinline__ int lds_byte(int r, int c) { const int st = (r >> 4) * 2 + (c >> 5), rr = r & 15, cc = c & 31, ob = rr * 64 + cc * 2; return st * 1024 + (ob ^ (((ob >> 9) & 1) << 5)); }
__host__ __device__ __forceinline__ void stage_rc(int b, int& R, int& C) { const int st = b / 1024, sb = b % 1024, swz = sb ^ (((sb >> 9) & 1) << 5); R = (st >> 1) * 16 + swz / 64; C = (st & 1) * 32 + (swz % 64) / 2; }

struct Unit { const char* A; const char* B; int pm, pn, kind; };

struct TileOrder {
    int nM, nN, nwg;
    __device__ __forceinline__ void init(int Mr, int N) { nM = Mr / BM; nN = N / BM; nwg = nM * nN; }
    __device__ __forceinline__ void map(int wgid, int& pm, int& pn) const {
        { const int q = nwg / NXCD, r = nwg % NXCD, xcd = wgid % NXCD, off = wgid / NXCD; wgid = (xcd < r ? xcd * (q + 1) : r * (q + 1) + (xcd - r) * q) + off; }
        const int nig = WGM * nN, gid = wgid / nig, fm = gid * WGM, gsz = (nM - fm) < WGM ? (nM - fm) : WGM;
        pm = fm + ((wgid % nig) % gsz); pn = (wgid % nig) / gsz;
    }
};
struct SchedPlain {
    TileOrder T; int G, c; const char* A; const char* B; size_t tstep;
    __device__ __forceinline__ bool next(int i, Unit& u) const {
        const long L = (long)i * G + c; if (L >= T.nwg) return false;
        T.map((int)L, u.pm, u.pn); u.A = A + (size_t)u.pm * tstep; u.B = B + (size_t)u.pn * tstep; u.kind = 0; return true;
    }
};
struct SchedBranch {
    TileOrder T; int G, c; const char* ws; const char* wl; size_t tstep;
    __device__ __forceinline__ bool next(int i, Unit& u) const {
        const long L = (long)(i >> 2) * G + c; if (L >= T.nwg) return false;
        T.map((int)L, u.pm, u.pn); const int sub = i & 3; u.kind = sub;
        const size_t oa = (sub == 1) ? R_Q : ((sub == 3) ? R_CB : R_H);
        const size_t ob = (sub == 0) ? (W_IN + (size_t)6144 * D * 2) : (sub == 1) ? W_A : (sub == 2) ? (W_IN + (size_t)7168 * D * 2) : W_B;
        u.A = ws + oa + (size_t)u.pm * tstep; u.B = wl + ob + (size_t)u.pn * tstep; return true;
    }
};

template <class Epi, class Sched>
__device__ __forceinline__ void gemm_phase(LAS unsigned char* lds, const int K, const Sched& S, const Epi& E, const int wid) {
    const int lane = lane_id_opaque(), tid = wid * 64 + lane, wr = wid >> 2, wc = wid & 3, fr = lane & 15, fq = lane >> 4;
    const int nt = K / BK;
    unsigned voff[2];
#pragma unroll
    for (int i = 0; i < 2; ++i) { int R, C; stage_rc(tid * 16 + i * 8192, R, C); voff[i] = (unsigned)(R * K + C) * 2u; }
    const size_t kstep = (size_t)(BK * 2);
    const size_t hstep = (size_t)HALF * K * 2;
    const unsigned ldsw = (unsigned)wid * 1024u;
    const int aoff = lds_byte(wr * 64 + fr, fq * 8), boff = lds_byte(wc * 32 + fr, fq * 8);
#define PG8_SA(b, h) (((b) * 2 + (h)) * HTB)
#define PG8_SB(b, h) ((4 + (b) * 2 + (h)) * HTB)
#define PG8_STAGE(bufoff, gbase) do { _Pragma("unroll") for (int _i = 0; _i < 2; ++_i) \
        __builtin_amdgcn_global_load_lds((const unsigned*)((const char*)(gbase) + voff[_i]), (LAS unsigned*)(lds + (bufoff) + ldsw + _i * 8192), 16, 0, 0); } while (0)
#define PG8_LDA(dst, b, h) do { _Pragma("unroll") for (int m = 0; m < 4; ++m) _Pragma("unroll") for (int k = 0; k < 2; ++k) dst[m][k] = *(const LAS bf16x8*)(lds + PG8_SA(b, h) + aoff + m * 2048 + k * 1024); } while (0)
#define PG8_LDB(dst, b, h) do { _Pragma("unroll") for (int n = 0; n < 2; ++n) _Pragma("unroll") for (int k = 0; k < 2; ++k) dst[n][k] = *(const LAS bf16x8*)(lds + PG8_SB(b, h) + boff + n * 2048 + k * 1024); } while (0)
#define PG8_MMA(ai, bj, At, Bt) do { __builtin_amdgcn_s_setprio(1); _Pragma("unroll") for (int m = 0; m < 4; ++m) _Pragma("unroll") for (int n = 0; n < 2; ++n) _Pragma("unroll") for (int k = 0; k < 2; ++k) \
        acc[ai][bj][m][n] = __builtin_amdgcn_mfma_f32_16x16x32_bf16(Bt[n][k], At[m][k], acc[ai][bj][m][n], 0, 0, 0); __builtin_amdgcn_s_setprio(0); } while (0)
#define PG8_WAIT_V(n) asm volatile("s_waitcnt vmcnt(" #n ")" ::: "memory")
#define PG8_WAIT_L(n) asm volatile("s_waitcnt lgkmcnt(" #n ")" ::: "memory")
#define PG8_BAR __builtin_amdgcn_s_barrier()
#define PG8_SCHED __builtin_amdgcn_sched_barrier(0)
    Unit cur, nxt; int ui = 0;
    if (!S.next(0, cur)) return;
    f32x4 acc[2][2][4][2];
#pragma unroll
    for (int a = 0; a < 2; ++a)
#pragma unroll
        for (int b = 0; b < 2; ++b)
#pragma unroll
            for (int m = 0; m < 4; ++m)
#pragma unroll
                for (int n = 0; n < 2; ++n) acc[a][b][m][n] = (f32x4){0.f, 0.f, 0.f, 0.f};
    bf16x8 At[4][2], B0[2][2], B1[2][2];
    const char* cA = cur.A; const char* cB = cur.B;
    PG8_STAGE(PG8_SB(0, 0), cB); PG8_STAGE(PG8_SB(0, 1), cB + hstep); PG8_STAGE(PG8_SA(0, 0), cA); PG8_STAGE(PG8_SA(0, 1), cA + hstep);
    if (wr == 1) PG8_BAR;
    PG8_WAIT_V(2); PG8_BAR;
    PG8_STAGE(PG8_SB(1, 0), cB + kstep); PG8_STAGE(PG8_SA(1, 0), cA + kstep); PG8_STAGE(PG8_SB(1, 1), cB + hstep + kstep);
    PG8_WAIT_V(6); PG8_BAR;
    for (;;) {
        const bool has_next = S.next(ui + 1, nxt);
        const char* nA = has_next ? nxt.A : cA; const char* nB = has_next ? nxt.B : cB;
        for (int t = 0; t < nt; t += 2) {
            const bool last = (t == nt - 2);
            const char* a1 = cA + (size_t)(t + 1) * kstep;
            const char* a2 = last ? nA : cA + (size_t)(t + 2) * kstep; const char* b2 = last ? nB : cB + (size_t)(t + 2) * kstep;
            const char* a3 = a2 + kstep; const char* b3 = b2 + kstep;
            PG8_LDB(B0, 0, 0); PG8_LDB(B1, 0, 1); PG8_SCHED; PG8_LDA(At, 0, 0); PG8_STAGE(PG8_SA(1, 1), a1 + hstep);
            PG8_WAIT_V(8); PG8_WAIT_L(0); PG8_BAR; PG8_MMA(0, 0, At, B0); PG8_MMA(0, 1, At, B1); PG8_BAR; PG8_SCHED;
            PG8_LDA(At, 0, 1); PG8_STAGE(PG8_SB(0, 0), b2); PG8_STAGE(PG8_SB(0, 1), b2 + hstep); PG8_STAGE(PG8_SA(0, 0), a2);
            PG8_WAIT_V(8); PG8_WAIT_L(0); PG8_BAR; PG8_MMA(1, 0, At, B0); PG8_MMA(1, 1, At, B1); PG8_BAR; PG8_SCHED;
            PG8_LDB(B0, 1, 0); PG8_LDB(B1, 1, 1); PG8_SCHED; PG8_LDA(At, 1, 0); PG8_STAGE(PG8_SA(0, 1), a2 + hstep);
            PG8_WAIT_V(8); PG8_WAIT_L(0); PG8_BAR; PG8_MMA(0, 0, At, B0); PG8_MMA(0, 1, At, B1); PG8_BAR; PG8_SCHED;
            PG8_LDA(At, 1, 1); PG8_STAGE(PG8_SB(1, 0), b3); PG8_STAGE(PG8_SB(1, 1), b3 + hstep); PG8_STAGE(PG8_SA(1, 0), a3);
            PG8_WAIT_V(8); PG8_WAIT_L(0); PG8_BAR; PG8_MMA(1, 0, At, B0); PG8_MMA(1, 1, At, B1); PG8_BAR; PG8_SCHED;
        }
        if (wr == 0) PG8_BAR;
        { const int l2 = lane_id_opaque(); E(acc, cur, wr, wc, l2 & 15, l2 >> 4); }
        if (!has_next) break;
#pragma unroll
        for (int a = 0; a < 2; ++a)
#pragma unroll
            for (int b = 0; b < 2; ++b)
#pragma unroll
                for (int m = 0; m < 4; ++m)
#pragma unroll
                    for (int n = 0; n < 2; ++n) acc[a][b][m][n] = (f32x4){0.f, 0.f, 0.f, 0.f};
        cur = nxt; cA = nA; cB = nB; ++ui;
        if (wr == 1) PG8_BAR;
    }
    PG8_WAIT_V(0);
    PG8_BAR;
#undef PG8_SA
#undef PG8_SB
#undef PG8_STAGE
#undef PG8_LDA
#undef PG8_LDB
#undef PG8_MMA
#undef PG8_WAIT_V
#undef PG8_WAIT_L
#undef PG8_BAR
#undef PG8_SCHED
}

__device__ __forceinline__ u32x4 pack8(const f32x4& a, const f32x4& b) { u32x4 w; w.x = cvt_pk(a[0], a[1]); w.y = cvt_pk(a[2], a[3]); w.z = cvt_pk(b[0], b[1]); w.w = cvt_pk(b[2], b[3]); return w; }

struct EpiRegions {
    bf16_t* base;
    __device__ __forceinline__ void operator()(const f32x4 (&acc)[2][2][4][2], const Unit& u, int wr, int wc, int fr, int fq) const {
        bf16_t* dst = base + (size_t)(u.pn >> 2) * ((size_t)M * D);
        const int col = (u.pn & 3) * 256 + wc * 64 + fq * 8, row0 = u.pm * BM + wr * 64 + fr;
#pragma unroll
        for (int ai = 0; ai < 2; ++ai)
#pragma unroll
            for (int m = 0; m < 4; ++m) { bf16_t* rp = dst + (size_t)(row0 + ai * HALF + m * 16) * D + col;
#pragma unroll
                for (int bj = 0; bj < 2; ++bj) *(u32x4*)(rp + bj * 32) = pack8(acc[ai][bj][m][0], acc[ai][bj][m][1]); }
    }
};
struct EpiQKV {
    bf16_t* base; const float* gq; const float* gk;
    __device__ __forceinline__ void operator()(const f32x4 (&acc)[2][2][4][2], const Unit& u, int wr, int wc, int fr, int fq) const {
        const int region = u.pn >> 2, head = (u.pn & 3) * 4 + wc, row0 = u.pm * BM + wr * 64 + fr;
        if (region == 2) {
            const int b = row0 >> 12;
            bf16_t* vb = base + (size_t)2 * M * D + ((size_t)(b * NH + head) * HD) * SEQ;
#pragma unroll
            for (int ai = 0; ai < 2; ++ai)
#pragma unroll
                for (int m = 0; m < 4; ++m) { const int s0 = (row0 + ai * HALF + m * 16) & (SEQ - 1), q = (s0 >> 2) & 3;
                    const int s = (s0 & ~12) | ((((q & 1) << 1) | (q >> 1)) << 2);
#pragma unroll
                    for (int bj = 0; bj < 2; ++bj)
#pragma unroll
                        for (int n = 0; n < 2; ++n)
#pragma unroll
                            for (int j = 0; j < 4; ++j) { const int d = bj * 32 + fq * 8 + n * 4 + j; const unsigned w = cvt_pk(acc[ai][bj][m][n][j], 0.f);
                                vb[(size_t)d * SEQ + s] = (bf16_t)(w & 0xffffu); } }
        } else if (region >= 3) {
            bf16_t* dst = base + (size_t)region * ((size_t)M * D);
            const int col = (u.pn & 3) * 256 + wc * 64 + fq * 8;
#pragma unroll
            for (int ai = 0; ai < 2; ++ai)
#pragma unroll
                for (int m = 0; m < 4; ++m) { bf16_t* rp = dst + (size_t)(row0 + ai * HALF + m * 16) * D + col;
#pragma unroll
                    for (int bj = 0; bj < 2; ++bj) *(u32x4*)(rp + bj * 32) = pack8(acc[ai][bj][m][0], acc[ai][bj][m][1]); }
        } else {
            const float* g = region == 0 ? gq : gk; const float sc = region == 0 ? C2 : 1.0f;
            bf16_t* dst = base + (size_t)region * ((size_t)M * D);
            f32x4 gv[2][2];
#pragma unroll
            for (int bj = 0; bj < 2; ++bj)
#pragma unroll
                for (int n = 0; n < 2; ++n) gv[bj][n] = *(const f32x4*)(g + bj * 32 + fq * 8 + n * 4) * sc;
            const int col = head * 64 + fq * 8;
#pragma unroll
            for (int ai = 0; ai < 2; ++ai)
#pragma unroll
                for (int m = 0; m < 4; ++m) {
                    float ss = 0.f;
#pragma unroll
                    for (int bj = 0; bj < 2; ++bj)
#pragma unroll
                        for (int n = 0; n < 2; ++n) { const f32x4 x = acc[ai][bj][m][n]; ss += (x[0] * x[0] + x[1] * x[1]) + (x[2] * x[2] + x[3] * x[3]); }
                    ss += shx(ss, 16, fr + 16 * fq); ss += shx(ss, 32, fr + 16 * fq);
                    const float r = 1.0f / sqrtf(ss * (1.0f / 64.0f) + EPS);
                    bf16_t* rp = dst + (size_t)(row0 + ai * HALF + m * 16) * D + col;
#pragma unroll
                    for (int bj = 0; bj < 2; ++bj) { const f32x4 a = acc[ai][bj][m][0] * r * gv[bj][0], b2 = acc[ai][bj][m][1] * r * gv[bj][1]; *(u32x4*)(rp + bj * 32) = pack8(a, b2); }
                }
        }
    }
};
struct EpiBranch {
    bf16_t* S1; bf16_t* TM;
    __device__ __forceinline__ void operator()(const f32x4 (&acc)[2][2][4][2], const Unit& u, int wr, int wc, int fr, int fq) const {
        const int col = u.pn * 256 + wc * 64 + fq * 8, row0 = u.pm * BM + wr * 64 + fr, kind = u.kind;
#pragma unroll
        for (int ai = 0; ai < 2; ++ai) {
            if (kind == 0 || kind == 2) {
#pragma unroll
                for (int m = 0; m < 4; ++m) { const size_t off = (size_t)(row0 + ai * HALF + m * 16) * D + col;
#pragma unroll
                    for (int bj = 0; bj < 2; ++bj) { f32x4 a = acc[ai][bj][m][0], b = acc[ai][bj][m][1];
#pragma unroll
                        for (int j = 0; j < 4; ++j) { a[j] = sigmoidf_(a[j]); b[j] = sigmoidf_(b[j]); }
                        *(u32x4*)(S1 + off + bj * 32) = pack8(a, b); } }
            } else {
#pragma unroll
              for (int mh = 0; mh < 2; ++mh) {
                u32x4 g[2][2], t[2][2];
#pragma unroll
                for (int m2 = 0; m2 < 2; ++m2) { const int m = 2 * mh + m2; const size_t off = (size_t)(row0 + ai * HALF + m * 16) * D + col;
#pragma unroll
                    for (int bj = 0; bj < 2; ++bj) { g[m2][bj] = *(const u32x4*)(S1 + off + bj * 32); if (kind == 3) t[m2][bj] = *(const u32x4*)(TM + off + bj * 32); else t[m2][bj] = (u32x4){0u, 0u, 0u, 0u}; } }
#pragma unroll
                for (int m2 = 0; m2 < 2; ++m2) { const int m = 2 * mh + m2; const size_t off = (size_t)(row0 + ai * HALF + m * 16) * D + col;
#pragma unroll
                    for (int bj = 0; bj < 2; ++bj) { f32x4 a = acc[ai][bj][m][0], b = acc[ai][bj][m][1]; const u32x4 gg = g[m2][bj], tt = t[m2][bj];
                        a[0] = a[0] * bf_lo(gg.x) + bf_lo(tt.x); a[1] = a[1] * bf_hi(gg.x) + bf_hi(tt.x); a[2] = a[2] * bf_lo(gg.y) + bf_lo(tt.y); a[3] = a[3] * bf_hi(gg.y) + bf_hi(tt.y);
                        b[0] = b[0] * bf_lo(gg.z) + bf_lo(tt.z); b[1] = b[1] * bf_hi(gg.z) + bf_hi(tt.z); b[2] = b[2] * bf_lo(gg.w) + bf_lo(tt.w); b[3] = b[3] * bf_hi(gg.w) + bf_hi(tt.w);
                        *(u32x4*)(TM + off + bj * 32) = pack8(a, b); } }
              }
            }
        }
    }
};
struct EpiResid {
    const float* xin; float* xout; const float* gmod;
    __device__ __forceinline__ void operator()(const f32x4 (&acc)[2][2][4][2], const Unit& u, int wr, int wc, int fr, int fq) const {
        const int col = u.pn * 256 + wc * 64 + fq * 8, row0 = u.pm * BM + wr * 64 + fr, b = row0 >> 12;
        f32x4 gv[2][2];
#pragma unroll
        for (int bj = 0; bj < 2; ++bj)
#pragma unroll
            for (int n = 0; n < 2; ++n) gv[bj][n] = *(const f32x4*)(gmod + b * 6144 + col + bj * 32 + n * 4);
#pragma unroll
        for (int ai = 0; ai < 2; ++ai)
#pragma unroll
          for (int mh = 0; mh < 2; ++mh) {
            f32x4 xo[2][2][2];
#pragma unroll
            for (int m2 = 0; m2 < 2; ++m2) { const size_t off = (size_t)(row0 + ai * HALF + (2 * mh + m2) * 16) * D + col;
#pragma unroll
                for (int bj = 0; bj < 2; ++bj)
#pragma unroll
                    for (int n = 0; n < 2; ++n) xo[m2][bj][n] = *(const f32x4*)(xin + off + bj * 32 + n * 4); }
#pragma unroll
            for (int m2 = 0; m2 < 2; ++m2) { const size_t off = (size_t)(row0 + ai * HALF + (2 * mh + m2) * 16) * D + col;
#pragma unroll
                for (int bj = 0; bj < 2; ++bj)
#pragma unroll
                    for (int n = 0; n < 2; ++n) *(f32x4*)(xout + off + bj * 32 + n * 4) = xo[m2][bj][n] + gv[bj][n] * acc[ai][bj][2 * mh + m2][n]; }
          }
    }
};
struct EpiGU {
    bf16_t* f;
    __device__ __forceinline__ void operator()(const f32x4 (&acc)[2][2][4][2], const Unit& u, int wr, int wc, int fr, int fq) const {
        const int col = u.pn * 128 + wc * 32 + fq * 8, row0 = u.pm * BM + wr * 64 + fr;
#pragma unroll
        for (int ai = 0; ai < 2; ++ai)
#pragma unroll
            for (int m = 0; m < 4; ++m) {
                f32x4 o[2];
#pragma unroll
                for (int n = 0; n < 2; ++n)
#pragma unroll
                    for (int j = 0; j < 4; ++j) { const float gt = acc[ai][0][m][n][j]; o[n][j] = gt * sigmoidf_(gt) * acc[ai][1][m][n][j]; }
                *(u32x4*)(f + (size_t)(row0 + ai * HALF + m * 16) * FF + col) = pack8(o[0], o[1]);
            }
    }
};
}

#define LDS_WAIT() asm volatile("s_waitcnt lgkmcnt(0)" ::: "memory")
__device__ __forceinline__ void transpose_item(const float* W, int N, int K, int n0, bf16_t* WT, int a0, int k0, LAS float* scr, int lane) {
    {
        const int kr = lane >> 3, c4 = (lane & 7) * 4;
        f32x4 t[8];
#pragma unroll
        for (int i = 0; i < 8; ++i) t[i] = __builtin_nontemporal_load((const f32x4*)(W + (size_t)(k0 + 8 * i + kr) * N + n0 + c4));
#pragma unroll
        for (int i = 0; i < 8; ++i) { LAS float* d = scr + (8 * i + kr) * 33 + c4; d[0] = t[i][0]; d[1] = t[i][1]; d[2] = t[i][2]; d[3] = t[i][3]; }
    }
    LDS_WAIT(); asm volatile("" ::: "memory");
    const int c = lane & 7;
#pragma unroll
    for (int j = 0; j < 4; ++j) { const int s = (lane >> 3) + 8 * j; const int lo = 8 * ((s >> 2) & 3) + 4 * (s >> 4) + (s & 3);
        const LAS float* sp = scr + (8 * c) * 33 + lo;
        u32x4 o; o.x = cvt_pk(sp[0 * 33], sp[1 * 33]); o.y = cvt_pk(sp[2 * 33], sp[3 * 33]); o.z = cvt_pk(sp[4 * 33], sp[5 * 33]); o.w = cvt_pk(sp[6 * 33], sp[7 * 33]);
        *(u32x4*)(WT + (size_t)(a0 + s) * K + k0 + 8 * c) = o; }
    LDS_WAIT(); asm volatile("" ::: "memory");
}

struct Params { const float* in[16]; float* out; unsigned char* ws; };

__device__ __forceinline__ void phase0(const Params& p, LAS unsigned char* lds, int gw, int NGW, int wave, int lane, const int l, const bool with_mod) {
    LAS float* scr = (LAS float*)(lds + wave * 16384);
    constexpr int I_IN = 256 * 16, I_SQ = 32 * 16, I_GU = 176 * 16, I_D = 32 * 44, I_LAYER = I_IN + 3 * I_SQ + I_GU + I_D;
    constexpr int I_MOD = 2 * 32 * 24;
    for (int it = gw; it < (with_mod ? I_MOD : 0); it += NGW) {
        const int l = it / (32 * 24), r = it % (32 * 24), kc = r / 24, nb = r % 24;
        const float* aw = p.in[2] + (size_t)l * D * 6144 + (size_t)(kc * 32) * 6144 + nb * 256 + lane * 4;
        const float* c = p.in[1];
        f32x4 a[4];
#pragma unroll
        for (int b = 0; b < 4; ++b) a[b] = (f32x4){0.f, 0.f, 0.f, 0.f};
#pragma unroll 8
        for (int k = 0; k < 32; ++k) { const f32x4 w = __builtin_nontemporal_load((const f32x4*)(aw + (size_t)k * 6144));
#pragma unroll
            for (int b = 0; b < 4; ++b) { const float cv = c[b * D + kc * 32 + k]; const float sv = cv * sigmoidf_(cv); a[b] += w * sv; } }
        float* mp = (float*)(p.ws + R_CX) + ((size_t)(l * 32 + kc) * 4) * 6144 + nb * 256 + lane * 4;
#pragma unroll
        for (int b = 0; b < 4; ++b) *(f32x4*)(mp + (size_t)b * 6144) = a[b];
    }
    for (int it = gw; it < I_LAYER; it += NGW) {
        int r = it;
        unsigned char* wl = p.ws + WS_W;
        if (r < I_IN) { const int kb = r / 256, g = r % 256; const int pn = g >> 3, bj = (g >> 2) & 1, wc = g & 3;
            transpose_item(p.in[5] + (size_t)l * D * INW, INW, D, 256 * pn + 64 * wc + 32 * bj, (bf16_t*)(wl + W_IN), 32 * g, 64 * kb, scr, lane); continue; }
        r -= I_IN;
        if (r < 3 * I_SQ) { const int which = r / I_SQ; r %= I_SQ; const int kb = r / 32, g = r % 32; const int pn = g >> 3, bj = (g >> 2) & 1, wc = g & 3;
            const float* src = p.in[9 + which] + (size_t)l * D * D; bf16_t* dst = (bf16_t*)(wl + (which == 0 ? W_A : which == 1 ? W_B : W_O));
            transpose_item(src, D, D, 256 * pn + 64 * wc + 32 * bj, dst, 32 * g, 64 * kb, scr, lane); continue; }
        r -= 3 * I_SQ;
        if (r < I_GU) { const int kb = r / 176, g = r % 176; const int pn = g >> 3, bj = (g >> 2) & 1, wc = g & 3;
            const float* src = p.in[bj ? 14 : 13] + (size_t)l * D * FF;
            transpose_item(src, FF, D, 128 * pn + 32 * wc, (bf16_t*)(wl + W_GU), 32 * g, 64 * kb, scr, lane); continue; }
        r -= I_GU;
        { const int kb = r / 32, g = r % 32; const int pn = g >> 3, bj = (g >> 2) & 1, wc = g & 3;
            transpose_item(p.in[15] + (size_t)l * FF * D, D, FF, 256 * pn + 64 * wc + 32 * bj, (bf16_t*)(wl + W_D), 32 * g, 64 * kb, scr, lane); }
    }
}

__device__ __forceinline__ void norm_phase(const float* x, const float* g, const float* modl, int sh_off, int sc_off, bf16_t* h, int gw, int NGW) {
    const int lane = lane_id_opaque();
    for (int q = gw; q < M / 4; q += NGW) {
        const int m0 = 4 * q, b = m0 >> 12;
        f32x4 v[4][4];
#pragma unroll
        for (int r = 0; r < 4; ++r) { const f32x4* xr = (const f32x4*)(x + (size_t)(m0 + r) * D) + lane;
#pragma unroll
            for (int j = 0; j < 4; ++j) v[r][j] = xr[64 * j]; }
        float rs[4];
#pragma unroll
        for (int r = 0; r < 4; ++r) { float s = 0.f;
#pragma unroll
            for (int j = 0; j < 4; ++j) s += (v[r][j][0] * v[r][j][0] + v[r][j][1] * v[r][j][1]) + (v[r][j][2] * v[r][j][2] + v[r][j][3] * v[r][j][3]);
            rs[r] = s; }
#pragma unroll
        for (int o = 1; o < 64; o <<= 1) {
#pragma unroll
            for (int r = 0; r < 4; ++r) rs[r] += shx(rs[r], o, lane); }
#pragma unroll
        for (int r = 0; r < 4; ++r) rs[r] = 1.0f / sqrtf(rs[r] * (1.0f / D) + EPS);
#pragma unroll
        for (int j = 0; j < 4; ++j) { const int col = 4 * (64 * j + lane);
            const f32x4 gg = *(const f32x4*)(g + col), sc = *(const f32x4*)(modl + b * 6144 + sc_off + col) + 1.0f, sh = *(const f32x4*)(modl + b * 6144 + sh_off + col);
#pragma unroll
            for (int r = 0; r < 4; ++r) { const f32x4 y = (v[r][j] * rs[r] * gg) * sc + sh;
                u32x2 w; w.x = cvt_pk(y[0], y[1]); w.y = cvt_pk(y[2], y[3]); *((u32x2*)(h + (size_t)(m0 + r) * D) + lane + 64 * j) = w; } }
    }
}

__device__ __forceinline__ void conv_phase(bf16_t* cb, const bf16_t* cc, const bf16_t* cx, const float* cw, int gt0, int NT) {
    const int gt = gt0 + lane_id_opaque();
    for (int it = gt; it < (M / 16) * (D / 8); it += NT) {
        const int c8 = it & 127, run = it >> 7, t0 = run * 16, ch = c8 * 8;
        float w0[8], w1[8], w2[8];
#pragma unroll
        for (int i = 0; i < 8; ++i) { w0[i] = cw[ch + i]; w1[i] = cw[D + ch + i]; w2[i] = cw[2 * D + ch + i]; }
        float um2[8], um1[8];
#pragma unroll
        for (int i = 0; i < 8; ++i) { um2[i] = 0.f; um1[i] = 0.f; }
        if ((t0 & (SEQ - 1)) != 0) {
            const u32x4 a2 = *(const u32x4*)(cc + (size_t)(t0 - 2) * D + ch), b2 = *(const u32x4*)(cx + (size_t)(t0 - 2) * D + ch);
            const u32x4 a1 = *(const u32x4*)(cc + (size_t)(t0 - 1) * D + ch), b1 = *(const u32x4*)(cx + (size_t)(t0 - 1) * D + ch);
#pragma unroll
            for (int i = 0; i < 4; ++i) { um2[2 * i] = bf_lo(a2[i]) * bf_lo(b2[i]); um2[2 * i + 1] = bf_hi(a2[i]) * bf_hi(b2[i]);
                um1[2 * i] = bf_lo(a1[i]) * bf_lo(b1[i]); um1[2 * i + 1] = bf_hi(a1[i]) * bf_hi(b1[i]); }
        }
#pragma unroll 4
        for (int t = 0; t < 16; ++t) {
            const size_t off = (size_t)(t0 + t) * D + ch;
            const u32x4 a = *(const u32x4*)(cc + off), b = *(const u32x4*)(cx + off), e = *(const u32x4*)(cb + off);
            float u[8], y[8];
#pragma unroll
            for (int i = 0; i < 4; ++i) { u[2 * i] = bf_lo(a[i]) * bf_lo(b[i]); u[2 * i + 1] = bf_hi(a[i]) * bf_hi(b[i]); }
#pragma unroll
            for (int i = 0; i < 4; ++i) {
                y[2 * i] = bf_lo(e[i]) * (w0[2 * i] * um2[2 * i] + w1[2 * i] * um1[2 * i] + w2[2 * i] * u[2 * i]);
                y[2 * i + 1] = bf_hi(e[i]) * (w0[2 * i + 1] * um2[2 * i + 1] + w1[2 * i + 1] * um1[2 * i + 1] + w2[2 * i + 1] * u[2 * i + 1]); }
            u32x4 o; o.x = cvt_pk(y[0], y[1]); o.y = cvt_pk(y[2], y[3]); o.z = cvt_pk(y[4], y[5]); o.w = cvt_pk(y[6], y[7]);
            *(u32x4*)(cb + off) = o;
#pragma unroll
            for (int i = 0; i < 8; ++i) { um2[i] = um1[i]; um1[i] = u[i]; }
        }
    }
}

#define MFMA32(a, b, c) __builtin_amdgcn_mfma_f32_32x32x16_bf16((a), (b), (c), 0, 0, 0)
constexpr float SB_EXIT = 1.0e-20f;
__device__ __forceinline__ float clamp_z(float z) { return __builtin_amdgcn_fmed3f(z, -126.0f, 80.0f); }
struct AttnState { f32x16 o0, o1; float P; bf16x8 kf[4]; };
template <bool DIAG>
__device__ __forceinline__ void attn_step(AttnState& st, const bf16x8 (&qf)[4], const bf16_t* kbase, const bf16_t* vbase, int j0, bool more, int n, int hh, int lane) {
    bf16x8 vf[2][2];
#pragma unroll
    for (int mb = 0; mb < 2; ++mb)
#pragma unroll
        for (int s = 0; s < 2; ++s) vf[mb][s] = *(const bf16x8*)(vbase + (size_t)mb * 32 * SEQ + j0 + 16 * s);
    f32x16 sa;
#pragma unroll
    for (int r = 0; r < 16; ++r) sa[r] = 0.f;
#pragma unroll
    for (int kk = 0; kk < 4; ++kk) sa = MFMA32(st.kf[kk], qf[kk], sa);
    if (more) {
#pragma unroll
        for (int kk = 0; kk < 4; ++kk) st.kf[kk] = *(const bf16x8*)(kbase + (size_t)(j0 - 32) * D + kk * 16);
    }
    float om[16], be[16];
#pragma unroll
    for (int r = 0; r < 16; ++r) {
        const float e = fast_exp2(clamp_z(sa[r]));
        float o = fast_rcp(1.0f + e), b = e * o;
        if (DIAG) { const int ki = (r & 3) + 8 * (r >> 2) + 4 * hh; if (ki >= n) { o = 1.0f; b = 0.f; } }
        om[r] = o; be[r] = b;
    }
    float g[4], pg[4];
#pragma unroll
    for (int q = 0; q < 4; ++q) g[q] = (om[4 * q] * om[4 * q + 1]) * (om[4 * q + 2] * om[4 * q + 3]);
#pragma unroll
    for (int q = 0; q < 4; ++q) pg[q] = shx(g[q], 32, lane);
    float run = st.P;
    float a[16];
#pragma unroll
    for (int q = 3; q >= 0; --q) {
        const float c3 = (hh == 0) ? run * pg[q] : run;
        const float c2 = c3 * om[4 * q + 3], c1 = c2 * om[4 * q + 2], c0 = c1 * om[4 * q + 1];
        a[4 * q + 3] = be[4 * q + 3] * c3; a[4 * q + 2] = be[4 * q + 2] * c2; a[4 * q + 1] = be[4 * q + 1] * c1; a[4 * q] = be[4 * q] * c0;
        run *= g[q] * pg[q];
    }
    st.P = run;
#pragma unroll
    for (int s = 0; s < 2; ++s) {
        u32x4 pw; pw.x = cvt_pk(a[8 * s + 0], a[8 * s + 1]); pw.y = cvt_pk(a[8 * s + 2], a[8 * s + 3]); pw.z = cvt_pk(a[8 * s + 4], a[8 * s + 5]); pw.w = cvt_pk(a[8 * s + 6], a[8 * s + 7]);
        const bf16x8 pf = __builtin_bit_cast(bf16x8, pw);
        st.o0 = MFMA32(vf[0][s], pf, st.o0); st.o1 = MFMA32(vf[1][s], pf, st.o1);
    }
}
__device__ __forceinline__ void attn_task(bf16_t* QO, const bf16_t* Kp, const bf16_t* VT, int b, int h, int qblk, int lane) {
    const int n = lane & 31, hh = lane >> 5, t0 = qblk * 32;
    bf16_t* qrow = QO + (size_t)(b * SEQ + t0 + n) * D + h * HD;
    bf16x8 qf[4];
#pragma unroll
    for (int kk = 0; kk < 4; ++kk) qf[kk] = *(const bf16x8*)(qrow + kk * 16 + hh * 8);
    AttnState st;
#pragma unroll
    for (int r = 0; r < 16; ++r) { st.o0[r] = 0.f; st.o1[r] = 0.f; }
    st.P = 1.0f;
    const bf16_t* kbase = Kp + (size_t)(b * SEQ + n) * D + h * HD + hh * 8;
    const bf16_t* vbase = VT + ((size_t)(b * NH + h) * HD + n) * SEQ + 8 * hh;
#pragma unroll
    for (int kk = 0; kk < 4; ++kk) st.kf[kk] = *(const bf16x8*)(kbase + (size_t)t0 * D + kk * 16);
    attn_step<true>(st, qf, kbase, vbase, t0, qblk > 0, n, hh, lane);
    for (int kb = qblk - 1; kb >= 0; --kb) {
        if (!__any(st.P > SB_EXIT)) break;
        attn_step<false>(st, qf, kbase, vbase, kb * 32, kb > 0, n, hh, lane);
    }
#pragma unroll
    for (int q = 0; q < 4; ++q) {
        u32x2 w0, w1; w0.x = cvt_pk(st.o0[4 * q], st.o0[4 * q + 1]); w0.y = cvt_pk(st.o0[4 * q + 2], st.o0[4 * q + 3]); w1.x = cvt_pk(st.o1[4 * q], st.o1[4 * q + 1]); w1.y = cvt_pk(st.o1[4 * q + 2], st.o1[4 * q + 3]);
        *(u32x2*)(qrow + 8 * q + 4 * hh) = w0; *(u32x2*)(qrow + 32 + 8 * q + 4 * hh) = w1;
    }
}
__device__ __forceinline__ void attn_phase(bf16_t* QO, const bf16_t* Kp, const bf16_t* VT, int G, int bx, int wave) {
    const int lane = lane_id_opaque();
    constexpr int NQB = SEQ / 32, NTASK = NB * NH * NQB;
    if (G == 256) {
#pragma unroll 1
        for (int i = 0; i < 4; ++i) { const int bh = 2 * (wave * 4 + i) + (bx & 1); attn_task(QO, Kp, VT, bh / NH, bh % NH, bx >> 1, lane); }
    } else {
        int i = 0;
        for (int tau = bx * NWAVES + wave; tau < NTASK; tau += G * NWAVES, ++i) {
            const int bh = tau / NQB, qr = tau % NQB, qblk = (i & 1) ? (NQB - 1 - qr) : qr;
            attn_task(QO, Kp, VT, bh / NH, bh % NH, qblk, lane);
        }
    }
}
__device__ __forceinline__ void mixer_phase(bf16_t* QO, const bf16_t* Kp, const bf16_t* VT, bf16_t* cb, const bf16_t* cc, const bf16_t* cx, const float* cw, int G, int bx, int wave, int gt0, int NT) {
    if (wave & 4) { conv_phase(cb, cc, cx, cw, gt0, NT); attn_phase(QO, Kp, VT, G, bx, wave); }
    else          { attn_phase(QO, Kp, VT, G, bx, wave); conv_phase(cb, cc, cx, cw, gt0, NT); }
}

#define XB_TMO      128
#define XB_XCNT(j)  (256  + 64 * (j))
#define XB_XSUB(j)  (1280 + 64 * (j))
#define XB_XGEN(j)  (2304 + 64 * (j))
#define XB_TOP      3328
#define XB_TOPGEN   3392
#define XCD_BAR_WORDS 3456
#define XB_SPIN_CAP (1u << 18)
__device__ __forceinline__ unsigned xb_ld(unsigned* p)              { return __hip_atomic_load(p, __ATOMIC_RELAXED, __HIP_MEMORY_SCOPE_AGENT); }
__device__ __forceinline__ unsigned xb_add(unsigned* p, unsigned v) { return __hip_atomic_fetch_add(p, v, __ATOMIC_RELAXED, __HIP_MEMORY_SCOPE_AGENT); }
__device__ __forceinline__ unsigned xb_xcc_id() { return (unsigned)__builtin_amdgcn_s_getreg((3 << 11) | 20) & 0xFu; }
#define XB_SPIN(cond, bar) do { unsigned _sp = 0; while (cond) { __builtin_amdgcn_s_sleep(1); \
    if ((++_sp & 255u) == 0u) { if (xb_ld(&(bar)[XB_TMO])) break; if (_sp > XB_SPIN_CAP) { atomicAdd(&(bar)[XB_TMO], 1u); break; } } } } while (0)
struct XcdBarrier { unsigned* bar; unsigned x; volatile LAS unsigned* st; };
__device__ __forceinline__ XcdBarrier xcd_barrier_post(unsigned* bar, volatile LAS unsigned* st, int tid) {
    XcdBarrier b; b.bar = bar; b.x = xb_xcc_id(); b.st = st;
    if (tid == 0) (void)xb_add(&bar[XB_XCNT(b.x)], 1u);
    return b;
}
__device__ __forceinline__ void xcd_barrier_complete(unsigned* bar, unsigned x, unsigned& nloc, unsigned& nx) {
    const unsigned G = gridDim.x * gridDim.y * gridDim.z;
    unsigned sum, cnt, mine, sp = 0u;
    for (;;) {
        sum = 0u; cnt = 0u; mine = 0u;
#pragma unroll
        for (unsigned j = 0; j < 16; ++j) { const unsigned c = xb_ld(&bar[XB_XCNT(j)]); sum += c; cnt += (c > 0u) ? 1u : 0u; mine = (j == x) ? c : mine; }
        if (sum == G) break;
        __builtin_amdgcn_s_sleep(1);
        if ((++sp & 255u) == 0u) { if (xb_ld(&bar[XB_TMO])) break; if (sp > XB_SPIN_CAP) { atomicAdd(&bar[XB_TMO], 1u); break; } }
    }
    nloc = mine > 0u ? mine : 1u; nx = cnt > 0u ? cnt : 1u;
}
__device__ __forceinline__ void xcd_barrier(const XcdBarrier& b, bool leader) {
    asm volatile("s_waitcnt vmcnt(0)" ::: "memory");
    __syncthreads();
    if (leader) {
        unsigned* bar = b.bar;
        __builtin_amdgcn_s_waitcnt(0);
        unsigned nloc = b.st[0], nx = b.st[1];
        if (nloc == 0u) { xcd_barrier_complete(bar, b.x, nloc, nx); b.st[0] = nloc; b.st[1] = nx; }
        const unsigned old = xb_add(&bar[XB_XSUB(b.x)], 1u);
        const unsigned gen = old / nloc;
        if (old + 1u == (gen + 1u) * nloc) {
            __builtin_amdgcn_fence(__ATOMIC_RELEASE, "agent");
            asm volatile("s_waitcnt vmcnt(0)" ::: "memory");
            const unsigned og = xb_add(&bar[XB_TOP], 1u);
            const unsigned tg = og / nx;
            if (og + 1u == (tg + 1u) * nx) xb_add(&bar[XB_TOPGEN], 1u);
            else XB_SPIN(xb_ld(&bar[XB_TOPGEN]) == tg, bar);
            __builtin_amdgcn_fence(__ATOMIC_ACQUIRE, "agent");
            xb_add(&bar[XB_XGEN(b.x)], 1u);
            asm volatile("s_waitcnt vmcnt(0)" ::: "memory");
        } else {
            XB_SPIN(xb_ld(&bar[XB_XGEN(b.x)]) == gen, bar);
            __builtin_amdgcn_fence(__ATOMIC_ACQUIRE, "agent");
            asm volatile("s_waitcnt vmcnt(0)" ::: "memory");
        }
    }
    __syncthreads();
}

#define XB_DONE XCD_BAR_WORDS
__device__ unsigned g_bar[XCD_BAR_WORDS + 64];

constexpr int LDS_BYTES = 131072 + 1024;
__global__ void __launch_bounds__(NTHREADS, 2) fwd_kernel(Params p) {
    extern __shared__ __attribute__((aligned(16))) unsigned char lds_raw[];
    LAS unsigned char* lds = (LAS unsigned char*)lds_raw;
    cg::grid_group grid = cg::this_grid();
#define CG_SYNC() do { asm volatile("s_waitcnt vmcnt(0)" ::: "memory"); grid.sync(); if (wave == 0) { __builtin_amdgcn_fence(__ATOMIC_ACQUIRE, "agent"); asm volatile("s_waitcnt vmcnt(0)" ::: "memory"); } __syncthreads(); } while (0)
#define GRID_SYNC_() xcd_barrier(xb, leader)
    unsigned long long pr_acc = 0, pr_t0 = 0;
#define TIC() do { if (PROBE_MASK) pr_t0 = __builtin_amdgcn_s_memrealtime(); } while (0)
#define TOC(bit) do { if (PROBE_MASK & (bit)) pr_acc += __builtin_amdgcn_s_memrealtime() - pr_t0; } while (0)
#define GRID_SYNC() do { TIC(); GRID_SYNC_(); TOC(2 | sync_kind); } while (0)
    int sync_kind = 128;
    const int tid0 = threadIdx.x, wave = __builtin_amdgcn_readfirstlane(tid0 >> 6);
    const int G = gridDim.x, bx = blockIdx.x;
    const int gw = bx * NWAVES + wave, NGW = G * NWAVES, NT = G * NTHREADS;
    unsigned char* ws = p.ws;
    float* mod = (float*)(ws + WS_CTL);
    bf16_t* Rh = (bf16_t*)(ws + R_H); bf16_t* Rq = (bf16_t*)(ws + R_Q); bf16_t* Rk = (bf16_t*)(ws + R_K); bf16_t* Rv = (bf16_t*)(ws + R_V);
    bf16_t* Rcb = (bf16_t*)(ws + R_CB); bf16_t* Rcc = (bf16_t*)(ws + R_CC); bf16_t* Rcx = (bf16_t*)(ws + R_CX);
    const unsigned char* wl = ws + WS_W;

    unsigned* barw = g_bar;
    volatile LAS unsigned* bst = (volatile LAS unsigned*)(lds + 131072);
    const bool leader = (wave == 0) && (lane_id_opaque() == 0);
    if (leader) { bst[0] = 0u; bst[1] = 0u; bst[2] = 0u; }
    const XcdBarrier xb = xcd_barrier_post(barw, bst, leader ? 0 : 1);
    if (G == 0x7fffffff) CG_SYNC();
    TIC();
    phase0(p, lds, gw, NGW, wave, lane_id_opaque(), 0, true);
    TOC(16);
    GRID_SYNC();
    TIC();
    {
        const int gt = bx * NTHREADS + wave * 64 + lane_id_opaque();
        for (int it = gt; it < 2 * 4 * 1536; it += NT) {
            const int l = it / 6144, r = it % 6144, b = r / 1536, n4 = r % 1536;
            f32x4 a = *(const f32x4*)(p.in[3] + l * 6144 + n4 * 4);
            const float* mp = (const float*)(ws + R_CX) + ((size_t)(l * 32) * 4 + b) * 6144 + n4 * 4;
#pragma unroll 8
            for (int kc = 0; kc < 32; ++kc) a += *(const f32x4*)(mp + (size_t)kc * 4 * 6144);
            *(f32x4*)(mod + (size_t)(l * 4 + b) * 6144 + n4 * 4) = a;
        }
    }
    TOC(16);
    GRID_SYNC();
    TIC(); norm_phase(p.in[0], p.in[4], mod, 0, 1024, Rh, gw, NGW); TOC(8); sync_kind = 128;
    GRID_SYNC();

#pragma unroll 1
    for (int l = 0; l < DEPTH; ++l) {
        const float* modl = mod + (size_t)l * 4 * 6144;
        const float* xin = (l == 0) ? p.in[0] : p.out;
        { pg8::SchedPlain S; S.T.init(M, 6144); S.G = G; S.c = bx; S.A = (const char*)Rh; S.B = (const char*)(wl + W_IN); S.tstep = (size_t)256 * D * 2;
          pg8::EpiQKV E{Rq, p.in[6] + l * HD, p.in[7] + l * HD};
          TIC(); pg8::gemm_phase(lds, D, S, E, wave); TOC(1); sync_kind = 32; }
        GRID_SYNC();
        TIC(); mixer_phase(Rq, Rk, Rv, Rcb, Rcc, Rcx, p.in[8] + (size_t)l * 3 * D, G, bx, wave, bx * NTHREADS + wave * 64, NT); TOC(4); sync_kind = 64;
        GRID_SYNC();
        { pg8::SchedBranch S; S.T.init(M, D); S.G = G; S.c = bx; S.ws = (const char*)ws; S.wl = (const char*)wl; S.tstep = (size_t)256 * D * 2;
          pg8::EpiBranch E{Rv, Rk};
          TIC(); pg8::gemm_phase(lds, D, S, E, wave); TOC(1); sync_kind = 32; }
        GRID_SYNC();
        { pg8::SchedPlain S; S.T.init(M, D); S.G = G; S.c = bx; S.A = (const char*)Rk; S.B = (const char*)(wl + W_O); S.tstep = (size_t)256 * D * 2;
          pg8::EpiResid E{xin, p.out, modl + 2048};
          TIC(); pg8::gemm_phase(lds, D, S, E, wave); TOC(1); sync_kind = 32; }
        GRID_SYNC();
        TIC(); norm_phase(p.out, p.in[12] + l * D, modl, 3072, 4096, Rh, gw, NGW); TOC(8); sync_kind = 128;
        GRID_SYNC();
        { pg8::SchedPlain S; S.T.init(M, 2 * FF); S.G = G; S.c = bx; S.A = (const char*)Rh; S.B = (const char*)(wl + W_GU); S.tstep = (size_t)256 * D * 2;
          pg8::EpiGU E{Rq};
          TIC(); pg8::gemm_phase(lds, D, S, E, wave); TOC(1); sync_kind = 32; }
        GRID_SYNC();
        { pg8::SchedPlain S; S.T.init(M, D); S.G = G; S.c = bx; S.A = (const char*)Rq; S.B = (const char*)(wl + W_D); S.tstep = (size_t)256 * FF * 2;
          pg8::EpiResid E{p.out, p.out, modl + 5120};
          TIC(); pg8::gemm_phase(lds, FF, S, E, wave); TOC(1); sync_kind = 32; }
        if (l + 1 < DEPTH) {
            GRID_SYNC();
            TIC();
            phase0(p, lds, gw, NGW, wave, lane_id_opaque(), l + 1, false);
            norm_phase(p.out, p.in[4] + (l + 1) * D, mod + (size_t)(l + 1) * 4 * 6144, 0, 1024, Rh, gw, NGW);
            TOC(8); sync_kind = 128;
            GRID_SYNC();
        }
    }
    asm volatile("s_waitcnt vmcnt(0)" ::: "memory");
    if (leader) { const unsigned old = xb_add(&barw[XB_DONE], 1u); bst[2] = (old + 1u == (unsigned)G) ? 1u : 0u; }
    __syncthreads();
    if (bst[2]) { const int t = wave * 64 + lane_id_opaque(); for (int i = t; i < XCD_BAR_WORDS + 64; i += NTHREADS) __hip_atomic_store(&barw[i], 0u, __ATOMIC_RELAXED, __HIP_MEMORY_SCOPE_AGENT); }
    if (PROBE_MASK && bx == 0 && leader) { const unsigned long long t = __builtin_amdgcn_s_memrealtime(); while (__builtin_amdgcn_s_memrealtime() - t < pr_acc) __builtin_amdgcn_s_sleep(8); }
}

extern "C" void kernel_launch(void* const* d_in, const int* in_sizes, int n_in, void* d_out, int out_size, void* d_ws, size_t ws_size, hipStream_t stream) {
    static int grid_blocks = 0;
    if (grid_blocks == 0) {
        if (n_in != 16 || out_size != M * D || ws_size < WS_END) { fprintf(stderr, "kernel_launch: unexpected shapes (n_in %d out %d ws %zu need %zu)\n", n_in, out_size, ws_size, (size_t)WS_END); grid_blocks = -1; return; }
        int dev = 0, cus = 0, per_cu = 0;
        hipGetDevice(&dev);
        hipDeviceGetAttribute(&cus, hipDeviceAttributeMultiprocessorCount, dev);
        hipFuncSetAttribute((const void*)fwd_kernel, hipFuncAttributeMaxDynamicSharedMemorySize, LDS_BYTES);
        hipOccupancyMaxActiveBlocksPerMultiprocessor(&per_cu, (const void*)fwd_kernel, NTHREADS, LDS_BYTES);
        (void)hipGetLastError();
        if (per_cu < 1) { fprintf(stderr, "kernel_launch: occupancy query says %d blocks per CU\n", per_cu); per_cu = 1; }
        grid_blocks = cus;
    }
    if (grid_blocks < 0) return;
    Params p{};
    for (int i = 0; i < 16; ++i) p.in[i] = (const float*)d_in[i];
    p.out = (float*)d_out; p.ws = (unsigned char*)d_ws;
    void* args[] = {&p};
    hipError_t e = hipLaunchCooperativeKernel((const void*)fwd_kernel, dim3(grid_blocks), dim3(NTHREADS), args, LDS_BYTES, stream);
    if (e != hipSuccess) fprintf(stderr, "cooperative launch failed: %s (grid %d)\n", hipGetErrorString(e), grid_blocks);
}
```

```cpp
#include <hip/hip_runtime.h>
#include <hip/hip_cooperative_groups.h>
#include <cstdio>
#include <cstdint>
namespace cg = cooperative_groups;
#ifndef PROBE_MASK
#define PROBE_MASK 0
#endif

#define LAS __attribute__((address_space(3)))
typedef unsigned short bf16_t;
typedef short bf16x8 __attribute__((ext_vector_type(8)));
typedef short s16x4 __attribute__((ext_vector_type(4)));
typedef float f32x4 __attribute__((ext_vector_type(4)));
typedef float f32x16 __attribute__((ext_vector_type(16)));
typedef unsigned u32x4 __attribute__((ext_vector_type(4)));
typedef unsigned u32x2 __attribute__((ext_vector_type(2)));
typedef float f32x2_t __attribute__((ext_vector_type(2)));
typedef __bf16 bf16x2_t __attribute__((ext_vector_type(2)));

constexpr int D = 1024, NB = 4, SEQ = 4096, M = NB * SEQ, NH = 16, HD = 64, FF = 2816, INW = 8192, DEPTH = 2;
constexpr float EPS = 1e-6f;
constexpr float LOG2E = 1.4426950408889634f;
constexpr float C2 = 0.125f * LOG2E;
constexpr int NWAVES = 8, NTHREADS = 512;

constexpr size_t MiB = 1u << 20;
constexpr size_t WS_CTL = 0, CTL_BYTES = 256 * 1024;
constexpr size_t WS_W = 1 * MiB;
constexpr size_t W_IN = 0, W_A = 16 * MiB, W_B = 18 * MiB, W_O = 20 * MiB, W_GU = 22 * MiB, W_D = 33 * MiB, W_LAYER = 38 * MiB + 512 * 1024;
constexpr size_t WS_ACT = 40 * MiB;
constexpr size_t REG = 32 * MiB;
constexpr size_t R_H = WS_ACT, R_Q = WS_ACT + REG, R_K = WS_ACT + 2 * REG, R_V = WS_ACT + 3 * REG, R_CB = WS_ACT + 4 * REG, R_CC = WS_ACT + 5 * REG, R_CX = WS_ACT + 6 * REG, WS_END = WS_ACT + 7 * REG;
static_assert(WS_W + W_LAYER <= WS_ACT, "weights");
static_assert((size_t)M * FF * 2 <= 3 * REG, "ffn hidden fits R_Q..R_V");
static_assert(WS_END <= 279028736, "workspace >= sum of the inputs' bytes");

__device__ __forceinline__ unsigned cvt_pk(float lo, float hi) { f32x2_t v = {lo, hi}; bf16x2_t b = __builtin_convertvector(v, bf16x2_t); return __builtin_bit_cast(unsigned, b); }
__device__ __forceinline__ float bf_lo(unsigned u) { return __uint_as_float(u << 16); }
__device__ __forceinline__ float bf_hi(unsigned u) { return __uint_as_float(u & 0xffff0000u); }
__device__ __forceinline__ float shx(float v, int o, int lane) { return __int_as_float(__builtin_amdgcn_ds_bpermute((lane ^ o) << 2, __float_as_int(v))); }
__device__ __forceinline__ float wave_sum(float v, int lane) {
#pragma unroll
    for (int o = 1; o < 64; o <<= 1) v += shx(v, o, lane);
    return v;
}
__device__ __forceinline__ int lane_id_opaque() { int l; asm volatile("v_mbcnt_lo_u32_b32 %0, -1, 0\n\tv_mbcnt_hi_u32_b32 %0, -1, %0" : "=v"(l)); return l; }
__device__ __forceinline__ float fast_exp2(float x) { return __builtin_amdgcn_exp2f(x); }
__device__ __forceinline__ float fast_log2(float x) { return __builtin_amdgcn_logf(x); }
__device__ __forceinline__ float fast_rcp(float x) { return __builtin_amdgcn_rcpf(x); }
__device__ __forceinline__ float sigmoidf_(float x) { return fast_rcp(1.0f + fast_exp2(-x * LOG2E)); }

namespace pg8 {
constexpr int BM = 256, BK = 64, HALF = 128, HTB = HALF * BK * 2, STAGE_BYTES = 8 * HTB, NXCD = 8, WGM = 8;
__host__ __device__ __forceinline__ int lds_byte(int r, int c) { const int st = (r >> 4) * 2 + (c >> 5), rr = r & 15, cc = c & 31, ob = rr * 64 + cc * 2; return st * 1024 + (ob ^ (((ob >> 9) & 1) << 5)); }
__host__ __device__ __forceinline__ void stage_rc(int b, int& R, int& C) { const int st = b / 1024, sb = b % 1024, swz = sb ^ (((sb >> 9) & 1) << 5); R = (st >> 1) * 16 + swz / 64; C = (st & 1) * 32 + (swz % 64) / 2; }

struct Unit { const char* A; const char* B; int pm, pn, kind; };

struct TileOrder {
    int nM, nN, nwg;
    __device__ __forceinline__ void init(int Mr, int N) { nM = Mr / BM; nN = N / BM; nwg = nM * nN; }
    __device__ __forceinline__ void map(int wgid, int& pm, int& pn) const {
        { const int q = nwg / NXCD, r = nwg % NXCD, xcd = wgid % NXCD, off = wgid / NXCD; wgid = (xcd < r ? xcd * (q + 1) : r * (q + 1) + (xcd - r) * q) + off; }
        const int nig = WGM * nN, gid = wgid / nig, fm = gid * WGM, gsz = (nM - fm) < WGM ? (nM - fm) : WGM;
        pm = fm + ((wgid % nig) % gsz); pn = (wgid % nig) / gsz;
    }
};
struct SchedPlain {
    TileOrder T; int G, c; const char* A; const char* B; size_t tstep;
    __device__ __forceinline__ bool next(int i, Unit& u) const {
        const long L = (long)i * G + c; if (L >= T.nwg) return false;
        T.map((int)L, u.pm, u.pn); u.A = A + (size_t)u.pm * tstep; u.B = B + (size_t)u.pn * tstep; u.kind = 0; return true;
    }
};
struct SchedBranch {
    TileOrder T; int G, c; const char* ws; const char* wl; size_t tstep;
    __device__ __forceinline__ bool next(int i, Unit& u) const {
        const long L = (long)(i >> 2) * G + c; if (L >= T.nwg) return false;
        T.map((int)L, u.pm, u.pn); const int sub = i & 3; u.kind = sub;
        const size_t oa = (sub == 1) ? R_Q : ((sub == 3) ? R_CB : R_H);
        const size_t ob = (sub == 0) ? (W_IN + (size_t)6144 * D * 2) : (sub == 1) ? W_A : (sub == 2) ? (W_IN + (size_t)7168 * D * 2) : W_B;
        u.A = ws + oa + (size_t)u.pm * tstep; u.B = wl + ob + (size_t)u.pn * tstep; return true;
    }
};

template <class Epi, class Sched>
__device__ __forceinline__ void gemm_phase(LAS unsigned char* lds, const int K, const Sched& S, const Epi& E, const int wid) {
    const int lane = lane_id_opaque(), tid = wid * 64 + lane, wr = wid >> 2, wc = wid & 3, fr = lane & 15, fq = lane >> 4;
    const int nt = K / BK;
    unsigned voff[2];
#pragma unroll
    for (int i = 0; i < 2; ++i) { int R, C; stage_rc(tid * 16 + i * 8192, R, C); voff[i] = (unsigned)(R * K + C) * 2u; }
    const size_t kstep = (size_t)(BK * 2);
    const size_t hstep = (size_t)HALF * K * 2;
    const unsigned ldsw = (unsigned)wid * 1024u;
    const int aoff = lds_byte(wr * 64 + fr, fq * 8), boff = lds_byte(wc * 32 + fr, fq * 8);
#define PG8_SA(b, h) (((b) * 2 + (h)) * HTB)
#define PG8_SB(b, h) ((4 + (b) * 2 + (h)) * HTB)
#define PG8_STAGE(bufoff, gbase) do { _Pragma("unroll") for (int _i = 0; _i < 2; ++_i) \
        __builtin_amdgcn_global_load_lds((const unsigned*)((const char*)(gbase) + voff[_i]), (LAS unsigned*)(lds + (bufoff) + ldsw + _i * 8192), 16, 0, 0); } while (0)
#define PG8_LDA(dst, b, h) do { _Pragma("unroll") for (int m = 0; m < 4; ++m) _Pragma("unroll") for (int k = 0; k < 2; ++k) dst[m][k] = *(const LAS bf16x8*)(lds + PG8_SA(b, h) + aoff + m * 2048 + k * 1024); } while (0)
#define PG8_LDB(dst, b, h) do { _Pragma("unroll") for (int n = 0; n < 2; ++n) _Pragma("unroll") for (int k = 0; k < 2; ++k) dst[n][k] = *(const LAS bf16x8*)(lds + PG8_SB(b, h) + boff + n * 2048 + k * 1024); } while (0)
#define PG8_MMA(ai, bj, At, Bt) do { __builtin_amdgcn_s_setprio(1); _Pragma("unroll") for (int m = 0; m < 4; ++m) _Pragma("unroll") for (int n = 0; n < 2; ++n) _Pragma("unroll") for (int k = 0; k < 2; ++k) \
        acc[ai][bj][m][n] = __builtin_amdgcn_mfma_f32_16x16x32_bf16(Bt[n][k], At[m][k], acc[ai][bj][m][n], 0, 0, 0); __builtin_amdgcn_s_setprio(0); } while (0)
#define PG8_WAIT_V(n) asm volatile("s_waitcnt vmcnt(" #n ")" ::: "memory")
#define PG8_WAIT_L(n) asm volatile("s_waitcnt lgkmcnt(" #n ")" ::: "memory")
#define PG8_BAR __builtin_amdgcn_s_barrier()
#define PG8_SCHED __builtin_amdgcn_sched_barrier(0)
    Unit cur, nxt; int ui = 0;
    if (!S.next(0, cur)) return;
    f32x4 acc[2][2][4][2];
#pragma unroll
    for (int a = 0; a < 2; ++a)
#pragma unroll
        for (int b = 0; b < 2; ++b)
#pragma unroll
            for (int m = 0; m < 4; ++m)
#pragma unroll
                for (int n = 0; n < 2; ++n) acc[a][b][m][n] = (f32x4){0.f, 0.f, 0.f, 0.f};
    bf16x8 At[4][2], B0[2][2], B1[2][2];
    const char* cA = cur.A; const char* cB = cur.B;
    PG8_STAGE(PG8_SB(0, 0), cB); PG8_STAGE(PG8_SB(0, 1), cB + hstep); PG8_STAGE(PG8_SA(0, 0), cA); PG8_STAGE(PG8_SA(0, 1), cA + hstep);
    if (wr == 1) PG8_BAR;
    PG8_WAIT_V(2); PG8_BAR;
    PG8_STAGE(PG8_SB(1, 0), cB + kstep); PG8_STAGE(PG8_SA(1, 0), cA + kstep); PG8_STAGE(PG8_SB(1, 1), cB + hstep + kstep);
    PG8_WAIT_V(6); PG8_BAR;
    for (;;) {
        const bool has_next = S.next(ui + 1, nxt);
        const char* nA = has_next ? nxt.A : cA; const char* nB = has_next ? nxt.B : cB;
        for (int t = 0; t < nt; t += 2) {
            const bool last = (t == nt - 2);
            const char* a1 = cA + (size_t)(t + 1) * kstep;
            const char* a2 = last ? nA : cA + (size_t)(t + 2) * kstep; const char* b2 = last ? nB : cB + (size_t)(t + 2) * kstep;
            const char* a3 = a2 + kstep; const char* b3 = b2 + kstep;
            PG8_LDB(B0, 0, 0); PG8_LDB(B1, 0, 1); PG8_SCHED; PG8_LDA(At, 0, 0); PG8_STAGE(PG8_SA(1, 1), a1 + hstep);
            PG8_WAIT_V(8); PG8_WAIT_L(0); PG8_BAR; PG8_MMA(0, 0, At, B0); PG8_MMA(0, 1, At, B1); PG8_BAR; PG8_SCHED;
            PG8_LDA(At, 0, 1); PG8_STAGE(PG8_SB(0, 0), b2); PG8_STAGE(PG8_SB(0, 1), b2 + hstep); PG8_STAGE(PG8_SA(0, 0), a2);
            PG8_WAIT_V(8); PG8_WAIT_L(0); PG8_BAR; PG8_MMA(1, 0, At, B0); PG8_MMA(1, 1, At, B1); PG8_BAR; PG8_SCHED;
            PG8_LDB(B0, 1, 0); PG8_LDB(B1, 1, 1); PG8_SCHED; PG8_LDA(At, 1, 0); PG8_STAGE(PG8_SA(0, 1), a2 + hstep);
            PG8_WAIT_V(8); PG8_WAIT_L(0); PG8_BAR; PG8_MMA(0, 0, At, B0); PG8_MMA(0, 1, At, B1); PG8_BAR; PG8_SCHED;
            PG8_LDA(At, 1, 1); PG8_STAGE(PG8_SB(1, 0), b3); PG8_STAGE(PG8_SB(1, 1), b3 + hstep); PG8_STAGE(PG8_SA(1, 0), a3);
            PG8_WAIT_V(8); PG8_WAIT_L(0); PG8_BAR; PG8_MMA(1, 0, At, B0); PG8_MMA(1, 1, At, B1); PG8_BAR; PG8_SCHED;
        }
        if (wr == 0) PG8_BAR;
        { const int l2 = lane_id_opaque(); E(acc, cur, wr, wc, l2 & 15, l2 >> 4); }
        if (!has_next) break;
#pragma unroll
        for (int a = 0; a < 2; ++a)
#pragma unroll
            for (int b = 0; b < 2; ++b)
#pragma unroll
                for (int m = 0; m < 4; ++m)
#pragma unroll
                    for (int n = 0; n < 2; ++n) acc[a][b][m][n] = (f32x4){0.f, 0.f, 0.f, 0.f};
        cur = nxt; cA = nA; cB = nB; ++ui;
        if (wr == 1) PG8_BAR;
    }
    PG8_WAIT_V(0);
    PG8_BAR;
#undef PG8_SA
#undef PG8_SB
#undef PG8_STAGE
#undef PG8_LDA
#undef PG8_LDB
#undef PG8_MMA
#undef PG8_WAIT_V
#undef PG8_WAIT_L
#undef PG8_BAR
#undef PG8_SCHED
}

__device__ __forceinline__ u32x4 pack8(const f32x4& a, const f32x4& b) { u32x4 w; w.x = cvt_pk(a[0], a[1]); w.y = cvt_pk(a[2], a[3]); w.z = cvt_pk(b[0], b[1]); w.w = cvt_pk(b[2], b[3]); return w; }

struct EpiRegions {
    bf16_t* base;
    __device__ __forceinline__ void operator()(const f32x4 (&acc)[2][2][4][2], const Unit& u, int wr, int wc, int fr, int fq) const {
        bf16_t* dst = base + (size_t)(u.pn >> 2) * ((size_t)M * D);
        const int col = (u.pn & 3) * 256 + wc * 64 + fq * 8, row0 = u.pm * BM + wr * 64 + fr;
#pragma unroll
        for (int ai = 0; ai < 2; ++ai)
#pragma unroll
            for (int m = 0; m < 4; ++m) { bf16_t* rp = dst + (size_t)(row0 + ai * HALF + m * 16) * D + col;
#pragma unroll
                for (int bj = 0; bj < 2; ++bj) *(u32x4*)(rp + bj * 32) = pack8(acc[ai][bj][m][0], acc[ai][bj][m][1]); }
    }
};
struct EpiQKV {
    bf16_t* base; const float* gq; const float* gk;
    __device__ __forceinline__ void operator()(const f32x4 (&acc)[2][2][4][2], const Unit& u, int wr, int wc, int fr, int fq) const {
        const int region = u.pn >> 2, head = (u.pn & 3) * 4 + wc, row0 = u.pm * BM + wr * 64 + fr;
        if (region == 2) {
            const int b = row0 >> 12;
            bf16_t* vb = base + (size_t)2 * M * D + ((size_t)(b * NH + head) * HD) * SEQ;
#pragma unroll
            for (int ai = 0; ai < 2; ++ai)
#pragma unroll
                for (int m = 0; m < 4; ++m) { const int s0 = (row0 + ai * HALF + m * 16) & (SEQ - 1), q = (s0 >> 2) & 3;
                    const int s = (s0 & ~12) | ((((q & 1) << 1) | (q >> 1)) << 2);
#pragma unroll
                    for (int bj = 0; bj < 2; ++bj)
#pragma unroll
                        for (int n = 0; n < 2; ++n)
#pragma unroll
                            for (int j = 0; j < 4; ++j) { const int d = bj * 32 + fq * 8 + n * 4 + j; const unsigned w = cvt_pk(acc[ai][bj][m][n][j], 0.f);
                                vb[(size_t)d * SEQ + s] = (bf16_t)(w & 0xffffu); } }
        } else if (region >= 3) {
            bf16_t* dst = base + (size_t)region * ((size_t)M * D);
            const int col = (u.pn & 3) * 256 + wc * 64 + fq * 8;
#pragma unroll
            for (int ai = 0; ai < 2; ++ai)
#pragma unroll
                for (int m = 0; m < 4; ++m) { bf16_t* rp = dst + (size_t)(row0 + ai * HALF + m * 16) * D + col;
#pragma unroll
                    for (int bj = 0; bj < 2; ++bj) *(u32x4*)(rp + bj * 32) = pack8(acc[ai][bj][m][0], acc[ai][bj][m][1]); }
        } else {
            const float* g = region == 0 ? gq : gk; const float sc = region == 0 ? C2 : 1.0f;
            bf16_t* dst = base + (size_t)region * ((size_t)M * D);
            f32x4 gv[2][2];
#pragma unroll
            for (int bj = 0; bj < 2; ++bj)
#pragma unroll
                for (int n = 0; n < 2; ++n) gv[bj][n] = *(const f32x4*)(g + bj * 32 + fq * 8 + n * 4) * sc;
            const int col = head * 64 + fq * 8;
#pragma unroll
            for (int ai = 0; ai < 2; ++ai)
#pragma unroll
                for (int m = 0; m < 4; ++m) {
                    float ss = 0.f;
#pragma unroll
                    for (int bj = 0; bj < 2; ++bj)
#pragma unroll
                        for (int n = 0; n < 2; ++n) { const f32x4 x = acc[ai][bj][m][n]; ss += (x[0] * x[0] + x[1] * x[1]) + (x[2] * x[2] + x[3] * x[3]); }
                    ss += shx(ss, 16, fr + 16 * fq); ss += shx(ss, 32, fr + 16 * fq);
                    const float r = 1.0f / sqrtf(ss * (1.0f / 64.0f) + EPS);
                    bf16_t* rp = dst + (size_t)(row0 + ai * HALF + m * 16) * D + col;
#pragma unroll
                    for (int bj = 0; bj < 2; ++bj) { const f32x4 a = acc[ai][bj][m][0] * r * gv[bj][0], b2 = acc[ai][bj][m][1] * r * gv[bj][1]; *(u32x4*)(rp + bj * 32) = pack8(a, b2); }
                }
        }
    }
};
struct EpiBranch {
    bf16_t* S1; bf16_t* TM;
    __device__ __forceinline__ void operator()(const f32x4 (&acc)[2][2][4][2], const Unit& u, int wr, int wc, int fr, int fq) const {
        const int col = u.pn * 256 + wc * 64 + fq * 8, row0 = u.pm * BM + wr * 64 + fr, kind = u.kind;
#pragma unroll
        for (int ai = 0; ai < 2; ++ai) {
            if (kind == 0 || kind == 2) {
#pragma unroll
                for (int m = 0; m < 4; ++m) { const size_t off = (size_t)(row0 + ai * HALF + m * 16) * D + col;
#pragma unroll
                    for (int bj = 0; bj < 2; ++bj) { f32x4 a = acc[ai][bj][m][0], b = acc[ai][bj][m][1];
#pragma unroll
                        for (int j = 0; j < 4; ++j) { a[j] = sigmoidf_(a[j]); b[j] = sigmoidf_(b[j]); }
                        *(u32x4*)(S1 + off + bj * 32) = pack8(a, b); } }
            } else {
#pragma unroll
              for (int mh = 0; mh < 2; ++mh) {
                u32x4 g[2][2], t[2][2];
#pragma unroll
                for (int m2 = 0; m2 < 2; ++m2) { const int m = 2 * mh + m2; const size_t off = (size_t)(row0 + ai * HALF + m * 16) * D + col;
#pragma unroll
                    for (int bj = 0; bj < 2; ++bj) { g[m2][bj] = *(const u32x4*)(S1 + off + bj * 32); if (kind == 3) t[m2][bj] = *(const u32x4*)(TM + off + bj * 32); else t[m2][bj] = (u32x4){0u, 0u, 0u, 0u}; } }
#pragma unroll
                for (int m2 = 0; m2 < 2; ++m2) { const int m = 2 * mh + m2; const size_t off = (size_t)(row0 + ai * HALF + m * 16) * D + col;
#pragma unroll
                    for (int bj = 0; bj < 2; ++bj) { f32x4 a = acc[ai][bj][m][0], b = acc[ai][bj][m][1]; const u32x4 gg = g[m2][bj], tt = t[m2][bj];
                        a[0] = a[0] * bf_lo(gg.x) + bf_lo(tt.x); a[1] = a[1] * bf_hi(gg.x) + bf_hi(tt.x); a[2] = a[2] * bf_lo(gg.y) + bf_lo(tt.y); a[3] = a[3] * bf_hi(gg.y) + bf_hi(tt.y);
                        b[0] = b[0] * bf_lo(gg.z) + bf_lo(tt.z); b[1] = b[1] * bf_hi(gg.z) + bf_hi(tt.z); b[2] = b[2] * bf_lo(gg.w) + bf_lo(tt.w); b[3] = b[3] * bf_hi(gg.w) + bf_hi(tt.w);
                        *(u32x4*)(TM + off + bj * 32) = pack8(a, b); } }
              }
            }
        }
    }
};
struct EpiResid {
    const float* xin; float* xout; const float* gmod;
    __device__ __forceinline__ void operator()(const f32x4 (&acc)[2][2][4][2], const Unit& u, int wr, int wc, int fr, int fq) const {
        const int col = u.pn * 256 + wc * 64 + fq * 8, row0 = u.pm * BM + wr * 64 + fr, b = row0 >> 12;
        f32x4 gv[2][2];
#pragma unroll
        for (int bj = 0; bj < 2; ++bj)
#pragma unroll
            for (int n = 0; n < 2; ++n) gv[bj][n] = *(const f32x4*)(gmod + b * 6144 + col + bj * 32 + n * 4);
#pragma unroll
        for (int ai = 0; ai < 2; ++ai)
#pragma unroll
          for (int mh = 0; mh < 2; ++mh) {
            f32x4 xo[2][2][2];
#pragma unroll
            for (int m2 = 0; m2 < 2; ++m2) { const size_t off = (size_t)(row0 + ai * HALF + (2 * mh + m2) * 16) * D + col;
#pragma unroll
                for (int bj = 0; bj < 2; ++bj)
#pragma unroll
                    for (int n = 0; n < 2; ++n) xo[m2][bj][n] = *(const f32x4*)(xin + off + bj * 32 + n * 4); }
#pragma unroll
            for (int m2 = 0; m2 < 2; ++m2) { const size_t off = (size_t)(row0 + ai * HALF + (2 * mh + m2) * 16) * D + col;
#pragma unroll
                for (int bj = 0; bj < 2; ++bj)
#pragma unroll
                    for (int n = 0; n < 2; ++n) *(f32x4*)(xout + off + bj * 32 + n * 4) = xo[m2][bj][n] + gv[bj][n] * acc[ai][bj][2 * mh + m2][n]; }
          }
    }
};
struct EpiGU {
    bf16_t* f;
    __device__ __forceinline__ void operator()(const f32x4 (&acc)[2][2][4][2], const Unit& u, int wr, int wc, int fr, int fq) const {
        const int col = u.pn * 128 + wc * 32 + fq * 8, row0 = u.pm * BM + wr * 64 + fr;
#pragma unroll
        for (int ai = 0; ai < 2; ++ai)
#pragma unroll
            for (int m = 0; m < 4; ++m) {
                f32x4 o[2];
#pragma unroll
                for (int n = 0; n < 2; ++n)
#pragma unroll
                    for (int j = 0; j < 4; ++j) { const float gt = acc[ai][0][m][n][j]; o[n][j] = gt * sigmoidf_(gt) * acc[ai][1][m][n][j]; }
                *(u32x4*)(f + (size_t)(row0 + ai * HALF + m * 16) * FF + col) = pack8(o[0], o[1]);
            }
    }
};
}

#define LDS_WAIT() asm volatile("s_waitcnt lgkmcnt(0)" ::: "memory")
__device__ __forceinline__ void transpose_item(const float* W, int N, int K, int n0, bf16_t* WT, int a0, int k0, LAS float* scr, int lane) {
    {
        const int kr = lane >> 3, c4 = (lane & 7) * 4;
        f32x4 t[8];
#pragma unroll
        for (int i = 0; i < 8; ++i) t[i] = __builtin_nontemporal_load((const f32x4*)(W + (size_t)(k0 + 8 * i + kr) * N + n0 + c4));
#pragma unroll
        for (int i = 0; i < 8; ++i) { LAS float* d = scr + (8 * i + kr) * 33 + c4; d[0] = t[i][0]; d[1] = t[i][1]; d[2] = t[i][2]; d[3] = t[i][3]; }
    }
    LDS_WAIT(); asm volatile("" ::: "memory");
    const int c = lane & 7;
#pragma unroll
    for (int j = 0; j < 4; ++j) { const int s = (lane >> 3) + 8 * j; const int lo = 8 * ((s >> 2) & 3) + 4 * (s >> 4) + (s & 3);
        const LAS float* sp = scr + (8 * c) * 33 + lo;
        u32x4 o; o.x = cvt_pk(sp[0 * 33], sp[1 * 33]); o.y = cvt_pk(sp[2 * 33], sp[3 * 33]); o.z = cvt_pk(sp[4 * 33], sp[5 * 33]); o.w = cvt_pk(sp[6 * 33], sp[7 * 33]);
        *(u32x4*)(WT + (size_t)(a0 + s) * K + k0 + 8 * c) = o; }
    LDS_WAIT(); asm volatile("" ::: "memory");
}

struct Params { const float* in[16]; float* out; unsigned char* ws; };

__device__ __forceinline__ void phase0(const Params& p, LAS unsigned char* lds, int gw, int NGW, int wave, int lane, const int l, const bool with_mod) {
    LAS float* scr = (LAS float*)(lds + wave * 16384);
    constexpr int I_IN = 256 * 16, I_SQ = 32 * 16, I_GU = 176 * 16, I_D = 32 * 44, I_LAYER = I_IN + 3 * I_SQ + I_GU + I_D;
    constexpr int I_MOD = 2 * 32 * 24;
    for (int it = gw; it < (with_mod ? I_MOD : 0); it += NGW) {
        const int l = it / (32 * 24), r = it % (32 * 24), kc = r / 24, nb = r % 24;
        const float* aw = p.in[2] + (size_t)l * D * 6144 + (size_t)(kc * 32) * 6144 + nb * 256 + lane * 4;
        const float* c = p.in[1];
        f32x4 a[4];
#pragma unroll
        for (int b = 0; b < 4; ++b) a[b] = (f32x4){0.f, 0.f, 0.f, 0.f};
#pragma unroll 8
        for (int k = 0; k < 32; ++k) { const f32x4 w = __builtin_nontemporal_load((const f32x4*)(aw + (size_t)k * 6144));
#pragma unroll
            for (int b = 0; b < 4; ++b) { const float cv = c[b * D + kc * 32 + k]; const float sv = cv * sigmoidf_(cv); a[b] += w * sv; } }
        float* mp = (float*)(p.ws + R_CX) + ((size_t)(l * 32 + kc) * 4) * 6144 + nb * 256 + lane * 4;
#pragma unroll
        for (int b = 0; b < 4; ++b) *(f32x4*)(mp + (size_t)b * 6144) = a[b];
    }
    for (int it = gw; it < I_LAYER; it += NGW) {
        int r = it;
        unsigned char* wl = p.ws + WS_W;
        if (r < I_IN) { const int kb = r / 256, g = r % 256; const int pn = g >> 3, bj = (g >> 2) & 1, wc = g & 3;
            transpose_item(p.in[5] + (size_t)l * D * INW, INW, D, 256 * pn + 64 * wc + 32 * bj, (bf16_t*)(wl + W_IN), 32 * g, 64 * kb, scr, lane); continue; }
        r -= I_IN;
        if (r < 3 * I_SQ) { const int which = r / I_SQ; r %= I_SQ; const int kb = r / 32, g = r % 32; const int pn = g >> 3, bj = (g >> 2) & 1, wc = g & 3;
            const float* src = p.in[9 + which] + (size_t)l * D * D; bf16_t* dst = (bf16_t*)(wl + (which == 0 ? W_A : which == 1 ? W_B : W_O));
            transpose_item(src, D, D, 256 * pn + 64 * wc + 32 * bj, dst, 32 * g, 64 * kb, scr, lane); continue; }
        r -= 3 * I_SQ;
        if (r < I_GU) { const int kb = r / 176, g = r % 176; const int pn = g >> 3, bj = (g >> 2) & 1, wc = g & 3;
            const float* src = p.in[bj ? 14 : 13] + (size_t)l * D * FF;
            transpose_item(src, FF, D, 128 * pn + 32 * wc, (bf16_t*)(wl + W_GU), 32 * g, 64 * kb, scr, lane); continue; }
        r -= I_GU;
        { const int kb = r / 32, g = r % 32; const int pn = g >> 3, bj = (g >> 2) & 1, wc = g & 3;
            transpose_item(p.in[15] + (size_t)l * FF * D, D, FF, 256 * pn + 64 * wc + 32 * bj, (bf16_t*)(wl + W_D), 32 * g, 64 * kb, scr, lane); }
    }
}

__device__ __forceinline__ void norm_phase(const float* x, const float* g, const float* modl, int sh_off, int sc_off, bf16_t* h, int gw, int NGW, const bool stream = false) {
    const int lane = lane_id_opaque();
    for (int q = gw; q < M / 4; q += NGW) {
        const int m0 = 4 * q, b = m0 >> 12;
        f32x4 v[4][4];
#pragma unroll
        for (int r = 0; r < 4; ++r) { const f32x4* xr = (const f32x4*)(x + (size_t)(m0 + r) * D) + lane;
#pragma unroll
            for (int j = 0; j < 4; ++j) v[r][j] = stream ? __builtin_nontemporal_load(xr + 64 * j) : xr[64 * j]; }
        float rs[4];
#pragma unroll
        for (int r = 0; r < 4; ++r) { float s = 0.f;
#pragma unroll
            for (int j = 0; j < 4; ++j) s += (v[r][j][0] * v[r][j][0] + v[r][j][1] * v[r][j][1]) + (v[r][j][2] * v[r][j][2] + v[r][j][3] * v[r][j][3]);
            rs[r] = s; }
#pragma unroll
        for (int o = 1; o < 64; o <<= 1) {
#pragma unroll
            for (int r = 0; r < 4; ++r) rs[r] += shx(rs[r], o, lane); }
#pragma unroll
        for (int r = 0; r < 4; ++r) rs[r] = 1.0f / sqrtf(rs[r] * (1.0f / D) + EPS);
#pragma unroll
        for (int j = 0; j < 4; ++j) { const int col = 4 * (64 * j + lane);
            const f32x4 gg = *(const f32x4*)(g + col), sc = *(const f32x4*)(modl + b * 6144 + sc_off + col) + 1.0f, sh = *(const f32x4*)(modl + b * 6144 + sh_off + col);
#pragma unroll
            for (int r = 0; r < 4; ++r) { const f32x4 y = (v[r][j] * rs[r] * gg) * sc + sh;
                u32x2 w; w.x = cvt_pk(y[0], y[1]); w.y = cvt_pk(y[2], y[3]); *((u32x2*)(h + (size_t)(m0 + r) * D) + lane + 64 * j) = w; } }
    }
}

__device__ __forceinline__ void conv_phase(bf16_t* cb, const bf16_t* cc, const bf16_t* cx, const float* cw, int gt0, int NT) {
    const int gt = gt0 + lane_id_opaque();
    for (int it = gt; it < (M / 16) * (D / 8); it += NT) {
        const int c8 = it & 127, run = it >> 7, t0 = run * 16, ch = c8 * 8;
        float w0[8], w1[8], w2[8];
#pragma unroll
        for (int i = 0; i < 8; ++i) { w0[i] = cw[ch + i]; w1[i] = cw[D + ch + i]; w2[i] = cw[2 * D + ch + i]; }
        float um2[8], um1[8];
#pragma unroll
        for (int i = 0; i < 8; ++i) { um2[i] = 0.f; um1[i] = 0.f; }
        if ((t0 & (SEQ - 1)) != 0) {
            const u32x4 a2 = *(const u32x4*)(cc + (size_t)(t0 - 2) * D + ch), b2 = *(const u32x4*)(cx + (size_t)(t0 - 2) * D + ch);
            const u32x4 a1 = *(const u32x4*)(cc + (size_t)(t0 - 1) * D + ch), b1 = *(const u32x4*)(cx + (size_t)(t0 - 1) * D + ch);
#pragma unroll
            for (int i = 0; i < 4; ++i) { um2[2 * i] = bf_lo(a2[i]) * bf_lo(b2[i]); um2[2 * i + 1] = bf_hi(a2[i]) * bf_hi(b2[i]);
                um1[2 * i] = bf_lo(a1[i]) * bf_lo(b1[i]); um1[2 * i + 1] = bf_hi(a1[i]) * bf_hi(b1[i]); }
        }
#pragma unroll 4
        for (int t = 0; t < 16; ++t) {
            const size_t off = (size_t)(t0 + t) * D + ch;
            const u32x4 a = *(const u32x4*)(cc + off), b = *(const u32x4*)(cx + off), e = *(const u32x4*)(cb + off);
            float u[8], y[8];
#pragma unroll
            for (int i = 0; i < 4; ++i) { u[2 * i] = bf_lo(a[i]) * bf_lo(b[i]); u[2 * i + 1] = bf_hi(a[i]) * bf_hi(b[i]); }
#pragma unroll
            for (int i = 0; i < 4; ++i) {
                y[2 * i] = bf_lo(e[i]) * (w0[2 * i] * um2[2 * i] + w1[2 * i] * um1[2 * i] + w2[2 * i] * u[2 * i]);
                y[2 * i + 1] = bf_hi(e[i]) * (w0[2 * i + 1] * um2[2 * i + 1] + w1[2 * i + 1] * um1[2 * i + 1] + w2[2 * i + 1] * u[2 * i + 1]); }
            u32x4 o; o.x = cvt_pk(y[0], y[1]); o.y = cvt_pk(y[2], y[3]); o.z = cvt_pk(y[4], y[5]); o.w = cvt_pk(y[6], y[7]);
            *(u32x4*)(cb + off) = o;
#pragma unroll
            for (int i = 0; i < 8; ++i) { um2[i] = um1[i]; um1[i] = u[i]; }
        }
    }
}

#define MFMA32(a, b, c) __builtin_amdgcn_mfma_f32_32x32x16_bf16((a), (b), (c), 0, 0, 0)
constexpr float SB_EXIT = 1.0e-20f;
__device__ __forceinline__ float clamp_z(float z) { return __builtin_amdgcn_fmed3f(z, -126.0f, 80.0f); }
struct AttnState { f32x16 o0, o1; float P; bf16x8 kf[4]; };
template <bool DIAG>
__device__ __forceinline__ void attn_step(AttnState& st, const bf16x8 (&qf)[4], const bf16_t* kbase, const bf16_t* vbase, int j0, bool more, int n, int hh, int lane) {
    bf16x8 vf[2][2];
#pragma unroll
    for (int mb = 0; mb < 2; ++mb)
#pragma unroll
        for (int s = 0; s < 2; ++s) vf[mb][s] = *(const bf16x8*)(vbase + (size_t)mb * 32 * SEQ + j0 + 16 * s);
    f32x16 sa;
#pragma unroll
    for (int r = 0; r < 16; ++r) sa[r] = 0.f;
#pragma unroll
    for (int kk = 0; kk < 4; ++kk) sa = MFMA32(st.kf[kk], qf[kk], sa);
    if (more) {
#pragma unroll
        for (int kk = 0; kk < 4; ++kk) st.kf[kk] = *(const bf16x8*)(kbase + (size_t)(j0 - 32) * D + kk * 16);
    }
    float om[16], be[16];
#pragma unroll
    for (int r = 0; r < 16; ++r) {
        const float e = fast_exp2(clamp_z(sa[r]));
        float o = fast_rcp(1.0f + e), b = e * o;
        if (DIAG) { const int ki = (r & 3) + 8 * (r >> 2) + 4 * hh; if (ki >= n) { o = 1.0f; b = 0.f; } }
        om[r] = o; be[r] = b;
    }
    float g[4], pg[4];
#pragma unroll
    for (int q = 0; q < 4; ++q) g[q] = (om[4 * q] * om[4 * q + 1]) * (om[4 * q + 2] * om[4 * q + 3]);
#pragma unroll
    for (int q = 0; q < 4; ++q) pg[q] = shx(g[q], 32, lane);
    float run = st.P;
    float a[16];
#pragma unroll
    for (int q = 3; q >= 0; --q) {
        const float c3 = (hh == 0) ? run * pg[q] : run;
        const float c2 = c3 * om[4 * q + 3], c1 = c2 * om[4 * q + 2], c0 = c1 * om[4 * q + 1];
        a[4 * q + 3] = be[4 * q + 3] * c3; a[4 * q + 2] = be[4 * q + 2] * c2; a[4 * q + 1] = be[4 * q + 1] * c1; a[4 * q] = be[4 * q] * c0;
        run *= g[q] * pg[q];
    }
    st.P = run;
#pragma unroll
    for (int s = 0; s < 2; ++s) {
        u32x4 pw; pw.x = cvt_pk(a[8 * s + 0], a[8 * s + 1]); pw.y = cvt_pk(a[8 * s + 2], a[8 * s + 3]); pw.z = cvt_pk(a[8 * s + 4], a[8 * s + 5]); pw.w = cvt_pk(a[8 * s + 6], a[8 * s + 7]);
        const bf16x8 pf = __builtin_bit_cast(bf16x8, pw);
        st.o0 = MFMA32(vf[0][s], pf, st.o0); st.o1 = MFMA32(vf[1][s], pf, st.o1);
    }
}
__device__ __forceinline__ void attn_task(bf16_t* QO, const bf16_t* Kp, const bf16_t* VT, int b, int h, int qblk, int lane) {
    const int n = lane & 31, hh = lane >> 5, t0 = qblk * 32;
    bf16_t* qrow = QO + (size_t)(b * SEQ + t0 + n) * D + h * HD;
    bf16x8 qf[4];
#pragma unroll
    for (int kk = 0; kk < 4; ++kk) qf[kk] = *(const bf16x8*)(qrow + kk * 16 + hh * 8);
    AttnState st;
#pragma unroll
    for (int r = 0; r < 16; ++r) { st.o0[r] = 0.f; st.o1[r] = 0.f; }
    st.P = 1.0f;
    const bf16_t* kbase = Kp + (size_t)(b * SEQ + n) * D + h * HD + hh * 8;
    const bf16_t* vbase = VT + ((size_t)(b * NH + h) * HD + n) * SEQ + 8 * hh;
#pragma unroll
    for (int kk = 0; kk < 4; ++kk) st.kf[kk] = *(const bf16x8*)(kbase + (size_t)t0 * D + kk * 16);
    attn_step<true>(st, qf, kbase, vbase, t0, qblk > 0, n, hh, lane);
    for (int kb = qblk - 1; kb >= 0; --kb) {
        if (!__any(st.P > SB_EXIT)) break;
        attn_step<false>(st, qf, kbase, vbase, kb * 32, kb > 0, n, hh, lane);
    }
#pragma unroll
    for (int q = 0; q < 4; ++q) {
        u32x2 w0, w1; w0.x = cvt_pk(st.o0[4 * q], st.o0[4 * q + 1]); w0.y = cvt_pk(st.o0[4 * q + 2], st.o0[4 * q + 3]); w1.x = cvt_pk(st.o1[4 * q], st.o1[4 * q + 1]); w1.y = cvt_pk(st.o1[4 * q + 2], st.o1[4 * q + 3]);
        *(u32x2*)(qrow + 8 * q + 4 * hh) = w0; *(u32x2*)(qrow + 32 + 8 * q + 4 * hh) = w1;
    }
}
__device__ __forceinline__ void attn_phase(bf16_t* QO, const bf16_t* Kp, const bf16_t* VT, int G, int bx, int wave) {
    const int lane = lane_id_opaque();
    constexpr int NQB = SEQ / 32, NTASK = NB * NH * NQB;
    if (G == 256) {
#pragma unroll 1
        for (int i = 0; i < 4; ++i) { const int bh = 2 * (wave * 4 + i) + (bx & 1); attn_task(QO, Kp, VT, bh / NH, bh % NH, bx >> 1, lane); }
    } else {
        int i = 0;
        for (int tau = bx * NWAVES + wave; tau < NTASK; tau += G * NWAVES, ++i) {
            const int bh = tau / NQB, qr = tau % NQB, qblk = (i & 1) ? (NQB - 1 - qr) : qr;
            attn_task(QO, Kp, VT, bh / NH, bh % NH, qblk, lane);
        }
    }
}
__device__ __forceinline__ void mixer_phase(bf16_t* QO, const bf16_t* Kp, const bf16_t* VT, bf16_t* cb, const bf16_t* cc, const bf16_t* cx, const float* cw, int G, int bx, int wave, int gt0, int NT) {
    if (wave & 4) { conv_phase(cb, cc, cx, cw, gt0, NT); attn_phase(QO, Kp, VT, G, bx, wave); }
    else          { attn_phase(QO, Kp, VT, G, bx, wave); conv_phase(cb, cc, cx, cw, gt0, NT); }
}

#define XB_TMO      128
#define XB_XCNT(j)  (256  + 64 * (j))
#define XB_XSUB(j)  (1280 + 64 * (j))
#define XB_XGEN(j)  (2304 + 64 * (j))
#define XB_TOP      3328
#define XB_TOPGEN   3392
#define XCD_BAR_WORDS 3456
#define XB_SPIN_CAP (1u << 18)
__device__ __forceinline__ unsigned xb_ld(unsigned* p)              { return __hip_atomic_load(p, __ATOMIC_RELAXED, __HIP_MEMORY_SCOPE_AGENT); }
__device__ __forceinline__ unsigned xb_add(unsigned* p, unsigned v) { return __hip_atomic_fetch_add(p, v, __ATOMIC_RELAXED, __HIP_MEMORY_SCOPE_AGENT); }
__device__ __forceinline__ unsigned xb_xcc_id() { return (unsigned)__builtin_amdgcn_s_getreg((3 << 11) | 20) & 0xFu; }
#define XB_SPIN(cond, bar) do { unsigned _sp = 0; while (cond) { __builtin_amdgcn_s_sleep(1); \
    if ((++_sp & 255u) == 0u) { if (xb_ld(&(bar)[XB_TMO])) break; if (_sp > XB_SPIN_CAP) { atomicAdd(&(bar)[XB_TMO], 1u); break; } } } } while (0)
struct XcdBarrier { unsigned* bar; unsigned x; volatile LAS unsigned* st; };
__device__ __forceinline__ XcdBarrier xcd_barrier_post(unsigned* bar, volatile LAS unsigned* st, int tid) {
    XcdBarrier b; b.bar = bar; b.x = xb_xcc_id(); b.st = st;
    if (tid == 0) (void)xb_add(&bar[XB_XCNT(b.x)], 1u);
    return b;
}
__device__ __forceinline__ void xcd_barrier_complete(unsigned* bar, unsigned x, unsigned& nloc, unsigned& nx) {
    const unsigned G = gridDim.x * gridDim.y * gridDim.z;
    unsigned sum, cnt, mine, sp = 0u;
    for (;;) {
        sum = 0u; cnt = 0u; mine = 0u;
#pragma unroll
        for (unsigned j = 0; j < 16; ++j) { const unsigned c = xb_ld(&bar[XB_XCNT(j)]); sum += c; cnt += (c > 0u) ? 1u : 0u; mine = (j == x) ? c : mine; }
        if (sum == G) break;
        __builtin_amdgcn_s_sleep(1);
        if ((++sp & 255u) == 0u) { if (xb_ld(&bar[XB_TMO])) break; if (sp > XB_SPIN_CAP) { atomicAdd(&bar[XB_TMO], 1u); break; } }
    }
    nloc = mine > 0u ? mine : 1u; nx = cnt > 0u ? cnt : 1u;
}
__device__ __forceinline__ void xcd_barrier(const XcdBarrier& b, bool leader) {
    asm volatile("s_waitcnt vmcnt(0)" ::: "memory");
    __syncthreads();
    if (leader) {
        unsigned* bar = b.bar;
        __builtin_amdgcn_s_waitcnt(0);
        unsigned nloc = b.st[0], nx = b.st[1];
        if (nloc == 0u) { xcd_barrier_complete(bar, b.x, nloc, nx); b.st[0] = nloc; b.st[1] = nx; }
        const unsigned old = xb_add(&bar[XB_XSUB(b.x)], 1u);
        const unsigned gen = old / nloc;
        if (old + 1u == (gen + 1u) * nloc) {
            __builtin_amdgcn_fence(__ATOMIC_RELEASE, "agent");
            asm volatile("s_waitcnt vmcnt(0)" ::: "memory");
            const unsigned og = xb_add(&bar[XB_TOP], 1u);
            const unsigned tg = og / nx;
            if (og + 1u == (tg + 1u) * nx) xb_add(&bar[XB_TOPGEN], 1u);
            else XB_SPIN(xb_ld(&bar[XB_TOPGEN]) == tg, bar);
            __builtin_amdgcn_fence(__ATOMIC_ACQUIRE, "agent");
            xb_add(&bar[XB_XGEN(b.x)], 1u);
            asm volatile("s_waitcnt vmcnt(0)" ::: "memory");
        } else {
            XB_SPIN(xb_ld(&bar[XB_XGEN(b.x)]) == gen, bar);
            __builtin_amdgcn_fence(__ATOMIC_ACQUIRE, "agent");
            asm volatile("s_waitcnt vmcnt(0)" ::: "memory");
        }
    }
    __syncthreads();
}

#define XB_DONE XCD_BAR_WORDS
__device__ unsigned g_bar[XCD_BAR_WORDS + 64];

constexpr int LDS_BYTES = 131072 + 1024;
__global__ void __launch_bounds__(NTHREADS, 2) fwd_kernel(Params p) {
    extern __shared__ __attribute__((aligned(16))) unsigned char lds_raw[];
    LAS unsigned char* lds = (LAS unsigned char*)lds_raw;
    cg::grid_group grid = cg::this_grid();
#define CG_SYNC() do { asm volatile("s_waitcnt vmcnt(0)" ::: "memory"); grid.sync(); if (wave == 0) { __builtin_amdgcn_fence(__ATOMIC_ACQUIRE, "agent"); asm volatile("s_waitcnt vmcnt(0)" ::: "memory"); } __syncthreads(); } while (0)
#define GRID_SYNC_() xcd_barrier(xb, leader)
    unsigned long long pr_acc = 0, pr_t0 = 0;
#define TIC() do { if (PROBE_MASK) pr_t0 = __builtin_amdgcn_s_memrealtime(); } while (0)
#define TOC(bit) do { if (PROBE_MASK & (bit)) pr_acc += __builtin_amdgcn_s_memrealtime() - pr_t0; } while (0)
#define GRID_SYNC() do { TIC(); GRID_SYNC_(); TOC(2 | sync_kind); } while (0)
    int sync_kind = 128;
    const int tid0 = threadIdx.x, wave = __builtin_amdgcn_readfirstlane(tid0 >> 6);
    const int G = gridDim.x, bx = blockIdx.x;
    const int gw = bx * NWAVES + wave, NGW = G * NWAVES, NT = G * NTHREADS;
    unsigned char* ws = p.ws;
    float* mod = (float*)(ws + WS_CTL);
    bf16_t* Rh = (bf16_t*)(ws + R_H); bf16_t* Rq = (bf16_t*)(ws + R_Q); bf16_t* Rk = (bf16_t*)(ws + R_K); bf16_t* Rv = (bf16_t*)(ws + R_V);
    bf16_t* Rcb = (bf16_t*)(ws + R_CB); bf16_t* Rcc = (bf16_t*)(ws + R_CC); bf16_t* Rcx = (bf16_t*)(ws + R_CX);
    const unsigned char* wl = ws + WS_W;

    unsigned* barw = g_bar;
    volatile LAS unsigned* bst = (volatile LAS unsigned*)(lds + 131072);
    const bool leader = (wave == 0) && (lane_id_opaque() == 0);
    if (leader) { bst[0] = 0u; bst[1] = 0u; bst[2] = 0u; }
    const XcdBarrier xb = xcd_barrier_post(barw, bst, leader ? 0 : 1);
    if (G == 0x7fffffff) CG_SYNC();
    TIC();
    phase0(p, lds, gw, NGW, wave, lane_id_opaque(), 0, true);
    TOC(16);
    GRID_SYNC();
    TIC();
    {
        const int gt = bx * NTHREADS + wave * 64 + lane_id_opaque();
        for (int it = gt; it < 2 * 4 * 1536; it += NT) {
            const int l = it / 6144, r = it % 6144, b = r / 1536, n4 = r % 1536;
            f32x4 a = *(const f32x4*)(p.in[3] + l * 6144 + n4 * 4);
            const float* mp = (const float*)(ws + R_CX) + ((size_t)(l * 32) * 4 + b) * 6144 + n4 * 4;
#pragma unroll 8
            for (int kc = 0; kc < 32; ++kc) a += *(const f32x4*)(mp + (size_t)kc * 4 * 6144);
            *(f32x4*)(mod + (size_t)(l * 4 + b) * 6144 + n4 * 4) = a;
        }
    }
    TOC(16);
    GRID_SYNC();
    TIC(); norm_phase(p.in[0], p.in[4], mod, 0, 1024, Rh, gw, NGW, true);
    GRID_SYNC();

#pragma unroll 1
    for (int l = 0; l < DEPTH; ++l) {
        const float* modl = mod + (size_t)l * 4 * 6144;
        const float* xin = (l == 0) ? p.in[0] : p.out;
        { pg8::SchedPlain S; S.T.init(M, 6144); S.G = G; S.c = bx; S.A = (const char*)Rh; S.B = (const char*)(wl + W_IN); S.tstep = (size_t)256 * D * 2;
          pg8::EpiQKV E{Rq, p.in[6] + l * HD, p.in[7] + l * HD};
          TIC(); pg8::gemm_phase(lds, D, S, E, wave); TOC(1); sync_kind = 32; }
        GRID_SYNC();
        TIC(); mixer_phase(Rq, Rk, Rv, Rcb, Rcc, Rcx, p.in[8] + (size_t)l * 3 * D, G, bx, wave, bx * NTHREADS + wave * 64, NT); TOC(4); sync_kind = 64;
        GRID_SYNC();
        { pg8::SchedBranch S; S.T.init(M, D); S.G = G; S.c = bx; S.ws = (const char*)ws; S.wl = (const char*)wl; S.tstep = (size_t)256 * D * 2;
          pg8::EpiBranch E{Rv, Rk};
          TIC(); pg8::gemm_phase(lds, D, S, E, wave); TOC(1); sync_kind = 32; }
        GRID_SYNC();
        { pg8::SchedPlain S; S.T.init(M, D); S.G = G; S.c = bx; S.A = (const char*)Rk; S.B = (const char*)(wl + W_O); S.tstep = (size_t)256 * D * 2;
          pg8::EpiResid E{xin, p.out, modl + 2048};
          TIC(); pg8::gemm_phase(lds, D, S, E, wave); TOC(1); sync_kind = 32; }
        GRID_SYNC();
        TIC(); norm_phase(p.out, p.in[12] + l * D, modl, 3072, 4096, Rh, gw, NGW, true); TOC(8); sync_kind = 128;
        GRID_SYNC();
        { pg8::SchedPlain S; S.T.init(M, 2 * FF); S.G = G; S.c = bx; S.A = (const char*)Rh; S.B = (const char*)(wl + W_GU); S.tstep = (size_t)256 * D * 2;
          pg8::EpiGU E{Rq};
          TIC(); pg8::gemm_phase(lds, D, S, E, wave); TOC(1); sync_kind = 32; }
        GRID_SYNC();
        { pg8::SchedPlain S; S.T.init(M, D); S.G = G; S.c = bx; S.A = (const char*)Rq; S.B = (const char*)(wl + W_D); S.tstep = (size_t)256 * FF * 2;
          pg8::EpiResid E{p.out, p.out, modl + 5120};
          TIC(); pg8::gemm_phase(lds, FF, S, E, wave); TOC(1); sync_kind = 32; }
        if (l + 1 < DEPTH) {
            GRID_SYNC();
            TIC();
            phase0(p, lds, gw, NGW, wave, lane_id_opaque(), l + 1, false);
            norm_phase(p.out, p.in[4] + (l + 1) * D, mod + (size_t)(l + 1) * 4 * 6144, 0, 1024, Rh, gw, NGW, true);
            TOC(8); sync_kind = 128;
            GRID_SYNC();
        }
    }
    asm volatile("s_waitcnt vmcnt(0)" ::: "memory");
    if (leader) { const unsigned old = xb_add(&barw[XB_DONE], 1u); bst[2] = (old + 1u == (unsigned)G) ? 1u : 0u; }
    __syncthreads();
    if (bst[2]) { const int t = wave * 64 + lane_id_opaque(); for (int i = t; i < XCD_BAR_WORDS + 64; i += NTHREADS) __hip_atomic_store(&barw[i], 0u, __ATOMIC_RELAXED, __HIP_MEMORY_SCOPE_AGENT); }
    if (PROBE_MASK && bx == 0 && leader) { const unsigned long long t = __builtin_amdgcn_s_memrealtime(); while (__builtin_amdgcn_s_memrealtime() - t < pr_acc) __builtin_amdgcn_s_sleep(8); }
}

extern "C" void kernel_launch(void* const* d_in, const int* in_sizes, int n_in, void* d_out, int out_size, void* d_ws, size_t ws_size, hipStream_t stream) {
    static int grid_blocks = 0;
    if (grid_blocks == 0) {
        if (n_in != 16 || out_size != M * D || ws_size < WS_END) { fprintf(stderr, "kernel_launch: unexpected shapes (n_in %d out %d ws %zu need %zu)\n", n_in, out_size, ws_size, (size_t)WS_END); grid_blocks = -1; return; }
        int dev = 0, cus = 0, per_cu = 0;
        hipGetDevice(&dev);
        hipDeviceGetAttribute(&cus, hipDeviceAttributeMultiprocessorCount, dev);
        hipFuncSetAttribute((const void*)fwd_kernel, hipFuncAttributeMaxDynamicSharedMemorySize, LDS_BYTES);
        hipOccupancyMaxActiveBlocksPerMultiprocessor(&per_cu, (const void*)fwd_kernel, NTHREADS, LDS_BYTES);
        (void)hipGetLastError();
        if (per_cu < 1) { fprintf(stderr, "kernel_launch: occupancy query says %d blocks per CU\n", per_cu); per_cu = 1; }
        grid_blocks = cus;
    }
    if (grid_blocks < 0) return;
    Params p{};
    for (int i = 0; i < 16; ++i) p.in[i] = (const float*)d_in[i];
    p.out = (float*)d_out; p.ws = (unsigned char*)d_ws;
    void* args[] = {&p};
    hipError_t e = hipLaunchCooperativeKernel((const void*)fwd_kernel, dim3(grid_blocks), dim3(NTHREADS), args, LDS_BYTES, stream);
    if (e != hipSuccess) fprintf(stderr, "cooperative launch failed: %s (grid %d)\n", hipGetErrorString(e), grid_blocks);
}
```

```cpp
#include <hip/hip_runtime.h>
#include <hip/hip_cooperative_groups.h>
#include <cstdio>
#include <cstdint>
namespace cg = cooperative_groups;
#ifndef PROBE_MASK
#define PROBE_MASK 0
#endif

#define LAS __attribute__((address_space(3)))
typedef unsigned short bf16_t;
typedef short bf16x8 __attribute__((ext_vector_type(8)));
typedef short s16x4 __attribute__((ext_vector_type(4)));
typedef float f32x4 __attribute__((ext_vector_type(4)));
typedef float f32x16 __attribute__((ext_vector_type(16)));
typedef unsigned u32x4 __attribute__((ext_vector_type(4)));
typedef unsigned u32x2 __attribute__((ext_vector_type(2)));
typedef float f32x2_t __attribute__((ext_vector_type(2)));
typedef __bf16 bf16x2_t __attribute__((ext_vector_type(2)));

constexpr int D = 1024, NB = 4, SEQ = 4096, M = NB * SEQ, NH = 16, HD = 64, FF = 2816, INW = 8192, DEPTH = 2;
constexpr float EPS = 1e-6f;
constexpr float LOG2E = 1.4426950408889634f;
constexpr float C2 = 0.125f * LOG2E;
constexpr int NWAVES = 8, NTHREADS = 512;

constexpr size_t MiB = 1u << 20;
constexpr size_t WS_CTL = 0, CTL_BYTES = 256 * 1024;
constexpr size_t WS_W = 1 * MiB;
constexpr size_t W_IN = 0, W_A = 16 * MiB, W_B = 18 * MiB, W_O = 20 * MiB, W_GU = 22 * MiB, W_D = 33 * MiB, W_LAYER = 38 * MiB + 512 * 1024;
constexpr size_t WS_ACT = 40 * MiB;
constexpr size_t REG = 32 * MiB;
constexpr size_t R_H = WS_ACT, R_Q = WS_ACT + REG, R_K = WS_ACT + 2 * REG, R_V = WS_ACT + 3 * REG, R_CB = WS_ACT + 4 * REG, R_CC = WS_ACT + 5 * REG, R_CX = WS_ACT + 6 * REG, WS_END = WS_ACT + 7 * REG;
static_assert(WS_W + W_LAYER <= WS_ACT, "weights");
static_assert((size_t)M * FF * 2 <= 3 * REG, "ffn hidden fits R_Q..R_V");
static_assert(WS_END <= 279028736, "workspace >= sum of the inputs' bytes");

__device__ __forceinline__ unsigned cvt_pk(float lo, float hi) { f32x2_t v = {lo, hi}; bf16x2_t b = __builtin_convertvector(v, bf16x2_t); return __builtin_bit_cast(unsigned, b); }
__device__ __forceinline__ float bf_lo(unsigned u) { return __uint_as_float(u << 16); }
__device__ __forceinline__ float bf_hi(unsigned u) { return __uint_as_float(u & 0xffff0000u); }
__device__ __forceinline__ float shx(float v, int o, int lane) { return __int_as_float(__builtin_amdgcn_ds_bpermute((lane ^ o) << 2, __float_as_int(v))); }
__device__ __forceinline__ float wave_sum(float v, int lane) {
#pragma unroll
    for (int o = 1; o < 64; o <<= 1) v += shx(v, o, lane);
    return v;
}
__device__ __forceinline__ int lane_id_opaque() { int l; asm volatile("v_mbcnt_lo_u32_b32 %0, -1, 0\n\tv_mbcnt_hi_u32_b32 %0, -1, %0" : "=v"(l)); return l; }
__device__ __forceinline__ float fast_exp2(float x) { return __builtin_amdgcn_exp2f(x); }
__device__ __forceinline__ float fast_log2(float x) { return __builtin_amdgcn_logf(x); }
__device__ __forceinline__ float fast_rcp(float x) { return __builtin_amdgcn_rcpf(x); }
__device__ __forceinline__ float sigmoidf_(float x) { return fast_rcp(1.0f + fast_exp2(-x * LOG2E)); }

namespace pg8 {
constexpr int BM = 256, BK = 64, HALF = 128, HTB = HALF * BK * 2, STAGE_BYTES = 8 * HTB, NXCD = 8, WGM = 8;
__host__ __device__ __forceinline__ int lds_byte(int r, int c) { const int st = (r >> 4) * 2 + (c >> 5), rr = r & 15, cc = c & 31, ob = rr * 64 + cc * 2; return st * 1024 + (ob ^ (((ob >> 9) & 1) << 5)); }
__host__ __device__ __forceinline__ void stage_rc(int b, int& R, int& C) { const int st = b / 1024, sb = b % 1024, swz = sb ^ (((sb >> 9) & 1) << 5); R = (st >> 1) * 16 + swz / 64; C = (st & 1) * 32 + (swz % 64) / 2; }

struct Unit { const char* A; const char* B; int pm, pn, kind; };

struct TileOrder {
    int nM, nN, nwg;
    __device__ __forceinline__ void init(int Mr, int N) { nM = Mr / BM; nN = N / BM; nwg = nM * nN; }
    __device__ __forceinline__ void map(int wgid, int& pm, int& pn) const {
        { const int q = nwg / NXCD, r = nwg % NXCD, xcd = wgid % NXCD, off = wgid / NXCD; wgid = (xcd < r ? xcd * (q + 1) : r * (q + 1) + (xcd - r) * q) + off; }
        const int nig = WGM * nN, gid = wgid / nig, fm = gid * WGM, gsz = (nM - fm) < WGM ? (nM - fm) : WGM;
        pm = fm + ((wgid % nig) % gsz); pn = (wgid % nig) / gsz;
    }
};
struct SchedPlain {
    TileOrder T; int G, c; const char* A; const char* B; size_t tstep;
    __device__ __forceinline__ bool next(int i, Unit& u) const {
        const long L = (long)i * G + c; if (L >= T.nwg) return false;
        T.map((int)L, u.pm, u.pn); u.A = A + (size_t)u.pm * tstep; u.B = B + (size_t)u.pn * tstep; u.kind = 0; return true;
    }
};
struct SchedBranch {
    TileOrder T; int G, c; const char* ws; const char* wl; size_t tstep;
    __device__ __forceinline__ bool next(int i, Unit& u) const {
        const long L = (long)(i >> 2) * G + c; if (L >= T.nwg) return false;
        T.map((int)L, u.pm, u.pn); const int sub = i & 3; u.kind = sub;
        const size_t oa = (sub == 1) ? R_Q : ((sub == 3) ? R_CB : R_H);
        const size_t ob = (sub == 0) ? (W_IN + (size_t)6144 * D * 2) : (sub == 1) ? W_A : (sub == 2) ? (W_IN + (size_t)7168 * D * 2) : W_B;
        u.A = ws + oa + (size_t)u.pm * tstep; u.B = wl + ob + (size_t)u.pn * tstep; return true;
    }
};

template <class Epi, class Sched>
__device__ __forceinline__ void gemm_phase(LAS unsigned char* lds, const int K, const Sched& S, const Epi& E, const int wid) {
    const int lane = lane_id_opaque(), tid = wid * 64 + lane, wr = wid >> 2, wc = wid & 3, fr = lane & 15, fq = lane >> 4;
    const int nt = K / BK;
    unsigned voff[2];
#pragma unroll
    for (int i = 0; i < 2; ++i) { int R, C; stage_rc(tid * 16 + i * 8192, R, C); voff[i] = (unsigned)(R * K + C) * 2u; }
    const size_t kstep = (size_t)(BK * 2);
    const size_t hstep = (size_t)HALF * K * 2;
    const unsigned ldsw = (unsigned)wid * 1024u;
    const int aoff = lds_byte(wr * 64 + fr, fq * 8), boff = lds_byte(wc * 32 + fr, fq * 8);
#define PG8_SA(b, h) (((b) * 2 + (h)) * HTB)
#define PG8_SB(b, h) ((4 + (b) * 2 + (h)) * HTB)
#define PG8_STAGE(bufoff, gbase) do { _Pragma("unroll") for (int _i = 0; _i < 2; ++_i) \
        __builtin_amdgcn_global_load_lds((const unsigned*)((const char*)(gbase) + voff[_i]), (LAS unsigned*)(lds + (bufoff) + ldsw + _i * 8192), 16, 0, 0); } while (0)
#define PG8_LDA(dst, b, h) do { _Pragma("unroll") for (int m = 0; m < 4; ++m) _Pragma("unroll") for (int k = 0; k < 2; ++k) dst[m][k] = *(const LAS bf16x8*)(lds + PG8_SA(b, h) + aoff + m * 2048 + k * 1024); } while (0)
#define PG8_LDB(dst, b, h) do { _Pragma("unroll") for (int n = 0; n < 2; ++n) _Pragma("unroll") for (int k = 0; k < 2; ++k) dst[n][k] = *(const LAS bf16x8*)(lds + PG8_SB(b, h) + boff + n * 2048 + k * 1024); } while (0)
#define PG8_MMA(ai, bj, At, Bt) do { __builtin_amdgcn_s_setprio(1); _Pragma("unroll") for (int m = 0; m < 4; ++m) _Pragma("unroll") for (int n = 0; n < 2; ++n) _Pragma("unroll") for (int k = 0; k < 2; ++k) \
        acc[ai][bj][m][n] = __builtin_amdgcn_mfma_f32_16x16x32_bf16(Bt[n][k], At[m][k], acc[ai][bj][m][n], 0, 0, 0); __builtin_amdgcn_s_setprio(0); } while (0)
#define PG8_WAIT_V(n) asm volatile("s_waitcnt vmcnt(" #n ")" ::: "memory")
#define PG8_WAIT_L(n) asm volatile("s_waitcnt lgkmcnt(" #n ")" ::: "memory")
#define PG8_BAR __builtin_amdgcn_s_barrier()
#define PG8_SCHED __builtin_amdgcn_sched_barrier(0)
    Unit cur, nxt; int ui = 0;
    if (!S.next(0, cur)) return;
    f32x4 acc[2][2][4][2];
#pragma unroll
    for (int a = 0; a < 2; ++a)
#pragma unroll
        for (int b = 0; b < 2; ++b)
#pragma unroll
            for (int m = 0; m < 4; ++m)
#pragma unroll
                for (int n = 0; n < 2; ++n) acc[a][b][m][n] = (f32x4){0.f, 0.f, 0.f, 0.f};
    bf16x8 At[4][2], B0[2][2], B1[2][2];
    const char* cA = cur.A; const char* cB = cur.B;
    PG8_STAGE(PG8_SB(0, 0), cB); PG8_STAGE(PG8_SB(0, 1), cB + hstep); PG8_STAGE(PG8_SA(0, 0), cA); PG8_STAGE(PG8_SA(0, 1), cA + hstep);
    if (wr == 1) PG8_BAR;
    PG8_WAIT_V(2); PG8_BAR;
    PG8_STAGE(PG8_SB(1, 0), cB + kstep); PG8_STAGE(PG8_SA(1, 0), cA + kstep); PG8_STAGE(PG8_SB(1, 1), cB + hstep + kstep);
    PG8_WAIT_V(6); PG8_BAR;
    for (;;) {
        const bool has_next = S.next(ui + 1, nxt);
        const char* nA = has_next ? nxt.A : cA; const char* nB = has_next ? nxt.B : cB;
        for (int t = 0; t < nt; t += 2) {
            const bool last = (t == nt - 2);
            const char* a1 = cA + (size_t)(t + 1) * kstep;
            const char* a2 = last ? nA : cA + (size_t)(t + 2) * kstep; const char* b2 = last ? nB : cB + (size_t)(t + 2) * kstep;
            const char* a3 = a2 + kstep; const char* b3 = b2 + kstep;
            PG8_LDB(B0, 0, 0); PG8_LDB(B1, 0, 1); PG8_SCHED; PG8_LDA(At, 0, 0); PG8_STAGE(PG8_SA(1, 1), a1 + hstep);
            PG8_WAIT_V(8); PG8_WAIT_L(0); PG8_BAR; PG8_MMA(0, 0, At, B0); PG8_MMA(0, 1, At, B1); PG8_BAR; PG8_SCHED;
            PG8_LDA(At, 0, 1); PG8_STAGE(PG8_SB(0, 0), b2); PG8_STAGE(PG8_SB(0, 1), b2 + hstep); PG8_STAGE(PG8_SA(0, 0), a2);
            PG8_WAIT_V(8); PG8_WAIT_L(0); PG8_BAR; PG8_MMA(1, 0, At, B0); PG8_MMA(1, 1, At, B1); PG8_BAR; PG8_SCHED;
            PG8_LDB(B0, 1, 0); PG8_LDB(B1, 1, 1); PG8_SCHED; PG8_LDA(At, 1, 0); PG8_STAGE(PG8_SA(0, 1), a2 + hstep);
            PG8_WAIT_V(8); PG8_WAIT_L(0); PG8_BAR; PG8_MMA(0, 0, At, B0); PG8_MMA(0, 1, At, B1); PG8_BAR; PG8_SCHED;
            PG8_LDA(At, 1, 1); PG8_STAGE(PG8_SB(1, 0), b3); PG8_STAGE(PG8_SB(1, 1), b3 + hstep); PG8_STAGE(PG8_SA(1, 0), a3);
            PG8_WAIT_V(8); PG8_WAIT_L(0); PG8_BAR; PG8_MMA(1, 0, At, B0); PG8_MMA(1, 1, At, B1); PG8_BAR; PG8_SCHED;
        }
        if (wr == 0) PG8_BAR;
        { const int l2 = lane_id_opaque(); E(acc, cur, wr, wc, l2 & 15, l2 >> 4); }
        if (!has_next) break;
#pragma unroll
        for (int a = 0; a < 2; ++a)
#pragma unroll
            for (int b = 0; b < 2; ++b)
#pragma unroll
                for (int m = 0; m < 4; ++m)
#pragma unroll
                    for (int n = 0; n < 2; ++n) acc[a][b][m][n] = (f32x4){0.f, 0.f, 0.f, 0.f};
        cur = nxt; cA = nA; cB = nB; ++ui;
        if (wr == 1) PG8_BAR;
    }
    PG8_WAIT_V(0);
    PG8_BAR;
#undef PG8_SA
#undef PG8_SB
#undef PG8_STAGE
#undef PG8_LDA
#undef PG8_LDB
#undef PG8_MMA
#undef PG8_WAIT_V
#undef PG8_WAIT_L
#undef PG8_BAR
#undef PG8_SCHED
}

__device__ __forceinline__ u32x4 pack8(const f32x4& a, const f32x4& b) { u32x4 w; w.x = cvt_pk(a[0], a[1]); w.y = cvt_pk(a[2], a[3]); w.z = cvt_pk(b[0], b[1]); w.w = cvt_pk(b[2], b[3]); return w; }

struct EpiRegions {
    bf16_t* base;
    __device__ __forceinline__ void operator()(const f32x4 (&acc)[2][2][4][2], const Unit& u, int wr, int wc, int fr, int fq) const {
        bf16_t* dst = base + (size_t)(u.pn >> 2) * ((size_t)M * D);
        const int col = (u.pn & 3) * 256 + wc * 64 + fq * 8, row0 = u.pm * BM + wr * 64 + fr;
#pragma unroll
        for (int ai = 0; ai < 2; ++ai)
#pragma unroll
            for (int m = 0; m < 4; ++m) { bf16_t* rp = dst + (size_t)(row0 + ai * HALF + m * 16) * D + col;
#pragma unroll
                for (int bj = 0; bj < 2; ++bj) *(u32x4*)(rp + bj * 32) = pack8(acc[ai][bj][m][0], acc[ai][bj][m][1]); }
    }
};
struct EpiQKV {
    bf16_t* base; const float* gq; const float* gk;
    __device__ __forceinline__ void operator()(const f32x4 (&acc)[2][2][4][2], const Unit& u, int wr, int wc, int fr, int fq) const {
        const int region = u.pn >> 2, head = (u.pn & 3) * 4 + wc, row0 = u.pm * BM + wr * 64 + fr;
        if (region == 2) {
            const int b = row0 >> 12;
            bf16_t* vb = base + (size_t)2 * M * D + ((size_t)(b * NH + head) * HD) * SEQ;
#pragma unroll
            for (int ai = 0; ai < 2; ++ai)
#pragma unroll
                for (int m = 0; m < 4; ++m) { const int s0 = (row0 + ai * HALF + m * 16) & (SEQ - 1), q = (s0 >> 2) & 3;
                    const int s = (s0 & ~12) | ((((q & 1) << 1) | (q >> 1)) << 2);
#pragma unroll
                    for (int bj = 0; bj < 2; ++bj)
#pragma unroll
                        for (int n = 0; n < 2; ++n)
#pragma unroll
                            for (int j = 0; j < 4; ++j) { const int d = bj * 32 + fq * 8 + n * 4 + j; const unsigned w = cvt_pk(acc[ai][bj][m][n][j], 0.f);
                                vb[(size_t)d * SEQ + s] = (bf16_t)(w & 0xffffu); } }
        } else if (region >= 3) {
            bf16_t* dst = base + (size_t)region * ((size_t)M * D);
            const int col = (u.pn & 3) * 256 + wc * 64 + fq * 8;
#pragma unroll
            for (int ai = 0; ai < 2; ++ai)
#pragma unroll
                for (int m = 0; m < 4; ++m) { bf16_t* rp = dst + (size_t)(row0 + ai * HALF + m * 16) * D + col;
#pragma unroll
                    for (int bj = 0; bj < 2; ++bj) *(u32x4*)(rp + bj * 32) = pack8(acc[ai][bj][m][0], acc[ai][bj][m][1]); }
        } else {
            const float* g = region == 0 ? gq : gk; const float sc = region == 0 ? C2 : 1.0f;
            bf16_t* dst = base + (size_t)region * ((size_t)M * D);
            f32x4 gv[2][2];
#pragma unroll
            for (int bj = 0; bj < 2; ++bj)
#pragma unroll
                for (int n = 0; n < 2; ++n) gv[bj][n] = *(const f32x4*)(g + bj * 32 + fq * 8 + n * 4) * sc;
            const int col = head * 64 + fq * 8;
#pragma unroll
            for (int ai = 0; ai < 2; ++ai)
#pragma unroll
                for (int m = 0; m < 4; ++m) {
                    float ss = 0.f;
#pragma unroll
                    for (int bj = 0; bj < 2; ++bj)
#pragma unroll
                        for (int n = 0; n < 2; ++n) { const f32x4 x = acc[ai][bj][m][n]; ss += (x[0] * x[0] + x[1] * x[1]) + (x[2] * x[2] + x[3] * x[3]); }
                    ss += shx(ss, 16, fr + 16 * fq); ss += shx(ss, 32, fr + 16 * fq);
                    const float r = 1.0f / sqrtf(ss * (1.0f / 64.0f) + EPS);
                    bf16_t* rp = dst + (size_t)(row0 + ai * HALF + m * 16) * D + col;
#pragma unroll
                    for (int bj = 0; bj < 2; ++bj) { const f32x4 a = acc[ai][bj][m][0] * r * gv[bj][0], b2 = acc[ai][bj][m][1] * r * gv[bj][1]; *(u32x4*)(rp + bj * 32) = pack8(a, b2); }
                }
        }
    }
};
struct EpiBranch {
    bf16_t* S1; bf16_t* TM;
    __device__ __forceinline__ void operator()(const f32x4 (&acc)[2][2][4][2], const Unit& u, int wr, int wc, int fr, int fq) const {
        const int col = u.pn * 256 + wc * 64 + fq * 8, row0 = u.pm * BM + wr * 64 + fr, kind = u.kind;
#pragma unroll
        for (int ai = 0; ai < 2; ++ai) {
            if (kind == 0 || kind == 2) {
#pragma unroll
                for (int m = 0; m < 4; ++m) { const size_t off = (size_t)(row0 + ai * HALF + m * 16) * D + col;
#pragma unroll
                    for (int bj = 0; bj < 2; ++bj) { f32x4 a = acc[ai][bj][m][0], b = acc[ai][bj][m][1];
#pragma unroll
                        for (int j = 0; j < 4; ++j) { a[j] = sigmoidf_(a[j]); b[j] = sigmoidf_(b[j]); }
                        *(u32x4*)(S1 + off + bj * 32) = pack8(a, b); } }
            } else {
#pragma unroll
              for (int mh = 0; mh < 2; ++mh) {
                u32x4 g[2][2], t[2][2];
#pragma unroll
                for (int m2 = 0; m2 < 2; ++m2) { const int m = 2 * mh + m2; const size_t off = (size_t)(row0 + ai * HALF + m * 16) * D + col;
#pragma unroll
                    for (int bj = 0; bj < 2; ++bj) { g[m2][bj] = *(const u32x4*)(S1 + off + bj * 32); if (kind == 3) t[m2][bj] = *(const u32x4*)(TM + off + bj * 32); else t[m2][bj] = (u32x4){0u, 0u, 0u, 0u}; } }
#pragma unroll
                for (int m2 = 0; m2 < 2; ++m2) { const int m = 2 * mh + m2; const size_t off = (size_t)(row0 + ai * HALF + m * 16) * D + col;
#pragma unroll
                    for (int bj = 0; bj < 2; ++bj) { f32x4 a = acc[ai][bj][m][0], b = acc[ai][bj][m][1]; const u32x4 gg = g[m2][bj], tt = t[m2][bj];
                        a[0] = a[0] * bf_lo(gg.x) + bf_lo(tt.x); a[1] = a[1] * bf_hi(gg.x) + bf_hi(tt.x); a[2] = a[2] * bf_lo(gg.y) + bf_lo(tt.y); a[3] = a[3] * bf_hi(gg.y) + bf_hi(tt.y);
                        b[0] = b[0] * bf_lo(gg.z) + bf_lo(tt.z); b[1] = b[1] * bf_hi(gg.z) + bf_hi(tt.z); b[2] = b[2] * bf_lo(gg.w) + bf_lo(tt.w); b[3] = b[3] * bf_hi(gg.w) + bf_hi(tt.w);
                        *(u32x4*)(TM + off + bj * 32) = pack8(a, b); } }
              }
            }
        }
    }
};
struct EpiResid {
    const float* xin; float* xout; const float* gmod;
    __device__ __forceinline__ void operator()(const f32x4 (&acc)[2][2][4][2], const Unit& u, int wr, int wc, int fr, int fq) const {
        const int col = u.pn * 256 + wc * 64 + fq * 8, row0 = u.pm * BM + wr * 64 + fr, b = row0 >> 12;
        f32x4 gv[2][2];
#pragma unroll
        for (int bj = 0; bj < 2; ++bj)
#pragma unroll
            for (int n = 0; n < 2; ++n) gv[bj][n] = *(const f32x4*)(gmod + b * 6144 + col + bj * 32 + n * 4);
#pragma unroll
        for (int ai = 0; ai < 2; ++ai)
#pragma unroll
          for (int mh = 0; mh < 2; ++mh) {
            f32x4 xo[2][2][2];
#pragma unroll
            for (int m2 = 0; m2 < 2; ++m2) { const size_t off = (size_t)(row0 + ai * HALF + (2 * mh + m2) * 16) * D + col;
#pragma unroll
                for (int bj = 0; bj < 2; ++bj)
#pragma unroll
                    for (int n = 0; n < 2; ++n) xo[m2][bj][n] = *(const f32x4*)(xin + off + bj * 32 + n * 4); }
#pragma unroll
            for (int m2 = 0; m2 < 2; ++m2) { const size_t off = (size_t)(row0 + ai * HALF + (2 * mh + m2) * 16) * D + col;
#pragma unroll
                for (int bj = 0; bj < 2; ++bj)
#pragma unroll
                    for (int n = 0; n < 2; ++n) *(f32x4*)(xout + off + bj * 32 + n * 4) = xo[m2][bj][n] + gv[bj][n] * acc[ai][bj][2 * mh + m2][n]; }
          }
    }
};
struct EpiGU {
    bf16_t* f;
    __device__ __forceinline__ void operator()(const f32x4 (&acc)[2][2][4][2], const Unit& u, int wr, int wc, int fr, int fq) const {
        const int col = u.pn * 128 + wc * 32 + fq * 8, row0 = u.pm * BM + wr * 64 + fr;
#pragma unroll
        for (int ai = 0; ai < 2; ++ai)
#pragma unroll
            for (int m = 0; m < 4; ++m) {
                f32x4 o[2];
#pragma unroll
                for (int n = 0; n < 2; ++n)
#pragma unroll
                    for (int j = 0; j < 4; ++j) { const float gt = acc[ai][0][m][n][j]; o[n][j] = gt * sigmoidf_(gt) * acc[ai][1][m][n][j]; }
                *(u32x4*)(f + (size_t)(row0 + ai * HALF + m * 16) * FF + col) = pack8(o[0], o[1]);
            }
    }
};
}

#define LDS_WAIT() asm volatile("s_waitcnt lgkmcnt(0)" ::: "memory")
__device__ __forceinline__ void transpose_item(const float* W, int N, int K, int n0, bf16_t* WT, int a0, int k0, LAS float* scr, int lane) {
    {
        const int kr = lane >> 3, c4 = (lane & 7) * 4;
        f32x4 t[8];
#pragma unroll
        for (int i = 0; i < 8; ++i) t[i] = __builtin_nontemporal_load((const f32x4*)(W + (size_t)(k0 + 8 * i + kr) * N + n0 + c4));
#pragma unroll
        for (int i = 0; i < 8; ++i) { LAS float* d = scr + (8 * i + kr) * 33 + c4; d[0] = t[i][0]; d[1] = t[i][1]; d[2] = t[i][2]; d[3] = t[i][3]; }
    }
    LDS_WAIT(); asm volatile("" ::: "memory");
    const int c = lane & 7;
#pragma unroll
    for (int j = 0; j < 4; ++j) { const int s = (lane >> 3) + 8 * j; const int lo = 8 * ((s >> 2) & 3) + 4 * (s >> 4) + (s & 3);
        const LAS float* sp = scr + (8 * c) * 33 + lo;
        u32x4 o; o.x = cvt_pk(sp[0 * 33], sp[1 * 33]); o.y = cvt_pk(sp[2 * 33], sp[3 * 33]); o.z = cvt_pk(sp[4 * 33], sp[5 * 33]); o.w = cvt_pk(sp[6 * 33], sp[7 * 33]);
        *(u32x4*)(WT + (size_t)(a0 + s) * K + k0 + 8 * c) = o; }
    LDS_WAIT(); asm volatile("" ::: "memory");
}

struct Params { const float* in[16]; float* out; unsigned char* ws; };

__device__ __forceinline__ void phase0(const Params& p, LAS unsigned char* lds, int gw, int NGW, int wave, int lane, const int l, const bool with_mod) {
    LAS float* scr = (LAS float*)(lds + wave * 16384);
    constexpr int I_IN = 256 * 16, I_SQ = 32 * 16, I_GU = 176 * 16, I_D = 32 * 44, I_LAYER = I_IN + 3 * I_SQ + I_GU + I_D;
    constexpr int I_MOD = 2 * 32 * 24;
    for (int it = gw; it < (with_mod ? I_MOD : 0); it += NGW) {
        const int l = it / (32 * 24), r = it % (32 * 24), kc = r / 24, nb = r % 24;
        const float* aw = p.in[2] + (size_t)l * D * 6144 + (size_t)(kc * 32) * 6144 + nb * 256 + lane * 4;
        const float* c = p.in[1];
        f32x4 a[4];
#pragma unroll
        for (int b = 0; b < 4; ++b) a[b] = (f32x4){0.f, 0.f, 0.f, 0.f};
#pragma unroll 8
        for (int k = 0; k < 32; ++k) { const f32x4 w = __builtin_nontemporal_load((const f32x4*)(aw + (size_t)k * 6144));
#pragma unroll
            for (int b = 0; b < 4; ++b) { const float cv = c[b * D + kc * 32 + k]; const float sv = cv * sigmoidf_(cv); a[b] += w * sv; } }
        float* mp = (float*)(p.ws + R_CX) + ((size_t)(l * 32 + kc) * 4) * 6144 + nb * 256 + lane * 4;
#pragma unroll
        for (int b = 0; b < 4; ++b) *(f32x4*)(mp + (size_t)b * 6144) = a[b];
    }
    for (int it = gw; it < I_LAYER; it += NGW) {
        int r = it;
        unsigned char* wl = p.ws + WS_W;
        if (r < I_IN) { const int kb = r / 256, g = r % 256; const int pn = g >> 3, bj = (g >> 2) & 1, wc = g & 3;
            transpose_item(p.in[5] + (size_t)l * D * INW, INW, D, 256 * pn + 64 * wc + 32 * bj, (bf16_t*)(wl + W_IN), 32 * g, 64 * kb, scr, lane); continue; }
        r -= I_IN;
        if (r < 3 * I_SQ) { const int which = r / I_SQ; r %= I_SQ; const int kb = r / 32, g = r % 32; const int pn = g >> 3, bj = (g >> 2) & 1, wc = g & 3;
            const float* src = p.in[9 + which] + (size_t)l * D * D; bf16_t* dst = (bf16_t*)(wl + (which == 0 ? W_A : which == 1 ? W_B : W_O));
            transpose_item(src, D, D, 256 * pn + 64 * wc + 32 * bj, dst, 32 * g, 64 * kb, scr, lane); continue; }
        r -= 3 * I_SQ;
        if (r < I_GU) { const int kb = r / 176, g = r % 176; const int pn = g >> 3, bj = (g >> 2) & 1, wc = g & 3;
            const float* src = p.in[bj ? 14 : 13] + (size_t)l * D * FF;
            transpose_item(src, FF, D, 128 * pn + 32 * wc, (bf16_t*)(wl + W_GU), 32 * g, 64 * kb, scr, lane); continue; }
        r -= I_GU;
        { const int kb = r / 32, g = r % 32; const int pn = g >> 3, bj = (g >> 2) & 1, wc = g & 3;
            transpose_item(p.in[15] + (size_t)l * FF * D, D, FF, 256 * pn + 64 * wc + 32 * bj, (bf16_t*)(wl + W_D), 32 * g, 64 * kb, scr, lane); }
    }
}

__device__ __forceinline__ void norm_phase(const float* x, const float* g, const float* modl, int sh_off, int sc_off, bf16_t* h, int gw, int NGW, const bool stream = false, const bool use_tab = false, const LAS float* tab = nullptr) {
    const int lane = lane_id_opaque();
    for (int q = gw; q < M / 4; q += NGW) {
        const int m0 = 4 * q, b = m0 >> 12;
        f32x4 v[4][4];
#pragma unroll
        for (int r = 0; r < 4; ++r) { const f32x4* xr = (const f32x4*)(x + (size_t)(m0 + r) * D) + lane;
#pragma unroll
            for (int j = 0; j < 4; ++j) v[r][j] = stream ? __builtin_nontemporal_load(xr + 64 * j) : xr[64 * j]; }
        float rs[4];
#pragma unroll
        for (int r = 0; r < 4; ++r) { float s = 0.f;
#pragma unroll
            for (int j = 0; j < 4; ++j) s += (v[r][j][0] * v[r][j][0] + v[r][j][1] * v[r][j][1]) + (v[r][j][2] * v[r][j][2] + v[r][j][3] * v[r][j][3]);
            rs[r] = s; }
#pragma unroll
        for (int o = 1; o < 64; o <<= 1) {
#pragma unroll
            for (int r = 0; r < 4; ++r) rs[r] += shx(rs[r], o, lane); }
#pragma unroll
        for (int r = 0; r < 4; ++r) rs[r] = 1.0f / sqrtf(rs[r] * (1.0f / D) + EPS);
#pragma unroll
        for (int j = 0; j < 4; ++j) { const int col = 4 * (64 * j + lane);
            const f32x4 gg = *(const f32x4*)(g + col);
            const f32x4 sc = (use_tab ? *(const LAS f32x4*)(tab + (b >> 1) * 2048 + sc_off + col) : *(const f32x4*)(modl + b * 6144 + sc_off + col)) + 1.0f;
            const f32x4 sh = use_tab ? *(const LAS f32x4*)(tab + (b >> 1) * 2048 + sh_off + col) : *(const f32x4*)(modl + b * 6144 + sh_off + col);
#pragma unroll
            for (int r = 0; r < 4; ++r) { const f32x4 y = (v[r][j] * rs[r] * gg) * sc + sh;
                u32x2 w; w.x = cvt_pk(y[0], y[1]); w.y = cvt_pk(y[2], y[3]); *((u32x2*)(h + (size_t)(m0 + r) * D) + lane + 64 * j) = w; } }
    }
}

__device__ __forceinline__ void conv_phase(bf16_t* cb, const bf16_t* cc, const bf16_t* cx, const float* cw, int gt0, int NT) {
    const int gt = gt0 + lane_id_opaque();
    for (int it = gt; it < (M / 16) * (D / 8); it += NT) {
        const int c8 = it & 127, run = it >> 7, t0 = run * 16, ch = c8 * 8;
        float w0[8], w1[8], w2[8];
#pragma unroll
        for (int i = 0; i < 8; ++i) { w0[i] = cw[ch + i]; w1[i] = cw[D + ch + i]; w2[i] = cw[2 * D + ch + i]; }
        float um2[8], um1[8];
#pragma unroll
        for (int i = 0; i < 8; ++i) { um2[i] = 0.f; um1[i] = 0.f; }
        if ((t0 & (SEQ - 1)) != 0) {
            const u32x4 a2 = *(const u32x4*)(cc + (size_t)(t0 - 2) * D + ch), b2 = *(const u32x4*)(cx + (size_t)(t0 - 2) * D + ch);
            const u32x4 a1 = *(const u32x4*)(cc + (size_t)(t0 - 1) * D + ch), b1 = *(const u32x4*)(cx + (size_t)(t0 - 1) * D + ch);
#pragma unroll
            for (int i = 0; i < 4; ++i) { um2[2 * i] = bf_lo(a2[i]) * bf_lo(b2[i]); um2[2 * i + 1] = bf_hi(a2[i]) * bf_hi(b2[i]);
                um1[2 * i] = bf_lo(a1[i]) * bf_lo(b1[i]); um1[2 * i + 1] = bf_hi(a1[i]) * bf_hi(b1[i]); }
        }
#pragma unroll 4
        for (int t = 0; t < 16; ++t) {
            const size_t off = (size_t)(t0 + t) * D + ch;
            const u32x4 a = *(const u32x4*)(cc + off), b = *(const u32x4*)(cx + off), e = *(const u32x4*)(cb + off);
            float u[8], y[8];
#pragma unroll
            for (int i = 0; i < 4; ++i) { u[2 * i] = bf_lo(a[i]) * bf_lo(b[i]); u[2 * i + 1] = bf_hi(a[i]) * bf_hi(b[i]); }
#pragma unroll
            for (int i = 0; i < 4; ++i) {
                y[2 * i] = bf_lo(e[i]) * (w0[2 * i] * um2[2 * i] + w1[2 * i] * um1[2 * i] + w2[2 * i] * u[2 * i]);
                y[2 * i + 1] = bf_hi(e[i]) * (w0[2 * i + 1] * um2[2 * i + 1] + w1[2 * i + 1] * um1[2 * i + 1] + w2[2 * i + 1] * u[2 * i + 1]); }
            u32x4 o; o.x = cvt_pk(y[0], y[1]); o.y = cvt_pk(y[2], y[3]); o.z = cvt_pk(y[4], y[5]); o.w = cvt_pk(y[6], y[7]);
            *(u32x4*)(cb + off) = o;
#pragma unroll
            for (int i = 0; i < 8; ++i) { um2[i] = um1[i]; um1[i] = u[i]; }
        }
    }
}

#define MFMA32(a, b, c) __builtin_amdgcn_mfma_f32_32x32x16_bf16((a), (b), (c), 0, 0, 0)
constexpr float SB_EXIT = 1.0e-20f;
__device__ __forceinline__ float clamp_z(float z) { return __builtin_amdgcn_fmed3f(z, -126.0f, 80.0f); }
struct AttnState { f32x16 o0, o1; float P; bf16x8 kf[4]; };
template <bool DIAG>
__device__ __forceinline__ void attn_step(AttnState& st, const bf16x8 (&qf)[4], const bf16_t* kbase, const bf16_t* vbase, int j0, bool more, int n, int hh, int lane) {
    bf16x8 vf[2][2];
#pragma unroll
    for (int mb = 0; mb < 2; ++mb)
#pragma unroll
        for (int s = 0; s < 2; ++s) vf[mb][s] = *(const bf16x8*)(vbase + (size_t)mb * 32 * SEQ + j0 + 16 * s);
    f32x16 sa;
#pragma unroll
    for (int r = 0; r < 16; ++r) sa[r] = 0.f;
#pragma unroll
    for (int kk = 0; kk < 4; ++kk) sa = MFMA32(st.kf[kk], qf[kk], sa);
    if (more) {
#pragma unroll
        for (int kk = 0; kk < 4; ++kk) st.kf[kk] = *(const bf16x8*)(kbase + (size_t)(j0 - 32) * D + kk * 16);
    }
    float om[16], be[16];
#pragma unroll
    for (int r = 0; r < 16; ++r) {
        const float e = fast_exp2(clamp_z(sa[r]));
        float o = fast_rcp(1.0f + e), b = e * o;
        if (DIAG) { const int ki = (r & 3) + 8 * (r >> 2) + 4 * hh; if (ki >= n) { o = 1.0f; b = 0.f; } }
        om[r] = o; be[r] = b;
    }
    float g[4], pg[4];
#pragma unroll
    for (int q = 0; q < 4; ++q) g[q] = (om[4 * q] * om[4 * q + 1]) * (om[4 * q + 2] * om[4 * q + 3]);
#pragma unroll
    for (int q = 0; q < 4; ++q) pg[q] = shx(g[q], 32, lane);
    float run = st.P;
    float a[16];
#pragma unroll
    for (int q = 3; q >= 0; --q) {
        const float c3 = (hh == 0) ? run * pg[q] : run;
        const float c2 = c3 * om[4 * q + 3], c1 = c2 * om[4 * q + 2], c0 = c1 * om[4 * q + 1];
        a[4 * q + 3] = be[4 * q + 3] * c3; a[4 * q + 2] = be[4 * q + 2] * c2; a[4 * q + 1] = be[4 * q + 1] * c1; a[4 * q] = be[4 * q] * c0;
        run *= g[q] * pg[q];
    }
    st.P = run;
#pragma unroll
    for (int s = 0; s < 2; ++s) {
        u32x4 pw; pw.x = cvt_pk(a[8 * s + 0], a[8 * s + 1]); pw.y = cvt_pk(a[8 * s + 2], a[8 * s + 3]); pw.z = cvt_pk(a[8 * s + 4], a[8 * s + 5]); pw.w = cvt_pk(a[8 * s + 6], a[8 * s + 7]);
        const bf16x8 pf = __builtin_bit_cast(bf16x8, pw);
        st.o0 = MFMA32(vf[0][s], pf, st.o0); st.o1 = MFMA32(vf[1][s], pf, st.o1);
    }
}
__device__ __forceinline__ void attn_task(bf16_t* QO, const bf16_t* Kp, const bf16_t* VT, int b, int h, int qblk, int lane) {
    const int n = lane & 31, hh = lane >> 5, t0 = qblk * 32;
    bf16_t* qrow = QO + (size_t)(b * SEQ + t0 + n) * D + h * HD;
    bf16x8 qf[4];
#pragma unroll
    for (int kk = 0; kk < 4; ++kk) qf[kk] = *(const bf16x8*)(qrow + kk * 16 + hh * 8);
    AttnState st;
#pragma unroll
    for (int r = 0; r < 16; ++r) { st.o0[r] = 0.f; st.o1[r] = 0.f; }
    st.P = 1.0f;
    const bf16_t* kbase = Kp + (size_t)(b * SEQ + n) * D + h * HD + hh * 8;
    const bf16_t* vbase = VT + ((size_t)(b * NH + h) * HD + n) * SEQ + 8 * hh;
#pragma unroll
    for (int kk = 0; kk < 4; ++kk) st.kf[kk] = *(const bf16x8*)(kbase + (size_t)t0 * D + kk * 16);
    attn_step<true>(st, qf, kbase, vbase, t0, qblk > 0, n, hh, lane);
    for (int kb = qblk - 1; kb >= 0; --kb) {
        if (!__any(st.P > SB_EXIT)) break;
        attn_step<false>(st, qf, kbase, vbase, kb * 32, kb > 0, n, hh, lane);
    }
#pragma unroll
    for (int q = 0; q < 4; ++q) {
        u32x2 w0, w1; w0.x = cvt_pk(st.o0[4 * q], st.o0[4 * q + 1]); w0.y = cvt_pk(st.o0[4 * q + 2], st.o0[4 * q + 3]); w1.x = cvt_pk(st.o1[4 * q], st.o1[4 * q + 1]); w1.y = cvt_pk(st.o1[4 * q + 2], st.o1[4 * q + 3]);
        *(u32x2*)(qrow + 8 * q + 4 * hh) = w0; *(u32x2*)(qrow + 32 + 8 * q + 4 * hh) = w1;
    }
}
__device__ __forceinline__ void attn_phase(bf16_t* QO, const bf16_t* Kp, const bf16_t* VT, int G, int bx, int wave) {
    const int lane = lane_id_opaque();
    constexpr int NQB = SEQ / 32, NTASK = NB * NH * NQB;
    if (G == 256) {
#pragma unroll 1
        for (int i = 0; i < 4; ++i) { const int bh = 2 * (wave * 4 + i) + (bx & 1); attn_task(QO, Kp, VT, bh / NH, bh % NH, bx >> 1, lane); }
    } else {
        int i = 0;
        for (int tau = bx * NWAVES + wave; tau < NTASK; tau += G * NWAVES, ++i) {
            const int bh = tau / NQB, qr = tau % NQB, qblk = (i & 1) ? (NQB - 1 - qr) : qr;
            attn_task(QO, Kp, VT, bh / NH, bh % NH, qblk, lane);
        }
    }
}
__device__ __forceinline__ void mixer_phase(bf16_t* QO, const bf16_t* Kp, const bf16_t* VT, bf16_t* cb, const bf16_t* cc, const bf16_t* cx, const float* cw, int G, int bx, int wave, int gt0, int NT) {
    if (wave & 4) { conv_phase(cb, cc, cx, cw, gt0, NT); attn_phase(QO, Kp, VT, G, bx, wave); }
    else          { attn_phase(QO, Kp, VT, G, bx, wave); conv_phase(cb, cc, cx, cw, gt0, NT); }
}

#define XB_TMO      128
#define XB_XCNT(j)  (256  + 64 * (j))
#define XB_XSUB(j)  (1280 + 64 * (j))
#define XB_XGEN(j)  (2304 + 64 * (j))
#define XB_TOP      3328
#define XB_TOPGEN   3392
#define XCD_BAR_WORDS 3456
#define XB_SPIN_CAP (1u << 18)
__device__ __forceinline__ unsigned xb_ld(unsigned* p)              { return __hip_atomic_load(p, __ATOMIC_RELAXED, __HIP_MEMORY_SCOPE_AGENT); }
__device__ __forceinline__ unsigned xb_add(unsigned* p, unsigned v) { return __hip_atomic_fetch_add(p, v, __ATOMIC_RELAXED, __HIP_MEMORY_SCOPE_AGENT); }
__device__ __forceinline__ unsigned xb_xcc_id() { return (unsigned)__builtin_amdgcn_s_getreg((3 << 11) | 20) & 0xFu; }
#define XB_SPIN(cond, bar) do { unsigned _sp = 0; while (cond) { __builtin_amdgcn_s_sleep(1); \
    if ((++_sp & 255u) == 0u) { if (xb_ld(&(bar)[XB_TMO])) break; if (_sp > XB_SPIN_CAP) { atomicAdd(&(bar)[XB_TMO], 1u); break; } } } } while (0)
struct XcdBarrier { unsigned* bar; unsigned x; volatile LAS unsigned* st; };
__device__ __forceinline__ XcdBarrier xcd_barrier_post(unsigned* bar, volatile LAS unsigned* st, int tid) {
    XcdBarrier b; b.bar = bar; b.x = xb_xcc_id(); b.st = st;
    if (tid == 0) (void)xb_add(&bar[XB_XCNT(b.x)], 1u);
    return b;
}
__device__ __forceinline__ void xcd_barrier_complete(unsigned* bar, unsigned x, unsigned& nloc, unsigned& nx) {
    const unsigned G = gridDim.x * gridDim.y * gridDim.z;
    unsigned sum, cnt, mine, sp = 0u;
    for (;;) {
        sum = 0u; cnt = 0u; mine = 0u;
#pragma unroll
        for (unsigned j = 0; j < 16; ++j) { const unsigned c = xb_ld(&bar[XB_XCNT(j)]); sum += c; cnt += (c > 0u) ? 1u : 0u; mine = (j == x) ? c : mine; }
        if (sum == G) break;
        __builtin_amdgcn_s_sleep(1);
        if ((++sp & 255u) == 0u) { if (xb_ld(&bar[XB_TMO])) break; if (sp > XB_SPIN_CAP) { atomicAdd(&bar[XB_TMO], 1u); break; } }
    }
    nloc = mine > 0u ? mine : 1u; nx = cnt > 0u ? cnt : 1u;
}
__device__ __forceinline__ void xcd_barrier(const XcdBarrier& b, bool leader) {
    asm volatile("s_waitcnt vmcnt(0)" ::: "memory");
    __syncthreads();
    if (leader) {
        unsigned* bar = b.bar;
        __builtin_amdgcn_s_waitcnt(0);
        unsigned nloc = b.st[0], nx = b.st[1];
        if (nloc == 0u) { xcd_barrier_complete(bar, b.x, nloc, nx); b.st[0] = nloc; b.st[1] = nx; }
        const unsigned old = xb_add(&bar[XB_XSUB(b.x)], 1u);
        const unsigned gen = old / nloc;
        if (old + 1u == (gen + 1u) * nloc) {
            __builtin_amdgcn_fence(__ATOMIC_RELEASE, "agent");
            asm volatile("s_waitcnt vmcnt(0)" ::: "memory");
            const unsigned og = xb_add(&bar[XB_TOP], 1u);
            const unsigned tg = og / nx;
            if (og + 1u == (tg + 1u) * nx) xb_add(&bar[XB_TOPGEN], 1u);
            else XB_SPIN(xb_ld(&bar[XB_TOPGEN]) == tg, bar);
            __builtin_amdgcn_fence(__ATOMIC_ACQUIRE, "agent");
            xb_add(&bar[XB_XGEN(b.x)], 1u);
            asm volatile("s_waitcnt vmcnt(0)" ::: "memory");
        } else {
            XB_SPIN(xb_ld(&bar[XB_XGEN(b.x)]) == gen, bar);
            __builtin_amdgcn_fence(__ATOMIC_ACQUIRE, "agent");
            asm volatile("s_waitcnt vmcnt(0)" ::: "memory");
        }
    }
    __syncthreads();
}

#define XB_DONE XCD_BAR_WORDS
__device__ unsigned g_bar[XCD_BAR_WORDS + 64];

constexpr int LDS_BYTES = 131072 + 1024;
__global__ void __launch_bounds__(NTHREADS, 2) fwd_kernel(Params p) {
    extern __shared__ __attribute__((aligned(16))) unsigned char lds_raw[];
    LAS unsigned char* lds = (LAS unsigned char*)lds_raw;
    cg::grid_group grid = cg::this_grid();
#define CG_SYNC() do { asm volatile("s_waitcnt vmcnt(0)" ::: "memory"); grid.sync(); if (wave == 0) { __builtin_amdgcn_fence(__ATOMIC_ACQUIRE, "agent"); asm volatile("s_waitcnt vmcnt(0)" ::: "memory"); } __syncthreads(); } while (0)
#define GRID_SYNC_() xcd_barrier(xb, leader)
    unsigned long long pr_acc = 0, pr_t0 = 0;
#define TIC() do { if (PROBE_MASK) pr_t0 = __builtin_amdgcn_s_memrealtime(); } while (0)
#define TOC(bit) do { if (PROBE_MASK & (bit)) pr_acc += __builtin_amdgcn_s_memrealtime() - pr_t0; } while (0)
#define GRID_SYNC() do { TIC(); GRID_SYNC_(); TOC(2 | sync_kind); } while (0)
    int sync_kind = 128;
    const int tid0 = threadIdx.x, wave = __builtin_amdgcn_readfirstlane(tid0 >> 6);
    const int G = gridDim.x, bx = blockIdx.x;
    const int gw = bx * NWAVES + wave, NGW = G * NWAVES, NT = G * NTHREADS;
    unsigned char* ws = p.ws;
    float* mod = (float*)(ws + WS_CTL);
    bf16_t* Rh = (bf16_t*)(ws + R_H); bf16_t* Rq = (bf16_t*)(ws + R_Q); bf16_t* Rk = (bf16_t*)(ws + R_K); bf16_t* Rv = (bf16_t*)(ws + R_V);
    bf16_t* Rcb = (bf16_t*)(ws + R_CB); bf16_t* Rcc = (bf16_t*)(ws + R_CC); bf16_t* Rcx = (bf16_t*)(ws + R_CX);
    const unsigned char* wl = ws + WS_W;

    unsigned* barw = g_bar;
    volatile LAS unsigned* bst = (volatile LAS unsigned*)(lds + 131072);
    const bool leader = (wave == 0) && (lane_id_opaque() == 0);
    if (leader) { bst[0] = 0u; bst[1] = 0u; bst[2] = 0u; }
    const XcdBarrier xb = xcd_barrier_post(barw, bst, leader ? 0 : 1);
    if (G == 0x7fffffff) CG_SYNC();
    TIC();
    phase0(p, lds, gw, NGW, wave, lane_id_opaque(), 0, true);
    TOC(16);
    GRID_SYNC();
    TIC();
    {
        const int gt = bx * NTHREADS + wave * 64 + lane_id_opaque();
        for (int it = gt; it < 2 * 4 * 1536; it += NT) {
            const int l = it / 6144, r = it % 6144, b = r / 1536, n4 = r % 1536;
            f32x4 a = *(const f32x4*)(p.in[3] + l * 6144 + n4 * 4);
            const float* mp = (const float*)(ws + R_CX) + ((size_t)(l * 32) * 4 + b) * 6144 + n4 * 4;
#pragma unroll 8
            for (int kc = 0; kc < 32; ++kc) a += *(const f32x4*)(mp + (size_t)kc * 4 * 6144);
            *(f32x4*)(mod + (size_t)(l * 4 + b) * 6144 + n4 * 4) = a;
        }
    }
    TOC(16);
    if (G == 256) {
        LAS float* tab = (LAS float*)(lds + 1024);
        const int t = wave * 64 + lane_id_opaque();
#pragma unroll 1
        for (int k = 0; k < 2; ++k) {
            const int idx = t + 512 * k, sel = idx >> 9, n4 = idx & 511, b = (bx >> 7) + 2 * sel;
            f32x4 a = *(const f32x4*)(p.in[3] + n4 * 4);
            const float* mp = (const float*)(ws + R_CX) + (size_t)b * 6144 + n4 * 4;
#pragma unroll 8
            for (int kc = 0; kc < 32; ++kc) a += *(const f32x4*)(mp + (size_t)kc * 4 * 6144);
            *(LAS f32x4*)(tab + sel * 2048 + n4 * 4) = a;
        }
        __syncthreads();
        TIC(); norm_phase(p.in[0], p.in[4], mod, 0, 1024, Rh, gw, NGW, true, true, tab); TOC(8); sync_kind = 128;
    } else {
        GRID_SYNC();
        TIC(); norm_phase(p.in[0], p.in[4], mod, 0, 1024, Rh, gw, NGW, true); TOC(8); sync_kind = 128;
    }
    GRID_SYNC();

#pragma unroll 1
    for (int l = 0; l < DEPTH; ++l) {
        const float* modl = mod + (size_t)l * 4 * 6144;
        const float* xin = (l == 0) ? p.in[0] : p.out;
        { pg8::SchedPlain S; S.T.init(M, 6144); S.G = G; S.c = bx; S.A = (const char*)Rh; S.B = (const char*)(wl + W_IN); S.tstep = (size_t)256 * D * 2;
          pg8::EpiQKV E{Rq, p.in[6] + l * HD, p.in[7] + l * HD};
          TIC(); pg8::gemm_phase(lds, D, S, E, wave); TOC(1); sync_kind = 32; }
        GRID_SYNC();
        TIC(); mixer_phase(Rq, Rk, Rv, Rcb, Rcc, Rcx, p.in[8] + (size_t)l * 3 * D, G, bx, wave, bx * NTHREADS + wave * 64, NT); TOC(4); sync_kind = 64;
        GRID_SYNC();
        { pg8::SchedBranch S; S.T.init(M, D); S.G = G; S.c = bx; S.ws = (const char*)ws; S.wl = (const char*)wl; S.tstep = (size_t)256 * D * 2;
          pg8::EpiBranch E{Rv, Rk};
          TIC(); pg8::gemm_phase(lds, D, S, E, wave); TOC(1); sync_kind = 32; }
        GRID_SYNC();
        { pg8::SchedPlain S; S.T.init(M, D); S.G = G; S.c = bx; S.A = (const char*)Rk; S.B = (const char*)(wl + W_O); S.tstep = (size_t)256 * D * 2;
          pg8::EpiResid E{xin, p.out, modl + 2048};
          TIC(); pg8::gemm_phase(lds, D, S, E, wave); TOC(1); sync_kind = 32; }
        GRID_SYNC();
        TIC(); norm_phase(p.out, p.in[12] + l * D, modl, 3072, 4096, Rh, gw, NGW, true); TOC(8); sync_kind = 128;
        GRID_SYNC();
        { pg8::SchedPlain S; S.T.init(M, 2 * FF); S.G = G; S.c = bx; S.A = (const char*)Rh; S.B = (const char*)(wl + W_GU); S.tstep = (size_t)256 * D * 2;
          pg8::EpiGU E{Rq};
          TIC(); pg8::gemm_phase(lds, D, S, E, wave); TOC(1); sync_kind = 32; }
        GRID_SYNC();
        { pg8::SchedPlain S; S.T.init(M, D); S.G = G; S.c = bx; S.A = (const char*)Rq; S.B = (const char*)(wl + W_D); S.tstep = (size_t)256 * FF * 2;
          pg8::EpiResid E{p.out, p.out, modl + 5120};
          TIC(); pg8::gemm_phase(lds, FF, S, E, wave); TOC(1); sync_kind = 32; }
        if (l + 1 < DEPTH) {
            GRID_SYNC();
            TIC();
            phase0(p, lds, gw, NGW, wave, lane_id_opaque(), l + 1, false);
            norm_phase(p.out, p.in[4] + (l + 1) * D, mod + (size_t)(l + 1) * 4 * 6144, 0, 1024, Rh, gw, NGW, true);
            TOC(8); sync_kind = 128;
            GRID_SYNC();
        }
    }
    asm volatile("s_waitcnt vmcnt(0)" ::: "memory");
    if (leader) { const unsigned old = xb_add(&barw[XB_DONE], 1u); bst[2] = (old + 1u == (unsigned)G) ? 1u : 0u; }
    __syncthreads();
    if (bst[2]) { const int t = wave * 64 + lane_id_opaque(); for (int i = t; i < XCD_BAR_WORDS + 64; i += NTHREADS) __hip_atomic_store(&barw[i], 0u, __ATOMIC_RELAXED, __HIP_MEMORY_SCOPE_AGENT); }
    if (PROBE_MASK && bx == 0 && leader) { const unsigned long long t = __builtin_amdgcn_s_memrealtime(); while (__builtin_amdgcn_s_memrealtime() - t < pr_acc) __builtin_amdgcn_s_sleep(8); }
}

extern "C" void kernel_launch(void* const* d_in, const int* in_sizes, int n_in, void* d_out, int out_size, void* d_ws, size_t ws_size, hipStream_t stream) {
    static int grid_blocks = 0;
    if (grid_blocks == 0) {
        if (n_in != 16 || out_size != M * D || ws_size < WS_END) { fprintf(stderr, "kernel_launch: unexpected shapes (n_in %d out %d ws %zu need %zu)\n", n_in, out_size, ws_size, (size_t)WS_END); grid_blocks = -1; return; }
        int dev = 0, cus = 0, per_cu = 0;
        hipGetDevice(&dev);
        hipDeviceGetAttribute(&cus, hipDeviceAttributeMultiprocessorCount, dev);
        hipFuncSetAttribute((const void*)fwd_kernel, hipFuncAttributeMaxDynamicSharedMemorySize, LDS_BYTES);
        hipOccupancyMaxActiveBlocksPerMultiprocessor(&per_cu, (const void*)fwd_kernel, NTHREADS, LDS_BYTES);
        (void)hipGetLastError();
        if (per_cu < 1) { fprintf(stderr, "kernel_launch: occupancy query says %d blocks per CU\n", per_cu); per_cu = 1; }
        grid_blocks = cus;
    }
    if (grid_blocks < 0) return;
    Params p{};
    for (int i = 0; i < 16; ++i) p.in[i] = (const float*)d_in[i];
    p.out = (float*)d_out; p.ws = (unsigned char*)d_ws;
    void* args[] = {&p};
    hipError_t e = hipLaunchCooperativeKernel((const void*)fwd_kernel, dim3(grid_blocks), dim3(NTHREADS), args, LDS_BYTES, stream);
    if (e != hipSuccess) fprintf(stderr, "cooperative launch failed: %s (grid %d)\n", hipGetErrorString(e), grid_blocks);
}
```

```cpp
#include <hip/hip_runtime.h>
#include <hip/hip_cooperative_groups.h>
#include <cstdio>
#include <cstdint>
namespace cg = cooperative_groups;
#ifndef PROBE_MASK
#define PROBE_MASK 0
#endif

#define LAS __attribute__((address_space(3)))
typedef unsigned short bf16_t;
typedef short bf16x8 __attribute__((ext_vector_type(8)));
typedef short s16x4 __attribute__((ext_vector_type(4)));
typedef float f32x4 __attribute__((ext_vector_type(4)));
typedef float f32x16 __attribute__((ext_vector_type(16)));
typedef unsigned u32x4 __attribute__((ext_vector_type(4)));
typedef unsigned u32x2 __attribute__((ext_vector_type(2)));
typedef float f32x2_t __attribute__((ext_vector_type(2)));
typedef __bf16 bf16x2_t __attribute__((ext_vector_type(2)));

constexpr int D = 1024, NB = 4, SEQ = 4096, M = NB * SEQ, NH = 16, HD = 64, FF = 2816, INW = 8192, DEPTH = 2;
constexpr float EPS = 1e-6f;
constexpr float LOG2E = 1.4426950408889634f;
constexpr float C2 = 0.125f * LOG2E;
constexpr int NWAVES = 8, NTHREADS = 512;

constexpr size_t MiB = 1u << 20;
constexpr size_t WS_CTL = 0, CTL_BYTES = 256 * 1024;
constexpr size_t WS_W = 1 * MiB;
constexpr size_t W_IN = 0, W_A = 16 * MiB, W_B = 18 * MiB, W_O = 20 * MiB, W_GU = 22 * MiB, W_D = 33 * MiB, W_LAYER = 38 * MiB + 512 * 1024;
constexpr size_t WS_ACT = 40 * MiB;
constexpr size_t REG = 32 * MiB;
constexpr size_t R_H = WS_ACT, R_Q = WS_ACT + REG, R_K = WS_ACT + 2 * REG, R_V = WS_ACT + 3 * REG, R_CB = WS_ACT + 4 * REG, R_CC = WS_ACT + 5 * REG, R_CX = WS_ACT + 6 * REG, WS_END = WS_ACT + 7 * REG;
static_assert(WS_W + W_LAYER <= WS_ACT, "weights");
static_assert((size_t)M * FF * 2 <= 3 * REG, "ffn hidden fits R_Q..R_V");
static_assert(WS_END <= 279028736, "workspace >= sum of the inputs' bytes");

__device__ __forceinline__ unsigned cvt_pk(float lo, float hi) { f32x2_t v = {lo, hi}; bf16x2_t b = __builtin_convertvector(v, bf16x2_t); return __builtin_bit_cast(unsigned, b); }
__device__ __forceinline__ float bf_lo(unsigned u) { return __uint_as_float(u << 16); }
__device__ __forceinline__ float bf_hi(unsigned u) { return __uint_as_float(u & 0xffff0000u); }
__device__ __forceinline__ float shx(float v, int o, int lane) { return __int_as_float(__builtin_amdgcn_ds_bpermute((lane ^ o) << 2, __float_as_int(v))); }
__device__ __forceinline__ float wave_sum(float v, int lane) {
#pragma unroll
    for (int o = 1; o < 64; o <<= 1) v += shx(v, o, lane);
    return v;
}
__device__ __forceinline__ int lane_id_opaque() { int l; asm volatile("v_mbcnt_lo_u32_b32 %0, -1, 0\n\tv_mbcnt_hi_u32_b32 %0, -1, %0" : "=v"(l)); return l; }
__device__ __forceinline__ float fast_exp2(float x) { return __builtin_amdgcn_exp2f(x); }
__device__ __forceinline__ float fast_log2(float x) { return __builtin_amdgcn_logf(x); }
__device__ __forceinline__ float fast_rcp(float x) { return __builtin_amdgcn_rcpf(x); }
__device__ __forceinline__ float sigmoidf_(float x) { return fast_rcp(1.0f + fast_exp2(-x * LOG2E)); }

namespace pg8 {
constexpr int BM = 256, BK = 64, HALF = 128, HTB = HALF * BK * 2, STAGE_BYTES = 8 * HTB, NXCD = 8, WGM = 8;
__host__ __device__ __forceinline__ int lds_byte(int r, int c) { const int st = (r >> 4) * 2 + (c >> 5), rr = r & 15, cc = c & 31, ob = rr * 64 + cc * 2; return st * 1024 + (ob ^ (((ob >> 9) & 1) << 5)); }
__host__ __device__ __forceinline__ void stage_rc(int b, int& R, int& C) { const int st = b / 1024, sb = b % 1024, swz = sb ^ (((sb >> 9) & 1) << 5); R = (st >> 1) * 16 + swz / 64; C = (st & 1) * 32 + (swz % 64) / 2; }

struct Unit { const char* A; const char* B; int pm, pn, kind; };

struct TileOrder {
    int nM, nN, nwg;
    __device__ __forceinline__ void init(int Mr, int N) { nM = Mr / BM; nN = N / BM; nwg = nM * nN; }
    __device__ __forceinline__ void map(int wgid, int& pm, int& pn) const {
        { const int q = nwg / NXCD, r = nwg % NXCD, xcd = wgid % NXCD, off = wgid / NXCD; wgid = (xcd < r ? xcd * (q + 1) : r * (q + 1) + (xcd - r) * q) + off; }
        const int nig = WGM * nN, gid = wgid / nig, fm = gid * WGM, gsz = (nM - fm) < WGM ? (nM - fm) : WGM;
        pm = fm + ((wgid % nig) % gsz); pn = (wgid % nig) / gsz;
    }
};
struct SchedPlain {
    TileOrder T; int G, c; const char* A; const char* B; size_t tstep;
    __device__ __forceinline__ bool next(int i, Unit& u) const {
        const long L = (long)i * G + c; if (L >= T.nwg) return false;
        T.map((int)L, u.pm, u.pn); u.A = A + (size_t)u.pm * tstep; u.B = B + (size_t)u.pn * tstep; u.kind = 0; return true;
    }
};
struct SchedBranch {
    TileOrder T; int G, c; const char* ws; const char* wl; size_t tstep;
    __device__ __forceinline__ bool next(int i, Unit& u) const {
        const long L = (long)(i >> 2) * G + c; if (L >= T.nwg) return false;
        T.map((int)L, u.pm, u.pn); const int sub = i & 3; u.kind = sub;
        const size_t oa = (sub == 1) ? R_Q : ((sub == 3) ? R_CB : R_H);
        const size_t ob = (sub == 0) ? (W_IN + (size_t)6144 * D * 2) : (sub == 1) ? W_A : (sub == 2) ? (W_IN + (size_t)7168 * D * 2) : W_B;
        u.A = ws + oa + (size_t)u.pm * tstep; u.B = wl + ob + (size_t)u.pn * tstep; return true;
    }
};

template <class Epi, class Sched>
__device__ __forceinline__ void gemm_phase(LAS unsigned char* lds, const int K, const Sched& S, const Epi& E, const int wid) {
    const int lane = lane_id_opaque(), tid = wid * 64 + lane, wr = wid >> 2, wc = wid & 3, fr = lane & 15, fq = lane >> 4;
    const int nt = K / BK;
    unsigned voff[2];
#pragma unroll
    for (int i = 0; i < 2; ++i) { int R, C; stage_rc(tid * 16 + i * 8192, R, C); voff[i] = (unsigned)(R * K + C) * 2u; }
    const size_t kstep = (size_t)(BK * 2);
    const size_t hstep = (size_t)HALF * K * 2;
    const unsigned ldsw = (unsigned)wid * 1024u;
    const int aoff = lds_byte(wr * 64 + fr, fq * 8), boff = lds_byte(wc * 32 + fr, fq * 8);
#define PG8_SA(b, h) (((b) * 2 + (h)) * HTB)
#define PG8_SB(b, h) ((4 + (b) * 2 + (h)) * HTB)
#define PG8_STAGE(bufoff, gbase) do { _Pragma("unroll") for (int _i = 0; _i < 2; ++_i) \
        __builtin_amdgcn_global_load_lds((const unsigned*)((const char*)(gbase) + voff[_i]), (LAS unsigned*)(lds + (bufoff) + ldsw + _i * 8192), 16, 0, 0); } while (0)
#define PG8_LDA(dst, b, h) do { _Pragma("unroll") for (int m = 0; m < 4; ++m) _Pragma("unroll") for (int k = 0; k < 2; ++k) dst[m][k] = *(const LAS bf16x8*)(lds + PG8_SA(b, h) + aoff + m * 2048 + k * 1024); } while (0)
#define PG8_LDB(dst, b, h) do { _Pragma("unroll") for (int n = 0; n < 2; ++n) _Pragma("unroll") for (int k = 0; k < 2; ++k) dst[n][k] = *(const LAS bf16x8*)(lds + PG8_SB(b, h) + boff + n * 2048 + k * 1024); } while (0)
#define PG8_MMA(ai, bj, At, Bt) do { __builtin_amdgcn_s_setprio(1); _Pragma("unroll") for (int m = 0; m < 4; ++m) _Pragma("unroll") for (int n = 0; n < 2; ++n) _Pragma("unroll") for (int k = 0; k < 2; ++k) \
        acc[ai][bj][m][n] = __builtin_amdgcn_mfma_f32_16x16x32_bf16(Bt[n][k], At[m][k], acc[ai][bj][m][n], 0, 0, 0); __builtin_amdgcn_s_setprio(0); } while (0)
#define PG8_WAIT_V(n) asm volatile("s_waitcnt vmcnt(" #n ")" ::: "memory")
#define PG8_WAIT_L(n) asm volatile("s_waitcnt lgkmcnt(" #n ")" ::: "memory")
#define PG8_BAR __builtin_amdgcn_s_barrier()
#define PG8_SCHED __builtin_amdgcn_sched_barrier(0)
    Unit cur, nxt; int ui = 0;
    if (!S.next(0, cur)) return;
    f32x4 acc[2][2][4][2];
#pragma unroll
    for (int a = 0; a < 2; ++a)
#pragma unroll
        for (int b = 0; b < 2; ++b)
#pragma unroll
            for (int m = 0; m < 4; ++m)
#pragma unroll
                for (int n = 0; n < 2; ++n) acc[a][b][m][n] = (f32x4){0.f, 0.f, 0.f, 0.f};
    bf16x8 At[4][2], B0[2][2], B1[2][2];
    const char* cA = cur.A; const char* cB = cur.B;
    PG8_STAGE(PG8_SB(0, 0), cB); PG8_STAGE(PG8_SB(0, 1), cB + hstep); PG8_STAGE(PG8_SA(0, 0), cA); PG8_STAGE(PG8_SA(0, 1), cA + hstep);
    if (wr == 1) PG8_BAR;
    PG8_WAIT_V(2); PG8_BAR;
    PG8_STAGE(PG8_SB(1, 0), cB + kstep); PG8_STAGE(PG8_SA(1, 0), cA + kstep); PG8_STAGE(PG8_SB(1, 1), cB + hstep + kstep);
    PG8_WAIT_V(6); PG8_BAR;
    for (;;) {
        const bool has_next = S.next(ui + 1, nxt);
        const char* nA = has_next ? nxt.A : cA; const char* nB = has_next ? nxt.B : cB;
        for (int t = 0; t < nt; t += 2) {
            const bool last = (t == nt - 2);
            const char* a1 = cA + (size_t)(t + 1) * kstep;
            const char* a2 = last ? nA : cA + (size_t)(t + 2) * kstep; const char* b2 = last ? nB : cB + (size_t)(t + 2) * kstep;
            const char* a3 = a2 + kstep; const char* b3 = b2 + kstep;
            PG8_LDB(B0, 0, 0); PG8_LDB(B1, 0, 1); PG8_SCHED; PG8_LDA(At, 0, 0); PG8_STAGE(PG8_SA(1, 1), a1 + hstep);
            PG8_WAIT_V(8); PG8_WAIT_L(0); PG8_BAR; PG8_MMA(0, 0, At, B0); PG8_MMA(0, 1, At, B1); PG8_BAR; PG8_SCHED;
            PG8_LDA(At, 0, 1); PG8_STAGE(PG8_SB(0, 0), b2); PG8_STAGE(PG8_SB(0, 1), b2 + hstep); PG8_STAGE(PG8_SA(0, 0), a2);
            PG8_WAIT_V(8); PG8_WAIT_L(0); PG8_BAR; PG8_MMA(1, 0, At, B0); PG8_MMA(1, 1, At, B1); PG8_BAR; PG8_SCHED;
            PG8_LDB(B0, 1, 0); PG8_LDB(B1, 1, 1); PG8_SCHED; PG8_LDA(At, 1, 0); PG8_STAGE(PG8_SA(0, 1), a2 + hstep);
            PG8_WAIT_V(8); PG8_WAIT_L(0); PG8_BAR; PG8_MMA(0, 0, At, B0); PG8_MMA(0, 1, At, B1); PG8_BAR; PG8_SCHED;
            PG8_LDA(At, 1, 1); PG8_STAGE(PG8_SB(1, 0), b3); PG8_STAGE(PG8_SB(1, 1), b3 + hstep); PG8_STAGE(PG8_SA(1, 0), a3);
            PG8_WAIT_V(8); PG8_WAIT_L(0); PG8_BAR; PG8_MMA(1, 0, At, B0); PG8_MMA(1, 1, At, B1); PG8_BAR; PG8_SCHED;
        }
        if (wr == 0) PG8_BAR;
        { const int l2 = lane_id_opaque(); E(acc, cur, wr, wc, l2 & 15, l2 >> 4); }
        if (!has_next) break;
#pragma unroll
        for (int a = 0; a < 2; ++a)
#pragma unroll
            for (int b = 0; b < 2; ++b)
#pragma unroll
                for (int m = 0; m < 4; ++m)
#pragma unroll
                    for (int n = 0; n < 2; ++n) acc[a][b][m][n] = (f32x4){0.f, 0.f, 0.f, 0.f};
        cur = nxt; cA = nA; cB = nB; ++ui;
        if (wr == 1) PG8_BAR;
    }
    PG8_WAIT_V(0);
    PG8_BAR;
#undef PG8_SA
#undef PG8_SB
#undef PG8_STAGE
#undef PG8_LDA
#undef PG8_LDB
#undef PG8_MMA
#undef PG8_WAIT_V
#undef PG8_WAIT_L
#undef PG8_BAR
#undef PG8_SCHED
}

__device__ __forceinline__ u32x4 pack8(const f32x4& a, const f32x4& b) { u32x4 w; w.x = cvt_pk(a[0], a[1]); w.y = cvt_pk(a[2], a[3]); w.z = cvt_pk(b[0], b[1]); w.w = cvt_pk(b[2], b[3]); return w; }

struct EpiRegions {
    bf16_t* base;
    __device__ __forceinline__ void operator()(const f32x4 (&acc)[2][2][4][2], const Unit& u, int wr, int wc, int fr, int fq) const {
        bf16_t* dst = base + (size_t)(u.pn >> 2) * ((size_t)M * D);
        const int col = (u.pn & 3) * 256 + wc * 64 + fq * 8, row0 = u.pm * BM + wr * 64 + fr;
#pragma unroll
        for (int ai = 0; ai < 2; ++ai)
#pragma unroll
            for (int m = 0; m < 4; ++m) { bf16_t* rp = dst + (size_t)(row0 + ai * HALF + m * 16) * D + col;
#pragma unroll
                for (int bj = 0; bj < 2; ++bj) *(u32x4*)(rp + bj * 32) = pack8(acc[ai][bj][m][0], acc[ai][bj][m][1]); }
    }
};
struct EpiQKV {
    bf16_t* base; const float* gq; const float* gk;
    __device__ __forceinline__ void operator()(const f32x4 (&acc)[2][2][4][2], const Unit& u, int wr, int wc, int fr, int fq) const {
        const int region = u.pn >> 2, head = (u.pn & 3) * 4 + wc, row0 = u.pm * BM + wr * 64 + fr;
        if (region == 2) {
            const int b = row0 >> 12;
            bf16_t* vb = base + (size_t)2 * M * D + ((size_t)(b * NH + head) * HD) * SEQ;
#pragma unroll
            for (int ai = 0; ai < 2; ++ai)
#pragma unroll
                for (int m = 0; m < 4; ++m) { const int s0 = (row0 + ai * HALF + m * 16) & (SEQ - 1), q = (s0 >> 2) & 3;
                    const int s = (s0 & ~12) | ((((q & 1) << 1) | (q >> 1)) << 2);
#pragma unroll
                    for (int bj = 0; bj < 2; ++bj)
#pragma unroll
                        for (int n = 0; n < 2; ++n)
#pragma unroll
                            for (int j = 0; j < 4; ++j) { const int d = bj * 32 + fq * 8 + n * 4 + j; const unsigned w = cvt_pk(acc[ai][bj][m][n][j], 0.f);
                                vb[(size_t)d * SEQ + s] = (bf16_t)(w & 0xffffu); } }
        } else if (region >= 3) {
            bf16_t* dst = base + (size_t)region * ((size_t)M * D);
            const int col = (u.pn & 3) * 256 + wc * 64 + fq * 8;
#pragma unroll
            for (int ai = 0; ai < 2; ++ai)
#pragma unroll
                for (int m = 0; m < 4; ++m) { bf16_t* rp = dst + (size_t)(row0 + ai * HALF + m * 16) * D + col;
#pragma unroll
                    for (int bj = 0; bj < 2; ++bj) *(u32x4*)(rp + bj * 32) = pack8(acc[ai][bj][m][0], acc[ai][bj][m][1]); }
        } else {
            const float* g = region == 0 ? gq : gk; const float sc = region == 0 ? C2 : 1.0f;
            bf16_t* dst = base + (size_t)region * ((size_t)M * D);
            f32x4 gv[2][2];
#pragma unroll
            for (int bj = 0; bj < 2; ++bj)
#pragma unroll
                for (int n = 0; n < 2; ++n) gv[bj][n] = *(const f32x4*)(g + bj * 32 + fq * 8 + n * 4) * sc;
            const int col = head * 64 + fq * 8;
#pragma unroll
            for (int ai = 0; ai < 2; ++ai)
#pragma unroll
                for (int m = 0; m < 4; ++m) {
                    float ss = 0.f;
#pragma unroll
                    for (int bj = 0; bj < 2; ++bj)
#pragma unroll
                        for (int n = 0; n < 2; ++n) { const f32x4 x = acc[ai][bj][m][n]; ss += (x[0] * x[0] + x[1] * x[1]) + (x[2] * x[2] + x[3] * x[3]); }
                    ss += shx(ss, 16, fr + 16 * fq); ss += shx(ss, 32, fr + 16 * fq);
                    const float r = 1.0f / sqrtf(ss * (1.0f / 64.0f) + EPS);
                    bf16_t* rp = dst + (size_t)(row0 + ai * HALF + m * 16) * D + col;
#pragma unroll
                    for (int bj = 0; bj < 2; ++bj) { const f32x4 a = acc[ai][bj][m][0] * r * gv[bj][0], b2 = acc[ai][bj][m][1] * r * gv[bj][1]; *(u32x4*)(rp + bj * 32) = pack8(a, b2); }
                }
        }
    }
};
struct EpiBranch {
    bf16_t* S1; bf16_t* TM;
    __device__ __forceinline__ void operator()(const f32x4 (&acc)[2][2][4][2], const Unit& u, int wr, int wc, int fr, int fq) const {
        const int col = u.pn * 256 + wc * 64 + fq * 8, row0 = u.pm * BM + wr * 64 + fr, kind = u.kind;
#pragma unroll
        for (int ai = 0; ai < 2; ++ai) {
            if (kind == 0 || kind == 2) {
#pragma unroll
                for (int m = 0; m < 4; ++m) { const size_t off = (size_t)(row0 + ai * HALF + m * 16) * D + col;
#pragma unroll
                    for (int bj = 0; bj < 2; ++bj) { f32x4 a = acc[ai][bj][m][0], b = acc[ai][bj][m][1];
#pragma unroll
                        for (int j = 0; j < 4; ++j) { a[j] = sigmoidf_(a[j]); b[j] = sigmoidf_(b[j]); }
                        *(u32x4*)(S1 + off + bj * 32) = pack8(a, b); } }
            } else {
#pragma unroll
              for (int mh = 0; mh < 2; ++mh) {
                u32x4 g[2][2], t[2][2];
#pragma unroll
                for (int m2 = 0; m2 < 2; ++m2) { const int m = 2 * mh + m2; const size_t off = (size_t)(row0 + ai * HALF + m * 16) * D + col;
#pragma unroll
                    for (int bj = 0; bj < 2; ++bj) { g[m2][bj] = *(const u32x4*)(S1 + off + bj * 32); if (kind == 3) t[m2][bj] = *(const u32x4*)(TM + off + bj * 32); else t[m2][bj] = (u32x4){0u, 0u, 0u, 0u}; } }
#pragma unroll
                for (int m2 = 0; m2 < 2; ++m2) { const int m = 2 * mh + m2; const size_t off = (size_t)(row0 + ai * HALF + m * 16) * D + col;
#pragma unroll
                    for (int bj = 0; bj < 2; ++bj) { f32x4 a = acc[ai][bj][m][0], b = acc[ai][bj][m][1]; const u32x4 gg = g[m2][bj], tt = t[m2][bj];
                        a[0] = a[0] * bf_lo(gg.x) + bf_lo(tt.x); a[1] = a[1] * bf_hi(gg.x) + bf_hi(tt.x); a[2] = a[2] * bf_lo(gg.y) + bf_lo(tt.y); a[3] = a[3] * bf_hi(gg.y) + bf_hi(tt.y);
                        b[0] = b[0] * bf_lo(gg.z) + bf_lo(tt.z); b[1] = b[1] * bf_hi(gg.z) + bf_hi(tt.z); b[2] = b[2] * bf_lo(gg.w) + bf_lo(tt.w); b[3] = b[3] * bf_hi(gg.w) + bf_hi(tt.w);
                        *(u32x4*)(TM + off + bj * 32) = pack8(a, b); } }
              }
            }
        }
    }
};
struct EpiResid {
    const float* xin; float* xout; const float* gmod;
    __device__ __forceinline__ void operator()(const f32x4 (&acc)[2][2][4][2], const Unit& u, int wr, int wc, int fr, int fq) const {
        const int col = u.pn * 256 + wc * 64 + fq * 8, row0 = u.pm * BM + wr * 64 + fr, b = row0 >> 12;
        f32x4 gv[2][2];
#pragma unroll
        for (int bj = 0; bj < 2; ++bj)
#pragma unroll
            for (int n = 0; n < 2; ++n) gv[bj][n] = *(const f32x4*)(gmod + b * 6144 + col + bj * 32 + n * 4);
#pragma unroll
        for (int ai = 0; ai < 2; ++ai)
#pragma unroll
          for (int mh = 0; mh < 2; ++mh) {
            f32x4 xo[2][2][2];
#pragma unroll
            for (int m2 = 0; m2 < 2; ++m2) { const size_t off = (size_t)(row0 + ai * HALF + (2 * mh + m2) * 16) * D + col;
#pragma unroll
                for (int bj = 0; bj < 2; ++bj)
#pragma unroll
                    for (int n = 0; n < 2; ++n) xo[m2][bj][n] = *(const f32x4*)(xin + off + bj * 32 + n * 4); }
#pragma unroll
            for (int m2 = 0; m2 < 2; ++m2) { const size_t off = (size_t)(row0 + ai * HALF + (2 * mh + m2) * 16) * D + col;
#pragma unroll
                for (int bj = 0; bj < 2; ++bj)
#pragma unroll
                    for (int n = 0; n < 2; ++n) *(f32x4*)(xout + off + bj * 32 + n * 4) = xo[m2][bj][n] + gv[bj][n] * acc[ai][bj][2 * mh + m2][n]; }
          }
    }
};
struct EpiGU {
    bf16_t* f;
    __device__ __forceinline__ void operator()(const f32x4 (&acc)[2][2][4][2], const Unit& u, int wr, int wc, int fr, int fq) const {
        const int col = u.pn * 128 + wc * 32 + fq * 8, row0 = u.pm * BM + wr * 64 + fr;
#pragma unroll
        for (int ai = 0; ai < 2; ++ai)
#pragma unroll
            for (int m = 0; m < 4; ++m) {
                f32x4 o[2];
#pragma unroll
                for (int n = 0; n < 2; ++n)
#pragma unroll
                    for (int j = 0; j < 4; ++j) { const float gt = acc[ai][0][m][n][j]; o[n][j] = gt * sigmoidf_(gt) * acc[ai][1][m][n][j]; }
                *(u32x4*)(f + (size_t)(row0 + ai * HALF + m * 16) * FF + col) = pack8(o[0], o[1]);
            }
    }
};
struct EpiResidNorm {
    const float* xin; float* xout; const float* gmod; const float* lng; const float* scmod; bf16_t* An; float* ssq;
    __device__ __forceinline__ void operator()(const f32x4 (&acc)[2][2][4][2], const Unit& u, int wr, int wc, int fr, int fq) const {
        const int col = u.pn * 256 + wc * 64 + fq * 8, row0 = u.pm * BM + wr * 64 + fr, b = row0 >> 12;
        f32x4 gv[2][2], gm[2][2];
#pragma unroll
        for (int bj = 0; bj < 2; ++bj)
#pragma unroll
            for (int n = 0; n < 2; ++n) { const int c = col + bj * 32 + n * 4; gv[bj][n] = *(const f32x4*)(gmod + b * 6144 + c);
                gm[bj][n] = *(const f32x4*)(lng + c) * (*(const f32x4*)(scmod + b * 6144 + c) + 1.0f); }
#pragma unroll
        for (int ai = 0; ai < 2; ++ai)
#pragma unroll
          for (int mh = 0; mh < 2; ++mh) {
            f32x4 xo[2][2][2];
#pragma unroll
            for (int m2 = 0; m2 < 2; ++m2) { const size_t off = (size_t)(row0 + ai * HALF + (2 * mh + m2) * 16) * D + col;
#pragma unroll
                for (int bj = 0; bj < 2; ++bj)
#pragma unroll
                    for (int n = 0; n < 2; ++n) xo[m2][bj][n] = *(const f32x4*)(xin + off + bj * 32 + n * 4); }
#pragma unroll
            for (int m2 = 0; m2 < 2; ++m2) { const int row = row0 + ai * HALF + (2 * mh + m2) * 16; const size_t off = (size_t)row * D + col;
                float ss = 0.f;
#pragma unroll
                for (int bj = 0; bj < 2; ++bj) {
                    f32x4 y[2];
#pragma unroll
                    for (int n = 0; n < 2; ++n) { const f32x4 x1 = xo[m2][bj][n] + gv[bj][n] * acc[ai][bj][2 * mh + m2][n];
                        *(f32x4*)(xout + off + bj * 32 + n * 4) = x1; ss += (x1[0] * x1[0] + x1[1] * x1[1]) + (x1[2] * x1[2] + x1[3] * x1[3]); y[n] = x1 * gm[bj][n]; }
                    *(u32x4*)(An + off + bj * 32) = pack8(y[0], y[1]);
                }
                ss += shx(ss, 16, fr + 16 * fq); ss += shx(ss, 32, fr + 16 * fq);
                if (fq == 0) ssq[(size_t)row * 16 + u.pn * 4 + wc] = ss;
            }
          }
    }
};
struct EpiGUNorm {
    bf16_t* f; const float* bias; LAS const float* rtab;
    __device__ __forceinline__ void operator()(const f32x4 (&acc)[2][2][4][2], const Unit& u, int wr, int wc, int fr, int fq) const {
        const int col = u.pn * 128 + wc * 32 + fq * 8, row0 = u.pm * BM + wr * 64 + fr, b = row0 >> 12;
        f32x4 bg[2], bu[2];
#pragma unroll
        for (int n = 0; n < 2; ++n) { const int a = u.pn * 256 + wc * 32 + n * 16 + fq * 4; bg[n] = *(const f32x4*)(bias + b * (2 * FF) + a); bu[n] = *(const f32x4*)(bias + b * (2 * FF) + a + 128); }
#pragma unroll
        for (int ai = 0; ai < 2; ++ai)
#pragma unroll
            for (int m = 0; m < 4; ++m) {
                const float r = rtab[wr * 64 + fr + ai * HALF + m * 16];
                f32x4 o[2];
#pragma unroll
                for (int n = 0; n < 2; ++n)
#pragma unroll
                    for (int j = 0; j < 4; ++j) { const float gt = acc[ai][0][m][n][j] * r + bg[n][j], up = acc[ai][1][m][n][j] * r + bu[n][j]; o[n][j] = gt * sigmoidf_(gt) * up; }
                *(u32x4*)(f + (size_t)(row0 + ai * HALF + m * 16) * FF + col) = pack8(o[0], o[1]);
            }
    }
};
}

#define LDS_WAIT() asm volatile("s_waitcnt lgkmcnt(0)" ::: "memory")
__device__ __forceinline__ void transpose_item(const float* W, int N, int K, int n0, bf16_t* WT, int a0, int k0, LAS float* scr, int lane) {
    {
        const int kr = lane >> 3, c4 = (lane & 7) * 4;
        f32x4 t[8];
#pragma unroll
        for (int i = 0; i < 8; ++i) t[i] = __builtin_nontemporal_load((const f32x4*)(W + (size_t)(k0 + 8 * i + kr) * N + n0 + c4));
#pragma unroll
        for (int i = 0; i < 8; ++i) { LAS float* d = scr + (8 * i + kr) * 33 + c4; d[0] = t[i][0]; d[1] = t[i][1]; d[2] = t[i][2]; d[3] = t[i][3]; }
    }
    LDS_WAIT(); asm volatile("" ::: "memory");
    const int c = lane & 7;
#pragma unroll
    for (int j = 0; j < 4; ++j) { const int s = (lane >> 3) + 8 * j; const int lo = 8 * ((s >> 2) & 3) + 4 * (s >> 4) + (s & 3);
        const LAS float* sp = scr + (8 * c) * 33 + lo;
        u32x4 o; o.x = cvt_pk(sp[0 * 33], sp[1 * 33]); o.y = cvt_pk(sp[2 * 33], sp[3 * 33]); o.z = cvt_pk(sp[4 * 33], sp[5 * 33]); o.w = cvt_pk(sp[6 * 33], sp[7 * 33]);
        *(u32x4*)(WT + (size_t)(a0 + s) * K + k0 + 8 * c) = o; }
    LDS_WAIT(); asm volatile("" ::: "memory");
}

struct Params { const float* in[16]; float* out; unsigned char* ws; };

__device__ __forceinline__ void phase0(const Params& p, LAS unsigned char* lds, int gw, int NGW, int wave, int lane, const int l, const bool with_mod) {
    LAS float* scr = (LAS float*)(lds + wave * 16384);
    constexpr int I_IN = 256 * 16, I_SQ = 32 * 16, I_GU = 176 * 16, I_D = 32 * 44, I_LAYER = I_IN + 3 * I_SQ + I_GU + I_D;
    constexpr int I_MOD = 2 * 32 * 24;
    for (int it = gw; it < (with_mod ? I_MOD : 0); it += NGW) {
        const int l = it / (32 * 24), r = it % (32 * 24), kc = r / 24, nb = r % 24;
        const float* aw = p.in[2] + (size_t)l * D * 6144 + (size_t)(kc * 32) * 6144 + nb * 256 + lane * 4;
        const float* c = p.in[1];
        f32x4 a[4];
#pragma unroll
        for (int b = 0; b < 4; ++b) a[b] = (f32x4){0.f, 0.f, 0.f, 0.f};
#pragma unroll 8
        for (int k = 0; k < 32; ++k) { const f32x4 w = __builtin_nontemporal_load((const f32x4*)(aw + (size_t)k * 6144));
#pragma unroll
            for (int b = 0; b < 4; ++b) { const float cv = c[b * D + kc * 32 + k]; const float sv = cv * sigmoidf_(cv); a[b] += w * sv; } }
        float* mp = (float*)(p.ws + R_CX) + ((size_t)(l * 32 + kc) * 4) * 6144 + nb * 256 + lane * 4;
#pragma unroll
        for (int b = 0; b < 4; ++b) *(f32x4*)(mp + (size_t)b * 6144) = a[b];
    }
    for (int it = gw; it < I_LAYER; it += NGW) {
        int r = it;
        unsigned char* wl = p.ws + WS_W;
        if (r < I_IN) { const int kb = r / 256, g = r % 256; const int pn = g >> 3, bj = (g >> 2) & 1, wc = g & 3;
            transpose_item(p.in[5] + (size_t)l * D * INW, INW, D, 256 * pn + 64 * wc + 32 * bj, (bf16_t*)(wl + W_IN), 32 * g, 64 * kb, scr, lane); continue; }
        r -= I_IN;
        if (r < 3 * I_SQ) { const int which = r / I_SQ; r %= I_SQ; const int kb = r / 32, g = r % 32; const int pn = g >> 3, bj = (g >> 2) & 1, wc = g & 3;
            const float* src = p.in[9 + which] + (size_t)l * D * D; bf16_t* dst = (bf16_t*)(wl + (which == 0 ? W_A : which == 1 ? W_B : W_O));
            transpose_item(src, D, D, 256 * pn + 64 * wc + 32 * bj, dst, 32 * g, 64 * kb, scr, lane); continue; }
        r -= 3 * I_SQ;
        if (r < I_GU) { const int kb = r / 176, g = r % 176; const int pn = g >> 3, bj = (g >> 2) & 1, wc = g & 3;
            const float* src = p.in[bj ? 14 : 13] + (size_t)l * D * FF;
            transpose_item(src, FF, D, 128 * pn + 32 * wc, (bf16_t*)(wl + W_GU), 32 * g, 64 * kb, scr, lane); continue; }
        r -= I_GU;
        { const int kb = r / 32, g = r % 32; const int pn = g >> 3, bj = (g >> 2) & 1, wc = g & 3;
            transpose_item(p.in[15] + (size_t)l * FF * D, D, FF, 256 * pn + 64 * wc + 32 * bj, (bf16_t*)(wl + W_D), 32 * g, 64 * kb, scr, lane); }
    }
}

__device__ __forceinline__ void norm_phase(const float* x, const float* g, const float* modl, int sh_off, int sc_off, bf16_t* h, int gw, int NGW, const bool stream = false, const bool use_tab = false, const LAS float* tab = nullptr) {
    const int lane = lane_id_opaque();
    for (int q = gw; q < M / 4; q += NGW) {
        const int m0 = 4 * q, b = m0 >> 12;
        f32x4 v[4][4];
#pragma unroll
        for (int r = 0; r < 4; ++r) { const f32x4* xr = (const f32x4*)(x + (size_t)(m0 + r) * D) + lane;
#pragma unroll
            for (int j = 0; j < 4; ++j) v[r][j] = stream ? __builtin_nontemporal_load(xr + 64 * j) : xr[64 * j]; }
        float rs[4];
#pragma unroll
        for (int r = 0; r < 4; ++r) { float s = 0.f;
#pragma unroll
            for (int j = 0; j < 4; ++j) s += (v[r][j][0] * v[r][j][0] + v[r][j][1] * v[r][j][1]) + (v[r][j][2] * v[r][j][2] + v[r][j][3] * v[r][j][3]);
            rs[r] = s; }
#pragma unroll
        for (int o = 1; o < 64; o <<= 1) {
#pragma unroll
            for (int r = 0; r < 4; ++r) rs[r] += shx(rs[r], o, lane); }
#pragma unroll
        for (int r = 0; r < 4; ++r) rs[r] = 1.0f / sqrtf(rs[r] * (1.0f / D) + EPS);
#pragma unroll
        for (int j = 0; j < 4; ++j) { const int col = 4 * (64 * j + lane);
            const f32x4 gg = *(const f32x4*)(g + col);
            const f32x4 sc = (use_tab ? *(const LAS f32x4*)(tab + (b >> 1) * 2048 + sc_off + col) : *(const f32x4*)(modl + b * 6144 + sc_off + col)) + 1.0f;
            const f32x4 sh = use_tab ? *(const LAS f32x4*)(tab + (b >> 1) * 2048 + sh_off + col) : *(const f32x4*)(modl + b * 6144 + sh_off + col);
#pragma unroll
            for (int r = 0; r < 4; ++r) { const f32x4 y = (v[r][j] * rs[r] * gg) * sc + sh;
                u32x2 w; w.x = cvt_pk(y[0], y[1]); w.y = cvt_pk(y[2], y[3]); *((u32x2*)(h + (size_t)(m0 + r) * D) + lane + 64 * j) = w; } }
    }
}

__device__ __forceinline__ void conv_phase(bf16_t* cb, const bf16_t* cc, const bf16_t* cx, const float* cw, int gt0, int NT) {
    const int gt = gt0 + lane_id_opaque();
    for (int it = gt; it < (M / 16) * (D / 8); it += NT) {
        const int c8 = it & 127, run = it >> 7, t0 = run * 16, ch = c8 * 8;
        float w0[8], w1[8], w2[8];
#pragma unroll
        for (int i = 0; i < 8; ++i) { w0[i] = cw[ch + i]; w1[i] = cw[D + ch + i]; w2[i] = cw[2 * D + ch + i]; }
        float um2[8], um1[8];
#pragma unroll
        for (int i = 0; i < 8; ++i) { um2[i] = 0.f; um1[i] = 0.f; }
        if ((t0 & (SEQ - 1)) != 0) {
            const u32x4 a2 = *(const u32x4*)(cc + (size_t)(t0 - 2) * D + ch), b2 = *(const u32x4*)(cx + (size_t)(t0 - 2) * D + ch);
            const u32x4 a1 = *(const u32x4*)(cc + (size_t)(t0 - 1) * D + ch), b1 = *(const u32x4*)(cx + (size_t)(t0 - 1) * D + ch);
#pragma unroll
            for (int i = 0; i < 4; ++i) { um2[2 * i] = bf_lo(a2[i]) * bf_lo(b2[i]); um2[2 * i + 1] = bf_hi(a2[i]) * bf_hi(b2[i]);
                um1[2 * i] = bf_lo(a1[i]) * bf_lo(b1[i]); um1[2 * i + 1] = bf_hi(a1[i]) * bf_hi(b1[i]); }
        }
#pragma unroll 4
        for (int t = 0; t < 16; ++t) {
            const size_t off = (size_t)(t0 + t) * D + ch;
            const u32x4 a = *(const u32x4*)(cc + off), b = *(const u32x4*)(cx + off), e = *(const u32x4*)(cb + off);
            float u[8], y[8];
#pragma unroll
            for (int i = 0; i < 4; ++i) { u[2 * i] = bf_lo(a[i]) * bf_lo(b[i]); u[2 * i + 1] = bf_hi(a[i]) * bf_hi(b[i]); }
#pragma unroll
            for (int i = 0; i < 4; ++i) {
                y[2 * i] = bf_lo(e[i]) * (w0[2 * i] * um2[2 * i] + w1[2 * i] * um1[2 * i] + w2[2 * i] * u[2 * i]);
                y[2 * i + 1] = bf_hi(e[i]) * (w0[2 * i + 1] * um2[2 * i + 1] + w1[2 * i + 1] * um1[2 * i + 1] + w2[2 * i + 1] * u[2 * i + 1]); }
            u32x4 o; o.x = cvt_pk(y[0], y[1]); o.y = cvt_pk(y[2], y[3]); o.z = cvt_pk(y[4], y[5]); o.w = cvt_pk(y[6], y[7]);
            *(u32x4*)(cb + off) = o;
#pragma unroll
            for (int i = 0; i < 8; ++i) { um2[i] = um1[i]; um1[i] = u[i]; }
        }
    }
}

#define MFMA32(a, b, c) __builtin_amdgcn_mfma_f32_32x32x16_bf16((a), (b), (c), 0, 0, 0)
constexpr float SB_EXIT = 1.0e-20f;
__device__ __forceinline__ float clamp_z(float z) { return __builtin_amdgcn_fmed3f(z, -126.0f, 80.0f); }
struct AttnState { f32x16 o0, o1; float P; bf16x8 kf[4]; };
template <bool DIAG>
__device__ __forceinline__ void attn_step(AttnState& st, const bf16x8 (&qf)[4], const bf16_t* kbase, const bf16_t* vbase, int j0, bool more, int n, int hh, int lane) {
    bf16x8 vf[2][2];
#pragma unroll
    for (int mb = 0; mb < 2; ++mb)
#pragma unroll
        for (int s = 0; s < 2; ++s) vf[mb][s] = *(const bf16x8*)(vbase + (size_t)mb * 32 * SEQ + j0 + 16 * s);
    f32x16 sa;
#pragma unroll
    for (int r = 0; r < 16; ++r) sa[r] = 0.f;
#pragma unroll
    for (int kk = 0; kk < 4; ++kk) sa = MFMA32(st.kf[kk], qf[kk], sa);
    if (more) {
#pragma unroll
        for (int kk = 0; kk < 4; ++kk) st.kf[kk] = *(const bf16x8*)(kbase + (size_t)(j0 - 32) * D + kk * 16);
    }
    float om[16], be[16];
#pragma unroll
    for (int r = 0; r < 16; ++r) {
        const float e = fast_exp2(clamp_z(sa[r]));
        float o = fast_rcp(1.0f + e), b = e * o;
        if (DIAG) { const int ki = (r & 3) + 8 * (r >> 2) + 4 * hh; if (ki >= n) { o = 1.0f; b = 0.f; } }
        om[r] = o; be[r] = b;
    }
    float g[4], pg[4];
#pragma unroll
    for (int q = 0; q < 4; ++q) g[q] = (om[4 * q] * om[4 * q + 1]) * (om[4 * q + 2] * om[4 * q + 3]);
#pragma unroll
    for (int q = 0; q < 4; ++q) pg[q] = shx(g[q], 32, lane);
    float run = st.P;
    float a[16];
#pragma unroll
    for (int q = 3; q >= 0; --q) {
        const float c3 = (hh == 0) ? run * pg[q] : run;
        const float c2 = c3 * om[4 * q + 3], c1 = c2 * om[4 * q + 2], c0 = c1 * om[4 * q + 1];
        a[4 * q + 3] = be[4 * q + 3] * c3; a[4 * q + 2] = be[4 * q + 2] * c2; a[4 * q + 1] = be[4 * q + 1] * c1; a[4 * q] = be[4 * q] * c0;
        run *= g[q] * pg[q];
    }
    st.P = run;
#pragma unroll
    for (int s = 0; s < 2; ++s) {
        u32x4 pw; pw.x = cvt_pk(a[8 * s + 0], a[8 * s + 1]); pw.y = cvt_pk(a[8 * s + 2], a[8 * s + 3]); pw.z = cvt_pk(a[8 * s + 4], a[8 * s + 5]); pw.w = cvt_pk(a[8 * s + 6], a[8 * s + 7]);
        const bf16x8 pf = __builtin_bit_cast(bf16x8, pw);
        st.o0 = MFMA32(vf[0][s], pf, st.o0); st.o1 = MFMA32(vf[1][s], pf, st.o1);
    }
}
__device__ __forceinline__ void attn_task(bf16_t* QO, const bf16_t* Kp, const bf16_t* VT, int b, int h, int qblk, int lane) {
    const int n = lane & 31, hh = lane >> 5, t0 = qblk * 32;
    bf16_t* qrow = QO + (size_t)(b * SEQ + t0 + n) * D + h * HD;
    bf16x8 qf[4];
#pragma unroll
    for (int kk = 0; kk < 4; ++kk) qf[kk] = *(const bf16x8*)(qrow + kk * 16 + hh * 8);
    AttnState st;
#pragma unroll
    for (int r = 0; r < 16; ++r) { st.o0[r] = 0.f; st.o1[r] = 0.f; }
    st.P = 1.0f;
    const bf16_t* kbase = Kp + (size_t)(b * SEQ + n) * D + h * HD + hh * 8;
    const bf16_t* vbase = VT + ((size_t)(b * NH + h) * HD + n) * SEQ + 8 * hh;
#pragma unroll
    for (int kk = 0; kk < 4; ++kk) st.kf[kk] = *(const bf16x8*)(kbase + (size_t)t0 * D + kk * 16);
    attn_step<true>(st, qf, kbase, vbase, t0, qblk > 0, n, hh, lane);
    for (int kb = qblk - 1; kb >= 0; --kb) {
        if (!__any(st.P > SB_EXIT)) break;
        attn_step<false>(st, qf, kbase, vbase, kb * 32, kb > 0, n, hh, lane);
    }
#pragma unroll
    for (int q = 0; q < 4; ++q) {
        u32x2 w0, w1; w0.x = cvt_pk(st.o0[4 * q], st.o0[4 * q + 1]); w0.y = cvt_pk(st.o0[4 * q + 2], st.o0[4 * q + 3]); w1.x = cvt_pk(st.o1[4 * q], st.o1[4 * q + 1]); w1.y = cvt_pk(st.o1[4 * q + 2], st.o1[4 * q + 3]);
        *(u32x2*)(qrow + 8 * q + 4 * hh) = w0; *(u32x2*)(qrow + 32 + 8 * q + 4 * hh) = w1;
    }
}
__device__ __forceinline__ void attn_phase(bf16_t* QO, const bf16_t* Kp, const bf16_t* VT, int G, int bx, int wave) {
    const int lane = lane_id_opaque();
    constexpr int NQB = SEQ / 32, NTASK = NB * NH * NQB;
    if (G == 256) {
#pragma unroll 1
        for (int i = 0; i < 4; ++i) { const int bh = 2 * (wave * 4 + i) + (bx & 1); attn_task(QO, Kp, VT, bh / NH, bh % NH, bx >> 1, lane); }
    } else {
        int i = 0;
        for (int tau = bx * NWAVES + wave; tau < NTASK; tau += G * NWAVES, ++i) {
            const int bh = tau / NQB, qr = tau % NQB, qblk = (i & 1) ? (NQB - 1 - qr) : qr;
            attn_task(QO, Kp, VT, bh / NH, bh % NH, qblk, lane);
        }
    }
}
__device__ __forceinline__ void bias_phase(const bf16_t* Wgu, const float* sh2  , float* bias, int gw, int NGW) {
    const int lane = lane_id_opaque();
    float sv[4][16];
#pragma unroll
    for (int b = 0; b < 4; ++b)
#pragma unroll
        for (int h = 0; h < 2; ++h)
#pragma unroll
            for (int q = 0; q < 2; ++q) { const f32x4 t = *(const f32x4*)(sh2 + b * 6144 + h * 512 + lane * 8 + q * 4);
#pragma unroll
                for (int i = 0; i < 4; ++i) sv[b][h * 8 + q * 4 + i] = t[i]; }
    for (int a = gw; a < 2 * FF; a += NGW) {
        const u32x4 w0 = *(const u32x4*)(Wgu + (size_t)a * D + lane * 8), w1 = *(const u32x4*)(Wgu + (size_t)a * D + 512 + lane * 8);
        float wv[16];
#pragma unroll
        for (int i = 0; i < 4; ++i) { wv[2 * i] = bf_lo(w0[i]); wv[2 * i + 1] = bf_hi(w0[i]); wv[8 + 2 * i] = bf_lo(w1[i]); wv[8 + 2 * i + 1] = bf_hi(w1[i]); }
        float sb[4];
#pragma unroll
        for (int b = 0; b < 4; ++b) { float t = 0.f;
#pragma unroll
            for (int i = 0; i < 16; ++i) t += wv[i] * sv[b][i];
            sb[b] = t; }
#pragma unroll
        for (int o = 1; o < 64; o <<= 1) {
#pragma unroll
            for (int b = 0; b < 4; ++b) sb[b] += shx(sb[b], o, lane); }
        if (lane == 0) {
#pragma unroll
            for (int b = 0; b < 4; ++b) bias[b * (2 * FF) + a] = sb[b]; }
    }
}

__device__ __forceinline__ void mixer_phase(bf16_t* QO, const bf16_t* Kp, const bf16_t* VT, bf16_t* cb, const bf16_t* cc, const bf16_t* cx, const float* cw, int G, int bx, int wave, int gt0, int NT) {
    if (wave & 4) { conv_phase(cb, cc, cx, cw, gt0, NT); attn_phase(QO, Kp, VT, G, bx, wave); }
    else          { attn_phase(QO, Kp, VT, G, bx, wave); conv_phase(cb, cc, cx, cw, gt0, NT); }
}

#define XB_TMO      128
#define XB_XCNT(j)  (256  + 64 * (j))
#define XB_XSUB(j)  (1280 + 64 * (j))
#define XB_XGEN(j)  (2304 + 64 * (j))
#define XB_TOP      3328
#define XB_TOPGEN   3392
#define XCD_BAR_WORDS 3456
#define XB_SPIN_CAP (1u << 18)
__device__ __forceinline__ unsigned xb_ld(unsigned* p)              { return __hip_atomic_load(p, __ATOMIC_RELAXED, __HIP_MEMORY_SCOPE_AGENT); }
__device__ __forceinline__ unsigned xb_add(unsigned* p, unsigned v) { return __hip_atomic_fetch_add(p, v, __ATOMIC_RELAXED, __HIP_MEMORY_SCOPE_AGENT); }
__device__ __forceinline__ unsigned xb_xcc_id() { return (unsigned)__builtin_amdgcn_s_getreg((3 << 11) | 20) & 0xFu; }
#define XB_SPIN(cond, bar) do { unsigned _sp = 0; while (cond) { __builtin_amdgcn_s_sleep(1); \
    if ((++_sp & 255u) == 0u) { if (xb_ld(&(bar)[XB_TMO])) break; if (_sp > XB_SPIN_CAP) { atomicAdd(&(bar)[XB_TMO], 1u); break; } } } } while (0)
struct XcdBarrier { unsigned* bar; unsigned x; volatile LAS unsigned* st; };
__device__ __forceinline__ XcdBarrier xcd_barrier_post(unsigned* bar, volatile LAS unsigned* st, int tid) {
    XcdBarrier b; b.bar = bar; b.x = xb_xcc_id(); b.st = st;
    if (tid == 0) (void)xb_add(&bar[XB_XCNT(b.x)], 1u);
    return b;
}
__device__ __forceinline__ void xcd_barrier_complete(unsigned* bar, unsigned x, unsigned& nloc, unsigned& nx) {
    const unsigned G = gridDim.x * gridDim.y * gridDim.z;
    unsigned sum, cnt, mine, sp = 0u;
    for (;;) {
        sum = 0u; cnt = 0u; mine = 0u;
#pragma unroll
        for (unsigned j = 0; j < 16; ++j) { const unsigned c = xb_ld(&bar[XB_XCNT(j)]); sum += c; cnt += (c > 0u) ? 1u : 0u; mine = (j == x) ? c : mine; }
        if (sum == G) break;
        __builtin_amdgcn_s_sleep(1);
        if ((++sp & 255u) == 0u) { if (xb_ld(&bar[XB_TMO])) break; if (sp > XB_SPIN_CAP) { atomicAdd(&bar[XB_TMO], 1u); break; } }
    }
    nloc = mine > 0u ? mine : 1u; nx = cnt > 0u ? cnt : 1u;
}
__device__ __forceinline__ void xcd_barrier(const XcdBarrier& b, bool leader) {
    asm volatile("s_waitcnt vmcnt(0)" ::: "memory");
    __syncthreads();
    if (leader) {
        unsigned* bar = b.bar;
        __builtin_amdgcn_s_waitcnt(0);
        unsigned nloc = b.st[0], nx = b.st[1];
        if (nloc == 0u) { xcd_barrier_complete(bar, b.x, nloc, nx); b.st[0] = nloc; b.st[1] = nx; }
        const unsigned old = xb_add(&bar[XB_XSUB(b.x)], 1u);
        const unsigned gen = old / nloc;
        if (old + 1u == (gen + 1u) * nloc) {
            __builtin_amdgcn_fence(__ATOMIC_RELEASE, "agent");
            asm volatile("s_waitcnt vmcnt(0)" ::: "memory");
            const unsigned og = xb_add(&bar[XB_TOP], 1u);
            const unsigned tg = og / nx;
            if (og + 1u == (tg + 1u) * nx) xb_add(&bar[XB_TOPGEN], 1u);
            else XB_SPIN(xb_ld(&bar[XB_TOPGEN]) == tg, bar);
            __builtin_amdgcn_fence(__ATOMIC_ACQUIRE, "agent");
            xb_add(&bar[XB_XGEN(b.x)], 1u);
            asm volatile("s_waitcnt vmcnt(0)" ::: "memory");
        } else {
            XB_SPIN(xb_ld(&bar[XB_XGEN(b.x)]) == gen, bar);
            __builtin_amdgcn_fence(__ATOMIC_ACQUIRE, "agent");
            asm volatile("s_waitcnt vmcnt(0)" ::: "memory");
        }
    }
    __syncthreads();
}

#define XB_DONE XCD_BAR_WORDS
__device__ unsigned g_bar[XCD_BAR_WORDS + 64];

constexpr int LDS_BYTES = 131072 + 2048;
__global__ void __launch_bounds__(NTHREADS, 2) fwd_kernel(Params p) {
    extern __shared__ __attribute__((aligned(16))) unsigned char lds_raw[];
    LAS unsigned char* lds = (LAS unsigned char*)lds_raw;
    cg::grid_group grid = cg::this_grid();
#define CG_SYNC() do { asm volatile("s_waitcnt vmcnt(0)" ::: "memory"); grid.sync(); if (wave == 0) { __builtin_amdgcn_fence(__ATOMIC_ACQUIRE, "agent"); asm volatile("s_waitcnt vmcnt(0)" ::: "memory"); } __syncthreads(); } while (0)
#define GRID_SYNC_() xcd_barrier(xb, leader)
    unsigned long long pr_acc = 0, pr_t0 = 0;
#define TIC() do { if (PROBE_MASK) pr_t0 = __builtin_amdgcn_s_memrealtime(); } while (0)
#define TOC(bit) do { if (PROBE_MASK & (bit)) pr_acc += __builtin_amdgcn_s_memrealtime() - pr_t0; } while (0)
#define GRID_SYNC() do { TIC(); GRID_SYNC_(); TOC(2 | sync_kind); } while (0)
    int sync_kind = 128;
    const int tid0 = threadIdx.x, wave = __builtin_amdgcn_readfirstlane(tid0 >> 6);
    const int G = gridDim.x, bx = blockIdx.x;
    const int gw = bx * NWAVES + wave, NGW = G * NWAVES, NT = G * NTHREADS;
    unsigned char* ws = p.ws;
    float* mod = (float*)(ws + WS_CTL);
    bf16_t* Rh = (bf16_t*)(ws + R_H); bf16_t* Rq = (bf16_t*)(ws + R_Q); bf16_t* Rk = (bf16_t*)(ws + R_K); bf16_t* Rv = (bf16_t*)(ws + R_V);
    bf16_t* Rcb = (bf16_t*)(ws + R_CB); bf16_t* Rcc = (bf16_t*)(ws + R_CC); bf16_t* Rcx = (bf16_t*)(ws + R_CX);
    const unsigned char* wl = ws + WS_W;

    unsigned* barw = g_bar;
    volatile LAS unsigned* bst = (volatile LAS unsigned*)(lds + 131072);
    const bool leader = (wave == 0) && (lane_id_opaque() == 0);
    if (leader) { bst[0] = 0u; bst[1] = 0u; bst[2] = 0u; }
    const XcdBarrier xb = xcd_barrier_post(barw, bst, leader ? 0 : 1);
    if (G == 0x7fffffff) CG_SYNC();
    TIC();
    phase0(p, lds, gw, NGW, wave, lane_id_opaque(), 0, true);
    TOC(16);
    GRID_SYNC();
    TIC();
    {
        const int gt = bx * NTHREADS + wave * 64 + lane_id_opaque();
        for (int it = gt; it < 2 * 4 * 1536; it += NT) {
            const int l = it / 6144, r = it % 6144, b = r / 1536, n4 = r % 1536;
            f32x4 a = *(const f32x4*)(p.in[3] + l * 6144 + n4 * 4);
            const float* mp = (const float*)(ws + R_CX) + ((size_t)(l * 32) * 4 + b) * 6144 + n4 * 4;
#pragma unroll 8
            for (int kc = 0; kc < 32; ++kc) a += *(const f32x4*)(mp + (size_t)kc * 4 * 6144);
            *(f32x4*)(mod + (size_t)(l * 4 + b) * 6144 + n4 * 4) = a;
        }
    }
    TOC(16);
    if (G == 256) {
        LAS float* tab = (LAS float*)(lds + 1024);
        const int t = wave * 64 + lane_id_opaque();
#pragma unroll 1
        for (int k = 0; k < 2; ++k) {
            const int idx = t + 512 * k, sel = idx >> 9, n4 = idx & 511, b = (bx >> 7) + 2 * sel;
            f32x4 a = *(const f32x4*)(p.in[3] + n4 * 4);
            const float* mp = (const float*)(ws + R_CX) + (size_t)b * 6144 + n4 * 4;
#pragma unroll 8
            for (int kc = 0; kc < 32; ++kc) a += *(const f32x4*)(mp + (size_t)kc * 4 * 6144);
            *(LAS f32x4*)(tab + sel * 2048 + n4 * 4) = a;
        }
        __syncthreads();
        TIC(); norm_phase(p.in[0], p.in[4], mod, 0, 1024, Rh, gw, NGW, true, true, tab); TOC(8); sync_kind = 128;
    } else {
        GRID_SYNC();
        TIC(); norm_phase(p.in[0], p.in[4], mod, 0, 1024, Rh, gw, NGW, true); TOC(8); sync_kind = 128;
    }
    GRID_SYNC();

#pragma unroll 1
    for (int l = 0; l < DEPTH; ++l) {
        const float* modl = mod + (size_t)l * 4 * 6144;
        const float* xin = (l == 0) ? p.in[0] : p.out;
        { pg8::SchedPlain S; S.T.init(M, 6144); S.G = G; S.c = bx; S.A = (const char*)Rh; S.B = (const char*)(wl + W_IN); S.tstep = (size_t)256 * D * 2;
          pg8::EpiQKV E{Rq, p.in[6] + l * HD, p.in[7] + l * HD};
          TIC(); pg8::gemm_phase(lds, D, S, E, wave); TOC(1); sync_kind = 32; }
        GRID_SYNC();
        const bool fuse_norm2 = (G == 256);
        float* biasgu = (float*)(ws + WS_CTL + 256 * 1024);
        float* ssqp = (float*)(ws + R_CC);
        TIC();
        if (fuse_norm2) bias_phase((const bf16_t*)(wl + W_GU), modl + 3072, biasgu, gw, NGW);
        mixer_phase(Rq, Rk, Rv, Rcb, Rcc, Rcx, p.in[8] + (size_t)l * 3 * D, G, bx, wave, bx * NTHREADS + wave * 64, NT); TOC(4); sync_kind = 64;
        GRID_SYNC();
        { pg8::SchedBranch S; S.T.init(M, D); S.G = G; S.c = bx; S.ws = (const char*)ws; S.wl = (const char*)wl; S.tstep = (size_t)256 * D * 2;
          pg8::EpiBranch E{Rv, Rk};
          TIC(); pg8::gemm_phase(lds, D, S, E, wave); TOC(1); sync_kind = 32; }
        GRID_SYNC();
        if (fuse_norm2) {
          { pg8::SchedPlain S; S.T.init(M, D); S.G = G; S.c = bx; S.A = (const char*)Rk; S.B = (const char*)(wl + W_O); S.tstep = (size_t)256 * D * 2;
            pg8::EpiResidNorm E{xin, p.out, modl + 2048, p.in[12] + l * D, modl + 4096, Rh, ssqp};
            TIC(); pg8::gemm_phase(lds, D, S, E, wave); TOC(1); sync_kind = 32; }
          GRID_SYNC();
          { pg8::SchedPlain S; S.T.init(M, 2 * FF); S.G = G; S.c = bx; S.A = (const char*)Rh; S.B = (const char*)(wl + W_GU); S.tstep = (size_t)256 * D * 2;
            LAS float* rtab = (LAS float*)(lds + 131072 + 64);
            { pg8::Unit u0; if (S.next(0, u0)) { const int t = wave * 64 + lane_id_opaque();
                if (t < 256) { const float* sp = ssqp + (size_t)(u0.pm * 256 + t) * 16; const f32x4 a = *(const f32x4*)sp, b4 = *(const f32x4*)(sp + 4), c = *(const f32x4*)(sp + 8), d = *(const f32x4*)(sp + 12);
                    const float ss = (((a[0] + a[1]) + (a[2] + a[3])) + ((b4[0] + b4[1]) + (b4[2] + b4[3]))) + (((c[0] + c[1]) + (c[2] + c[3])) + ((d[0] + d[1]) + (d[2] + d[3])));
                    rtab[t] = 1.0f / sqrtf(ss * (1.0f / D) + EPS); } } }
            __syncthreads();
            pg8::EpiGUNorm E{Rq, biasgu, rtab};
            TIC(); pg8::gemm_phase(lds, D, S, E, wave); TOC(1); sync_kind = 32; }
          GRID_SYNC();
        } else {
        { pg8::SchedPlain S; S.T.init(M, D); S.G = G; S.c = bx; S.A = (const char*)Rk; S.B = (const char*)(wl + W_O); S.tstep = (size_t)256 * D * 2;
          pg8::EpiResid E{xin, p.out, modl + 2048};
          TIC(); pg8::gemm_phase(lds, D, S, E, wave); TOC(1); sync_kind = 32; }
        GRID_SYNC();
        TIC(); norm_phase(p.out, p.in[12] + l * D, modl, 3072, 4096, Rh, gw, NGW, true); TOC(8); sync_kind = 128;
        GRID_SYNC();
        { pg8::SchedPlain S; S.T.init(M, 2 * FF); S.G = G; S.c = bx; S.A = (const char*)Rh; S.B = (const char*)(wl + W_GU); S.tstep = (size_t)256 * D * 2;
          pg8::EpiGU E{Rq};
          TIC(); pg8::gemm_phase(lds, D, S, E, wave); TOC(1); sync_kind = 32; }
        GRID_SYNC();
        }
        { pg8::SchedPlain S; S.T.init(M, D); S.G = G; S.c = bx; S.A = (const char*)Rq; S.B = (const char*)(wl + W_D); S.tstep = (size_t)256 * FF * 2;
          pg8::EpiResid E{p.out, p.out, modl + 5120};
          TIC(); pg8::gemm_phase(lds, FF, S, E, wave); TOC(1); sync_kind = 32; }
        if (l + 1 < DEPTH) {
            GRID_SYNC();
            TIC();
            phase0(p, lds, gw, NGW, wave, lane_id_opaque(), l + 1, false);
            norm_phase(p.out, p.in[4] + (l + 1) * D, mod + (size_t)(l + 1) * 4 * 6144, 0, 1024, Rh, gw, NGW, true);
            TOC(8); sync_kind = 128;
            GRID_SYNC();
        }
    }
    asm volatile("s_waitcnt vmcnt(0)" ::: "memory");
    if (leader) { const unsigned old = xb_add(&barw[XB_DONE], 1u); bst[2] = (old + 1u == (unsigned)G) ? 1u : 0u; }
    __syncthreads();
    if (bst[2]) { const int t = wave * 64 + lane_id_opaque(); for (int i = t; i < XCD_BAR_WORDS + 64; i += NTHREADS) __hip_atomic_store(&barw[i], 0u, __ATOMIC_RELAXED, __HIP_MEMORY_SCOPE_AGENT); }
    if (PROBE_MASK && bx == 0 && leader) { const unsigned long long t = __builtin_amdgcn_s_memrealtime(); while (__builtin_amdgcn_s_memrealtime() - t < pr_acc) __builtin_amdgcn_s_sleep(8); }
}

extern "C" void kernel_launch(void* const* d_in, const int* in_sizes, int n_in, void* d_out, int out_size, void* d_ws, size_t ws_size, hipStream_t stream) {
    static int grid_blocks = 0;
    if (grid_blocks == 0) {
        if (n_in != 16 || out_size != M * D || ws_size < WS_END) { fprintf(stderr, "kernel_launch: unexpected shapes (n_in %d out %d ws %zu need %zu)\n", n_in, out_size, ws_size, (size_t)WS_END); grid_blocks = -1; return; }
        int dev = 0, cus = 0, per_cu = 0;
        hipGetDevice(&dev);
        hipDeviceGetAttribute(&cus, hipDeviceAttributeMultiprocessorCount, dev);
        hipFuncSetAttribute((const void*)fwd_kernel, hipFuncAttributeMaxDynamicSharedMemorySize, LDS_BYTES);
        hipOccupancyMaxActiveBlocksPerMultiprocessor(&per_cu, (const void*)fwd_kernel, NTHREADS, LDS_BYTES);
        (void)hipGetLastError();
        if (per_cu < 1) { fprintf(stderr, "kernel_launch: occupancy query says %d blocks per CU\n", per_cu); per_cu = 1; }
        grid_blocks = cus;
    }
    if (grid_blocks < 0) return;
    Params p{};
    for (int i = 0; i < 16; ++i) p.in[i] = (const float*)d_in[i];
    p.out = (float*)d_out; p.ws = (unsigned char*)d_ws;
    void* args[] = {&p};
    hipError_t e = hipLaunchCooperativeKernel((const void*)fwd_kernel, dim3(grid_blocks), dim3(NTHREADS), args, LDS_BYTES, stream);
    if (e != hipSuccess) fprintf(stderr, "cooperative launch failed: %s (grid %d)\n", hipGetErrorString(e), grid_blocks);
}
```

```cpp
#include <hip/hip_runtime.h>
#include <hip/hip_cooperative_groups.h>
#include <cstdio>
#include <cstdint>
namespace cg = cooperative_groups;
#ifndef PROBE_MASK
#define PROBE_MASK 0
#endif

#define LAS __attribute__((address_space(3)))
typedef unsigned short bf16_t;
typedef short bf16x8 __attribute__((ext_vector_type(8)));
typedef short s16x4 __attribute__((ext_vector_type(4)));
typedef float f32x4 __attribute__((ext_vector_type(4)));
typedef float f32x16 __attribute__((ext_vector_type(16)));
typedef unsigned u32x4 __attribute__((ext_vector_type(4)));
typedef unsigned u32x2 __attribute__((ext_vector_type(2)));
typedef float f32x2_t __attribute__((ext_vector_type(2)));
typedef __bf16 bf16x2_t __attribute__((ext_vector_type(2)));

constexpr int D = 1024, NB = 4, SEQ = 4096, M = NB * SEQ, NH = 16, HD = 64, FF = 2816, INW = 8192, DEPTH = 2;
constexpr float EPS = 1e-6f;
constexpr float LOG2E = 1.4426950408889634f;
constexpr float C2 = 0.125f * LOG2E;
constexpr int NWAVES = 8, NTHREADS = 512;

constexpr size_t MiB = 1u << 20;
constexpr size_t WS_CTL = 0, CTL_BYTES = 256 * 1024;
constexpr size_t WS_W = 1 * MiB;
constexpr size_t W_IN = 0, W_A = 16 * MiB, W_B = 18 * MiB, W_O = 20 * MiB, W_GU = 22 * MiB, W_D = 33 * MiB, W_LAYER = 38 * MiB + 512 * 1024;
constexpr size_t WS_ACT = 40 * MiB;
constexpr size_t REG = 32 * MiB;
constexpr size_t R_H = WS_ACT, R_Q = WS_ACT + REG, R_K = WS_ACT + 2 * REG, R_V = WS_ACT + 3 * REG, R_CB = WS_ACT + 4 * REG, R_CC = WS_ACT + 5 * REG, R_CX = WS_ACT + 6 * REG, WS_END = WS_ACT + 7 * REG;
static_assert(WS_W + W_LAYER <= WS_ACT, "weights");
static_assert((size_t)M * FF * 2 <= 3 * REG, "ffn hidden fits R_Q..R_V");
static_assert(WS_END <= 279028736, "workspace >= sum of the inputs' bytes");

__device__ __forceinline__ unsigned cvt_pk(float lo, float hi) { f32x2_t v = {lo, hi}; bf16x2_t b = __builtin_convertvector(v, bf16x2_t); return __builtin_bit_cast(unsigned, b); }
__device__ __forceinline__ float bf_lo(unsigned u) { return __uint_as_float(u << 16); }
__device__ __forceinline__ float bf_hi(unsigned u) { return __uint_as_float(u & 0xffff0000u); }
__device__ __forceinline__ float shx(float v, int o, int lane) { return __int_as_float(__builtin_amdgcn_ds_bpermute((lane ^ o) << 2, __float_as_int(v))); }
__device__ __forceinline__ float wave_sum(float v, int lane) {
#pragma unroll
    for (int o = 1; o < 64; o <<= 1) v += shx(v, o, lane);
    return v;
}
__device__ __forceinline__ int lane_id_opaque() { int l; asm volatile("v_mbcnt_lo_u32_b32 %0, -1, 0\n\tv_mbcnt_hi_u32_b32 %0, -1, %0" : "=v"(l)); return l; }
__device__ __forceinline__ float fast_exp2(float x) { return __builtin_amdgcn_exp2f(x); }
__device__ __forceinline__ float fast_log2(float x) { return __builtin_amdgcn_logf(x); }
__device__ __forceinline__ float fast_rcp(float x) { return __builtin_amdgcn_rcpf(x); }
__device__ __forceinline__ float sigmoidf_(float x) { return fast_rcp(1.0f + fast_exp2(-x * LOG2E)); }

namespace pg8 {
constexpr int BM = 256, BK = 64, HALF = 128, HTB = HALF * BK * 2, STAGE_BYTES = 8 * HTB, NXCD = 8, WGM = 8;
__host__ __device__ __forceinline__ int lds_byte(int r, int c) { const int st = (r >> 4) * 2 + (c >> 5), rr = r & 15, cc = c & 31, ob = rr * 64 + cc * 2; return st * 1024 + (ob ^ (((ob >> 9) & 1) << 5)); }
__host__ __device__ __forceinline__ void stage_rc(int b, int& R, int& C) { const int st = b / 1024, sb = b % 1024, swz = sb ^ (((sb >> 9) & 1) << 5); R = (st >> 1) * 16 + swz / 64; C = (st & 1) * 32 + (swz % 64) / 2; }

struct Unit { const char* A; const char* B; int pm, pn, kind; };

struct TileOrder {
    int nM, nN, nwg;
    __device__ __forceinline__ void init(int Mr, int N) { nM = Mr / BM; nN = N / BM; nwg = nM * nN; }
    __device__ __forceinline__ void map(int wgid, int& pm, int& pn) const {
        { const int q = nwg / NXCD, r = nwg % NXCD, xcd = wgid % NXCD, off = wgid / NXCD; wgid = (xcd < r ? xcd * (q + 1) : r * (q + 1) + (xcd - r) * q) + off; }
        const int nig = WGM * nN, gid = wgid / nig, fm = gid * WGM, gsz = (nM - fm) < WGM ? (nM - fm) : WGM;
        pm = fm + ((wgid % nig) % gsz); pn = (wgid % nig) / gsz;
    }
};
struct SchedPlain {
    TileOrder T; int G, c; const char* A; const char* B; size_t tstep;
    __device__ __forceinline__ bool next(int i, Unit& u) const {
        const long L = (long)i * G + c; if (L >= T.nwg) return false;
        T.map((int)L, u.pm, u.pn); u.A = A + (size_t)u.pm * tstep; u.B = B + (size_t)u.pn * tstep; u.kind = 0; return true;
    }
};
struct SchedBranch {
    TileOrder T; int G, c; const char* ws; const char* wl; size_t tstep;
    __device__ __forceinline__ bool next(int i, Unit& u) const {
        const long L = (long)(i >> 2) * G + c; if (L >= T.nwg) return false;
        T.map((int)L, u.pm, u.pn); const int sub = i & 3; u.kind = sub;
        const size_t oa = (sub == 1) ? R_Q : ((sub == 3) ? R_CB : R_H);
        const size_t ob = (sub == 0) ? (W_IN + (size_t)6144 * D * 2) : (sub == 1) ? W_A : (sub == 2) ? (W_IN + (size_t)7168 * D * 2) : W_B;
        u.A = ws + oa + (size_t)u.pm * tstep; u.B = wl + ob + (size_t)u.pn * tstep; return true;
    }
};

template <class Epi, class Sched>
__device__ __forceinline__ void gemm_phase(LAS unsigned char* lds, const int K, const Sched& S, const Epi& E, const int wid) {
    const int lane = lane_id_opaque(), tid = wid * 64 + lane, wr = wid >> 2, wc = wid & 3, fr = lane & 15, fq = lane >> 4;
    const int nt = K / BK;
    unsigned voff[2];
#pragma unroll
    for (int i = 0; i < 2; ++i) { int R, C; stage_rc(tid * 16 + i * 8192, R, C); voff[i] = (unsigned)(R * K + C) * 2u; }
    const size_t kstep = (size_t)(BK * 2);
    const size_t hstep = (size_t)HALF * K * 2;
    const unsigned ldsw = (unsigned)wid * 1024u;
    const int aoff = lds_byte(wr * 64 + fr, fq * 8), boff = lds_byte(wc * 32 + fr, fq * 8);
#define PG8_SA(b, h) (((b) * 2 + (h)) * HTB)
#define PG8_SB(b, h) ((4 + (b) * 2 + (h)) * HTB)
#define PG8_STAGE(bufoff, gbase) do { _Pragma("unroll") for (int _i = 0; _i < 2; ++_i) \
        __builtin_amdgcn_global_load_lds((const unsigned*)((const char*)(gbase) + voff[_i]), (LAS unsigned*)(lds + (bufoff) + ldsw + _i * 8192), 16, 0, 0); } while (0)
#define PG8_LDA(dst, b, h) do { _Pragma("unroll") for (int m = 0; m < 4; ++m) _Pragma("unroll") for (int k = 0; k < 2; ++k) dst[m][k] = *(const LAS bf16x8*)(lds + PG8_SA(b, h) + aoff + m * 2048 + k * 1024); } while (0)
#define PG8_LDB(dst, b, h) do { _Pragma("unroll") for (int n = 0; n < 2; ++n) _Pragma("unroll") for (int k = 0; k < 2; ++k) dst[n][k] = *(const LAS bf16x8*)(lds + PG8_SB(b, h) + boff + n * 2048 + k * 1024); } while (0)
#define PG8_MMA(ai, bj, At, Bt) do { __builtin_amdgcn_s_setprio(1); _Pragma("unroll") for (int m = 0; m < 4; ++m) _Pragma("unroll") for (int n = 0; n < 2; ++n) _Pragma("unroll") for (int k = 0; k < 2; ++k) \
        acc[ai][bj][m][n] = __builtin_amdgcn_mfma_f32_16x16x32_bf16(Bt[n][k], At[m][k], acc[ai][bj][m][n], 0, 0, 0); __builtin_amdgcn_s_setprio(0); } while (0)
#define PG8_WAIT_V(n) asm volatile("s_waitcnt vmcnt(" #n ")" ::: "memory")
#define PG8_WAIT_L(n) asm volatile("s_waitcnt lgkmcnt(" #n ")" ::: "memory")
#define PG8_BAR __builtin_amdgcn_s_barrier()
#define PG8_SCHED __builtin_amdgcn_sched_barrier(0)
    Unit cur, nxt; int ui = 0;
    if (!S.next(0, cur)) return;
    f32x4 acc[2][2][4][2];
#pragma unroll
    for (int a = 0; a < 2; ++a)
#pragma unroll
        for (int b = 0; b < 2; ++b)
#pragma unroll
            for (int m = 0; m < 4; ++m)
#pragma unroll
                for (int n = 0; n < 2; ++n) acc[a][b][m][n] = (f32x4){0.f, 0.f, 0.f, 0.f};
    bf16x8 At[4][2], B0[2][2], B1[2][2];
    const char* cA = cur.A; const char* cB = cur.B;
    PG8_STAGE(PG8_SB(0, 0), cB); PG8_STAGE(PG8_SB(0, 1), cB + hstep); PG8_STAGE(PG8_SA(0, 0), cA); PG8_STAGE(PG8_SA(0, 1), cA + hstep);
    if (wr == 1) PG8_BAR;
    PG8_WAIT_V(2); PG8_BAR;
    PG8_STAGE(PG8_SB(1, 0), cB + kstep); PG8_STAGE(PG8_SA(1, 0), cA + kstep); PG8_STAGE(PG8_SB(1, 1), cB + hstep + kstep);
    PG8_WAIT_V(6); PG8_BAR;
    for (;;) {
        const bool has_next = S.next(ui + 1, nxt);
        const char* nA = has_next ? nxt.A : cA; const char* nB = has_next ? nxt.B : cB;
        for (int t = 0; t < nt; t += 2) {
            const bool last = (t == nt - 2);
            const char* a1 = cA + (size_t)(t + 1) * kstep;
            const char* a2 = last ? nA : cA + (size_t)(t + 2) * kstep; const char* b2 = last ? nB : cB + (size_t)(t + 2) * kstep;
            const char* a3 = a2 + kstep; const char* b3 = b2 + kstep;
            PG8_LDB(B0, 0, 0); PG8_LDB(B1, 0, 1); PG8_SCHED; PG8_LDA(At, 0, 0); PG8_STAGE(PG8_SA(1, 1), a1 + hstep);
            PG8_WAIT_V(8); PG8_WAIT_L(0); PG8_BAR; PG8_MMA(0, 0, At, B0); PG8_MMA(0, 1, At, B1); PG8_BAR; PG8_SCHED;
            PG8_LDA(At, 0, 1); PG8_STAGE(PG8_SB(0, 0), b2); PG8_STAGE(PG8_SB(0, 1), b2 + hstep); PG8_STAGE(PG8_SA(0, 0), a2);
            PG8_WAIT_V(8); PG8_WAIT_L(0); PG8_BAR; PG8_MMA(1, 0, At, B0); PG8_MMA(1, 1, At, B1); PG8_BAR; PG8_SCHED;
            PG8_LDB(B0, 1, 0); PG8_LDB(B1, 1, 1); PG8_SCHED; PG8_LDA(At, 1, 0); PG8_STAGE(PG8_SA(0, 1), a2 + hstep);
            PG8_WAIT_V(8); PG8_WAIT_L(0); PG8_BAR; PG8_MMA(0, 0, At, B0); PG8_MMA(0, 1, At, B1); PG8_BAR; PG8_SCHED;
            PG8_LDA(At, 1, 1); PG8_STAGE(PG8_SB(1, 0), b3); PG8_STAGE(PG8_SB(1, 1), b3 + hstep); PG8_STAGE(PG8_SA(1, 0), a3);
            PG8_WAIT_V(8); PG8_WAIT_L(0); PG8_BAR; PG8_MMA(1, 0, At, B0); PG8_MMA(1, 1, At, B1); PG8_BAR; PG8_SCHED;
        }
        if (wr == 0) PG8_BAR;
        { const int l2 = lane_id_opaque(); E(acc, cur, wr, wc, l2 & 15, l2 >> 4); }
        if (!has_next) break;
#pragma unroll
        for (int a = 0; a < 2; ++a)
#pragma unroll
            for (int b = 0; b < 2; ++b)
#pragma unroll
                for (int m = 0; m < 4; ++m)
#pragma unroll
                    for (int n = 0; n < 2; ++n) acc[a][b][m][n] = (f32x4){0.f, 0.f, 0.f, 0.f};
        cur = nxt; cA = nA; cB = nB; ++ui;
        if (wr == 1) PG8_BAR;
    }
    PG8_WAIT_V(0);
    PG8_BAR;
#undef PG8_SA
#undef PG8_SB
#undef PG8_STAGE
#undef PG8_LDA
#undef PG8_LDB
#undef PG8_MMA
#undef PG8_WAIT_V
#undef PG8_WAIT_L
#undef PG8_BAR
#undef PG8_SCHED
}

__device__ __forceinline__ u32x4 pack8(const f32x4& a, const f32x4& b) { u32x4 w; w.x = cvt_pk(a[0], a[1]); w.y = cvt_pk(a[2], a[3]); w.z = cvt_pk(b[0], b[1]); w.w = cvt_pk(b[2], b[3]); return w; }

struct EpiRegions {
    bf16_t* base;
    __device__ __forceinline__ void operator()(const f32x4 (&acc)[2][2][4][2], const Unit& u, int wr, int wc, int fr, int fq) const {
        bf16_t* dst = base + (size_t)(u.pn >> 2) * ((size_t)M * D);
        const int col = (u.pn & 3) * 256 + wc * 64 + fq * 8, row0 = u.pm * BM + wr * 64 + fr;
#pragma unroll
        for (int ai = 0; ai < 2; ++ai)
#pragma unroll
            for (int m = 0; m < 4; ++m) { bf16_t* rp = dst + (size_t)(row0 + ai * HALF + m * 16) * D + col;
#pragma unroll
                for (int bj = 0; bj < 2; ++bj) *(u32x4*)(rp + bj * 32) = pack8(acc[ai][bj][m][0], acc[ai][bj][m][1]); }
    }
};
struct EpiQKV {
    bf16_t* base; const float* gq; const float* gk;
    __device__ __forceinline__ void operator()(const f32x4 (&acc)[2][2][4][2], const Unit& u, int wr, int wc, int fr, int fq) const {
        const int region = u.pn >> 2, head = (u.pn & 3) * 4 + wc, row0 = u.pm * BM + wr * 64 + fr;
        if (region == 2) {
            const int b = row0 >> 12;
            bf16_t* vb = base + (size_t)2 * M * D + ((size_t)(b * NH + head) * HD) * SEQ;
#pragma unroll
            for (int ai = 0; ai < 2; ++ai)
#pragma unroll
                for (int m = 0; m < 4; ++m) { const int s0 = (row0 + ai * HALF + m * 16) & (SEQ - 1), q = (s0 >> 2) & 3;
                    const int s = (s0 & ~12) | ((((q & 1) << 1) | (q >> 1)) << 2);
#pragma unroll
                    for (int bj = 0; bj < 2; ++bj)
#pragma unroll
                        for (int n = 0; n < 2; ++n)
#pragma unroll
                            for (int j = 0; j < 4; ++j) { const int d = bj * 32 + fq * 8 + n * 4 + j; const unsigned w = cvt_pk(acc[ai][bj][m][n][j], 0.f);
                                vb[(size_t)d * SEQ + s] = (bf16_t)(w & 0xffffu); } }
        } else if (region >= 3) {
            bf16_t* dst = base + (size_t)region * ((size_t)M * D);
            const int col = (u.pn & 3) * 256 + wc * 64 + fq * 8;
#pragma unroll
            for (int ai = 0; ai < 2; ++ai)
#pragma unroll
                for (int m = 0; m < 4; ++m) { bf16_t* rp = dst + (size_t)(row0 + ai * HALF + m * 16) * D + col;
#pragma unroll
                    for (int bj = 0; bj < 2; ++bj) *(u32x4*)(rp + bj * 32) = pack8(acc[ai][bj][m][0], acc[ai][bj][m][1]); }
        } else {
            const float* g = region == 0 ? gq : gk; const float sc = region == 0 ? C2 : 1.0f;
            bf16_t* dst = base + (size_t)region * ((size_t)M * D);
            f32x4 gv[2][2];
#pragma unroll
            for (int bj = 0; bj < 2; ++bj)
#pragma unroll
                for (int n = 0; n < 2; ++n) gv[bj][n] = *(const f32x4*)(g + bj * 32 + fq * 8 + n * 4) * sc;
            const int col = head * 64 + fq * 8;
#pragma unroll
            for (int ai = 0; ai < 2; ++ai)
#pragma unroll
                for (int m = 0; m < 4; ++m) {
                    float ss = 0.f;
#pragma unroll
                    for (int bj = 0; bj < 2; ++bj)
#pragma unroll
                        for (int n = 0; n < 2; ++n) { const f32x4 x = acc[ai][bj][m][n]; ss += (x[0] * x[0] + x[1] * x[1]) + (x[2] * x[2] + x[3] * x[3]); }
                    ss += shx(ss, 16, fr + 16 * fq); ss += shx(ss, 32, fr + 16 * fq);
                    const float r = 1.0f / sqrtf(ss * (1.0f / 64.0f) + EPS);
                    bf16_t* rp = dst + (size_t)(row0 + ai * HALF + m * 16) * D + col;
#pragma unroll
                    for (int bj = 0; bj < 2; ++bj) { const f32x4 a = acc[ai][bj][m][0] * r * gv[bj][0], b2 = acc[ai][bj][m][1] * r * gv[bj][1]; *(u32x4*)(rp + bj * 32) = pack8(a, b2); }
                }
        }
    }
};
struct EpiBranch {
    bf16_t* S1; bf16_t* TM;
    __device__ __forceinline__ void operator()(const f32x4 (&acc)[2][2][4][2], const Unit& u, int wr, int wc, int fr, int fq) const {
        const int col = u.pn * 256 + wc * 64 + fq * 8, row0 = u.pm * BM + wr * 64 + fr, kind = u.kind;
#pragma unroll
        for (int ai = 0; ai < 2; ++ai) {
            if (kind == 0 || kind == 2) {
#pragma unroll
                for (int m = 0; m < 4; ++m) { const size_t off = (size_t)(row0 + ai * HALF + m * 16) * D + col;
#pragma unroll
                    for (int bj = 0; bj < 2; ++bj) { f32x4 a = acc[ai][bj][m][0], b = acc[ai][bj][m][1];
#pragma unroll
                        for (int j = 0; j < 4; ++j) { a[j] = sigmoidf_(a[j]); b[j] = sigmoidf_(b[j]); }
                        *(u32x4*)(S1 + off + bj * 32) = pack8(a, b); } }
            } else {
#pragma unroll
              for (int mh = 0; mh < 2; ++mh) {
                u32x4 g[2][2], t[2][2];
#pragma unroll
                for (int m2 = 0; m2 < 2; ++m2) { const int m = 2 * mh + m2; const size_t off = (size_t)(row0 + ai * HALF + m * 16) * D + col;
#pragma unroll
                    for (int bj = 0; bj < 2; ++bj) { g[m2][bj] = *(const u32x4*)(S1 + off + bj * 32); if (kind == 3) t[m2][bj] = *(const u32x4*)(TM + off + bj * 32); else t[m2][bj] = (u32x4){0u, 0u, 0u, 0u}; } }
#pragma unroll
                for (int m2 = 0; m2 < 2; ++m2) { const int m = 2 * mh + m2; const size_t off = (size_t)(row0 + ai * HALF + m * 16) * D + col;
#pragma unroll
                    for (int bj = 0; bj < 2; ++bj) { f32x4 a = acc[ai][bj][m][0], b = acc[ai][bj][m][1]; const u32x4 gg = g[m2][bj], tt = t[m2][bj];
                        a[0] = a[0] * bf_lo(gg.x) + bf_lo(tt.x); a[1] = a[1] * bf_hi(gg.x) + bf_hi(tt.x); a[2] = a[2] * bf_lo(gg.y) + bf_lo(tt.y); a[3] = a[3] * bf_hi(gg.y) + bf_hi(tt.y);
                        b[0] = b[0] * bf_lo(gg.z) + bf_lo(tt.z); b[1] = b[1] * bf_hi(gg.z) + bf_hi(tt.z); b[2] = b[2] * bf_lo(gg.w) + bf_lo(tt.w); b[3] = b[3] * bf_hi(gg.w) + bf_hi(tt.w);
                        if (kind == 3) { const u32x4 pk = pack8(a, b); asm volatile("global_store_dwordx4 %0, %1, off sc1\n\ts_nop 1" :: "v"(TM + off + bj * 32), "v"(pk) : "memory"); }
                        else *(u32x4*)(TM + off + bj * 32) = pack8(a, b); } }
              }
            }
        }
    }
};
struct EpiResid {
    const float* xin; float* xout; const float* gmod;
    __device__ __forceinline__ void operator()(const f32x4 (&acc)[2][2][4][2], const Unit& u, int wr, int wc, int fr, int fq) const {
        const int col = u.pn * 256 + wc * 64 + fq * 8, row0 = u.pm * BM + wr * 64 + fr, b = row0 >> 12;
        f32x4 gv[2][2];
#pragma unroll
        for (int bj = 0; bj < 2; ++bj)
#pragma unroll
            for (int n = 0; n < 2; ++n) gv[bj][n] = *(const f32x4*)(gmod + b * 6144 + col + bj * 32 + n * 4);
#pragma unroll
        for (int ai = 0; ai < 2; ++ai)
#pragma unroll
          for (int mh = 0; mh < 2; ++mh) {
            f32x4 xo[2][2][2];
#pragma unroll
            for (int m2 = 0; m2 < 2; ++m2) { const size_t off = (size_t)(row0 + ai * HALF + (2 * mh + m2) * 16) * D + col;
#pragma unroll
                for (int bj = 0; bj < 2; ++bj)
#pragma unroll
                    for (int n = 0; n < 2; ++n) xo[m2][bj][n] = *(const f32x4*)(xin + off + bj * 32 + n * 4); }
#pragma unroll
            for (int m2 = 0; m2 < 2; ++m2) { const size_t off = (size_t)(row0 + ai * HALF + (2 * mh + m2) * 16) * D + col;
#pragma unroll
                for (int bj = 0; bj < 2; ++bj)
#pragma unroll
                    for (int n = 0; n < 2; ++n) *(f32x4*)(xout + off + bj * 32 + n * 4) = xo[m2][bj][n] + gv[bj][n] * acc[ai][bj][2 * mh + m2][n]; }
          }
    }
};
struct EpiGU {
    bf16_t* f;
    __device__ __forceinline__ void operator()(const f32x4 (&acc)[2][2][4][2], const Unit& u, int wr, int wc, int fr, int fq) const {
        const int col = u.pn * 128 + wc * 32 + fq * 8, row0 = u.pm * BM + wr * 64 + fr;
#pragma unroll
        for (int ai = 0; ai < 2; ++ai)
#pragma unroll
            for (int m = 0; m < 4; ++m) {
                f32x4 o[2];
#pragma unroll
                for (int n = 0; n < 2; ++n)
#pragma unroll
                    for (int j = 0; j < 4; ++j) { const float gt = acc[ai][0][m][n][j]; o[n][j] = gt * sigmoidf_(gt) * acc[ai][1][m][n][j]; }
                *(u32x4*)(f + (size_t)(row0 + ai * HALF + m * 16) * FF + col) = pack8(o[0], o[1]);
            }
    }
};
struct EpiResidNorm {
    const float* xin; float* xout; const float* gmod; const float* lng; const float* scmod; bf16_t* An; float* ssq;
    __device__ __forceinline__ void operator()(const f32x4 (&acc)[2][2][4][2], const Unit& u, int wr, int wc, int fr, int fq) const {
        const int col = u.pn * 256 + wc * 64 + fq * 8, row0 = u.pm * BM + wr * 64 + fr, b = row0 >> 12;
        f32x4 gv[2][2], gm[2][2];
#pragma unroll
        for (int bj = 0; bj < 2; ++bj)
#pragma unroll
            for (int n = 0; n < 2; ++n) { const int c = col + bj * 32 + n * 4; gv[bj][n] = *(const f32x4*)(gmod + b * 6144 + c);
                gm[bj][n] = *(const f32x4*)(lng + c) * (*(const f32x4*)(scmod + b * 6144 + c) + 1.0f); }
#pragma unroll
        for (int ai = 0; ai < 2; ++ai)
#pragma unroll
          for (int mh = 0; mh < 2; ++mh) {
            f32x4 xo[2][2][2];
#pragma unroll
            for (int m2 = 0; m2 < 2; ++m2) { const size_t off = (size_t)(row0 + ai * HALF + (2 * mh + m2) * 16) * D + col;
#pragma unroll
                for (int bj = 0; bj < 2; ++bj)
#pragma unroll
                    for (int n = 0; n < 2; ++n) xo[m2][bj][n] = *(const f32x4*)(xin + off + bj * 32 + n * 4); }
#pragma unroll
            for (int m2 = 0; m2 < 2; ++m2) { const int row = row0 + ai * HALF + (2 * mh + m2) * 16; const size_t off = (size_t)row * D + col;
                float ss = 0.f;
#pragma unroll
                for (int bj = 0; bj < 2; ++bj) {
                    f32x4 y[2];
#pragma unroll
                    for (int n = 0; n < 2; ++n) { const f32x4 x1 = xo[m2][bj][n] + gv[bj][n] * acc[ai][bj][2 * mh + m2][n];
                        *(f32x4*)(xout + off + bj * 32 + n * 4) = x1; ss += (x1[0] * x1[0] + x1[1] * x1[1]) + (x1[2] * x1[2] + x1[3] * x1[3]); y[n] = x1 * gm[bj][n]; }
                    *(u32x4*)(An + off + bj * 32) = pack8(y[0], y[1]);
                }
                ss += shx(ss, 16, fr + 16 * fq); ss += shx(ss, 32, fr + 16 * fq);
                if (fq == 0) ssq[(size_t)row * 16 + u.pn * 4 + wc] = ss;
            }
          }
    }
};
struct EpiGUNorm {
    bf16_t* f; const float* bias; LAS const float* rtab;
    __device__ __forceinline__ void operator()(const f32x4 (&acc)[2][2][4][2], const Unit& u, int wr, int wc, int fr, int fq) const {
        const int col = u.pn * 128 + wc * 32 + fq * 8, row0 = u.pm * BM + wr * 64 + fr, b = row0 >> 12;
        f32x4 bg[2], bu[2];
#pragma unroll
        for (int n = 0; n < 2; ++n) { const int a = u.pn * 256 + wc * 32 + n * 16 + fq * 4; bg[n] = *(const f32x4*)(bias + b * (2 * FF) + a); bu[n] = *(const f32x4*)(bias + b * (2 * FF) + a + 128); }
#pragma unroll
        for (int ai = 0; ai < 2; ++ai)
#pragma unroll
            for (int m = 0; m < 4; ++m) {
                const float r = rtab[wr * 64 + fr + ai * HALF + m * 16];
                f32x4 o[2];
#pragma unroll
                for (int n = 0; n < 2; ++n)
#pragma unroll
                    for (int j = 0; j < 4; ++j) { const float gt = acc[ai][0][m][n][j] * r + bg[n][j], up = acc[ai][1][m][n][j] * r + bu[n][j]; o[n][j] = gt * sigmoidf_(gt) * up; }
                *(u32x4*)(f + (size_t)(row0 + ai * HALF + m * 16) * FF + col) = pack8(o[0], o[1]);
            }
    }
};
}

#define LDS_WAIT() asm volatile("s_waitcnt lgkmcnt(0)" ::: "memory")
__device__ __forceinline__ void transpose_item(const float* W, int N, int K, int n0, bf16_t* WT, int a0, int k0, LAS float* scr, int lane) {
    {
        const int kr = lane >> 3, c4 = (lane & 7) * 4;
        f32x4 t[8];
#pragma unroll
        for (int i = 0; i < 8; ++i) t[i] = __builtin_nontemporal_load((const f32x4*)(W + (size_t)(k0 + 8 * i + kr) * N + n0 + c4));
#pragma unroll
        for (int i = 0; i < 8; ++i) { LAS float* d = scr + (8 * i + kr) * 33 + c4; d[0] = t[i][0]; d[1] = t[i][1]; d[2] = t[i][2]; d[3] = t[i][3]; }
    }
    LDS_WAIT(); asm volatile("" ::: "memory");
    const int c = lane & 7;
#pragma unroll
    for (int j = 0; j < 4; ++j) { const int s = (lane >> 3) + 8 * j; const int lo = 8 * ((s >> 2) & 3) + 4 * (s >> 4) + (s & 3);
        const LAS float* sp = scr + (8 * c) * 33 + lo;
        u32x4 o; o.x = cvt_pk(sp[0 * 33], sp[1 * 33]); o.y = cvt_pk(sp[2 * 33], sp[3 * 33]); o.z = cvt_pk(sp[4 * 33], sp[5 * 33]); o.w = cvt_pk(sp[6 * 33], sp[7 * 33]);
        *(u32x4*)(WT + (size_t)(a0 + s) * K + k0 + 8 * c) = o; }
    LDS_WAIT(); asm volatile("" ::: "memory");
}

struct Params { const float* in[16]; float* out; unsigned char* ws; };

__device__ __forceinline__ void phase0(const Params& p, LAS unsigned char* lds, int gw, int NGW, int wave, int lane, const int l, const bool with_mod) {
    LAS float* scr = (LAS float*)(lds + wave * 16384);
    constexpr int I_IN = 256 * 16, I_SQ = 32 * 16, I_GU = 176 * 16, I_D = 32 * 44, I_LAYER = I_IN + 3 * I_SQ + I_GU + I_D;
    constexpr int I_MOD = 2 * 32 * 24;
    for (int it = gw; it < (with_mod ? I_MOD : 0); it += NGW) {
        const int l = it / (32 * 24), r = it % (32 * 24), kc = r / 24, nb = r % 24;
        const float* aw = p.in[2] + (size_t)l * D * 6144 + (size_t)(kc * 32) * 6144 + nb * 256 + lane * 4;
        const float* c = p.in[1];
        f32x4 a[4];
#pragma unroll
        for (int b = 0; b < 4; ++b) a[b] = (f32x4){0.f, 0.f, 0.f, 0.f};
#pragma unroll 8
        for (int k = 0; k < 32; ++k) { const f32x4 w = __builtin_nontemporal_load((const f32x4*)(aw + (size_t)k * 6144));
#pragma unroll
            for (int b = 0; b < 4; ++b) { const float cv = c[b * D + kc * 32 + k]; const float sv = cv * sigmoidf_(cv); a[b] += w * sv; } }
        float* mp = (float*)(p.ws + R_CX) + ((size_t)(l * 32 + kc) * 4) * 6144 + nb * 256 + lane * 4;
#pragma unroll
        for (int b = 0; b < 4; ++b) *(f32x4*)(mp + (size_t)b * 6144) = a[b];
    }
    for (int it = gw; it < I_LAYER; it += NGW) {
        int r = it;
        unsigned char* wl = p.ws + WS_W;
        if (r < I_IN) { const int kb = r / 256, g = r % 256; const int pn = g >> 3, bj = (g >> 2) & 1, wc = g & 3;
            transpose_item(p.in[5] + (size_t)l * D * INW, INW, D, 256 * pn + 64 * wc + 32 * bj, (bf16_t*)(wl + W_IN), 32 * g, 64 * kb, scr, lane); continue; }
        r -= I_IN;
        if (r < 3 * I_SQ) { const int which = r / I_SQ; r %= I_SQ; const int kb = r / 32, g = r % 32; const int pn = g >> 3, bj = (g >> 2) & 1, wc = g & 3;
            const float* src = p.in[9 + which] + (size_t)l * D * D; bf16_t* dst = (bf16_t*)(wl + (which == 0 ? W_A : which == 1 ? W_B : W_O));
            transpose_item(src, D, D, 256 * pn + 64 * wc + 32 * bj, dst, 32 * g, 64 * kb, scr, lane); continue; }
        r -= 3 * I_SQ;
        if (r < I_GU) { const int kb = r / 176, g = r % 176; const int pn = g >> 3, bj = (g >> 2) & 1, wc = g & 3;
            const float* src = p.in[bj ? 14 : 13] + (size_t)l * D * FF;
            transpose_item(src, FF, D, 128 * pn + 32 * wc, (bf16_t*)(wl + W_GU), 32 * g, 64 * kb, scr, lane); continue; }
        r -= I_GU;
        { const int kb = r / 32, g = r % 32; const int pn = g >> 3, bj = (g >> 2) & 1, wc = g & 3;
            transpose_item(p.in[15] + (size_t)l * FF * D, D, FF, 256 * pn + 64 * wc + 32 * bj, (bf16_t*)(wl + W_D), 32 * g, 64 * kb, scr, lane); }
    }
}

__device__ __forceinline__ void norm_phase(const float* x, const float* g, const float* modl, int sh_off, int sc_off, bf16_t* h, int gw, int NGW, const bool stream = false, const bool use_tab = false, const LAS float* tab = nullptr) {
    const int lane = lane_id_opaque();
    for (int q = gw; q < M / 4; q += NGW) {
        const int m0 = 4 * q, b = m0 >> 12;
        f32x4 v[4][4];
#pragma unroll
        for (int r = 0; r < 4; ++r) { const f32x4* xr = (const f32x4*)(x + (size_t)(m0 + r) * D) + lane;
#pragma unroll
            for (int j = 0; j < 4; ++j) v[r][j] = stream ? __builtin_nontemporal_load(xr + 64 * j) : xr[64 * j]; }
        float rs[4];
#pragma unroll
        for (int r = 0; r < 4; ++r) { float s = 0.f;
#pragma unroll
            for (int j = 0; j < 4; ++j) s += (v[r][j][0] * v[r][j][0] + v[r][j][1] * v[r][j][1]) + (v[r][j][2] * v[r][j][2] + v[r][j][3] * v[r][j][3]);
            rs[r] = s; }
#pragma unroll
        for (int o = 1; o < 64; o <<= 1) {
#pragma unroll
            for (int r = 0; r < 4; ++r) rs[r] += shx(rs[r], o, lane); }
#pragma unroll
        for (int r = 0; r < 4; ++r) rs[r] = 1.0f / sqrtf(rs[r] * (1.0f / D) + EPS);
#pragma unroll
        for (int j = 0; j < 4; ++j) { const int col = 4 * (64 * j + lane);
            const f32x4 gg = *(const f32x4*)(g + col);
            const f32x4 sc = (use_tab ? *(const LAS f32x4*)(tab + (b >> 1) * 2048 + sc_off + col) : *(const f32x4*)(modl + b * 6144 + sc_off + col)) + 1.0f;
            const f32x4 sh = use_tab ? *(const LAS f32x4*)(tab + (b >> 1) * 2048 + sh_off + col) : *(const f32x4*)(modl + b * 6144 + sh_off + col);
#pragma unroll
            for (int r = 0; r < 4; ++r) { const f32x4 y = (v[r][j] * rs[r] * gg) * sc + sh;
                u32x2 w; w.x = cvt_pk(y[0], y[1]); w.y = cvt_pk(y[2], y[3]); *((u32x2*)(h + (size_t)(m0 + r) * D) + lane + 64 * j) = w; } }
    }
}

__device__ __forceinline__ void conv_phase(bf16_t* cb, const bf16_t* cc, const bf16_t* cx, const float* cw, int gt0, int NT) {
    const int gt = gt0 + lane_id_opaque();
    for (int it = gt; it < (M / 16) * (D / 8); it += NT) {
        const int c8 = it & 127, run = it >> 7, t0 = run * 16, ch = c8 * 8;
        float w0[8], w1[8], w2[8];
#pragma unroll
        for (int i = 0; i < 8; ++i) { w0[i] = cw[ch + i]; w1[i] = cw[D + ch + i]; w2[i] = cw[2 * D + ch + i]; }
        float um2[8], um1[8];
#pragma unroll
        for (int i = 0; i < 8; ++i) { um2[i] = 0.f; um1[i] = 0.f; }
        if ((t0 & (SEQ - 1)) != 0) {
            const u32x4 a2 = *(const u32x4*)(cc + (size_t)(t0 - 2) * D + ch), b2 = *(const u32x4*)(cx + (size_t)(t0 - 2) * D + ch);
            const u32x4 a1 = *(const u32x4*)(cc + (size_t)(t0 - 1) * D + ch), b1 = *(const u32x4*)(cx + (size_t)(t0 - 1) * D + ch);
#pragma unroll
            for (int i = 0; i < 4; ++i) { um2[2 * i] = bf_lo(a2[i]) * bf_lo(b2[i]); um2[2 * i + 1] = bf_hi(a2[i]) * bf_hi(b2[i]);
                um1[2 * i] = bf_lo(a1[i]) * bf_lo(b1[i]); um1[2 * i + 1] = bf_hi(a1[i]) * bf_hi(b1[i]); }
        }
#pragma unroll 4
        for (int t = 0; t < 16; ++t) {
            const size_t off = (size_t)(t0 + t) * D + ch;
            const u32x4 a = *(const u32x4*)(cc + off), b = *(const u32x4*)(cx + off), e = *(const u32x4*)(cb + off);
            float u[8], y[8];
#pragma unroll
            for (int i = 0; i < 4; ++i) { u[2 * i] = bf_lo(a[i]) * bf_lo(b[i]); u[2 * i + 1] = bf_hi(a[i]) * bf_hi(b[i]); }
#pragma unroll
            for (int i = 0; i < 4; ++i) {
                y[2 * i] = bf_lo(e[i]) * (w0[2 * i] * um2[2 * i] + w1[2 * i] * um1[2 * i] + w2[2 * i] * u[2 * i]);
                y[2 * i + 1] = bf_hi(e[i]) * (w0[2 * i + 1] * um2[2 * i + 1] + w1[2 * i + 1] * um1[2 * i + 1] + w2[2 * i + 1] * u[2 * i + 1]); }
            u32x4 o; o.x = cvt_pk(y[0], y[1]); o.y = cvt_pk(y[2], y[3]); o.z = cvt_pk(y[4], y[5]); o.w = cvt_pk(y[6], y[7]);
            *(u32x4*)(cb + off) = o;
#pragma unroll
            for (int i = 0; i < 8; ++i) { um2[i] = um1[i]; um1[i] = u[i]; }
        }
    }
}

#define MFMA32(a, b, c) __builtin_amdgcn_mfma_f32_32x32x16_bf16((a), (b), (c), 0, 0, 0)
constexpr float SB_EXIT = 1.0e-20f;
__device__ __forceinline__ float clamp_z(float z) { return __builtin_amdgcn_fmed3f(z, -126.0f, 80.0f); }
struct AttnState { f32x16 o0, o1; float P; bf16x8 kf[4]; };
template <bool DIAG>
__device__ __forceinline__ void attn_step(AttnState& st, const bf16x8 (&qf)[4], const bf16_t* kbase, const bf16_t* vbase, int j0, bool more, int n, int hh, int lane) {
    bf16x8 vf[2][2];
#pragma unroll
    for (int mb = 0; mb < 2; ++mb)
#pragma unroll
        for (int s = 0; s < 2; ++s) vf[mb][s] = *(const bf16x8*)(vbase + (size_t)mb * 32 * SEQ + j0 + 16 * s);
    f32x16 sa;
#pragma unroll
    for (int r = 0; r < 16; ++r) sa[r] = 0.f;
#pragma unroll
    for (int kk = 0; kk < 4; ++kk) sa = MFMA32(st.kf[kk], qf[kk], sa);
    if (more) {
#pragma unroll
        for (int kk = 0; kk < 4; ++kk) st.kf[kk] = *(const bf16x8*)(kbase + (size_t)(j0 - 32) * D + kk * 16);
    }
    float om[16], be[16];
#pragma unroll
    for (int r = 0; r < 16; ++r) {
        const float e = fast_exp2(clamp_z(sa[r]));
        float o = fast_rcp(1.0f + e), b = e * o;
        if (DIAG) { const int ki = (r & 3) + 8 * (r >> 2) + 4 * hh; if (ki >= n) { o = 1.0f; b = 0.f; } }
        om[r] = o; be[r] = b;
    }
    float g[4], pg[4];
#pragma unroll
    for (int q = 0; q < 4; ++q) g[q] = (om[4 * q] * om[4 * q + 1]) * (om[4 * q + 2] * om[4 * q + 3]);
#pragma unroll
    for (int q = 0; q < 4; ++q) pg[q] = shx(g[q], 32, lane);
    float run = st.P;
    float a[16];
#pragma unroll
    for (int q = 3; q >= 0; --q) {
        const float c3 = (hh == 0) ? run * pg[q] : run;
        const float c2 = c3 * om[4 * q + 3], c1 = c2 * om[4 * q + 2], c0 = c1 * om[4 * q + 1];
        a[4 * q + 3] = be[4 * q + 3] * c3; a[4 * q + 2] = be[4 * q + 2] * c2; a[4 * q + 1] = be[4 * q + 1] * c1; a[4 * q] = be[4 * q] * c0;
        run *= g[q] * pg[q];
    }
    st.P = run;
#pragma unroll
    for (int s = 0; s < 2; ++s) {
        u32x4 pw; pw.x = cvt_pk(a[8 * s + 0], a[8 * s + 1]); pw.y = cvt_pk(a[8 * s + 2], a[8 * s + 3]); pw.z = cvt_pk(a[8 * s + 4], a[8 * s + 5]); pw.w = cvt_pk(a[8 * s + 6], a[8 * s + 7]);
        const bf16x8 pf = __builtin_bit_cast(bf16x8, pw);
        st.o0 = MFMA32(vf[0][s], pf, st.o0); st.o1 = MFMA32(vf[1][s], pf, st.o1);
    }
}
__device__ __forceinline__ void attn_task(bf16_t* QO, const bf16_t* Kp, const bf16_t* VT, int b, int h, int qblk, int lane) {
    const int n = lane & 31, hh = lane >> 5, t0 = qblk * 32;
    bf16_t* qrow = QO + (size_t)(b * SEQ + t0 + n) * D + h * HD;
    bf16x8 qf[4];
#pragma unroll
    for (int kk = 0; kk < 4; ++kk) qf[kk] = *(const bf16x8*)(qrow + kk * 16 + hh * 8);
    AttnState st;
#pragma unroll
    for (int r = 0; r < 16; ++r) { st.o0[r] = 0.f; st.o1[r] = 0.f; }
    st.P = 1.0f;
    const bf16_t* kbase = Kp + (size_t)(b * SEQ + n) * D + h * HD + hh * 8;
    const bf16_t* vbase = VT + ((size_t)(b * NH + h) * HD + n) * SEQ + 8 * hh;
#pragma unroll
    for (int kk = 0; kk < 4; ++kk) st.kf[kk] = *(const bf16x8*)(kbase + (size_t)t0 * D + kk * 16);
    attn_step<true>(st, qf, kbase, vbase, t0, qblk > 0, n, hh, lane);
    for (int kb = qblk - 1; kb >= 0; --kb) {
        if (!__any(st.P > SB_EXIT)) break;
        attn_step<false>(st, qf, kbase, vbase, kb * 32, kb > 0, n, hh, lane);
    }
#pragma unroll
    for (int q = 0; q < 4; ++q) {
        u32x2 w0, w1; w0.x = cvt_pk(st.o0[4 * q], st.o0[4 * q + 1]); w0.y = cvt_pk(st.o0[4 * q + 2], st.o0[4 * q + 3]); w1.x = cvt_pk(st.o1[4 * q], st.o1[4 * q + 1]); w1.y = cvt_pk(st.o1[4 * q + 2], st.o1[4 * q + 3]);
        *(u32x2*)(qrow + 8 * q + 4 * hh) = w0; *(u32x2*)(qrow + 32 + 8 * q + 4 * hh) = w1;
    }
}
__device__ __forceinline__ void attn_phase(bf16_t* QO, const bf16_t* Kp, const bf16_t* VT, int G, int bx, int wave) {
    const int lane = lane_id_opaque();
    constexpr int NQB = SEQ / 32, NTASK = NB * NH * NQB;
    if (G == 256) {
#pragma unroll 1
        for (int i = 0; i < 4; ++i) { const int bh = 2 * (wave * 4 + i) + (bx & 1); attn_task(QO, Kp, VT, bh / NH, bh % NH, bx >> 1, lane); }
    } else {
        int i = 0;
        for (int tau = bx * NWAVES + wave; tau < NTASK; tau += G * NWAVES, ++i) {
            const int bh = tau / NQB, qr = tau % NQB, qblk = (i & 1) ? (NQB - 1 - qr) : qr;
            attn_task(QO, Kp, VT, bh / NH, bh % NH, qblk, lane);
        }
    }
}
__device__ __forceinline__ void bias_phase(const bf16_t* Wgu, const float* sh2  , float* bias, int gw, int NGW) {
    const int lane = lane_id_opaque();
    float sv[4][16];
#pragma unroll
    for (int b = 0; b < 4; ++b)
#pragma unroll
        for (int h = 0; h < 2; ++h)
#pragma unroll
            for (int q = 0; q < 2; ++q) { const f32x4 t = *(const f32x4*)(sh2 + b * 6144 + h * 512 + lane * 8 + q * 4);
#pragma unroll
                for (int i = 0; i < 4; ++i) sv[b][h * 8 + q * 4 + i] = t[i]; }
    for (int a = gw; a < 2 * FF; a += NGW) {
        const u32x4 w0 = *(const u32x4*)(Wgu + (size_t)a * D + lane * 8), w1 = *(const u32x4*)(Wgu + (size_t)a * D + 512 + lane * 8);
        float wv[16];
#pragma unroll
        for (int i = 0; i < 4; ++i) { wv[2 * i] = bf_lo(w0[i]); wv[2 * i + 1] = bf_hi(w0[i]); wv[8 + 2 * i] = bf_lo(w1[i]); wv[8 + 2 * i + 1] = bf_hi(w1[i]); }
        float sb[4];
#pragma unroll
        for (int b = 0; b < 4; ++b) { float t = 0.f;
#pragma unroll
            for (int i = 0; i < 16; ++i) t += wv[i] * sv[b][i];
            sb[b] = t; }
#pragma unroll
        for (int o = 1; o < 64; o <<= 1) {
#pragma unroll
            for (int b = 0; b < 4; ++b) sb[b] += shx(sb[b], o, lane); }
        if (lane == 0) {
#pragma unroll
            for (int b = 0; b < 4; ++b) bias[b * (2 * FF) + a] = sb[b]; }
    }
}

__device__ __forceinline__ void mixer_phase(bf16_t* QO, const bf16_t* Kp, const bf16_t* VT, bf16_t* cb, const bf16_t* cc, const bf16_t* cx, const float* cw, int G, int bx, int wave, int gt0, int NT) {
    if (wave & 4) { conv_phase(cb, cc, cx, cw, gt0, NT); attn_phase(QO, Kp, VT, G, bx, wave); }
    else          { attn_phase(QO, Kp, VT, G, bx, wave); conv_phase(cb, cc, cx, cw, gt0, NT); }
}

#define XB_TMO      128
#define XB_XCNT(j)  (256  + 64 * (j))
#define XB_XSUB(j)  (1280 + 64 * (j))
#define XB_XGEN(j)  (2304 + 64 * (j))
#define XB_TOP      3328
#define XB_TOPGEN   3392
#define XCD_BAR_WORDS 3456
#define XB_SPIN_CAP (1u << 18)
__device__ __forceinline__ unsigned xb_ld(unsigned* p)              { return __hip_atomic_load(p, __ATOMIC_RELAXED, __HIP_MEMORY_SCOPE_AGENT); }
__device__ __forceinline__ unsigned xb_add(unsigned* p, unsigned v) { return __hip_atomic_fetch_add(p, v, __ATOMIC_RELAXED, __HIP_MEMORY_SCOPE_AGENT); }
__device__ __forceinline__ unsigned xb_xcc_id() { return (unsigned)__builtin_amdgcn_s_getreg((3 << 11) | 20) & 0xFu; }
#define XB_SPIN(cond, bar) do { unsigned _sp = 0; while (cond) { __builtin_amdgcn_s_sleep(1); \
    if ((++_sp & 255u) == 0u) { if (xb_ld(&(bar)[XB_TMO])) break; if (_sp > XB_SPIN_CAP) { atomicAdd(&(bar)[XB_TMO], 1u); break; } } } } while (0)
struct XcdBarrier { unsigned* bar; unsigned x; volatile LAS unsigned* st; };
__device__ __forceinline__ XcdBarrier xcd_barrier_post(unsigned* bar, volatile LAS unsigned* st, int tid) {
    XcdBarrier b; b.bar = bar; b.x = xb_xcc_id(); b.st = st;
    if (tid == 0) (void)xb_add(&bar[XB_XCNT(b.x)], 1u);
    return b;
}
__device__ __forceinline__ void xcd_barrier_complete(unsigned* bar, unsigned x, unsigned& nloc, unsigned& nx) {
    const unsigned G = gridDim.x * gridDim.y * gridDim.z;
    unsigned sum, cnt, mine, sp = 0u;
    for (;;) {
        sum = 0u; cnt = 0u; mine = 0u;
#pragma unroll
        for (unsigned j = 0; j < 16; ++j) { const unsigned c = xb_ld(&bar[XB_XCNT(j)]); sum += c; cnt += (c > 0u) ? 1u : 0u; mine = (j == x) ? c : mine; }
        if (sum == G) break;
        __builtin_amdgcn_s_sleep(1);
        if ((++sp & 255u) == 0u) { if (xb_ld(&bar[XB_TMO])) break; if (sp > XB_SPIN_CAP) { atomicAdd(&bar[XB_TMO], 1u); break; } }
    }
    nloc = mine > 0u ? mine : 1u; nx = cnt > 0u ? cnt : 1u;
}
__device__ __forceinline__ void xcd_barrier(const XcdBarrier& b, bool leader) {
    asm volatile("s_waitcnt vmcnt(0)" ::: "memory");
    __syncthreads();
    if (leader) {
        unsigned* bar = b.bar;
        __builtin_amdgcn_s_waitcnt(0);
        unsigned nloc = b.st[0], nx = b.st[1];
        if (nloc == 0u) { xcd_barrier_complete(bar, b.x, nloc, nx); b.st[0] = nloc; b.st[1] = nx; }
        const unsigned old = xb_add(&bar[XB_XSUB(b.x)], 1u);
        const unsigned gen = old / nloc;
        if (old + 1u == (gen + 1u) * nloc) {
            __builtin_amdgcn_fence(__ATOMIC_RELEASE, "agent");
            asm volatile("s_waitcnt vmcnt(0)" ::: "memory");
            const unsigned og = xb_add(&bar[XB_TOP], 1u);
            const unsigned tg = og / nx;
            if (og + 1u == (tg + 1u) * nx) xb_add(&bar[XB_TOPGEN], 1u);
            else XB_SPIN(xb_ld(&bar[XB_TOPGEN]) == tg, bar);
            __builtin_amdgcn_fence(__ATOMIC_ACQUIRE, "agent");
            xb_add(&bar[XB_XGEN(b.x)], 1u);
            asm volatile("s_waitcnt vmcnt(0)" ::: "memory");
        } else {
            XB_SPIN(xb_ld(&bar[XB_XGEN(b.x)]) == gen, bar);
            __builtin_amdgcn_fence(__ATOMIC_ACQUIRE, "agent");
            asm volatile("s_waitcnt vmcnt(0)" ::: "memory");
        }
    }
    __syncthreads();
}

#define XB_DONE XCD_BAR_WORDS
#define XB_PANEL (XCD_BAR_WORDS + 64)
#define XB_ALL   (XB_PANEL + 64 * 64)
__device__ unsigned g_bar[XB_ALL];
__device__ __forceinline__ void panel_barrier(unsigned* ctr, unsigned target, bool leader) {
    asm volatile("s_waitcnt vmcnt(0)" ::: "memory");
    __syncthreads();
    if (leader) {
        (void)xb_add(ctr, 1u);
        unsigned sp = 0u;
        while (xb_ld(ctr) < target) { __builtin_amdgcn_s_sleep(1); if (++sp > XB_SPIN_CAP) break; }
        __builtin_amdgcn_fence(__ATOMIC_ACQUIRE, "agent");
        asm volatile("s_waitcnt vmcnt(0)" ::: "memory");
    }
    __syncthreads();
}

constexpr int LDS_BYTES = 131072 + 2048;
__global__ void __launch_bounds__(NTHREADS, 2) fwd_kernel(Params p) {
    extern __shared__ __attribute__((aligned(16))) unsigned char lds_raw[];
    LAS unsigned char* lds = (LAS unsigned char*)lds_raw;
    cg::grid_group grid = cg::this_grid();
#define CG_SYNC() do { asm volatile("s_waitcnt vmcnt(0)" ::: "memory"); grid.sync(); if (wave == 0) { __builtin_amdgcn_fence(__ATOMIC_ACQUIRE, "agent"); asm volatile("s_waitcnt vmcnt(0)" ::: "memory"); } __syncthreads(); } while (0)
#define GRID_SYNC_() xcd_barrier(xb, leader)
    unsigned long long pr_acc = 0, pr_t0 = 0;
#define TIC() do { if (PROBE_MASK) pr_t0 = __builtin_amdgcn_s_memrealtime(); } while (0)
#define TOC(bit) do { if (PROBE_MASK & (bit)) pr_acc += __builtin_amdgcn_s_memrealtime() - pr_t0; } while (0)
#define GRID_SYNC() do { TIC(); GRID_SYNC_(); TOC(2 | sync_kind); } while (0)
    int sync_kind = 128;
    const int tid0 = threadIdx.x, wave = __builtin_amdgcn_readfirstlane(tid0 >> 6);
    const int G = gridDim.x, bx = blockIdx.x;
    const int gw = bx * NWAVES + wave, NGW = G * NWAVES, NT = G * NTHREADS;
    unsigned char* ws = p.ws;
    float* mod = (float*)(ws + WS_CTL);
    bf16_t* Rh = (bf16_t*)(ws + R_H); bf16_t* Rq = (bf16_t*)(ws + R_Q); bf16_t* Rk = (bf16_t*)(ws + R_K); bf16_t* Rv = (bf16_t*)(ws + R_V);
    bf16_t* Rcb = (bf16_t*)(ws + R_CB); bf16_t* Rcc = (bf16_t*)(ws + R_CC); bf16_t* Rcx = (bf16_t*)(ws + R_CX);
    const unsigned char* wl = ws + WS_W;

    unsigned* barw = g_bar;
    volatile LAS unsigned* bst = (volatile LAS unsigned*)(lds + 131072);
    const bool leader = (wave == 0) && (lane_id_opaque() == 0);
    if (leader) { bst[0] = 0u; bst[1] = 0u; bst[2] = 0u; }
    const XcdBarrier xb = xcd_barrier_post(barw, bst, leader ? 0 : 1);
    if (G == 0x7fffffff) CG_SYNC();
    TIC();
    phase0(p, lds, gw, NGW, wave, lane_id_opaque(), 0, true);
    TOC(16);
    GRID_SYNC();
    TIC();
    {
        const int gt = bx * NTHREADS + wave * 64 + lane_id_opaque();
        for (int it = gt; it < 2 * 4 * 1536; it += NT) {
            const int l = it / 6144, r = it % 6144, b = r / 1536, n4 = r % 1536;
            f32x4 a = *(const f32x4*)(p.in[3] + l * 6144 + n4 * 4);
            const float* mp = (const float*)(ws + R_CX) + ((size_t)(l * 32) * 4 + b) * 6144 + n4 * 4;
#pragma unroll 8
            for (int kc = 0; kc < 32; ++kc) a += *(const f32x4*)(mp + (size_t)kc * 4 * 6144);
            *(f32x4*)(mod + (size_t)(l * 4 + b) * 6144 + n4 * 4) = a;
        }
    }
    TOC(16);
    if (G == 256) {
        LAS float* tab = (LAS float*)(lds + 1024);
        const int t = wave * 64 + lane_id_opaque();
#pragma unroll 1
        for (int k = 0; k < 2; ++k) {
            const int idx = t + 512 * k, sel = idx >> 9, n4 = idx & 511, b = (bx >> 7) + 2 * sel;
            f32x4 a = *(const f32x4*)(p.in[3] + n4 * 4);
            const float* mp = (const float*)(ws + R_CX) + (size_t)b * 6144 + n4 * 4;
#pragma unroll 8
            for (int kc = 0; kc < 32; ++kc) a += *(const f32x4*)(mp + (size_t)kc * 4 * 6144);
            *(LAS f32x4*)(tab + sel * 2048 + n4 * 4) = a;
        }
        __syncthreads();
        TIC(); norm_phase(p.in[0], p.in[4], mod, 0, 1024, Rh, gw, NGW, true, true, tab); TOC(8); sync_kind = 128;
    } else {
        GRID_SYNC();
        TIC(); norm_phase(p.in[0], p.in[4], mod, 0, 1024, Rh, gw, NGW, true); TOC(8); sync_kind = 128;
    }
    GRID_SYNC();

#pragma unroll 1
    for (int l = 0; l < DEPTH; ++l) {
        const float* modl = mod + (size_t)l * 4 * 6144;
        const float* xin = (l == 0) ? p.in[0] : p.out;
        { pg8::SchedPlain S; S.T.init(M, 6144); S.G = G; S.c = bx; S.A = (const char*)Rh; S.B = (const char*)(wl + W_IN); S.tstep = (size_t)256 * D * 2;
          pg8::EpiQKV E{Rq, p.in[6] + l * HD, p.in[7] + l * HD};
          TIC(); pg8::gemm_phase(lds, D, S, E, wave); TOC(1); sync_kind = 32; }
        GRID_SYNC();
        const bool fuse_norm2 = (G == 256);
        float* biasgu = (float*)(ws + WS_CTL + 256 * 1024);
        float* ssqp = (float*)(ws + R_CC);
        TIC();
        if (fuse_norm2) bias_phase((const bf16_t*)(wl + W_GU), modl + 3072, biasgu, gw, NGW);
        mixer_phase(Rq, Rk, Rv, Rcb, Rcc, Rcx, p.in[8] + (size_t)l * 3 * D, G, bx, wave, bx * NTHREADS + wave * 64, NT); TOC(4); sync_kind = 64;
        GRID_SYNC();
        { pg8::SchedBranch S; S.T.init(M, D); S.G = G; S.c = bx; S.ws = (const char*)ws; S.wl = (const char*)wl; S.tstep = (size_t)256 * D * 2;
          pg8::EpiBranch E{Rv, Rk};
          TIC(); pg8::gemm_phase(lds, D, S, E, wave); TOC(1); sync_kind = 32; }
        if (G == 256) {
            pg8::TileOrder T4; T4.init(M, D); int pm4, pn4; T4.map(bx, pm4, pn4);
            panel_barrier(barw + XB_PANEL + 64 * pm4, 4u * (unsigned)(l + 1), leader);
        } else GRID_SYNC();
        if (fuse_norm2) {
          { pg8::SchedPlain S; S.T.init(M, D); S.G = G; S.c = bx; S.A = (const char*)Rk; S.B = (const char*)(wl + W_O); S.tstep = (size_t)256 * D * 2;
            pg8::EpiResidNorm E{xin, p.out, modl + 2048, p.in[12] + l * D, modl + 4096, Rh, ssqp};
            TIC(); pg8::gemm_phase(lds, D, S, E, wave); TOC(1); sync_kind = 32; }
          GRID_SYNC();
          { pg8::SchedPlain S; S.T.init(M, 2 * FF); S.G = G; S.c = bx; S.A = (const char*)Rh; S.B = (const char*)(wl + W_GU); S.tstep = (size_t)256 * D * 2;
            LAS float* rtab = (LAS float*)(lds + 131072 + 64);
            { pg8::Unit u0; if (S.next(0, u0)) { const int t = wave * 64 + lane_id_opaque();
                if (t < 256) { const float* sp = ssqp + (size_t)(u0.pm * 256 + t) * 16; const f32x4 a = *(const f32x4*)sp, b4 = *(const f32x4*)(sp + 4), c = *(const f32x4*)(sp + 8), d = *(const f32x4*)(sp + 12);
                    const float ss = (((a[0] + a[1]) + (a[2] + a[3])) + ((b4[0] + b4[1]) + (b4[2] + b4[3]))) + (((c[0] + c[1]) + (c[2] + c[3])) + ((d[0] + d[1]) + (d[2] + d[3])));
                    rtab[t] = 1.0f / sqrtf(ss * (1.0f / D) + EPS); } } }
            __syncthreads();
            pg8::EpiGUNorm E{Rq, biasgu, rtab};
            TIC(); pg8::gemm_phase(lds, D, S, E, wave); TOC(1); sync_kind = 32; }
          GRID_SYNC();
        } else {
        { pg8::SchedPlain S; S.T.init(M, D); S.G = G; S.c = bx; S.A = (const char*)Rk; S.B = (const char*)(wl + W_O); S.tstep = (size_t)256 * D * 2;
          pg8::EpiResid E{xin, p.out, modl + 2048};
          TIC(); pg8::gemm_phase(lds, D, S, E, wave); TOC(1); sync_kind = 32; }
        GRID_SYNC();
        TIC(); norm_phase(p.out, p.in[12] + l * D, modl, 3072, 4096, Rh, gw, NGW, true); TOC(8); sync_kind = 128;
        GRID_SYNC();
        { pg8::SchedPlain S; S.T.init(M, 2 * FF); S.G = G; S.c = bx; S.A = (const char*)Rh; S.B = (const char*)(wl + W_GU); S.tstep = (size_t)256 * D * 2;
          pg8::EpiGU E{Rq};
          TIC(); pg8::gemm_phase(lds, D, S, E, wave); TOC(1); sync_kind = 32; }
        GRID_SYNC();
        }
        { pg8::SchedPlain S; S.T.init(M, D); S.G = G; S.c = bx; S.A = (const char*)Rq; S.B = (const char*)(wl + W_D); S.tstep = (size_t)256 * FF * 2;
          pg8::EpiResid E{p.out, p.out, modl + 5120};
          TIC(); pg8::gemm_phase(lds, FF, S, E, wave); TOC(1); sync_kind = 32; }
        if (l + 1 < DEPTH) {
            GRID_SYNC();
            TIC();
            phase0(p, lds, gw, NGW, wave, lane_id_opaque(), l + 1, false);
            norm_phase(p.out, p.in[4] + (l + 1) * D, mod + (size_t)(l + 1) * 4 * 6144, 0, 1024, Rh, gw, NGW, true);
            TOC(8); sync_kind = 128;
            GRID_SYNC();
        }
    }
    asm volatile("s_waitcnt vmcnt(0)" ::: "memory");
    if (leader) { const unsigned old = xb_add(&barw[XB_DONE], 1u); bst[2] = (old + 1u == (unsigned)G) ? 1u : 0u; }
    __syncthreads();
    if (bst[2]) { const int t = wave * 64 + lane_id_opaque(); for (int i = t; i < XB_ALL; i += NTHREADS) __hip_atomic_store(&barw[i], 0u, __ATOMIC_RELAXED, __HIP_MEMORY_SCOPE_AGENT); }
    if (PROBE_MASK && bx == 0 && leader) { const unsigned long long t = __builtin_amdgcn_s_memrealtime(); while (__builtin_amdgcn_s_memrealtime() - t < pr_acc) __builtin_amdgcn_s_sleep(8); }
}

extern "C" void kernel_launch(void* const* d_in, const int* in_sizes, int n_in, void* d_out, int out_size, void* d_ws, size_t ws_size, hipStream_t stream) {
    static int grid_blocks = 0;
    if (grid_blocks == 0) {
        if (n_in != 16 || out_size != M * D || ws_size < WS_END) { fprintf(stderr, "kernel_launch: unexpected shapes (n_in %d out %d ws %zu need %zu)\n", n_in, out_size, ws_size, (size_t)WS_END); grid_blocks = -1; return; }
        int dev = 0, cus = 0, per_cu = 0;
        hipGetDevice(&dev);
        hipDeviceGetAttribute(&cus, hipDeviceAttributeMultiprocessorCount, dev);
        hipFuncSetAttribute((const void*)fwd_kernel, hipFuncAttributeMaxDynamicSharedMemorySize, LDS_BYTES);
        hipOccupancyMaxActiveBlocksPerMultiprocessor(&per_cu, (const void*)fwd_kernel, NTHREADS, LDS_BYTES);
        (void)hipGetLastError();
        if (per_cu < 1) { fprintf(stderr, "kernel_launch: occupancy query says %d blocks per CU\n", per_cu); per_cu = 1; }
        grid_blocks = cus;
    }
    if (grid_blocks < 0) return;
    Params p{};
    for (int i = 0; i < 16; ++i) p.in[i] = (const float*)d_in[i];
    p.out = (float*)d_out; p.ws = (unsigned char*)d_ws;
    void* args[] = {&p};
    hipError_t e = hipLaunchCooperativeKernel((const void*)fwd_kernel, dim3(grid_blocks), dim3(NTHREADS), args, LDS_BYTES, stream);
    if (e != hipSuccess) fprintf(stderr, "cooperative launch failed: %s (grid %d)\n", hipGetErrorString(e), grid_blocks);
}
```

```cpp
#include <hip/hip_runtime.h>
#include <hip/hip_cooperative_groups.h>
#include <cstdio>
#include <cstdint>
namespace cg = cooperative_groups;
#ifndef PROBE_MASK
#define PROBE_MASK 0
#endif

#define LAS __attribute__((address_space(3)))
typedef unsigned short bf16_t;
typedef short bf16x8 __attribute__((ext_vector_type(8)));
typedef short s16x4 __attribute__((ext_vector_type(4)));
typedef float f32x4 __attribute__((ext_vector_type(4)));
typedef float f32x16 __attribute__((ext_vector_type(16)));
typedef unsigned u32x4 __attribute__((ext_vector_type(4)));
typedef unsigned u32x2 __attribute__((ext_vector_type(2)));
typedef float f32x2_t __attribute__((ext_vector_type(2)));
typedef __bf16 bf16x2_t __attribute__((ext_vector_type(2)));

constexpr int D = 1024, NB = 4, SEQ = 4096, M = NB * SEQ, NH = 16, HD = 64, FF = 2816, INW = 8192, DEPTH = 2;
constexpr float EPS = 1e-6f;
constexpr float LOG2E = 1.4426950408889634f;
constexpr float C2 = 0.125f * LOG2E;
constexpr int NWAVES = 8, NTHREADS = 512;

constexpr size_t MiB = 1u << 20;
constexpr size_t WS_CTL = 0, CTL_BYTES = 256 * 1024;
constexpr size_t WS_W = 1 * MiB;
constexpr size_t W_IN = 0, W_A = 16 * MiB, W_B = 18 * MiB, W_O = 20 * MiB, W_GU = 22 * MiB, W_D = 33 * MiB, W_LAYER = 38 * MiB + 512 * 1024;
constexpr size_t WS_ACT = 40 * MiB;
constexpr size_t REG = 32 * MiB;
constexpr size_t R_H = WS_ACT, R_Q = WS_ACT + REG, R_K = WS_ACT + 2 * REG, R_V = WS_ACT + 3 * REG, R_CB = WS_ACT + 4 * REG, R_CC = WS_ACT + 5 * REG, R_CX = WS_ACT + 6 * REG, WS_END = WS_ACT + 7 * REG;
static_assert(WS_W + W_LAYER <= WS_ACT, "weights");
static_assert((size_t)M * FF * 2 <= 3 * REG, "ffn hidden fits R_Q..R_V");
static_assert(WS_END <= 279028736, "workspace >= sum of the inputs' bytes");

__device__ __forceinline__ unsigned cvt_pk(float lo, float hi) { f32x2_t v = {lo, hi}; bf16x2_t b = __builtin_convertvector(v, bf16x2_t); return __builtin_bit_cast(unsigned, b); }
__device__ __forceinline__ float bf_lo(unsigned u) { return __uint_as_float(u << 16); }
__device__ __forceinline__ float bf_hi(unsigned u) { return __uint_as_float(u & 0xffff0000u); }
__device__ __forceinline__ float shx(float v, int o, int lane) { return __int_as_float(__builtin_amdgcn_ds_bpermute((lane ^ o) << 2, __float_as_int(v))); }
__device__ __forceinline__ float wave_sum(float v, int lane) {
#pragma unroll
    for (int o = 1; o < 64; o <<= 1) v += shx(v, o, lane);
    return v;
}
__device__ __forceinline__ int lane_id_opaque() { int l; asm volatile("v_mbcnt_lo_u32_b32 %0, -1, 0\n\tv_mbcnt_hi_u32_b32 %0, -1, %0" : "=v"(l)); return l; }
__device__ __forceinline__ float fast_exp2(float x) { return __builtin_amdgcn_exp2f(x); }
__device__ __forceinline__ float fast_log2(float x) { return __builtin_amdgcn_logf(x); }
__device__ __forceinline__ float fast_rcp(float x) { return __builtin_amdgcn_rcpf(x); }
__device__ __forceinline__ float sigmoidf_(float x) { return fast_rcp(1.0f + fast_exp2(-x * LOG2E)); }

namespace pg8 {
constexpr int BM = 256, BK = 64, HALF = 128, HTB = HALF * BK * 2, STAGE_BYTES = 8 * HTB, NXCD = 8, WGM = 8;
__host__ __device__ __forceinline__ int lds_byte(int r, int c) { const int st = (r >> 4) * 2 + (c >> 5), rr = r & 15, cc = c & 31, ob = rr * 64 + cc * 2; return st * 1024 + (ob ^ (((ob >> 9) & 1) << 5)); }
__host__ __device__ __forceinline__ void stage_rc(int b, int& R, int& C) { const int st = b / 1024, sb = b % 1024, swz = sb ^ (((sb >> 9) & 1) << 5); R = (st >> 1) * 16 + swz / 64; C = (st & 1) * 32 + (swz % 64) / 2; }

struct Unit { const char* A; const char* B; int pm, pn, kind; };

struct TileOrder {
    int nM, nN, nwg;
    __device__ __forceinline__ void init(int Mr, int N) { nM = Mr / BM; nN = N / BM; nwg = nM * nN; }
    __device__ __forceinline__ void map(int wgid, int& pm, int& pn) const {
        { const int q = nwg / NXCD, r = nwg % NXCD, xcd = wgid % NXCD, off = wgid / NXCD; wgid = (xcd < r ? xcd * (q + 1) : r * (q + 1) + (xcd - r) * q) + off; }
        const int nig = WGM * nN, gid = wgid / nig, fm = gid * WGM, gsz = (nM - fm) < WGM ? (nM - fm) : WGM;
        pm = fm + ((wgid % nig) % gsz); pn = (wgid % nig) / gsz;
    }
};
struct SchedPlain {
    TileOrder T; int G, c; const char* A; const char* B; size_t tstep;
    __device__ __forceinline__ bool next(int i, Unit& u) const {
        const long L = (long)i * G + c; if (L >= T.nwg) return false;
        T.map((int)L, u.pm, u.pn); u.A = A + (size_t)u.pm * tstep; u.B = B + (size_t)u.pn * tstep; u.kind = 0; return true;
    }
};
struct SchedBranch {
    TileOrder T; int G, c; const char* ws; const char* wl; size_t tstep;
    __device__ __forceinline__ bool next(int i, Unit& u) const {
        const long L = (long)(i >> 2) * G + c; if (L >= T.nwg) return false;
        T.map((int)L, u.pm, u.pn); const int sub = i & 3; u.kind = sub;
        const size_t oa = (sub == 1) ? R_Q : ((sub == 3) ? R_CB : R_H);
        const size_t ob = (sub == 0) ? (W_IN + (size_t)6144 * D * 2) : (sub == 1) ? W_A : (sub == 2) ? (W_IN + (size_t)7168 * D * 2) : W_B;
        u.A = ws + oa + (size_t)u.pm * tstep; u.B = wl + ob + (size_t)u.pn * tstep; return true;
    }
};

template <class Epi, class Sched>
__device__ __forceinline__ void gemm_phase(LAS unsigned char* lds, const int K, const Sched& S, const Epi& E, const int wid) {
    const int lane = lane_id_opaque(), tid = wid * 64 + lane, wr = wid >> 2, wc = wid & 3, fr = lane & 15, fq = lane >> 4;
    const int nt = K / BK;
    unsigned voff[2];
#pragma unroll
    for (int i = 0; i < 2; ++i) { int R, C; stage_rc(tid * 16 + i * 8192, R, C); voff[i] = (unsigned)(R * K + C) * 2u; }
    const size_t kstep = (size_t)(BK * 2);
    const size_t hstep = (size_t)HALF * K * 2;
    const unsigned ldsw = (unsigned)wid * 1024u;
    const int aoff = lds_byte(wr * 64 + fr, fq * 8), boff = lds_byte(wc * 32 + fr, fq * 8);
#define PG8_SA(b, h) (((b) * 2 + (h)) * HTB)
#define PG8_SB(b, h) ((4 + (b) * 2 + (h)) * HTB)
#define PG8_STAGE(bufoff, gbase) do { _Pragma("unroll") for (int _i = 0; _i < 2; ++_i) \
        __builtin_amdgcn_global_load_lds((const unsigned*)((const char*)(gbase) + voff[_i]), (LAS unsigned*)(lds + (bufoff) + ldsw + _i * 8192), 16, 0, 0); } while (0)
#define PG8_LDA(dst, b, h) do { _Pragma("unroll") for (int m = 0; m < 4; ++m) _Pragma("unroll") for (int k = 0; k < 2; ++k) dst[m][k] = *(const LAS bf16x8*)(lds + PG8_SA(b, h) + aoff + m * 2048 + k * 1024); } while (0)
#define PG8_LDB(dst, b, h) do { _Pragma("unroll") for (int n = 0; n < 2; ++n) _Pragma("unroll") for (int k = 0; k < 2; ++k) dst[n][k] = *(const LAS bf16x8*)(lds + PG8_SB(b, h) + boff + n * 2048 + k * 1024); } while (0)
#define PG8_MMA(ai, bj, At, Bt) do { __builtin_amdgcn_s_setprio(1); _Pragma("unroll") for (int m = 0; m < 4; ++m) _Pragma("unroll") for (int n = 0; n < 2; ++n) _Pragma("unroll") for (int k = 0; k < 2; ++k) \
        acc[ai][bj][m][n] = __builtin_amdgcn_mfma_f32_16x16x32_bf16(Bt[n][k], At[m][k], acc[ai][bj][m][n], 0, 0, 0); __builtin_amdgcn_s_setprio(0); } while (0)
#define PG8_WAIT_V(n) asm volatile("s_waitcnt vmcnt(" #n ")" ::: "memory")
#define PG8_WAIT_L(n) asm volatile("s_waitcnt lgkmcnt(" #n ")" ::: "memory")
#define PG8_BAR __builtin_amdgcn_s_barrier()
#define PG8_SCHED __builtin_amdgcn_sched_barrier(0)
    Unit cur, nxt; int ui = 0;
    if (!S.next(0, cur)) return;
    f32x4 acc[2][2][4][2];
#pragma unroll
    for (int a = 0; a < 2; ++a)
#pragma unroll
        for (int b = 0; b < 2; ++b)
#pragma unroll
            for (int m = 0; m < 4; ++m)
#pragma unroll
                for (int n = 0; n < 2; ++n) acc[a][b][m][n] = (f32x4){0.f, 0.f, 0.f, 0.f};
    bf16x8 At[4][2], B0[2][2], B1[2][2];
    const char* cA = cur.A; const char* cB = cur.B;
    PG8_STAGE(PG8_SB(0, 0), cB); PG8_STAGE(PG8_SB(0, 1), cB + hstep); PG8_STAGE(PG8_SA(0, 0), cA); PG8_STAGE(PG8_SA(0, 1), cA + hstep);
    if (wr == 1) PG8_BAR;
    PG8_WAIT_V(2); PG8_BAR;
    PG8_STAGE(PG8_SB(1, 0), cB + kstep); PG8_STAGE(PG8_SA(1, 0), cA + kstep); PG8_STAGE(PG8_SB(1, 1), cB + hstep + kstep);
    PG8_WAIT_V(6); PG8_BAR;
    for (;;) {
        const bool has_next = S.next(ui + 1, nxt);
        const char* nA = has_next ? nxt.A : cA; const char* nB = has_next ? nxt.B : cB;
        for (int t = 0; t < nt; t += 2) {
            const bool last = (t == nt - 2);
            const char* a1 = cA + (size_t)(t + 1) * kstep;
            const char* a2 = last ? nA : cA + (size_t)(t + 2) * kstep; const char* b2 = last ? nB : cB + (size_t)(t + 2) * kstep;
            const char* a3 = a2 + kstep; const char* b3 = b2 + kstep;
            PG8_LDB(B0, 0, 0); PG8_LDB(B1, 0, 1); PG8_SCHED; PG8_LDA(At, 0, 0); PG8_STAGE(PG8_SA(1, 1), a1 + hstep);
            PG8_WAIT_V(8); PG8_WAIT_L(0); PG8_BAR; PG8_MMA(0, 0, At, B0); PG8_MMA(0, 1, At, B1); PG8_BAR; PG8_SCHED;
            PG8_LDA(At, 0, 1); PG8_STAGE(PG8_SB(0, 0), b2); PG8_STAGE(PG8_SB(0, 1), b2 + hstep); PG8_STAGE(PG8_SA(0, 0), a2);
            PG8_WAIT_V(8); PG8_WAIT_L(0); PG8_BAR; PG8_MMA(1, 0, At, B0); PG8_MMA(1, 1, At, B1); PG8_BAR; PG8_SCHED;
            PG8_LDB(B0, 1, 0); PG8_LDB(B1, 1, 1); PG8_SCHED; PG8_LDA(At, 1, 0); PG8_STAGE(PG8_SA(0, 1), a2 + hstep);
            PG8_WAIT_V(8); PG8_WAIT_L(0); PG8_BAR; PG8_MMA(0, 0, At, B0); PG8_MMA(0, 1, At, B1); PG8_BAR; PG8_SCHED;
            PG8_LDA(At, 1, 1); PG8_STAGE(PG8_SB(1, 0), b3); PG8_STAGE(PG8_SB(1, 1), b3 + hstep); PG8_STAGE(PG8_SA(1, 0), a3);
            PG8_WAIT_V(8); PG8_WAIT_L(0); PG8_BAR; PG8_MMA(1, 0, At, B0); PG8_MMA(1, 1, At, B1); PG8_BAR; PG8_SCHED;
        }
        if (wr == 0) PG8_BAR;
        { const int l2 = lane_id_opaque(); E(acc, cur, wr, wc, l2 & 15, l2 >> 4); }
        if (!has_next) break;
#pragma unroll
        for (int a = 0; a < 2; ++a)
#pragma unroll
            for (int b = 0; b < 2; ++b)
#pragma unroll
                for (int m = 0; m < 4; ++m)
#pragma unroll
                    for (int n = 0; n < 2; ++n) acc[a][b][m][n] = (f32x4){0.f, 0.f, 0.f, 0.f};
        cur = nxt; cA = nA; cB = nB; ++ui;
        if (wr == 1) PG8_BAR;
    }
    PG8_WAIT_V(0);
    PG8_BAR;
#undef PG8_SA
#undef PG8_SB
#undef PG8_STAGE
#undef PG8_LDA
#undef PG8_LDB
#undef PG8_MMA
#undef PG8_WAIT_V
#undef PG8_WAIT_L
#undef PG8_BAR
#undef PG8_SCHED
}

__device__ __forceinline__ u32x4 pack8(const f32x4& a, const f32x4& b) { u32x4 w; w.x = cvt_pk(a[0], a[1]); w.y = cvt_pk(a[2], a[3]); w.z = cvt_pk(b[0], b[1]); w.w = cvt_pk(b[2], b[3]); return w; }

struct EpiRegions {
    bf16_t* base;
    __device__ __forceinline__ void operator()(const f32x4 (&acc)[2][2][4][2], const Unit& u, int wr, int wc, int fr, int fq) const {
        bf16_t* dst = base + (size_t)(u.pn >> 2) * ((size_t)M * D);
        const int col = (u.pn & 3) * 256 + wc * 64 + fq * 8, row0 = u.pm * BM + wr * 64 + fr;
#pragma unroll
        for (int ai = 0; ai < 2; ++ai)
#pragma unroll
            for (int m = 0; m < 4; ++m) { bf16_t* rp = dst + (size_t)(row0 + ai * HALF + m * 16) * D + col;
#pragma unroll
                for (int bj = 0; bj < 2; ++bj) *(u32x4*)(rp + bj * 32) = pack8(acc[ai][bj][m][0], acc[ai][bj][m][1]); }
    }
};
struct EpiQKV {
    bf16_t* base; const float* gq; const float* gk;
    __device__ __forceinline__ void operator()(const f32x4 (&acc)[2][2][4][2], const Unit& u, int wr, int wc, int fr, int fq) const {
        const int region = u.pn >> 2, head = (u.pn & 3) * 4 + wc, row0 = u.pm * BM + wr * 64 + fr;
        if (region == 2) {
            const int b = row0 >> 12;
            bf16_t* vb = base + (size_t)2 * M * D + ((size_t)(b * NH + head) * HD) * SEQ;
#pragma unroll
            for (int ai = 0; ai < 2; ++ai)
#pragma unroll
                for (int m = 0; m < 4; ++m) { const int s0 = (row0 + ai * HALF + m * 16) & (SEQ - 1), q = (s0 >> 2) & 3;
                    const int s = (s0 & ~12) | ((((q & 1) << 1) | (q >> 1)) << 2);
#pragma unroll
                    for (int bj = 0; bj < 2; ++bj)
#pragma unroll
                        for (int n = 0; n < 2; ++n)
#pragma unroll
                            for (int j = 0; j < 4; ++j) { const int d = bj * 32 + fq * 8 + n * 4 + j; const unsigned w = cvt_pk(acc[ai][bj][m][n][j], 0.f);
                                vb[(size_t)d * SEQ + s] = (bf16_t)(w & 0xffffu); } }
        } else if (region >= 3) {
            bf16_t* dst = base + (size_t)region * ((size_t)M * D);
            const int col = (u.pn & 3) * 256 + wc * 64 + fq * 8;
#pragma unroll
            for (int ai = 0; ai < 2; ++ai)
#pragma unroll
                for (int m = 0; m < 4; ++m) { bf16_t* rp = dst + (size_t)(row0 + ai * HALF + m * 16) * D + col;
#pragma unroll
                    for (int bj = 0; bj < 2; ++bj) *(u32x4*)(rp + bj * 32) = pack8(acc[ai][bj][m][0], acc[ai][bj][m][1]); }
        } else {
            const float* g = region == 0 ? gq : gk; const float sc = region == 0 ? C2 : 1.0f;
            bf16_t* dst = base + (size_t)region * ((size_t)M * D);
            f32x4 gv[2][2];
#pragma unroll
            for (int bj = 0; bj < 2; ++bj)
#pragma unroll
                for (int n = 0; n < 2; ++n) gv[bj][n] = *(const f32x4*)(g + bj * 32 + fq * 8 + n * 4) * sc;
            const int col = head * 64 + fq * 8;
#pragma unroll
            for (int ai = 0; ai < 2; ++ai)
#pragma unroll
                for (int m = 0; m < 4; ++m) {
                    float ss = 0.f;
#pragma unroll
                    for (int bj = 0; bj < 2; ++bj)
#pragma unroll
                        for (int n = 0; n < 2; ++n) { const f32x4 x = acc[ai][bj][m][n]; ss += (x[0] * x[0] + x[1] * x[1]) + (x[2] * x[2] + x[3] * x[3]); }
                    ss += shx(ss, 16, fr + 16 * fq); ss += shx(ss, 32, fr + 16 * fq);
                    const float r = 1.0f / sqrtf(ss * (1.0f / 64.0f) + EPS);
                    bf16_t* rp = dst + (size_t)(row0 + ai * HALF + m * 16) * D + col;
#pragma unroll
                    for (int bj = 0; bj < 2; ++bj) { const f32x4 a = acc[ai][bj][m][0] * r * gv[bj][0], b2 = acc[ai][bj][m][1] * r * gv[bj][1]; *(u32x4*)(rp + bj * 32) = pack8(a, b2); }
                }
        }
    }
};
struct EpiBranch {
    bf16_t* S1; bf16_t* TM;
    __device__ __forceinline__ void operator()(const f32x4 (&acc)[2][2][4][2], const Unit& u, int wr, int wc, int fr, int fq) const {
        const int col = u.pn * 256 + wc * 64 + fq * 8, row0 = u.pm * BM + wr * 64 + fr, kind = u.kind;
#pragma unroll
        for (int ai = 0; ai < 2; ++ai) {
            if (kind == 0 || kind == 2) {
#pragma unroll
                for (int m = 0; m < 4; ++m) { const size_t off = (size_t)(row0 + ai * HALF + m * 16) * D + col;
#pragma unroll
                    for (int bj = 0; bj < 2; ++bj) { f32x4 a = acc[ai][bj][m][0], b = acc[ai][bj][m][1];
#pragma unroll
                        for (int j = 0; j < 4; ++j) { a[j] = sigmoidf_(a[j]); b[j] = sigmoidf_(b[j]); }
                        *(u32x4*)(S1 + off + bj * 32) = pack8(a, b); } }
            } else {
#pragma unroll
              for (int mh = 0; mh < 2; ++mh) {
                u32x4 g[2][2], t[2][2];
#pragma unroll
                for (int m2 = 0; m2 < 2; ++m2) { const int m = 2 * mh + m2; const size_t off = (size_t)(row0 + ai * HALF + m * 16) * D + col;
#pragma unroll
                    for (int bj = 0; bj < 2; ++bj) { g[m2][bj] = *(const u32x4*)(S1 + off + bj * 32); if (kind == 3) t[m2][bj] = *(const u32x4*)(TM + off + bj * 32); else t[m2][bj] = (u32x4){0u, 0u, 0u, 0u}; } }
#pragma unroll
                for (int m2 = 0; m2 < 2; ++m2) { const int m = 2 * mh + m2; const size_t off = (size_t)(row0 + ai * HALF + m * 16) * D + col;
#pragma unroll
                    for (int bj = 0; bj < 2; ++bj) { f32x4 a = acc[ai][bj][m][0], b = acc[ai][bj][m][1]; const u32x4 gg = g[m2][bj], tt = t[m2][bj];
                        a[0] = a[0] * bf_lo(gg.x) + bf_lo(tt.x); a[1] = a[1] * bf_hi(gg.x) + bf_hi(tt.x); a[2] = a[2] * bf_lo(gg.y) + bf_lo(tt.y); a[3] = a[3] * bf_hi(gg.y) + bf_hi(tt.y);
                        b[0] = b[0] * bf_lo(gg.z) + bf_lo(tt.z); b[1] = b[1] * bf_hi(gg.z) + bf_hi(tt.z); b[2] = b[2] * bf_lo(gg.w) + bf_lo(tt.w); b[3] = b[3] * bf_hi(gg.w) + bf_hi(tt.w);
                        if (kind == 3) { const u32x4 pk = pack8(a, b); asm volatile("global_store_dwordx4 %0, %1, off sc1\n\ts_nop 1" :: "v"(TM + off + bj * 32), "v"(pk) : "memory"); }
                        else *(u32x4*)(TM + off + bj * 32) = pack8(a, b); } }
              }
            }
        }
    }
};
struct EpiResid {
    const float* xin; float* xout; const float* gmod;
    __device__ __forceinline__ void operator()(const f32x4 (&acc)[2][2][4][2], const Unit& u, int wr, int wc, int fr, int fq) const {
        const int col = u.pn * 256 + wc * 64 + fq * 8, row0 = u.pm * BM + wr * 64 + fr, b = row0 >> 12;
        f32x4 gv[2][2];
#pragma unroll
        for (int bj = 0; bj < 2; ++bj)
#pragma unroll
            for (int n = 0; n < 2; ++n) gv[bj][n] = *(const f32x4*)(gmod + b * 6144 + col + bj * 32 + n * 4);
#pragma unroll
        for (int ai = 0; ai < 2; ++ai)
#pragma unroll
          for (int mh = 0; mh < 2; ++mh) {
            f32x4 xo[2][2][2];
#pragma unroll
            for (int m2 = 0; m2 < 2; ++m2) { const size_t off = (size_t)(row0 + ai * HALF + (2 * mh + m2) * 16) * D + col;
#pragma unroll
                for (int bj = 0; bj < 2; ++bj)
#pragma unroll
                    for (int n = 0; n < 2; ++n) xo[m2][bj][n] = *(const f32x4*)(xin + off + bj * 32 + n * 4); }
#pragma unroll
            for (int m2 = 0; m2 < 2; ++m2) { const size_t off = (size_t)(row0 + ai * HALF + (2 * mh + m2) * 16) * D + col;
#pragma unroll
                for (int bj = 0; bj < 2; ++bj)
#pragma unroll
                    for (int n = 0; n < 2; ++n) *(f32x4*)(xout + off + bj * 32 + n * 4) = xo[m2][bj][n] + gv[bj][n] * acc[ai][bj][2 * mh + m2][n]; }
          }
    }
};
struct EpiGU {
    bf16_t* f;
    __device__ __forceinline__ void operator()(const f32x4 (&acc)[2][2][4][2], const Unit& u, int wr, int wc, int fr, int fq) const {
        const int col = u.pn * 128 + wc * 32 + fq * 8, row0 = u.pm * BM + wr * 64 + fr;
#pragma unroll
        for (int ai = 0; ai < 2; ++ai)
#pragma unroll
            for (int m = 0; m < 4; ++m) {
                f32x4 o[2];
#pragma unroll
                for (int n = 0; n < 2; ++n)
#pragma unroll
                    for (int j = 0; j < 4; ++j) { const float gt = acc[ai][0][m][n][j]; o[n][j] = gt * sigmoidf_(gt) * acc[ai][1][m][n][j]; }
                *(u32x4*)(f + (size_t)(row0 + ai * HALF + m * 16) * FF + col) = pack8(o[0], o[1]);
            }
    }
};
struct EpiResidNorm {
    const float* xin; float* xout; const float* gmod; const float* lng; const float* scmod; bf16_t* An; float* ssq;
    __device__ __forceinline__ void operator()(const f32x4 (&acc)[2][2][4][2], const Unit& u, int wr, int wc, int fr, int fq) const {
        const int col = u.pn * 256 + wc * 64 + fq * 8, row0 = u.pm * BM + wr * 64 + fr, b = row0 >> 12;
        f32x4 gv[2][2], gm[2][2];
#pragma unroll
        for (int bj = 0; bj < 2; ++bj)
#pragma unroll
            for (int n = 0; n < 2; ++n) { const int c = col + bj * 32 + n * 4; gv[bj][n] = *(const f32x4*)(gmod + b * 6144 + c);
                gm[bj][n] = *(const f32x4*)(lng + c) * (*(const f32x4*)(scmod + b * 6144 + c) + 1.0f); }
#pragma unroll
        for (int ai = 0; ai < 2; ++ai)
#pragma unroll
          for (int mh = 0; mh < 2; ++mh) {
            f32x4 xo[2][2][2];
#pragma unroll
            for (int m2 = 0; m2 < 2; ++m2) { const size_t off = (size_t)(row0 + ai * HALF + (2 * mh + m2) * 16) * D + col;
#pragma unroll
                for (int bj = 0; bj < 2; ++bj)
#pragma unroll
                    for (int n = 0; n < 2; ++n) xo[m2][bj][n] = *(const f32x4*)(xin + off + bj * 32 + n * 4); }
#pragma unroll
            for (int m2 = 0; m2 < 2; ++m2) { const int row = row0 + ai * HALF + (2 * mh + m2) * 16; const size_t off = (size_t)row * D + col;
                float ss = 0.f;
#pragma unroll
                for (int bj = 0; bj < 2; ++bj) {
                    f32x4 y[2];
#pragma unroll
                    for (int n = 0; n < 2; ++n) { const f32x4 x1 = xo[m2][bj][n] + gv[bj][n] * acc[ai][bj][2 * mh + m2][n];
                        *(f32x4*)(xout + off + bj * 32 + n * 4) = x1; ss += (x1[0] * x1[0] + x1[1] * x1[1]) + (x1[2] * x1[2] + x1[3] * x1[3]); y[n] = x1 * gm[bj][n]; }
                    *(u32x4*)(An + off + bj * 32) = pack8(y[0], y[1]);
                }
                ss += shx(ss, 16, fr + 16 * fq); ss += shx(ss, 32, fr + 16 * fq);
                if (fq == 0) ssq[(size_t)row * 16 + u.pn * 4 + wc] = ss;
            }
          }
    }
};
struct EpiGUNorm {
    bf16_t* f; const float* bias; LAS const float* rtab;
    __device__ __forceinline__ void operator()(const f32x4 (&acc)[2][2][4][2], const Unit& u, int wr, int wc, int fr, int fq) const {
        const int col = u.pn * 128 + wc * 32 + fq * 8, row0 = u.pm * BM + wr * 64 + fr, b = row0 >> 12;
        f32x4 bg[2], bu[2];
#pragma unroll
        for (int n = 0; n < 2; ++n) { const int a = u.pn * 256 + wc * 32 + n * 16 + fq * 4; bg[n] = *(const f32x4*)(bias + b * (2 * FF) + a); bu[n] = *(const f32x4*)(bias + b * (2 * FF) + a + 128); }
#pragma unroll
        for (int ai = 0; ai < 2; ++ai)
#pragma unroll
            for (int m = 0; m < 4; ++m) {
                const float r = rtab[wr * 64 + fr + ai * HALF + m * 16];
                f32x4 o[2];
#pragma unroll
                for (int n = 0; n < 2; ++n)
#pragma unroll
                    for (int j = 0; j < 4; ++j) { const float gt = acc[ai][0][m][n][j] * r + bg[n][j], up = acc[ai][1][m][n][j] * r + bu[n][j]; o[n][j] = gt * sigmoidf_(gt) * up; }
                { const u32x4 pk = pack8(o[0], o[1]); asm volatile("global_store_dwordx4 %0, %1, off sc1\n\ts_nop 1" :: "v"(f + (size_t)(row0 + ai * HALF + m * 16) * FF + col), "v"(pk) : "memory"); }
            }
    }
};
}

#define LDS_WAIT() asm volatile("s_waitcnt lgkmcnt(0)" ::: "memory")
__device__ __forceinline__ void transpose_item(const float* W, int N, int K, int n0, bf16_t* WT, int a0, int k0, LAS float* scr, int lane) {
    {
        const int kr = lane >> 3, c4 = (lane & 7) * 4;
        f32x4 t[8];
#pragma unroll
        for (int i = 0; i < 8; ++i) t[i] = __builtin_nontemporal_load((const f32x4*)(W + (size_t)(k0 + 8 * i + kr) * N + n0 + c4));
#pragma unroll
        for (int i = 0; i < 8; ++i) { LAS float* d = scr + (8 * i + kr) * 33 + c4; d[0] = t[i][0]; d[1] = t[i][1]; d[2] = t[i][2]; d[3] = t[i][3]; }
    }
    LDS_WAIT(); asm volatile("" ::: "memory");
    const int c = lane & 7;
#pragma unroll
    for (int j = 0; j < 4; ++j) { const int s = (lane >> 3) + 8 * j; const int lo = 8 * ((s >> 2) & 3) + 4 * (s >> 4) + (s & 3);
        const LAS float* sp = scr + (8 * c) * 33 + lo;
        u32x4 o; o.x = cvt_pk(sp[0 * 33], sp[1 * 33]); o.y = cvt_pk(sp[2 * 33], sp[3 * 33]); o.z = cvt_pk(sp[4 * 33], sp[5 * 33]); o.w = cvt_pk(sp[6 * 33], sp[7 * 33]);
        *(u32x4*)(WT + (size_t)(a0 + s) * K + k0 + 8 * c) = o; }
    LDS_WAIT(); asm volatile("" ::: "memory");
}

struct Params { const float* in[16]; float* out; unsigned char* ws; };

__device__ __forceinline__ void phase0(const Params& p, LAS unsigned char* lds, int gw, int NGW, int wave, int lane, const int l, const bool with_mod) {
    LAS float* scr = (LAS float*)(lds + wave * 16384);
    constexpr int I_IN = 256 * 16, I_SQ = 32 * 16, I_GU = 176 * 16, I_D = 32 * 44, I_LAYER = I_IN + 3 * I_SQ + I_GU + I_D;
    constexpr int I_MOD = 2 * 32 * 24;
    for (int it = gw; it < (with_mod ? I_MOD : 0); it += NGW) {
        const int l = it / (32 * 24), r = it % (32 * 24), kc = r / 24, nb = r % 24;
        const float* aw = p.in[2] + (size_t)l * D * 6144 + (size_t)(kc * 32) * 6144 + nb * 256 + lane * 4;
        const float* c = p.in[1];
        f32x4 a[4];
#pragma unroll
        for (int b = 0; b < 4; ++b) a[b] = (f32x4){0.f, 0.f, 0.f, 0.f};
#pragma unroll 8
        for (int k = 0; k < 32; ++k) { const f32x4 w = __builtin_nontemporal_load((const f32x4*)(aw + (size_t)k * 6144));
#pragma unroll
            for (int b = 0; b < 4; ++b) { const float cv = c[b * D + kc * 32 + k]; const float sv = cv * sigmoidf_(cv); a[b] += w * sv; } }
        float* mp = (float*)(p.ws + R_CX) + ((size_t)(l * 32 + kc) * 4) * 6144 + nb * 256 + lane * 4;
#pragma unroll
        for (int b = 0; b < 4; ++b) *(f32x4*)(mp + (size_t)b * 6144) = a[b];
    }
    for (int it = gw; it < I_LAYER; it += NGW) {
        int r = it;
        unsigned char* wl = p.ws + WS_W;
        if (r < I_IN) { const int kb = r / 256, g = r % 256; const int pn = g >> 3, bj = (g >> 2) & 1, wc = g & 3;
            transpose_item(p.in[5] + (size_t)l * D * INW, INW, D, 256 * pn + 64 * wc + 32 * bj, (bf16_t*)(wl + W_IN), 32 * g, 64 * kb, scr, lane); continue; }
        r -= I_IN;
        if (r < 3 * I_SQ) { const int which = r / I_SQ; r %= I_SQ; const int kb = r / 32, g = r % 32; const int pn = g >> 3, bj = (g >> 2) & 1, wc = g & 3;
            const float* src = p.in[9 + which] + (size_t)l * D * D; bf16_t* dst = (bf16_t*)(wl + (which == 0 ? W_A : which == 1 ? W_B : W_O));
            transpose_item(src, D, D, 256 * pn + 64 * wc + 32 * bj, dst, 32 * g, 64 * kb, scr, lane); continue; }
        r -= 3 * I_SQ;
        if (r < I_GU) { const int kb = r / 176, g = r % 176; const int pn = g >> 3, bj = (g >> 2) & 1, wc = g & 3;
            const float* src = p.in[bj ? 14 : 13] + (size_t)l * D * FF;
            transpose_item(src, FF, D, 128 * pn + 32 * wc, (bf16_t*)(wl + W_GU), 32 * g, 64 * kb, scr, lane); continue; }
        r -= I_GU;
        { const int kb = r / 32, g = r % 32; const int pn = g >> 3, bj = (g >> 2) & 1, wc = g & 3;
            transpose_item(p.in[15] + (size_t)l * FF * D, D, FF, 256 * pn + 64 * wc + 32 * bj, (bf16_t*)(wl + W_D), 32 * g, 64 * kb, scr, lane); }
    }
}

__device__ __forceinline__ void norm_phase(const float* x, const float* g, const float* modl, int sh_off, int sc_off, bf16_t* h, int gw, int NGW, const bool stream = false, const bool use_tab = false, const LAS float* tab = nullptr) {
    const int lane = lane_id_opaque();
    for (int q = gw; q < M / 4; q += NGW) {
        const int m0 = 4 * q, b = m0 >> 12;
        f32x4 v[4][4];
#pragma unroll
        for (int r = 0; r < 4; ++r) { const f32x4* xr = (const f32x4*)(x + (size_t)(m0 + r) * D) + lane;
#pragma unroll
            for (int j = 0; j < 4; ++j) v[r][j] = stream ? __builtin_nontemporal_load(xr + 64 * j) : xr[64 * j]; }
        float rs[4];
#pragma unroll
        for (int r = 0; r < 4; ++r) { float s = 0.f;
#pragma unroll
            for (int j = 0; j < 4; ++j) s += (v[r][j][0] * v[r][j][0] + v[r][j][1] * v[r][j][1]) + (v[r][j][2] * v[r][j][2] + v[r][j][3] * v[r][j][3]);
            rs[r] = s; }
#pragma unroll
        for (int o = 1; o < 64; o <<= 1) {
#pragma unroll
            for (int r = 0; r < 4; ++r) rs[r] += shx(rs[r], o, lane); }
#pragma unroll
        for (int r = 0; r < 4; ++r) rs[r] = 1.0f / sqrtf(rs[r] * (1.0f / D) + EPS);
#pragma unroll
        for (int j = 0; j < 4; ++j) { const int col = 4 * (64 * j + lane);
            const f32x4 gg = *(const f32x4*)(g + col);
            const f32x4 sc = (use_tab ? *(const LAS f32x4*)(tab + (b >> 1) * 2048 + sc_off + col) : *(const f32x4*)(modl + b * 6144 + sc_off + col)) + 1.0f;
            const f32x4 sh = use_tab ? *(const LAS f32x4*)(tab + (b >> 1) * 2048 + sh_off + col) : *(const f32x4*)(modl + b * 6144 + sh_off + col);
#pragma unroll
            for (int r = 0; r < 4; ++r) { const f32x4 y = (v[r][j] * rs[r] * gg) * sc + sh;
                u32x2 w; w.x = cvt_pk(y[0], y[1]); w.y = cvt_pk(y[2], y[3]); *((u32x2*)(h + (size_t)(m0 + r) * D) + lane + 64 * j) = w; } }
    }
}

__device__ __forceinline__ void conv_phase(bf16_t* cb, const bf16_t* cc, const bf16_t* cx, const float* cw, int gt0, int NT) {
    const int gt = gt0 + lane_id_opaque();
    for (int it = gt; it < (M / 16) * (D / 8); it += NT) {
        const int c8 = it & 127, run = it >> 7, t0 = run * 16, ch = c8 * 8;
        float w0[8], w1[8], w2[8];
#pragma unroll
        for (int i = 0; i < 8; ++i) { w0[i] = cw[ch + i]; w1[i] = cw[D + ch + i]; w2[i] = cw[2 * D + ch + i]; }
        float um2[8], um1[8];
#pragma unroll
        for (int i = 0; i < 8; ++i) { um2[i] = 0.f; um1[i] = 0.f; }
        if ((t0 & (SEQ - 1)) != 0) {
            const u32x4 a2 = *(const u32x4*)(cc + (size_t)(t0 - 2) * D + ch), b2 = *(const u32x4*)(cx + (size_t)(t0 - 2) * D + ch);
            const u32x4 a1 = *(const u32x4*)(cc + (size_t)(t0 - 1) * D + ch), b1 = *(const u32x4*)(cx + (size_t)(t0 - 1) * D + ch);
#pragma unroll
            for (int i = 0; i < 4; ++i) { um2[2 * i] = bf_lo(a2[i]) * bf_lo(b2[i]); um2[2 * i + 1] = bf_hi(a2[i]) * bf_hi(b2[i]);
                um1[2 * i] = bf_lo(a1[i]) * bf_lo(b1[i]); um1[2 * i + 1] = bf_hi(a1[i]) * bf_hi(b1[i]); }
        }
#pragma unroll 4
        for (int t = 0; t < 16; ++t) {
            const size_t off = (size_t)(t0 + t) * D + ch;
            const u32x4 a = *(const u32x4*)(cc + off), b = *(const u32x4*)(cx + off), e = *(const u32x4*)(cb + off);
            float u[8], y[8];
#pragma unroll
            for (int i = 0; i < 4; ++i) { u[2 * i] = bf_lo(a[i]) * bf_lo(b[i]); u[2 * i + 1] = bf_hi(a[i]) * bf_hi(b[i]); }
#pragma unroll
            for (int i = 0; i < 4; ++i) {
                y[2 * i] = bf_lo(e[i]) * (w0[2 * i] * um2[2 * i] + w1[2 * i] * um1[2 * i] + w2[2 * i] * u[2 * i]);
                y[2 * i + 1] = bf_hi(e[i]) * (w0[2 * i + 1] * um2[2 * i + 1] + w1[2 * i + 1] * um1[2 * i + 1] + w2[2 * i + 1] * u[2 * i + 1]); }
            u32x4 o; o.x = cvt_pk(y[0], y[1]); o.y = cvt_pk(y[2], y[3]); o.z = cvt_pk(y[4], y[5]); o.w = cvt_pk(y[6], y[7]);
            *(u32x4*)(cb + off) = o;
#pragma unroll
            for (int i = 0; i < 8; ++i) { um2[i] = um1[i]; um1[i] = u[i]; }
        }
    }
}

#define MFMA32(a, b, c) __builtin_amdgcn_mfma_f32_32x32x16_bf16((a), (b), (c), 0, 0, 0)
constexpr float SB_EXIT = 1.0e-20f;
__device__ __forceinline__ float clamp_z(float z) { return __builtin_amdgcn_fmed3f(z, -126.0f, 80.0f); }
struct AttnState { f32x16 o0, o1; float P; bf16x8 kf[4]; };
template <bool DIAG>
__device__ __forceinline__ void attn_step(AttnState& st, const bf16x8 (&qf)[4], const bf16_t* kbase, const bf16_t* vbase, int j0, bool more, int n, int hh, int lane) {
    bf16x8 vf[2][2];
#pragma unroll
    for (int mb = 0; mb < 2; ++mb)
#pragma unroll
        for (int s = 0; s < 2; ++s) vf[mb][s] = *(const bf16x8*)(vbase + (size_t)mb * 32 * SEQ + j0 + 16 * s);
    f32x16 sa;
#pragma unroll
    for (int r = 0; r < 16; ++r) sa[r] = 0.f;
#pragma unroll
    for (int kk = 0; kk < 4; ++kk) sa = MFMA32(st.kf[kk], qf[kk], sa);
    if (more) {
#pragma unroll
        for (int kk = 0; kk < 4; ++kk) st.kf[kk] = *(const bf16x8*)(kbase + (size_t)(j0 - 32) * D + kk * 16);
    }
    float om[16], be[16];
#pragma unroll
    for (int r = 0; r < 16; ++r) {
        const float e = fast_exp2(clamp_z(sa[r]));
        float o = fast_rcp(1.0f + e), b = e * o;
        if (DIAG) { const int ki = (r & 3) + 8 * (r >> 2) + 4 * hh; if (ki >= n) { o = 1.0f; b = 0.f; } }
        om[r] = o; be[r] = b;
    }
    float g[4], pg[4];
#pragma unroll
    for (int q = 0; q < 4; ++q) g[q] = (om[4 * q] * om[4 * q + 1]) * (om[4 * q + 2] * om[4 * q + 3]);
#pragma unroll
    for (int q = 0; q < 4; ++q) pg[q] = shx(g[q], 32, lane);
    float run = st.P;
    float a[16];
#pragma unroll
    for (int q = 3; q >= 0; --q) {
        const float c3 = (hh == 0) ? run * pg[q] : run;
        const float c2 = c3 * om[4 * q + 3], c1 = c2 * om[4 * q + 2], c0 = c1 * om[4 * q + 1];
        a[4 * q + 3] = be[4 * q + 3] * c3; a[4 * q + 2] = be[4 * q + 2] * c2; a[4 * q + 1] = be[4 * q + 1] * c1; a[4 * q] = be[4 * q] * c0;
        run *= g[q] * pg[q];
    }
    st.P = run;
#pragma unroll
    for (int s = 0; s < 2; ++s) {
        u32x4 pw; pw.x = cvt_pk(a[8 * s + 0], a[8 * s + 1]); pw.y = cvt_pk(a[8 * s + 2], a[8 * s + 3]); pw.z = cvt_pk(a[8 * s + 4], a[8 * s + 5]); pw.w = cvt_pk(a[8 * s + 6], a[8 * s + 7]);
        const bf16x8 pf = __builtin_bit_cast(bf16x8, pw);
        st.o0 = MFMA32(vf[0][s], pf, st.o0); st.o1 = MFMA32(vf[1][s], pf, st.o1);
    }
}
__device__ __forceinline__ void attn_task(bf16_t* QO, const bf16_t* Kp, const bf16_t* VT, int b, int h, int qblk, int lane) {
    const int n = lane & 31, hh = lane >> 5, t0 = qblk * 32;
    bf16_t* qrow = QO + (size_t)(b * SEQ + t0 + n) * D + h * HD;
    bf16x8 qf[4];
#pragma unroll
    for (int kk = 0; kk < 4; ++kk) qf[kk] = *(const bf16x8*)(qrow + kk * 16 + hh * 8);
    AttnState st;
#pragma unroll
    for (int r = 0; r < 16; ++r) { st.o0[r] = 0.f; st.o1[r] = 0.f; }
    st.P = 1.0f;
    const bf16_t* kbase = Kp + (size_t)(b * SEQ + n) * D + h * HD + hh * 8;
    const bf16_t* vbase = VT + ((size_t)(b * NH + h) * HD + n) * SEQ + 8 * hh;
#pragma unroll
    for (int kk = 0; kk < 4; ++kk) st.kf[kk] = *(const bf16x8*)(kbase + (size_t)t0 * D + kk * 16);
    attn_step<true>(st, qf, kbase, vbase, t0, qblk > 0, n, hh, lane);
    for (int kb = qblk - 1; kb >= 0; --kb) {
        if (!__any(st.P > SB_EXIT)) break;
        attn_step<false>(st, qf, kbase, vbase, kb * 32, kb > 0, n, hh, lane);
    }
#pragma unroll
    for (int q = 0; q < 4; ++q) {
        u32x2 w0, w1; w0.x = cvt_pk(st.o0[4 * q], st.o0[4 * q + 1]); w0.y = cvt_pk(st.o0[4 * q + 2], st.o0[4 * q + 3]); w1.x = cvt_pk(st.o1[4 * q], st.o1[4 * q + 1]); w1.y = cvt_pk(st.o1[4 * q + 2], st.o1[4 * q + 3]);
        *(u32x2*)(qrow + 8 * q + 4 * hh) = w0; *(u32x2*)(qrow + 32 + 8 * q + 4 * hh) = w1;
    }
}
__device__ __forceinline__ void attn_phase(bf16_t* QO, const bf16_t* Kp, const bf16_t* VT, int G, int bx, int wave) {
    const int lane = lane_id_opaque();
    constexpr int NQB = SEQ / 32, NTASK = NB * NH * NQB;
    if (G == 256) {
#pragma unroll 1
        for (int i = 0; i < 4; ++i) { const int bh = 2 * (wave * 4 + i) + (bx & 1); attn_task(QO, Kp, VT, bh / NH, bh % NH, bx >> 1, lane); }
    } else {
        int i = 0;
        for (int tau = bx * NWAVES + wave; tau < NTASK; tau += G * NWAVES, ++i) {
            const int bh = tau / NQB, qr = tau % NQB, qblk = (i & 1) ? (NQB - 1 - qr) : qr;
            attn_task(QO, Kp, VT, bh / NH, bh % NH, qblk, lane);
        }
    }
}
__device__ __forceinline__ void bias_phase(const bf16_t* Wgu, const float* sh2  , float* bias, int gw, int NGW) {
    const int lane = lane_id_opaque();
    float sv[4][16];
#pragma unroll
    for (int b = 0; b < 4; ++b)
#pragma unroll
        for (int h = 0; h < 2; ++h)
#pragma unroll
            for (int q = 0; q < 2; ++q) { const f32x4 t = *(const f32x4*)(sh2 + b * 6144 + h * 512 + lane * 8 + q * 4);
#pragma unroll
                for (int i = 0; i < 4; ++i) sv[b][h * 8 + q * 4 + i] = t[i]; }
    for (int a = gw; a < 2 * FF; a += NGW) {
        const u32x4 w0 = *(const u32x4*)(Wgu + (size_t)a * D + lane * 8), w1 = *(const u32x4*)(Wgu + (size_t)a * D + 512 + lane * 8);
        float wv[16];
#pragma unroll
        for (int i = 0; i < 4; ++i) { wv[2 * i] = bf_lo(w0[i]); wv[2 * i + 1] = bf_hi(w0[i]); wv[8 + 2 * i] = bf_lo(w1[i]); wv[8 + 2 * i + 1] = bf_hi(w1[i]); }
        float sb[4];
#pragma unroll
        for (int b = 0; b < 4; ++b) { float t = 0.f;
#pragma unroll
            for (int i = 0; i < 16; ++i) t += wv[i] * sv[b][i];
            sb[b] = t; }
#pragma unroll
        for (int o = 1; o < 64; o <<= 1) {
#pragma unroll
            for (int b = 0; b < 4; ++b) sb[b] += shx(sb[b], o, lane); }
        if (lane == 0) {
#pragma unroll
            for (int b = 0; b < 4; ++b) bias[b * (2 * FF) + a] = sb[b]; }
    }
}

__device__ __forceinline__ void mixer_phase(bf16_t* QO, const bf16_t* Kp, const bf16_t* VT, bf16_t* cb, const bf16_t* cc, const bf16_t* cx, const float* cw, int G, int bx, int wave, int gt0, int NT) {
    if (wave & 4) { conv_phase(cb, cc, cx, cw, gt0, NT); attn_phase(QO, Kp, VT, G, bx, wave); }
    else          { attn_phase(QO, Kp, VT, G, bx, wave); conv_phase(cb, cc, cx, cw, gt0, NT); }
}

#define XB_TMO      128
#define XB_XCNT(j)  (256  + 64 * (j))
#define XB_XSUB(j)  (1280 + 64 * (j))
#define XB_XGEN(j)  (2304 + 64 * (j))
#define XB_TOP      3328
#define XB_TOPGEN   3392
#define XCD_BAR_WORDS 3456
#define XB_SPIN_CAP (1u << 18)
__device__ __forceinline__ unsigned xb_ld(unsigned* p)              { return __hip_atomic_load(p, __ATOMIC_RELAXED, __HIP_MEMORY_SCOPE_AGENT); }
__device__ __forceinline__ unsigned xb_add(unsigned* p, unsigned v) { return __hip_atomic_fetch_add(p, v, __ATOMIC_RELAXED, __HIP_MEMORY_SCOPE_AGENT); }
__device__ __forceinline__ unsigned xb_xcc_id() { return (unsigned)__builtin_amdgcn_s_getreg((3 << 11) | 20) & 0xFu; }
#define XB_SPIN(cond, bar) do { unsigned _sp = 0; while (cond) { __builtin_amdgcn_s_sleep(1); \
    if ((++_sp & 255u) == 0u) { if (xb_ld(&(bar)[XB_TMO])) break; if (_sp > XB_SPIN_CAP) { atomicAdd(&(bar)[XB_TMO], 1u); break; } } } } while (0)
struct XcdBarrier { unsigned* bar; unsigned x; volatile LAS unsigned* st; };
__device__ __forceinline__ XcdBarrier xcd_barrier_post(unsigned* bar, volatile LAS unsigned* st, int tid) {
    XcdBarrier b; b.bar = bar; b.x = xb_xcc_id(); b.st = st;
    if (tid == 0) (void)xb_add(&bar[XB_XCNT(b.x)], 1u);
    return b;
}
__device__ __forceinline__ void xcd_barrier_complete(unsigned* bar, unsigned x, unsigned& nloc, unsigned& nx) {
    const unsigned G = gridDim.x * gridDim.y * gridDim.z;
    unsigned sum, cnt, mine, sp = 0u;
    for (;;) {
        sum = 0u; cnt = 0u; mine = 0u;
#pragma unroll
        for (unsigned j = 0; j < 16; ++j) { const unsigned c = xb_ld(&bar[XB_XCNT(j)]); sum += c; cnt += (c > 0u) ? 1u : 0u; mine = (j == x) ? c : mine; }
        if (sum == G) break;
        __builtin_amdgcn_s_sleep(1);
        if ((++sp & 255u) == 0u) { if (xb_ld(&bar[XB_TMO])) break; if (sp > XB_SPIN_CAP) { atomicAdd(&bar[XB_TMO], 1u); break; } }
    }
    nloc = mine > 0u ? mine : 1u; nx = cnt > 0u ? cnt : 1u;
}
__device__ __forceinline__ void xcd_barrier(const XcdBarrier& b, bool leader) {
    asm volatile("s_waitcnt vmcnt(0)" ::: "memory");
    __syncthreads();
    if (leader) {
        unsigned* bar = b.bar;
        __builtin_amdgcn_s_waitcnt(0);
        unsigned nloc = b.st[0], nx = b.st[1];
        if (nloc == 0u) { xcd_barrier_complete(bar, b.x, nloc, nx); b.st[0] = nloc; b.st[1] = nx; }
        const unsigned old = xb_add(&bar[XB_XSUB(b.x)], 1u);
        const unsigned gen = old / nloc;
        if (old + 1u == (gen + 1u) * nloc) {
            __builtin_amdgcn_fence(__ATOMIC_RELEASE, "agent");
            asm volatile("s_waitcnt vmcnt(0)" ::: "memory");
            const unsigned og = xb_add(&bar[XB_TOP], 1u);
            const unsigned tg = og / nx;
            if (og + 1u == (tg + 1u) * nx) xb_add(&bar[XB_TOPGEN], 1u);
            else XB_SPIN(xb_ld(&bar[XB_TOPGEN]) == tg, bar);
            __builtin_amdgcn_fence(__ATOMIC_ACQUIRE, "agent");
            xb_add(&bar[XB_XGEN(b.x)], 1u);
            asm volatile("s_waitcnt vmcnt(0)" ::: "memory");
        } else {
            XB_SPIN(xb_ld(&bar[XB_XGEN(b.x)]) == gen, bar);
            __builtin_amdgcn_fence(__ATOMIC_ACQUIRE, "agent");
            asm volatile("s_waitcnt vmcnt(0)" ::: "memory");
        }
    }
    __syncthreads();
}

#define XB_DONE XCD_BAR_WORDS
#define XB_PANEL (XCD_BAR_WORDS + 64)
#define XB_ALL   (XB_PANEL + 64 * 64)
__device__ unsigned g_bar[XB_ALL];
__device__ __forceinline__ void panel_barrier(unsigned* ctr, unsigned target, bool leader) {
    asm volatile("s_waitcnt vmcnt(0)" ::: "memory");
    __syncthreads();
    if (leader) {
        (void)xb_add(ctr, 1u);
        unsigned sp = 0u;
        while (xb_ld(ctr) < target) { __builtin_amdgcn_s_sleep(1); if (++sp > XB_SPIN_CAP) break; }
        __builtin_amdgcn_fence(__ATOMIC_ACQUIRE, "agent");
        asm volatile("s_waitcnt vmcnt(0)" ::: "memory");
    }
    __syncthreads();
}

constexpr int LDS_BYTES = 131072 + 2048;
__global__ void __launch_bounds__(NTHREADS, 2) fwd_kernel(Params p) {
    extern __shared__ __attribute__((aligned(16))) unsigned char lds_raw[];
    LAS unsigned char* lds = (LAS unsigned char*)lds_raw;
    cg::grid_group grid = cg::this_grid();
#define CG_SYNC() do { asm volatile("s_waitcnt vmcnt(0)" ::: "memory"); grid.sync(); if (wave == 0) { __builtin_amdgcn_fence(__ATOMIC_ACQUIRE, "agent"); asm volatile("s_waitcnt vmcnt(0)" ::: "memory"); } __syncthreads(); } while (0)
#define GRID_SYNC_() xcd_barrier(xb, leader)
    unsigned long long pr_acc = 0, pr_t0 = 0;
#define TIC() do { if (PROBE_MASK) pr_t0 = __builtin_amdgcn_s_memrealtime(); } while (0)
#define TOC(bit) do { if (PROBE_MASK & (bit)) pr_acc += __builtin_amdgcn_s_memrealtime() - pr_t0; } while (0)
#define GRID_SYNC() do { TIC(); GRID_SYNC_(); TOC(2 | sync_kind); } while (0)
    int sync_kind = 128;
    const int tid0 = threadIdx.x, wave = __builtin_amdgcn_readfirstlane(tid0 >> 6);
    const int G = gridDim.x, bx = blockIdx.x;
    const int gw = bx * NWAVES + wave, NGW = G * NWAVES, NT = G * NTHREADS;
    unsigned char* ws = p.ws;
    float* mod = (float*)(ws + WS_CTL);
    bf16_t* Rh = (bf16_t*)(ws + R_H); bf16_t* Rq = (bf16_t*)(ws + R_Q); bf16_t* Rk = (bf16_t*)(ws + R_K); bf16_t* Rv = (bf16_t*)(ws + R_V);
    bf16_t* Rcb = (bf16_t*)(ws + R_CB); bf16_t* Rcc = (bf16_t*)(ws + R_CC); bf16_t* Rcx = (bf16_t*)(ws + R_CX);
    const unsigned char* wl = ws + WS_W;

    unsigned* barw = g_bar;
    volatile LAS unsigned* bst = (volatile LAS unsigned*)(lds + 131072);
    const bool leader = (wave == 0) && (lane_id_opaque() == 0);
    if (leader) { bst[0] = 0u; bst[1] = 0u; bst[2] = 0u; }
    const XcdBarrier xb = xcd_barrier_post(barw, bst, leader ? 0 : 1);
    if (G == 0x7fffffff) CG_SYNC();
    TIC();
    phase0(p, lds, gw, NGW, wave, lane_id_opaque(), 0, true);
    TOC(16);
    GRID_SYNC();
    TIC();
    {
        const int gt = bx * NTHREADS + wave * 64 + lane_id_opaque();
        for (int it = gt; it < 2 * 4 * 1536; it += NT) {
            const int l = it / 6144, r = it % 6144, b = r / 1536, n4 = r % 1536;
            f32x4 a = *(const f32x4*)(p.in[3] + l * 6144 + n4 * 4);
            const float* mp = (const float*)(ws + R_CX) + ((size_t)(l * 32) * 4 + b) * 6144 + n4 * 4;
#pragma unroll 8
            for (int kc = 0; kc < 32; ++kc) a += *(const f32x4*)(mp + (size_t)kc * 4 * 6144);
            *(f32x4*)(mod + (size_t)(l * 4 + b) * 6144 + n4 * 4) = a;
        }
    }
    TOC(16);
    if (G == 256) {
        LAS float* tab = (LAS float*)(lds + 1024);
        const int t = wave * 64 + lane_id_opaque();
#pragma unroll 1
        for (int k = 0; k < 2; ++k) {
            const int idx = t + 512 * k, sel = idx >> 9, n4 = idx & 511, b = (bx >> 7) + 2 * sel;
            f32x4 a = *(const f32x4*)(p.in[3] + n4 * 4);
            const float* mp = (const float*)(ws + R_CX) + (size_t)b * 6144 + n4 * 4;
#pragma unroll 8
            for (int kc = 0; kc < 32; ++kc) a += *(const f32x4*)(mp + (size_t)kc * 4 * 6144);
            *(LAS f32x4*)(tab + sel * 2048 + n4 * 4) = a;
        }
        __syncthreads();
        TIC(); norm_phase(p.in[0], p.in[4], mod, 0, 1024, Rh, gw, NGW, true, true, tab); TOC(8); sync_kind = 128;
    } else {
        GRID_SYNC();
        TIC(); norm_phase(p.in[0], p.in[4], mod, 0, 1024, Rh, gw, NGW, true); TOC(8); sync_kind = 128;
    }
    GRID_SYNC();

#pragma unroll 1
    for (int l = 0; l < DEPTH; ++l) {
        const float* modl = mod + (size_t)l * 4 * 6144;
        const float* xin = (l == 0) ? p.in[0] : p.out;
        { pg8::SchedPlain S; S.T.init(M, 6144); S.G = G; S.c = bx; S.A = (const char*)Rh; S.B = (const char*)(wl + W_IN); S.tstep = (size_t)256 * D * 2;
          pg8::EpiQKV E{Rq, p.in[6] + l * HD, p.in[7] + l * HD};
          TIC(); pg8::gemm_phase(lds, D, S, E, wave); TOC(1); sync_kind = 32; }
        GRID_SYNC();
        const bool fuse_norm2 = (G == 256);
        float* biasgu = (float*)(ws + WS_CTL + 256 * 1024);
        float* ssqp = (float*)(ws + R_CC);
        TIC();
        if (fuse_norm2) bias_phase((const bf16_t*)(wl + W_GU), modl + 3072, biasgu, gw, NGW);
        mixer_phase(Rq, Rk, Rv, Rcb, Rcc, Rcx, p.in[8] + (size_t)l * 3 * D, G, bx, wave, bx * NTHREADS + wave * 64, NT); TOC(4); sync_kind = 64;
        GRID_SYNC();
        { pg8::SchedBranch S; S.T.init(M, D); S.G = G; S.c = bx; S.ws = (const char*)ws; S.wl = (const char*)wl; S.tstep = (size_t)256 * D * 2;
          pg8::EpiBranch E{Rv, Rk};
          TIC(); pg8::gemm_phase(lds, D, S, E, wave); TOC(1); sync_kind = 32; }
        if (G == 256) {
            pg8::TileOrder T4; T4.init(M, D); int pm4, pn4; T4.map(bx, pm4, pn4);
            panel_barrier(barw + XB_PANEL + 64 * pm4, 8u * (unsigned)l + 4u, leader);
        } else GRID_SYNC();
        if (fuse_norm2) {
          { pg8::SchedPlain S; S.T.init(M, D); S.G = G; S.c = bx; S.A = (const char*)Rk; S.B = (const char*)(wl + W_O); S.tstep = (size_t)256 * D * 2;
            pg8::EpiResidNorm E{xin, p.out, modl + 2048, p.in[12] + l * D, modl + 4096, Rh, ssqp};
            TIC(); pg8::gemm_phase(lds, D, S, E, wave); TOC(1); sync_kind = 32; }
          GRID_SYNC();
          { pg8::SchedPlain S; S.T.init(M, 2 * FF); S.G = G; S.c = bx; S.A = (const char*)Rh; S.B = (const char*)(wl + W_GU); S.tstep = (size_t)256 * D * 2;
            LAS float* rtab = (LAS float*)(lds + 131072 + 64);
            { pg8::Unit u0; if (S.next(0, u0)) { const int t = wave * 64 + lane_id_opaque();
                if (t < 256) { const float* sp = ssqp + (size_t)(u0.pm * 256 + t) * 16; const f32x4 a = *(const f32x4*)sp, b4 = *(const f32x4*)(sp + 4), c = *(const f32x4*)(sp + 8), d = *(const f32x4*)(sp + 12);
                    const float ss = (((a[0] + a[1]) + (a[2] + a[3])) + ((b4[0] + b4[1]) + (b4[2] + b4[3]))) + (((c[0] + c[1]) + (c[2] + c[3])) + ((d[0] + d[1]) + (d[2] + d[3])));
                    rtab[t] = 1.0f / sqrtf(ss * (1.0f / D) + EPS); } } }
            __syncthreads();
            pg8::EpiGUNorm E{Rq, biasgu, rtab};
            TIC(); pg8::gemm_phase(lds, D, S, E, wave); TOC(1); sync_kind = 32; }
          {
            pg8::TileOrder T4; T4.init(M, D); int pm4, pn4; T4.map(bx, pm4, pn4);
            panel_barrier(barw + XB_PANEL + 64 * pm4, 8u * (unsigned)l + 8u, leader); }
        } else {
        { pg8::SchedPlain S; S.T.init(M, D); S.G = G; S.c = bx; S.A = (const char*)Rk; S.B = (const char*)(wl + W_O); S.tstep = (size_t)256 * D * 2;
          pg8::EpiResid E{xin, p.out, modl + 2048};
          TIC(); pg8::gemm_phase(lds, D, S, E, wave); TOC(1); sync_kind = 32; }
        GRID_SYNC();
        TIC(); norm_phase(p.out, p.in[12] + l * D, modl, 3072, 4096, Rh, gw, NGW, true); TOC(8); sync_kind = 128;
        GRID_SYNC();
        { pg8::SchedPlain S; S.T.init(M, 2 * FF); S.G = G; S.c = bx; S.A = (const char*)Rh; S.B = (const char*)(wl + W_GU); S.tstep = (size_t)256 * D * 2;
          pg8::EpiGU E{Rq};
          TIC(); pg8::gemm_phase(lds, D, S, E, wave); TOC(1); sync_kind = 32; }
        GRID_SYNC();
        }
        { pg8::SchedPlain S; S.T.init(M, D); S.G = G; S.c = bx; S.A = (const char*)Rq; S.B = (const char*)(wl + W_D); S.tstep = (size_t)256 * FF * 2;
          pg8::EpiResid E{p.out, p.out, modl + 5120};
          TIC(); pg8::gemm_phase(lds, FF, S, E, wave); TOC(1); sync_kind = 32; }
        if (l + 1 < DEPTH) {
            GRID_SYNC();
            TIC();
            phase0(p, lds, gw, NGW, wave, lane_id_opaque(), l + 1, false);
            norm_phase(p.out, p.in[4] + (l + 1) * D, mod + (size_t)(l + 1) * 4 * 6144, 0, 1024, Rh, gw, NGW, true);
            TOC(8); sync_kind = 128;
            GRID_SYNC();
        }
    }
    asm volatile("s_waitcnt vmcnt(0)" ::: "memory");
    if (leader) { const unsigned old = xb_add(&barw[XB_DONE], 1u); bst[2] = (old + 1u == (unsigned)G) ? 1u : 0u; }
    __syncthreads();
    if (bst[2]) { const int t = wave * 64 + lane_id_opaque(); for (int i = t; i < XB_ALL; i += NTHREADS) __hip_atomic_store(&barw[i], 0u, __ATOMIC_RELAXED, __HIP_MEMORY_SCOPE_AGENT); }
    if (PROBE_MASK && bx == 0 && leader) { const unsigned long long t = __builtin_amdgcn_s_memrealtime(); while (__builtin_amdgcn_s_memrealtime() - t < pr_acc) __builtin_amdgcn_s_sleep(8); }
}

extern "C" void kernel_launch(void* const* d_in, const int* in_sizes, int n_in, void* d_out, int out_size, void* d_ws, size_t ws_size, hipStream_t stream) {
    static int grid_blocks = 0;
    if (grid_blocks == 0) {
        if (n_in != 16 || out_size != M * D || ws_size < WS_END) { fprintf(stderr, "kernel_launch: unexpected shapes (n_in %d out %d ws %zu need %zu)\n", n_in, out_size, ws_size, (size_t)WS_END); grid_blocks = -1; return; }
        int dev = 0, cus = 0, per_cu = 0;
        hipGetDevice(&dev);
        hipDeviceGetAttribute(&cus, hipDeviceAttributeMultiprocessorCount, dev);
        hipFuncSetAttribute((const void*)fwd_kernel, hipFuncAttributeMaxDynamicSharedMemorySize, LDS_BYTES);
        hipOccupancyMaxActiveBlocksPerMultiprocessor(&per_cu, (const void*)fwd_kernel, NTHREADS, LDS_BYTES);
        (void)hipGetLastError();
        if (per_cu < 1) { fprintf(stderr, "kernel_launch: occupancy query says %d blocks per CU\n", per_cu); per_cu = 1; }
        grid_blocks = cus;
    }
    if (grid_blocks < 0) return;
    Params p{};
    for (int i = 0; i < 16; ++i) p.in[i] = (const float*)d_in[i];
    p.out = (float*)d_out; p.ws = (unsigned char*)d_ws;
    void* args[] = {&p};
    hipError_t e = hipLaunchCooperativeKernel((const void*)fwd_kernel, dim3(grid_blocks), dim3(NTHREADS), args, LDS_BYTES, stream);
    if (e != hipSuccess) fprintf(stderr, "cooperative launch failed: %s (grid %d)\n", hipGetErrorString(e), grid_blocks);
}
```

```cpp
#include <hip/hip_runtime.h>
#include <hip/hip_cooperative_groups.h>
#include <cstdio>
#include <cstdint>
namespace cg = cooperative_groups;
#ifndef PROBE_MASK
#define PROBE_MASK 0
#endif

#define LAS __attribute__((address_space(3)))
typedef unsigned short bf16_t;
typedef short bf16x8 __attribute__((ext_vector_type(8)));
typedef short s16x4 __attribute__((ext_vector_type(4)));
typedef float f32x4 __attribute__((ext_vector_type(4)));
typedef float f32x16 __attribute__((ext_vector_type(16)));
typedef unsigned u32x4 __attribute__((ext_vector_type(4)));
typedef unsigned u32x2 __attribute__((ext_vector_type(2)));
typedef float f32x2_t __attribute__((ext_vector_type(2)));
typedef __bf16 bf16x2_t __attribute__((ext_vector_type(2)));

constexpr int D = 1024, NB = 4, SEQ = 4096, M = NB * SEQ, NH = 16, HD = 64, FF = 2816, INW = 8192, DEPTH = 2;
constexpr float EPS = 1e-6f;
constexpr float LOG2E = 1.4426950408889634f;
constexpr float C2 = 0.125f * LOG2E;
constexpr int NWAVES = 8, NTHREADS = 512;

constexpr size_t MiB = 1u << 20;
constexpr size_t WS_CTL = 0, CTL_BYTES = 256 * 1024;
constexpr size_t WS_W = 1 * MiB;
constexpr size_t W_IN = 0, W_A = 16 * MiB, W_B = 18 * MiB, W_O = 20 * MiB, W_GU = 22 * MiB, W_D = 33 * MiB, W_LAYER = 38 * MiB + 512 * 1024;
constexpr size_t WS_ACT = 40 * MiB;
constexpr size_t REG = 32 * MiB;
constexpr size_t R_H = WS_ACT, R_Q = WS_ACT + REG, R_K = WS_ACT + 2 * REG, R_V = WS_ACT + 3 * REG, R_CB = WS_ACT + 4 * REG, R_CC = WS_ACT + 5 * REG, R_CX = WS_ACT + 6 * REG, WS_END = WS_ACT + 7 * REG;
static_assert(WS_W + W_LAYER <= WS_ACT, "weights");
static_assert((size_t)M * FF * 2 <= 3 * REG, "ffn hidden fits R_Q..R_V");
static_assert(WS_END <= 279028736, "workspace >= sum of the inputs' bytes");

__device__ __forceinline__ unsigned cvt_pk(float lo, float hi) { f32x2_t v = {lo, hi}; bf16x2_t b = __builtin_convertvector(v, bf16x2_t); return __builtin_bit_cast(unsigned, b); }
__device__ __forceinline__ float bf_lo(unsigned u) { return __uint_as_float(u << 16); }
__device__ __forceinline__ float bf_hi(unsigned u) { return __uint_as_float(u & 0xffff0000u); }
__device__ __forceinline__ float shx(float v, int o, int lane) { return __int_as_float(__builtin_amdgcn_ds_bpermute((lane ^ o) << 2, __float_as_int(v))); }
__device__ __forceinline__ float wave_sum(float v, int lane) {
#pragma unroll
    for (int o = 1; o < 64; o <<= 1) v += shx(v, o, lane);
    return v;
}
__device__ __forceinline__ int lane_id_opaque() { int l; asm volatile("v_mbcnt_lo_u32_b32 %0, -1, 0\n\tv_mbcnt_hi_u32_b32 %0, -1, %0" : "=v"(l)); return l; }
__device__ __forceinline__ float fast_exp2(float x) { return __builtin_amdgcn_exp2f(x); }
__device__ __forceinline__ float fast_log2(float x) { return __builtin_amdgcn_logf(x); }
__device__ __forceinline__ float fast_rcp(float x) { return __builtin_amdgcn_rcpf(x); }
__device__ __forceinline__ float sigmoidf_(float x) { return fast_rcp(1.0f + fast_exp2(-x * LOG2E)); }

namespace pg8 {
constexpr int BM = 256, BK = 64, HALF = 128, HTB = HALF * BK * 2, STAGE_BYTES = 8 * HTB, NXCD = 8, WGM = 8;
__host__ __device__ __forceinline__ int lds_byte(int r, int c) { const int st = (r >> 4) * 2 + (c >> 5), rr = r & 15, cc = c & 31, ob = rr * 64 + cc * 2; return st * 1024 + (ob ^ (((ob >> 9) & 1) << 5)); }
__host__ __device__ __forceinline__ void stage_rc(int b, int& R, int& C) { const int st = b / 1024, sb = b % 1024, swz = sb ^ (((sb >> 9) & 1) << 5); R = (st >> 1) * 16 + swz / 64; C = (st & 1) * 32 + (swz % 64) / 2; }

struct Unit { const char* A; const char* B; int pm, pn, kind; };

struct TileOrder {
    int nM, nN, nwg;
    __device__ __forceinline__ void init(int Mr, int N) { nM = Mr / BM; nN = N / BM; nwg = nM * nN; }
    __device__ __forceinline__ void map(int wgid, int& pm, int& pn) const {
        { const int q = nwg / NXCD, r = nwg % NXCD, xcd = wgid % NXCD, off = wgid / NXCD; wgid = (xcd < r ? xcd * (q + 1) : r * (q + 1) + (xcd - r) * q) + off; }
        const int nig = WGM * nN, gid = wgid / nig, fm = gid * WGM, gsz = (nM - fm) < WGM ? (nM - fm) : WGM;
        pm = fm + ((wgid % nig) % gsz); pn = (wgid % nig) / gsz;
    }
};
struct SchedPlain {
    TileOrder T; int G, c; const char* A; const char* B; size_t tstep;
    __device__ __forceinline__ bool next(int i, Unit& u) const {
        const long L = (long)i * G + c; if (L >= T.nwg) return false;
        T.map((int)L, u.pm, u.pn); u.A = A + (size_t)u.pm * tstep; u.B = B + (size_t)u.pn * tstep; u.kind = 0; return true;
    }
};
struct SchedBranch {
    TileOrder T; int G, c; const char* ws; const char* wl; size_t tstep;
    __device__ __forceinline__ bool next(int i, Unit& u) const {
        const long L = (long)(i >> 2) * G + c; if (L >= T.nwg) return false;
        T.map((int)L, u.pm, u.pn); const int sub = i & 3; u.kind = sub;
        const size_t oa = (sub == 1) ? R_Q : ((sub == 3) ? R_CB : R_H);
        const size_t ob = (sub == 0) ? (W_IN + (size_t)6144 * D * 2) : (sub == 1) ? W_A : (sub == 2) ? (W_IN + (size_t)7168 * D * 2) : W_B;
        u.A = ws + oa + (size_t)u.pm * tstep; u.B = wl + ob + (size_t)u.pn * tstep; return true;
    }
};

template <class Epi, class Sched>
__device__ __forceinline__ void gemm_phase(LAS unsigned char* lds, const int K, const Sched& S, const Epi& E, const int wid) {
    const int lane = lane_id_opaque(), tid = wid * 64 + lane, wr = wid >> 2, wc = wid & 3, fr = lane & 15, fq = lane >> 4;
    const int nt = K / BK;
    unsigned voff[2];
#pragma unroll
    for (int i = 0; i < 2; ++i) { int R, C; stage_rc(tid * 16 + i * 8192, R, C); voff[i] = (unsigned)(R * K + C) * 2u; }
    const size_t kstep = (size_t)(BK * 2);
    const size_t hstep = (size_t)HALF * K * 2;
    const unsigned ldsw = (unsigned)wid * 1024u;
    const int aoff = lds_byte(wr * 64 + fr, fq * 8), boff = lds_byte(wc * 32 + fr, fq * 8);
#define PG8_SA(b, h) (((b) * 2 + (h)) * HTB)
#define PG8_SB(b, h) ((4 + (b) * 2 + (h)) * HTB)
#define PG8_STAGE(bufoff, gbase) do { _Pragma("unroll") for (int _i = 0; _i < 2; ++_i) \
        __builtin_amdgcn_global_load_lds((const unsigned*)((const char*)(gbase) + voff[_i]), (LAS unsigned*)(lds + (bufoff) + ldsw + _i * 8192), 16, 0, 0); } while (0)
#define PG8_LDA(dst, b, h) do { _Pragma("unroll") for (int m = 0; m < 4; ++m) _Pragma("unroll") for (int k = 0; k < 2; ++k) dst[m][k] = *(const LAS bf16x8*)(lds + PG8_SA(b, h) + aoff + m * 2048 + k * 1024); } while (0)
#define PG8_LDB(dst, b, h) do { _Pragma("unroll") for (int n = 0; n < 2; ++n) _Pragma("unroll") for (int k = 0; k < 2; ++k) dst[n][k] = *(const LAS bf16x8*)(lds + PG8_SB(b, h) + boff + n * 2048 + k * 1024); } while (0)
#define PG8_MMA(ai, bj, At, Bt) do { __builtin_amdgcn_s_setprio(1); _Pragma("unroll") for (int m = 0; m < 4; ++m) _Pragma("unroll") for (int n = 0; n < 2; ++n) _Pragma("unroll") for (int k = 0; k < 2; ++k) \
        acc[ai][bj][m][n] = __builtin_amdgcn_mfma_f32_16x16x32_bf16(Bt[n][k], At[m][k], acc[ai][bj][m][n], 0, 0, 0); __builtin_amdgcn_s_setprio(0); } while (0)
#define PG8_WAIT_V(n) asm volatile("s_waitcnt vmcnt(" #n ")" ::: "memory")
#define PG8_WAIT_L(n) asm volatile("s_waitcnt lgkmcnt(" #n ")" ::: "memory")
#define PG8_BAR __builtin_amdgcn_s_barrier()
#define PG8_SCHED __builtin_amdgcn_sched_barrier(0)
    Unit cur, nxt; int ui = 0;
    if (!S.next(0, cur)) return;
    f32x4 acc[2][2][4][2];
#pragma unroll
    for (int a = 0; a < 2; ++a)
#pragma unroll
        for (int b = 0; b < 2; ++b)
#pragma unroll
            for (int m = 0; m < 4; ++m)
#pragma unroll
                for (int n = 0; n < 2; ++n) acc[a][b][m][n] = (f32x4){0.f, 0.f, 0.f, 0.f};
    bf16x8 At[4][2], B0[2][2], B1[2][2];
    const char* cA = cur.A; const char* cB = cur.B;
    PG8_STAGE(PG8_SB(0, 0), cB); PG8_STAGE(PG8_SB(0, 1), cB + hstep); PG8_STAGE(PG8_SA(0, 0), cA); PG8_STAGE(PG8_SA(0, 1), cA + hstep);
    if (wr == 1) PG8_BAR;
    PG8_WAIT_V(2); PG8_BAR;
    PG8_STAGE(PG8_SB(1, 0), cB + kstep); PG8_STAGE(PG8_SA(1, 0), cA + kstep); PG8_STAGE(PG8_SB(1, 1), cB + hstep + kstep);
    PG8_WAIT_V(6); PG8_BAR;
    for (;;) {
        const bool has_next = S.next(ui + 1, nxt);
        const char* nA = has_next ? nxt.A : cA; const char* nB = has_next ? nxt.B : cB;
        for (int t = 0; t < nt; t += 2) {
            const bool last = (t == nt - 2);
            const char* a1 = cA + (size_t)(t + 1) * kstep;
            const char* a2 = last ? nA : cA + (size_t)(t + 2) * kstep; const char* b2 = last ? nB : cB + (size_t)(t + 2) * kstep;
            const char* a3 = a2 + kstep; const char* b3 = b2 + kstep;
            PG8_LDB(B0, 0, 0); PG8_LDB(B1, 0, 1); PG8_SCHED; PG8_LDA(At, 0, 0); PG8_STAGE(PG8_SA(1, 1), a1 + hstep);
            PG8_WAIT_V(8); PG8_WAIT_L(0); PG8_BAR; PG8_MMA(0, 0, At, B0); PG8_MMA(0, 1, At, B1); PG8_BAR; PG8_SCHED;
            PG8_LDA(At, 0, 1); PG8_STAGE(PG8_SB(0, 0), b2); PG8_STAGE(PG8_SB(0, 1), b2 + hstep); PG8_STAGE(PG8_SA(0, 0), a2);
            PG8_WAIT_V(8); PG8_WAIT_L(0); PG8_BAR; PG8_MMA(1, 0, At, B0); PG8_MMA(1, 1, At, B1); PG8_BAR; PG8_SCHED;
            PG8_LDB(B0, 1, 0); PG8_LDB(B1, 1, 1); PG8_SCHED; PG8_LDA(At, 1, 0); PG8_STAGE(PG8_SA(0, 1), a2 + hstep);
            PG8_WAIT_V(8); PG8_WAIT_L(0); PG8_BAR; PG8_MMA(0, 0, At, B0); PG8_MMA(0, 1, At, B1); PG8_BAR; PG8_SCHED;
            PG8_LDA(At, 1, 1); PG8_STAGE(PG8_SB(1, 0), b3); PG8_STAGE(PG8_SB(1, 1), b3 + hstep); PG8_STAGE(PG8_SA(1, 0), a3);
            PG8_WAIT_V(8); PG8_WAIT_L(0); PG8_BAR; PG8_MMA(1, 0, At, B0); PG8_MMA(1, 1, At, B1); PG8_BAR; PG8_SCHED;
        }
        if (wr == 0) PG8_BAR;
        { const int l2 = lane_id_opaque(); E(acc, cur, wr, wc, l2 & 15, l2 >> 4); }
        if (!has_next) break;
#pragma unroll
        for (int a = 0; a < 2; ++a)
#pragma unroll
            for (int b = 0; b < 2; ++b)
#pragma unroll
                for (int m = 0; m < 4; ++m)
#pragma unroll
                    for (int n = 0; n < 2; ++n) acc[a][b][m][n] = (f32x4){0.f, 0.f, 0.f, 0.f};
        cur = nxt; cA = nA; cB = nB; ++ui;
        if (wr == 1) PG8_BAR;
    }
    PG8_WAIT_V(0);
    PG8_BAR;
#undef PG8_SA
#undef PG8_SB
#undef PG8_STAGE
#undef PG8_LDA
#undef PG8_LDB
#undef PG8_MMA
#undef PG8_WAIT_V
#undef PG8_WAIT_L
#undef PG8_BAR
#undef PG8_SCHED
}

__device__ __forceinline__ u32x4 pack8(const f32x4& a, const f32x4& b) { u32x4 w; w.x = cvt_pk(a[0], a[1]); w.y = cvt_pk(a[2], a[3]); w.z = cvt_pk(b[0], b[1]); w.w = cvt_pk(b[2], b[3]); return w; }

struct EpiRegions {
    bf16_t* base;
    __device__ __forceinline__ void operator()(const f32x4 (&acc)[2][2][4][2], const Unit& u, int wr, int wc, int fr, int fq) const {
        bf16_t* dst = base + (size_t)(u.pn >> 2) * ((size_t)M * D);
        const int col = (u.pn & 3) * 256 + wc * 64 + fq * 8, row0 = u.pm * BM + wr * 64 + fr;
#pragma unroll
        for (int ai = 0; ai < 2; ++ai)
#pragma unroll
            for (int m = 0; m < 4; ++m) { bf16_t* rp = dst + (size_t)(row0 + ai * HALF + m * 16) * D + col;
#pragma unroll
                for (int bj = 0; bj < 2; ++bj) *(u32x4*)(rp + bj * 32) = pack8(acc[ai][bj][m][0], acc[ai][bj][m][1]); }
    }
};
struct EpiQKV {
    bf16_t* base; const float* gq; const float* gk;
    __device__ __forceinline__ void operator()(const f32x4 (&acc)[2][2][4][2], const Unit& u, int wr, int wc, int fr, int fq) const {
        const int region = u.pn >> 2, head = (u.pn & 3) * 4 + wc, row0 = u.pm * BM + wr * 64 + fr;
        if (region == 2) {
            const int b = row0 >> 12;
            bf16_t* vb = base + (size_t)2 * M * D + ((size_t)(b * NH + head) * HD) * SEQ;
#pragma unroll
            for (int ai = 0; ai < 2; ++ai)
#pragma unroll
                for (int m = 0; m < 4; ++m) { const int s0 = (row0 + ai * HALF + m * 16) & (SEQ - 1), q = (s0 >> 2) & 3;
                    const int s = (s0 & ~12) | ((((q & 1) << 1) | (q >> 1)) << 2);
#pragma unroll
                    for (int bj = 0; bj < 2; ++bj)
#pragma unroll
                        for (int n = 0; n < 2; ++n)
#pragma unroll
                            for (int j = 0; j < 4; ++j) { const int d = bj * 32 + fq * 8 + n * 4 + j; const unsigned w = cvt_pk(acc[ai][bj][m][n][j], 0.f);
                                vb[(size_t)d * SEQ + s] = (bf16_t)(w & 0xffffu); } }
        } else if (region >= 3) {
            bf16_t* dst = base + (size_t)region * ((size_t)M * D);
            const int col = (u.pn & 3) * 256 + wc * 64 + fq * 8;
#pragma unroll
            for (int ai = 0; ai < 2; ++ai)
#pragma unroll
                for (int m = 0; m < 4; ++m) { bf16_t* rp = dst + (size_t)(row0 + ai * HALF + m * 16) * D + col;
#pragma unroll
                    for (int bj = 0; bj < 2; ++bj) *(u32x4*)(rp + bj * 32) = pack8(acc[ai][bj][m][0], acc[ai][bj][m][1]); }
        } else {
            const float* g = region == 0 ? gq : gk; const float sc = region == 0 ? C2 : 1.0f;
            bf16_t* dst = base + (size_t)region * ((size_t)M * D);
            f32x4 gv[2][2];
#pragma unroll
            for (int bj = 0; bj < 2; ++bj)
#pragma unroll
                for (int n = 0; n < 2; ++n) gv[bj][n] = *(const f32x4*)(g + bj * 32 + fq * 8 + n * 4) * sc;
            const int col = head * 64 + fq * 8;
#pragma unroll
            for (int ai = 0; ai < 2; ++ai)
#pragma unroll
                for (int m = 0; m < 4; ++m) {
                    float ss = 0.f;
#pragma unroll
                    for (int bj = 0; bj < 2; ++bj)
#pragma unroll
                        for (int n = 0; n < 2; ++n) { const f32x4 x = acc[ai][bj][m][n]; ss += (x[0] * x[0] + x[1] * x[1]) + (x[2] * x[2] + x[3] * x[3]); }
                    ss += shx(ss, 16, fr + 16 * fq); ss += shx(ss, 32, fr + 16 * fq);
                    const float r = 1.0f / sqrtf(ss * (1.0f / 64.0f) + EPS);
                    bf16_t* rp = dst + (size_t)(row0 + ai * HALF + m * 16) * D + col;
#pragma unroll
                    for (int bj = 0; bj < 2; ++bj) { const f32x4 a = acc[ai][bj][m][0] * r * gv[bj][0], b2 = acc[ai][bj][m][1] * r * gv[bj][1]; *(u32x4*)(rp + bj * 32) = pack8(a, b2); }
                }
        }
    }
};
struct EpiBranch {
    bf16_t* S1; bf16_t* TM;
    __device__ __forceinline__ void operator()(const f32x4 (&acc)[2][2][4][2], const Unit& u, int wr, int wc, int fr, int fq) const {
        const int col = u.pn * 256 + wc * 64 + fq * 8, row0 = u.pm * BM + wr * 64 + fr, kind = u.kind;
#pragma unroll
        for (int ai = 0; ai < 2; ++ai) {
            if (kind == 0 || kind == 2) {
#pragma unroll
                for (int m = 0; m < 4; ++m) { const size_t off = (size_t)(row0 + ai * HALF + m * 16) * D + col;
#pragma unroll
                    for (int bj = 0; bj < 2; ++bj) { f32x4 a = acc[ai][bj][m][0], b = acc[ai][bj][m][1];
#pragma unroll
                        for (int j = 0; j < 4; ++j) { a[j] = sigmoidf_(a[j]); b[j] = sigmoidf_(b[j]); }
                        *(u32x4*)(S1 + off + bj * 32) = pack8(a, b); } }
            } else {
#pragma unroll
              for (int mh = 0; mh < 2; ++mh) {
                u32x4 g[2][2], t[2][2];
#pragma unroll
                for (int m2 = 0; m2 < 2; ++m2) { const int m = 2 * mh + m2; const size_t off = (size_t)(row0 + ai * HALF + m * 16) * D + col;
#pragma unroll
                    for (int bj = 0; bj < 2; ++bj) { g[m2][bj] = *(const u32x4*)(S1 + off + bj * 32); if (kind == 3) t[m2][bj] = *(const u32x4*)(TM + off + bj * 32); else t[m2][bj] = (u32x4){0u, 0u, 0u, 0u}; } }
#pragma unroll
                for (int m2 = 0; m2 < 2; ++m2) { const int m = 2 * mh + m2; const size_t off = (size_t)(row0 + ai * HALF + m * 16) * D + col;
#pragma unroll
                    for (int bj = 0; bj < 2; ++bj) { f32x4 a = acc[ai][bj][m][0], b = acc[ai][bj][m][1]; const u32x4 gg = g[m2][bj], tt = t[m2][bj];
                        a[0] = a[0] * bf_lo(gg.x) + bf_lo(tt.x); a[1] = a[1] * bf_hi(gg.x) + bf_hi(tt.x); a[2] = a[2] * bf_lo(gg.y) + bf_lo(tt.y); a[3] = a[3] * bf_hi(gg.y) + bf_hi(tt.y);
                        b[0] = b[0] * bf_lo(gg.z) + bf_lo(tt.z); b[1] = b[1] * bf_hi(gg.z) + bf_hi(tt.z); b[2] = b[2] * bf_lo(gg.w) + bf_lo(tt.w); b[3] = b[3] * bf_hi(gg.w) + bf_hi(tt.w);
                        if (kind == 3) { const u32x4 pk = pack8(a, b); asm volatile("global_store_dwordx4 %0, %1, off sc1\n\ts_nop 1" :: "v"(TM + off + bj * 32), "v"(pk) : "memory"); }
                        else *(u32x4*)(TM + off + bj * 32) = pack8(a, b); } }
              }
            }
        }
    }
};
struct EpiResid {
    const float* xin; float* xout; const float* gmod;
    __device__ __forceinline__ void operator()(const f32x4 (&acc)[2][2][4][2], const Unit& u, int wr, int wc, int fr, int fq) const {
        const int col = u.pn * 256 + wc * 64 + fq * 8, row0 = u.pm * BM + wr * 64 + fr, b = row0 >> 12;
        f32x4 gv[2][2];
#pragma unroll
        for (int bj = 0; bj < 2; ++bj)
#pragma unroll
            for (int n = 0; n < 2; ++n) gv[bj][n] = *(const f32x4*)(gmod + b * 6144 + col + bj * 32 + n * 4);
#pragma unroll
        for (int ai = 0; ai < 2; ++ai)
#pragma unroll
          for (int mh = 0; mh < 2; ++mh) {
            f32x4 xo[2][2][2];
#pragma unroll
            for (int m2 = 0; m2 < 2; ++m2) { const size_t off = (size_t)(row0 + ai * HALF + (2 * mh + m2) * 16) * D + col;
#pragma unroll
                for (int bj = 0; bj < 2; ++bj)
#pragma unroll
                    for (int n = 0; n < 2; ++n) xo[m2][bj][n] = *(const f32x4*)(xin + off + bj * 32 + n * 4); }
#pragma unroll
            for (int m2 = 0; m2 < 2; ++m2) { const size_t off = (size_t)(row0 + ai * HALF + (2 * mh + m2) * 16) * D + col;
#pragma unroll
                for (int bj = 0; bj < 2; ++bj)
#pragma unroll
                    for (int n = 0; n < 2; ++n) *(f32x4*)(xout + off + bj * 32 + n * 4) = xo[m2][bj][n] + gv[bj][n] * acc[ai][bj][2 * mh + m2][n]; }
          }
    }
};
struct EpiGU {
    bf16_t* f;
    __device__ __forceinline__ void operator()(const f32x4 (&acc)[2][2][4][2], const Unit& u, int wr, int wc, int fr, int fq) const {
        const int col = u.pn * 128 + wc * 32 + fq * 8, row0 = u.pm * BM + wr * 64 + fr;
#pragma unroll
        for (int ai = 0; ai < 2; ++ai)
#pragma unroll
            for (int m = 0; m < 4; ++m) {
                f32x4 o[2];
#pragma unroll
                for (int n = 0; n < 2; ++n)
#pragma unroll
                    for (int j = 0; j < 4; ++j) { const float gt = acc[ai][0][m][n][j]; o[n][j] = gt * sigmoidf_(gt) * acc[ai][1][m][n][j]; }
                *(u32x4*)(f + (size_t)(row0 + ai * HALF + m * 16) * FF + col) = pack8(o[0], o[1]);
            }
    }
};
struct EpiResidNorm {
    const float* xin; float* xout; const float* gmod; const float* lng; const float* scmod; bf16_t* An; float* ssq;
    __device__ __forceinline__ void operator()(const f32x4 (&acc)[2][2][4][2], const Unit& u, int wr, int wc, int fr, int fq) const {
        const int col = u.pn * 256 + wc * 64 + fq * 8, row0 = u.pm * BM + wr * 64 + fr, b = row0 >> 12;
        f32x4 gv[2][2], gm[2][2];
#pragma unroll
        for (int bj = 0; bj < 2; ++bj)
#pragma unroll
            for (int n = 0; n < 2; ++n) { const int c = col + bj * 32 + n * 4; gv[bj][n] = *(const f32x4*)(gmod + b * 6144 + c);
                gm[bj][n] = *(const f32x4*)(lng + c) * (*(const f32x4*)(scmod + b * 6144 + c) + 1.0f); }
#pragma unroll
        for (int ai = 0; ai < 2; ++ai)
#pragma unroll
          for (int mh = 0; mh < 2; ++mh) {
            f32x4 xo[2][2][2];
#pragma unroll
            for (int m2 = 0; m2 < 2; ++m2) { const size_t off = (size_t)(row0 + ai * HALF + (2 * mh + m2) * 16) * D + col;
#pragma unroll
                for (int bj = 0; bj < 2; ++bj)
#pragma unroll
                    for (int n = 0; n < 2; ++n) xo[m2][bj][n] = *(const f32x4*)(xin + off + bj * 32 + n * 4); }
#pragma unroll
            for (int m2 = 0; m2 < 2; ++m2) { const int row = row0 + ai * HALF + (2 * mh + m2) * 16; const size_t off = (size_t)row * D + col;
                float ss = 0.f;
#pragma unroll
                for (int bj = 0; bj < 2; ++bj) {
                    f32x4 y[2];
#pragma unroll
                    for (int n = 0; n < 2; ++n) { const f32x4 x1 = xo[m2][bj][n] + gv[bj][n] * acc[ai][bj][2 * mh + m2][n];
                        *(f32x4*)(xout + off + bj * 32 + n * 4) = x1; ss += (x1[0] * x1[0] + x1[1] * x1[1]) + (x1[2] * x1[2] + x1[3] * x1[3]); y[n] = x1 * gm[bj][n]; }
                    *(u32x4*)(An + off + bj * 32) = pack8(y[0], y[1]);
                }
                ss += shx(ss, 16, fr + 16 * fq); ss += shx(ss, 32, fr + 16 * fq);
                if (fq == 0) ssq[(size_t)row * 16 + u.pn * 4 + wc] = ss;
            }
          }
    }
};
struct EpiGUNorm {
    bf16_t* f; const float* bias; LAS const float* rtab;
    __device__ __forceinline__ void operator()(const f32x4 (&acc)[2][2][4][2], const Unit& u, int wr, int wc, int fr, int fq) const {
        const int col = u.pn * 128 + wc * 32 + fq * 8, row0 = u.pm * BM + wr * 64 + fr, b = row0 >> 12;
        f32x4 bg[2], bu[2];
#pragma unroll
        for (int n = 0; n < 2; ++n) { const int a = u.pn * 256 + wc * 32 + n * 16 + fq * 4; bg[n] = *(const f32x4*)(bias + b * (2 * FF) + a); bu[n] = *(const f32x4*)(bias + b * (2 * FF) + a + 128); }
#pragma unroll
        for (int ai = 0; ai < 2; ++ai)
#pragma unroll
            for (int m = 0; m < 4; ++m) {
                const float r = rtab[wr * 64 + fr + ai * HALF + m * 16];
                f32x4 o[2];
#pragma unroll
                for (int n = 0; n < 2; ++n)
#pragma unroll
                    for (int j = 0; j < 4; ++j) { const float gt = acc[ai][0][m][n][j] * r + bg[n][j], up = acc[ai][1][m][n][j] * r + bu[n][j]; o[n][j] = gt * sigmoidf_(gt) * up; }
                { const u32x4 pk = pack8(o[0], o[1]); asm volatile("global_store_dwordx4 %0, %1, off sc1\n\ts_nop 1" :: "v"(f + (size_t)(row0 + ai * HALF + m * 16) * FF + col), "v"(pk) : "memory"); }
            }
    }
};
}

#define LDS_WAIT() asm volatile("s_waitcnt lgkmcnt(0)" ::: "memory")
__device__ __forceinline__ void transpose_item(const float* W, int N, int K, int n0, bf16_t* WT, int a0, int k0, LAS float* scr, int lane) {
    {
        const int kr = lane >> 3, c4 = (lane & 7) * 4;
        f32x4 t[8];
#pragma unroll
        for (int i = 0; i < 8; ++i) t[i] = __builtin_nontemporal_load((const f32x4*)(W + (size_t)(k0 + 8 * i + kr) * N + n0 + c4));
#pragma unroll
        for (int i = 0; i < 8; ++i) { LAS float* d = scr + (8 * i + kr) * 33 + c4; d[0] = t[i][0]; d[1] = t[i][1]; d[2] = t[i][2]; d[3] = t[i][3]; }
    }
    LDS_WAIT(); asm volatile("" ::: "memory");
    const int c = lane & 7;
#pragma unroll
    for (int j = 0; j < 4; ++j) { const int s = (lane >> 3) + 8 * j; const int lo = 8 * ((s >> 2) & 3) + 4 * (s >> 4) + (s & 3);
        const LAS float* sp = scr + (8 * c) * 33 + lo;
        u32x4 o; o.x = cvt_pk(sp[0 * 33], sp[1 * 33]); o.y = cvt_pk(sp[2 * 33], sp[3 * 33]); o.z = cvt_pk(sp[4 * 33], sp[5 * 33]); o.w = cvt_pk(sp[6 * 33], sp[7 * 33]);
        *(u32x4*)(WT + (size_t)(a0 + s) * K + k0 + 8 * c) = o; }
    LDS_WAIT(); asm volatile("" ::: "memory");
}

struct Params { const float* in[16]; float* out; unsigned char* ws; };

__device__ __forceinline__ void phase0(const Params& p, LAS unsigned char* lds, int gw, int NGW, int wave, int lane, const int l, const bool with_mod) {
    LAS float* scr = (LAS float*)(lds + wave * 16384);
    constexpr int I_IN = 256 * 16, I_SQ = 32 * 16, I_GU = 176 * 16, I_D = 32 * 44, I_LAYER = I_IN + 3 * I_SQ + I_GU + I_D;
    constexpr int I_MOD = 2 * 32 * 24;
    for (int it = gw; it < (with_mod ? I_MOD : 0); it += NGW) {
        const int l = it / (32 * 24), r = it % (32 * 24), kc = r / 24, nb = r % 24;
        const float* aw = p.in[2] + (size_t)l * D * 6144 + (size_t)(kc * 32) * 6144 + nb * 256 + lane * 4;
        const float* c = p.in[1];
        f32x4 a[4];
#pragma unroll
        for (int b = 0; b < 4; ++b) a[b] = (f32x4){0.f, 0.f, 0.f, 0.f};
#pragma unroll 8
        for (int k = 0; k < 32; ++k) { const f32x4 w = __builtin_nontemporal_load((const f32x4*)(aw + (size_t)k * 6144));
#pragma unroll
            for (int b = 0; b < 4; ++b) { const float cv = c[b * D + kc * 32 + k]; const float sv = cv * sigmoidf_(cv); a[b] += w * sv; } }
        float* mp = (float*)(p.ws + R_CX) + ((size_t)(l * 32 + kc) * 4) * 6144 + nb * 256 + lane * 4;
#pragma unroll
        for (int b = 0; b < 4; ++b) *(f32x4*)(mp + (size_t)b * 6144) = a[b];
    }
    for (int it = gw; it < I_LAYER; it += NGW) {
        int r = it;
        unsigned char* wl = p.ws + WS_W;
        if (r < I_IN) { const int kb = r / 256, g = r % 256; const int pn = g >> 3, bj = (g >> 2) & 1, wc = g & 3;
            transpose_item(p.in[5] + (size_t)l * D * INW, INW, D, 256 * pn + 64 * wc + 32 * bj, (bf16_t*)(wl + W_IN), 32 * g, 64 * kb, scr, lane); continue; }
        r -= I_IN;
        if (r < 3 * I_SQ) { const int which = r / I_SQ; r %= I_SQ; const int kb = r / 32, g = r % 32; const int pn = g >> 3, bj = (g >> 2) & 1, wc = g & 3;
            const float* src = p.in[9 + which] + (size_t)l * D * D; bf16_t* dst = (bf16_t*)(wl + (which == 0 ? W_A : which == 1 ? W_B : W_O));
            transpose_item(src, D, D, 256 * pn + 64 * wc + 32 * bj, dst, 32 * g, 64 * kb, scr, lane); continue; }
        r -= 3 * I_SQ;
        if (r < I_GU) { const int kb = r / 176, g = r % 176; const int pn = g >> 3, bj = (g >> 2) & 1, wc = g & 3;
            const float* src = p.in[bj ? 14 : 13] + (size_t)l * D * FF;
            transpose_item(src, FF, D, 128 * pn + 32 * wc, (bf16_t*)(wl + W_GU), 32 * g, 64 * kb, scr, lane); continue; }
        r -= I_GU;
        { const int kb = r / 32, g = r % 32; const int pn = g >> 3, bj = (g >> 2) & 1, wc = g & 3;
            transpose_item(p.in[15] + (size_t)l * FF * D, D, FF, 256 * pn + 64 * wc + 32 * bj, (bf16_t*)(wl + W_D), 32 * g, 64 * kb, scr, lane); }
    }
}

__device__ __forceinline__ void norm_phase(const float* x, const float* g, const float* modl, int sh_off, int sc_off, bf16_t* h, int gw, int NGW, const bool stream = false, const bool use_tab = false, const LAS float* tab = nullptr) {
    const int lane = lane_id_opaque();
    for (int q = gw; q < M / 4; q += NGW) {
        const int m0 = 4 * q, b = m0 >> 12;
        f32x4 v[4][4];
#pragma unroll
        for (int r = 0; r < 4; ++r) { const f32x4* xr = (const f32x4*)(x + (size_t)(m0 + r) * D) + lane;
#pragma unroll
            for (int j = 0; j < 4; ++j) v[r][j] = stream ? __builtin_nontemporal_load(xr + 64 * j) : xr[64 * j]; }
        float rs[4];
#pragma unroll
        for (int r = 0; r < 4; ++r) { float s = 0.f;
#pragma unroll
            for (int j = 0; j < 4; ++j) s += (v[r][j][0] * v[r][j][0] + v[r][j][1] * v[r][j][1]) + (v[r][j][2] * v[r][j][2] + v[r][j][3] * v[r][j][3]);
            rs[r] = s; }
#pragma unroll
        for (int o = 1; o < 64; o <<= 1) {
#pragma unroll
            for (int r = 0; r < 4; ++r) rs[r] += shx(rs[r], o, lane); }
#pragma unroll
        for (int r = 0; r < 4; ++r) rs[r] = 1.0f / sqrtf(rs[r] * (1.0f / D) + EPS);
#pragma unroll
        for (int j = 0; j < 4; ++j) { const int col = 4 * (64 * j + lane);
            const f32x4 gg = *(const f32x4*)(g + col);
            const f32x4 sc = (use_tab ? *(const LAS f32x4*)(tab + (b >> 1) * 2048 + sc_off + col) : *(const f32x4*)(modl + b * 6144 + sc_off + col)) + 1.0f;
            const f32x4 sh = use_tab ? *(const LAS f32x4*)(tab + (b >> 1) * 2048 + sh_off + col) : *(const f32x4*)(modl + b * 6144 + sh_off + col);
#pragma unroll
            for (int r = 0; r < 4; ++r) { const f32x4 y = (v[r][j] * rs[r] * gg) * sc + sh;
                u32x2 w; w.x = cvt_pk(y[0], y[1]); w.y = cvt_pk(y[2], y[3]); *((u32x2*)(h + (size_t)(m0 + r) * D) + lane + 64 * j) = w; } }
    }
}

__device__ __forceinline__ void conv_phase(bf16_t* cb, const bf16_t* cc, const bf16_t* cx, const float* cw, int gt0, int NT) {
    const int gt = gt0 + lane_id_opaque();
    for (int it = gt; it < (M / 16) * (D / 8); it += NT) {
        const int c8 = it & 127, run = it >> 7, t0 = run * 16, ch = c8 * 8;
        float w0[8], w1[8], w2[8];
#pragma unroll
        for (int i = 0; i < 8; ++i) { w0[i] = cw[ch + i]; w1[i] = cw[D + ch + i]; w2[i] = cw[2 * D + ch + i]; }
        float um2[8], um1[8];
#pragma unroll
        for (int i = 0; i < 8; ++i) { um2[i] = 0.f; um1[i] = 0.f; }
        if ((t0 & (SEQ - 1)) != 0) {
            const u32x4 a2 = *(const u32x4*)(cc + (size_t)(t0 - 2) * D + ch), b2 = *(const u32x4*)(cx + (size_t)(t0 - 2) * D + ch);
            const u32x4 a1 = *(const u32x4*)(cc + (size_t)(t0 - 1) * D + ch), b1 = *(const u32x4*)(cx + (size_t)(t0 - 1) * D + ch);
#pragma unroll
            for (int i = 0; i < 4; ++i) { um2[2 * i] = bf_lo(a2[i]) * bf_lo(b2[i]); um2[2 * i + 1] = bf_hi(a2[i]) * bf_hi(b2[i]);
                um1[2 * i] = bf_lo(a1[i]) * bf_lo(b1[i]); um1[2 * i + 1] = bf_hi(a1[i]) * bf_hi(b1[i]); }
        }
#pragma unroll 4
        for (int t = 0; t < 16; ++t) {
            const size_t off = (size_t)(t0 + t) * D + ch;
            const u32x4 a = *(const u32x4*)(cc + off), b = *(const u32x4*)(cx + off), e = *(const u32x4*)(cb + off);
            float u[8], y[8];
#pragma unroll
            for (int i = 0; i < 4; ++i) { u[2 * i] = bf_lo(a[i]) * bf_lo(b[i]); u[2 * i + 1] = bf_hi(a[i]) * bf_hi(b[i]); }
#pragma unroll
            for (int i = 0; i < 4; ++i) {
                y[2 * i] = bf_lo(e[i]) * (w0[2 * i] * um2[2 * i] + w1[2 * i] * um1[2 * i] + w2[2 * i] * u[2 * i]);
                y[2 * i + 1] = bf_hi(e[i]) * (w0[2 * i + 1] * um2[2 * i + 1] + w1[2 * i + 1] * um1[2 * i + 1] + w2[2 * i + 1] * u[2 * i + 1]); }
            u32x4 o; o.x = cvt_pk(y[0], y[1]); o.y = cvt_pk(y[2], y[3]); o.z = cvt_pk(y[4], y[5]); o.w = cvt_pk(y[6], y[7]);
            *(u32x4*)(cb + off) = o;
#pragma unroll
            for (int i = 0; i < 8; ++i) { um2[i] = um1[i]; um1[i] = u[i]; }
        }
    }
}

#define MFMA32(a, b, c) __builtin_amdgcn_mfma_f32_32x32x16_bf16((a), (b), (c), 0, 0, 0)
constexpr float SB_EXIT = 1.0e-20f;
__device__ __forceinline__ float clamp_z(float z) { return __builtin_amdgcn_fmed3f(z, -126.0f, 80.0f); }
struct AttnState { f32x16 o0, o1; float P; bf16x8 kf[4]; };
template <bool DIAG>
__device__ __forceinline__ void attn_step(AttnState& st, const bf16x8 (&qf)[4], const bf16_t* kbase, const bf16_t* vbase, int j0, bool more, int n, int hh, int lane) {
    bf16x8 vf[2][2];
#pragma unroll
    for (int mb = 0; mb < 2; ++mb)
#pragma unroll
        for (int s = 0; s < 2; ++s) vf[mb][s] = *(const bf16x8*)(vbase + (size_t)mb * 32 * SEQ + j0 + 16 * s);
    f32x16 sa;
#pragma unroll
    for (int r = 0; r < 16; ++r) sa[r] = 0.f;
#pragma unroll
    for (int kk = 0; kk < 4; ++kk) sa = MFMA32(st.kf[kk], qf[kk], sa);
    if (more) {
#pragma unroll
        for (int kk = 0; kk < 4; ++kk) st.kf[kk] = *(const bf16x8*)(kbase + (size_t)(j0 - 32) * D + kk * 16);
    }
    float om[16], be[16];
#pragma unroll
    for (int r = 0; r < 16; ++r) {
        const float e = fast_exp2(clamp_z(sa[r]));
        float o = fast_rcp(1.0f + e), b = e * o;
        if (DIAG) { const int ki = (r & 3) + 8 * (r >> 2) + 4 * hh; if (ki >= n) { o = 1.0f; b = 0.f; } }
        om[r] = o; be[r] = b;
    }
    float g[4], pg[4];
#pragma unroll
    for (int q = 0; q < 4; ++q) g[q] = (om[4 * q] * om[4 * q + 1]) * (om[4 * q + 2] * om[4 * q + 3]);
#pragma unroll
    for (int q = 0; q < 4; ++q) pg[q] = shx(g[q], 32, lane);
    float run = st.P;
    float a[16];
#pragma unroll
    for (int q = 3; q >= 0; --q) {
        const float c3 = (hh == 0) ? run * pg[q] : run;
        const float c2 = c3 * om[4 * q + 3], c1 = c2 * om[4 * q + 2], c0 = c1 * om[4 * q + 1];
        a[4 * q + 3] = be[4 * q + 3] * c3; a[4 * q + 2] = be[4 * q + 2] * c2; a[4 * q + 1] = be[4 * q + 1] * c1; a[4 * q] = be[4 * q] * c0;
        run *= g[q] * pg[q];
    }
    st.P = run;
#pragma unroll
    for (int s = 0; s < 2; ++s) {
        u32x4 pw; pw.x = cvt_pk(a[8 * s + 0], a[8 * s + 1]); pw.y = cvt_pk(a[8 * s + 2], a[8 * s + 3]); pw.z = cvt_pk(a[8 * s + 4], a[8 * s + 5]); pw.w = cvt_pk(a[8 * s + 6], a[8 * s + 7]);
        const bf16x8 pf = __builtin_bit_cast(bf16x8, pw);
        st.o0 = MFMA32(vf[0][s], pf, st.o0); st.o1 = MFMA32(vf[1][s], pf, st.o1);
    }
}
__device__ __forceinline__ void attn_task(bf16_t* QO, const bf16_t* Kp, const bf16_t* VT, int b, int h, int qblk, int lane) {
    const int n = lane & 31, hh = lane >> 5, t0 = qblk * 32;
    bf16_t* qrow = QO + (size_t)(b * SEQ + t0 + n) * D + h * HD;
    bf16x8 qf[4];
#pragma unroll
    for (int kk = 0; kk < 4; ++kk) qf[kk] = *(const bf16x8*)(qrow + kk * 16 + hh * 8);
    AttnState st;
#pragma unroll
    for (int r = 0; r < 16; ++r) { st.o0[r] = 0.f; st.o1[r] = 0.f; }
    st.P = 1.0f;
    const bf16_t* kbase = Kp + (size_t)(b * SEQ + n) * D + h * HD + hh * 8;
    const bf16_t* vbase = VT + ((size_t)(b * NH + h) * HD + n) * SEQ + 8 * hh;
#pragma unroll
    for (int kk = 0; kk < 4; ++kk) st.kf[kk] = *(const bf16x8*)(kbase + (size_t)t0 * D + kk * 16);
    attn_step<true>(st, qf, kbase, vbase, t0, qblk > 0, n, hh, lane);
    for (int kb = qblk - 1; kb >= 0; --kb) {
        if (!__any(st.P > SB_EXIT)) break;
        attn_step<false>(st, qf, kbase, vbase, kb * 32, kb > 0, n, hh, lane);
    }
#pragma unroll
    for (int q = 0; q < 4; ++q) {
        u32x2 w0, w1; w0.x = cvt_pk(st.o0[4 * q], st.o0[4 * q + 1]); w0.y = cvt_pk(st.o0[4 * q + 2], st.o0[4 * q + 3]); w1.x = cvt_pk(st.o1[4 * q], st.o1[4 * q + 1]); w1.y = cvt_pk(st.o1[4 * q + 2], st.o1[4 * q + 3]);
        *(u32x2*)(qrow + 8 * q + 4 * hh) = w0; *(u32x2*)(qrow + 32 + 8 * q + 4 * hh) = w1;
    }
}
__device__ __forceinline__ void attn_phase(bf16_t* QO, const bf16_t* Kp, const bf16_t* VT, int G, int bx, int wave) {
    const int lane = lane_id_opaque();
    constexpr int NQB = SEQ / 32, NTASK = NB * NH * NQB;
    if (G == 256) {
#pragma unroll 1
        for (int i = 0; i < 4; ++i) { const int bh = 2 * (wave * 4 + i) + (bx & 1); attn_task(QO, Kp, VT, bh / NH, bh % NH, bx >> 1, lane); }
    } else {
        int i = 0;
        for (int tau = bx * NWAVES + wave; tau < NTASK; tau += G * NWAVES, ++i) {
            const int bh = tau / NQB, qr = tau % NQB, qblk = (i & 1) ? (NQB - 1 - qr) : qr;
            attn_task(QO, Kp, VT, bh / NH, bh % NH, qblk, lane);
        }
    }
}
__device__ __forceinline__ void bias_phase(const bf16_t* Wgu, const float* sh2  , float* bias, int gw, int NGW) {
    const int lane = lane_id_opaque();
    float sv[4][16];
#pragma unroll
    for (int b = 0; b < 4; ++b)
#pragma unroll
        for (int h = 0; h < 2; ++h)
#pragma unroll
            for (int q = 0; q < 2; ++q) { const f32x4 t = *(const f32x4*)(sh2 + b * 6144 + h * 512 + lane * 8 + q * 4);
#pragma unroll
                for (int i = 0; i < 4; ++i) sv[b][h * 8 + q * 4 + i] = t[i]; }
    for (int a = gw; a < 2 * FF; a += NGW) {
        const u32x4 w0 = *(const u32x4*)(Wgu + (size_t)a * D + lane * 8), w1 = *(const u32x4*)(Wgu + (size_t)a * D + 512 + lane * 8);
        float wv[16];
#pragma unroll
        for (int i = 0; i < 4; ++i) { wv[2 * i] = bf_lo(w0[i]); wv[2 * i + 1] = bf_hi(w0[i]); wv[8 + 2 * i] = bf_lo(w1[i]); wv[8 + 2 * i + 1] = bf_hi(w1[i]); }
        float sb[4];
#pragma unroll
        for (int b = 0; b < 4; ++b) { float t = 0.f;
#pragma unroll
            for (int i = 0; i < 16; ++i) t += wv[i] * sv[b][i];
            sb[b] = t; }
#pragma unroll
        for (int o = 1; o < 64; o <<= 1) {
#pragma unroll
            for (int b = 0; b < 4; ++b) sb[b] += shx(sb[b], o, lane); }
        if (lane == 0) {
#pragma unroll
            for (int b = 0; b < 4; ++b) bias[b * (2 * FF) + a] = sb[b]; }
    }
}

__device__ __forceinline__ void mixer_phase(bf16_t* QO, const bf16_t* Kp, const bf16_t* VT, bf16_t* cb, const bf16_t* cc, const bf16_t* cx, const float* cw, int G, int bx, int wave, int gt0, int NT) {
    if (wave & 4) { conv_phase(cb, cc, cx, cw, gt0, NT); attn_phase(QO, Kp, VT, G, bx, wave); }
    else          { attn_phase(QO, Kp, VT, G, bx, wave); conv_phase(cb, cc, cx, cw, gt0, NT); }
}

#define XB_TMO      128
#define XB_XCNT(j)  (256  + 64 * (j))
#define XB_XSUB(j)  (1280 + 64 * (j))
#define XB_XGEN(j)  (2304 + 64 * (j))
#define XB_TOP      3328
#define XB_TOPGEN   3392
#define XCD_BAR_WORDS 3456
#define XB_SPIN_CAP (1u << 18)
__device__ __forceinline__ unsigned xb_ld(unsigned* p)              { return __hip_atomic_load(p, __ATOMIC_RELAXED, __HIP_MEMORY_SCOPE_AGENT); }
__device__ __forceinline__ unsigned xb_add(unsigned* p, unsigned v) { return __hip_atomic_fetch_add(p, v, __ATOMIC_RELAXED, __HIP_MEMORY_SCOPE_AGENT); }
__device__ __forceinline__ unsigned xb_xcc_id() { return (unsigned)__builtin_amdgcn_s_getreg((3 << 11) | 20) & 0xFu; }
#define XB_SPIN(cond, bar) do { unsigned _sp = 0; while (cond) { __builtin_amdgcn_s_sleep(1); \
    if ((++_sp & 255u) == 0u) { if (xb_ld(&(bar)[XB_TMO])) break; if (_sp > XB_SPIN_CAP) { atomicAdd(&(bar)[XB_TMO], 1u); break; } } } } while (0)
struct XcdBarrier { unsigned* bar; unsigned x; volatile LAS unsigned* st; };
__device__ __forceinline__ XcdBarrier xcd_barrier_post(unsigned* bar, volatile LAS unsigned* st, int tid) {
    XcdBarrier b; b.bar = bar; b.x = xb_xcc_id(); b.st = st;
    if (tid == 0) (void)xb_add(&bar[XB_XCNT(b.x)], 1u);
    return b;
}
__device__ __forceinline__ void xcd_barrier_complete(unsigned* bar, unsigned x, unsigned& nloc, unsigned& nx) {
    const unsigned G = gridDim.x * gridDim.y * gridDim.z;
    unsigned sum, cnt, mine, sp = 0u;
    for (;;) {
        sum = 0u; cnt = 0u; mine = 0u;
#pragma unroll
        for (unsigned j = 0; j < 16; ++j) { const unsigned c = xb_ld(&bar[XB_XCNT(j)]); sum += c; cnt += (c > 0u) ? 1u : 0u; mine = (j == x) ? c : mine; }
        if (sum == G) break;
        __builtin_amdgcn_s_sleep(1);
        if ((++sp & 255u) == 0u) { if (xb_ld(&bar[XB_TMO])) break; if (sp > XB_SPIN_CAP) { atomicAdd(&bar[XB_TMO], 1u); break; } }
    }
    nloc = mine > 0u ? mine : 1u; nx = cnt > 0u ? cnt : 1u;
}
__device__ __forceinline__ void xcd_barrier(const XcdBarrier& b, bool leader) {
    asm volatile("s_waitcnt vmcnt(0)" ::: "memory");
    __syncthreads();
    if (leader) {
        unsigned* bar = b.bar;
        __builtin_amdgcn_s_waitcnt(0);
        unsigned nloc = b.st[0], nx = b.st[1];
        if (nloc == 0u) { xcd_barrier_complete(bar, b.x, nloc, nx); b.st[0] = nloc; b.st[1] = nx; }
        const unsigned old = xb_add(&bar[XB_XSUB(b.x)], 1u);
        const unsigned gen = old / nloc;
        if (old + 1u == (gen + 1u) * nloc) {
            __builtin_amdgcn_fence(__ATOMIC_RELEASE, "agent");
            asm volatile("s_waitcnt vmcnt(0)" ::: "memory");
            const unsigned og = xb_add(&bar[XB_TOP], 1u);
            const unsigned tg = og / nx;
            if (og + 1u == (tg + 1u) * nx) xb_add(&bar[XB_TOPGEN], 1u);
            else XB_SPIN(xb_ld(&bar[XB_TOPGEN]) == tg, bar);
            __builtin_amdgcn_fence(__ATOMIC_ACQUIRE, "agent");
            xb_add(&bar[XB_XGEN(b.x)], 1u);
            asm volatile("s_waitcnt vmcnt(0)" ::: "memory");
        } else {
            XB_SPIN(xb_ld(&bar[XB_XGEN(b.x)]) == gen, bar);
            __builtin_amdgcn_fence(__ATOMIC_ACQUIRE, "agent");
            asm volatile("s_waitcnt vmcnt(0)" ::: "memory");
        }
    }
    __syncthreads();
}

#define XB_DONE XCD_BAR_WORDS
#define XB_PANEL (XCD_BAR_WORDS + 64)
#define XB_ALL   (XB_PANEL + 64 * 64)
__device__ unsigned g_bar[XB_ALL];
__device__ __forceinline__ void panel_barrier(unsigned* ctr, unsigned target, bool leader) {
    asm volatile("s_waitcnt vmcnt(0)" ::: "memory");
    __syncthreads();
    if (leader) {
        (void)xb_add(ctr, 1u);
        unsigned sp = 0u;
        while (xb_ld(ctr) < target) { __builtin_amdgcn_s_sleep(1); if (++sp > XB_SPIN_CAP) break; }
        __builtin_amdgcn_fence(__ATOMIC_ACQUIRE, "agent");
        asm volatile("s_waitcnt vmcnt(0)" ::: "memory");
    }
    __syncthreads();
}

constexpr int LDS_BYTES = 131072 + 2048;
__global__ void __launch_bounds__(NTHREADS, 2) fwd_kernel(Params p) {
    extern __shared__ __attribute__((aligned(16))) unsigned char lds_raw[];
    LAS unsigned char* lds = (LAS unsigned char*)lds_raw;
    cg::grid_group grid = cg::this_grid();
#define CG_SYNC() do { asm volatile("s_waitcnt vmcnt(0)" ::: "memory"); grid.sync(); if (wave == 0) { __builtin_amdgcn_fence(__ATOMIC_ACQUIRE, "agent"); asm volatile("s_waitcnt vmcnt(0)" ::: "memory"); } __syncthreads(); } while (0)
#define GRID_SYNC_() xcd_barrier(xb, leader)
    unsigned long long pr_acc = 0, pr_t0 = 0;
#define TIC() do { if (PROBE_MASK) pr_t0 = __builtin_amdgcn_s_memrealtime(); } while (0)
#define TOC(bit) do { if (PROBE_MASK & (bit)) pr_acc += __builtin_amdgcn_s_memrealtime() - pr_t0; } while (0)
#define GRID_SYNC() do { TIC(); GRID_SYNC_(); TOC(2 | sync_kind); } while (0)
    int sync_kind = 128;
    const int tid0 = threadIdx.x, wave = __builtin_amdgcn_readfirstlane(tid0 >> 6);
    const int G = gridDim.x, bx = blockIdx.x;
    const int gw = bx * NWAVES + wave, NGW = G * NWAVES, NT = G * NTHREADS;
    unsigned char* ws = p.ws;
    float* mod = (float*)(ws + WS_CTL);
    bf16_t* Rh = (bf16_t*)(ws + R_H); bf16_t* Rq = (bf16_t*)(ws + R_Q); bf16_t* Rk = (bf16_t*)(ws + R_K); bf16_t* Rv = (bf16_t*)(ws + R_V);
    bf16_t* Rcb = (bf16_t*)(ws + R_CB); bf16_t* Rcc = (bf16_t*)(ws + R_CC); bf16_t* Rcx = (bf16_t*)(ws + R_CX);
    const unsigned char* wl = ws + WS_W;

    unsigned* barw = g_bar;
    volatile LAS unsigned* bst = (volatile LAS unsigned*)(lds + 131072);
    const bool leader = (wave == 0) && (lane_id_opaque() == 0);
    if (leader) { bst[0] = 0u; bst[1] = 0u; bst[2] = 0u; }
    const XcdBarrier xb = xcd_barrier_post(barw, bst, leader ? 0 : 1);
    if (G == 0x7fffffff) CG_SYNC();
    TIC();
    phase0(p, lds, gw, NGW, wave, lane_id_opaque(), 0, true);
    TOC(16);
    GRID_SYNC();
    TIC();
    {
        const int gt = bx * NTHREADS + wave * 64 + lane_id_opaque();
        for (int it = gt; it < 2 * 4 * 1536; it += NT) {
            const int l = it / 6144, r = it % 6144, b = r / 1536, n4 = r % 1536;
            f32x4 a = *(const f32x4*)(p.in[3] + l * 6144 + n4 * 4);
            const float* mp = (const float*)(ws + R_CX) + ((size_t)(l * 32) * 4 + b) * 6144 + n4 * 4;
#pragma unroll 8
            for (int kc = 0; kc < 32; ++kc) a += *(const f32x4*)(mp + (size_t)kc * 4 * 6144);
            *(f32x4*)(mod + (size_t)(l * 4 + b) * 6144 + n4 * 4) = a;
        }
    }
    TOC(16);
    if (G == 256) {
        LAS float* tab = (LAS float*)(lds + 1024);
        const int t = wave * 64 + lane_id_opaque();
#pragma unroll 1
        for (int k = 0; k < 2; ++k) {
            const int idx = t + 512 * k, sel = idx >> 9, n4 = idx & 511, b = (bx >> 7) + 2 * sel;
            f32x4 a = *(const f32x4*)(p.in[3] + n4 * 4);
            const float* mp = (const float*)(ws + R_CX) + (size_t)b * 6144 + n4 * 4;
#pragma unroll 8
            for (int kc = 0; kc < 32; ++kc) a += *(const f32x4*)(mp + (size_t)kc * 4 * 6144);
            *(LAS f32x4*)(tab + sel * 2048 + n4 * 4) = a;
        }
        __syncthreads();
        TIC(); norm_phase(p.in[0], p.in[4], mod, 0, 1024, Rh, gw, NGW, true, true, tab); TOC(8); sync_kind = 128;
    } else {
        GRID_SYNC();
        TIC(); norm_phase(p.in[0], p.in[4], mod, 0, 1024, Rh, gw, NGW, true); TOC(8); sync_kind = 128;
    }
    GRID_SYNC();

#pragma unroll 1
    for (int l = 0; l < DEPTH; ++l) {
        const float* modl = mod + (size_t)l * 4 * 6144;
        const float* xin = (l == 0) ? p.in[0] : p.out;
        { pg8::SchedPlain S; S.T.init(M, 6144); S.G = G; S.c = bx; S.A = (const char*)Rh; S.B = (const char*)(wl + W_IN); S.tstep = (size_t)256 * D * 2;
          pg8::EpiQKV E{Rq, p.in[6] + l * HD, p.in[7] + l * HD};
          TIC(); pg8::gemm_phase(lds, D, S, E, wave); TOC(1); sync_kind = 32; }
        GRID_SYNC();
        const bool fuse_norm2 = (G == 256);
        float* biasgu = (float*)(ws + WS_CTL + 256 * 1024);
        float* ssqp = (float*)(ws + R_CC);
        TIC();
        if (fuse_norm2 && (wave & 4)) bias_phase((const bf16_t*)(wl + W_GU), modl + 3072, biasgu, bx * 4 + (wave & 3), G * 4);
        mixer_phase(Rq, Rk, Rv, Rcb, Rcc, Rcx, p.in[8] + (size_t)l * 3 * D, G, bx, wave, bx * NTHREADS + wave * 64, NT); TOC(4); sync_kind = 64;
        GRID_SYNC();
        { pg8::SchedBranch S; S.T.init(M, D); S.G = G; S.c = bx; S.ws = (const char*)ws; S.wl = (const char*)wl; S.tstep = (size_t)256 * D * 2;
          pg8::EpiBranch E{Rv, Rk};
          TIC(); pg8::gemm_phase(lds, D, S, E, wave); TOC(1); sync_kind = 32; }
        if (G == 256) {
            pg8::TileOrder T4; T4.init(M, D); int pm4, pn4; T4.map(bx, pm4, pn4);
            panel_barrier(barw + XB_PANEL + 64 * pm4, 8u * (unsigned)l + 4u, leader);
        } else GRID_SYNC();
        if (fuse_norm2) {
          { pg8::SchedPlain S; S.T.init(M, D); S.G = G; S.c = bx; S.A = (const char*)Rk; S.B = (const char*)(wl + W_O); S.tstep = (size_t)256 * D * 2;
            pg8::EpiResidNorm E{xin, p.out, modl + 2048, p.in[12] + l * D, modl + 4096, Rh, ssqp};
            TIC(); pg8::gemm_phase(lds, D, S, E, wave); TOC(1); sync_kind = 32; }
          GRID_SYNC();
          { pg8::SchedPlain S; S.T.init(M, 2 * FF); S.G = G; S.c = bx; S.A = (const char*)Rh; S.B = (const char*)(wl + W_GU); S.tstep = (size_t)256 * D * 2;
            LAS float* rtab = (LAS float*)(lds + 131072 + 64);
            { pg8::Unit u0; if (S.next(0, u0)) { const int t = wave * 64 + lane_id_opaque();
                if (t < 256) { const float* sp = ssqp + (size_t)(u0.pm * 256 + t) * 16; const f32x4 a = *(const f32x4*)sp, b4 = *(const f32x4*)(sp + 4), c = *(const f32x4*)(sp + 8), d = *(const f32x4*)(sp + 12);
                    const float ss = (((a[0] + a[1]) + (a[2] + a[3])) + ((b4[0] + b4[1]) + (b4[2] + b4[3]))) + (((c[0] + c[1]) + (c[2] + c[3])) + ((d[0] + d[1]) + (d[2] + d[3])));
                    rtab[t] = 1.0f / sqrtf(ss * (1.0f / D) + EPS); } } }
            __syncthreads();
            pg8::EpiGUNorm E{Rq, biasgu, rtab};
            TIC(); pg8::gemm_phase(lds, D, S, E, wave); TOC(1); sync_kind = 32; }
          {
            pg8::TileOrder T4; T4.init(M, D); int pm4, pn4; T4.map(bx, pm4, pn4);
            panel_barrier(barw + XB_PANEL + 64 * pm4, 8u * (unsigned)l + 8u, leader); }
        } else {
        { pg8::SchedPlain S; S.T.init(M, D); S.G = G; S.c = bx; S.A = (const char*)Rk; S.B = (const char*)(wl + W_O); S.tstep = (size_t)256 * D * 2;
          pg8::EpiResid E{xin, p.out, modl + 2048};
          TIC(); pg8::gemm_phase(lds, D, S, E, wave); TOC(1); sync_kind = 32; }
        GRID_SYNC();
        TIC(); norm_phase(p.out, p.in[12] + l * D, modl, 3072, 4096, Rh, gw, NGW, true); TOC(8); sync_kind = 128;
        GRID_SYNC();
        { pg8::SchedPlain S; S.T.init(M, 2 * FF); S.G = G; S.c = bx; S.A = (const char*)Rh; S.B = (const char*)(wl + W_GU); S.tstep = (size_t)256 * D * 2;
          pg8::EpiGU E{Rq};
          TIC(); pg8::gemm_phase(lds, D, S, E, wave); TOC(1); sync_kind = 32; }
        GRID_SYNC();
        }
        { pg8::SchedPlain S; S.T.init(M, D); S.G = G; S.c = bx; S.A = (const char*)Rq; S.B = (const char*)(wl + W_D); S.tstep = (size_t)256 * FF * 2;
          pg8::EpiResid E{p.out, p.out, modl + 5120};
          TIC(); pg8::gemm_phase(lds, FF, S, E, wave); TOC(1); sync_kind = 32; }
        if (l + 1 < DEPTH) {
            GRID_SYNC();
            TIC();
            phase0(p, lds, gw, NGW, wave, lane_id_opaque(), l + 1, false);
            norm_phase(p.out, p.in[4] + (l + 1) * D, mod + (size_t)(l + 1) * 4 * 6144, 0, 1024, Rh, gw, NGW, true);
            TOC(8); sync_kind = 128;
            GRID_SYNC();
        }
    }
    asm volatile("s_waitcnt vmcnt(0)" ::: "memory");
    if (leader) { const unsigned old = xb_add(&barw[XB_DONE], 1u); bst[2] = (old + 1u == (unsigned)G) ? 1u : 0u; }
    __syncthreads();
    if (bst[2]) { const int t = wave * 64 + lane_id_opaque(); for (int i = t; i < XB_ALL; i += NTHREADS) __hip_atomic_store(&barw[i], 0u, __ATOMIC_RELAXED, __HIP_MEMORY_SCOPE_AGENT); }
    if (PROBE_MASK && bx == 0 && leader) { const unsigned long long t = __builtin_amdgcn_s_memrealtime(); while (__builtin_amdgcn_s_memrealtime() - t < pr_acc) __builtin_amdgcn_s_sleep(8); }
}

extern "C" void kernel_launch(void* const* d_in, const int* in_sizes, int n_in, void* d_out, int out_size, void* d_ws, size_t ws_size, hipStream_t stream) {
    static int grid_blocks = 0;
    if (grid_blocks == 0) {
        if (n_in != 16 || out_size != M * D || ws_size < WS_END) { fprintf(stderr, "kernel_launch: unexpected shapes (n_in %d out %d ws %zu need %zu)\n", n_in, out_size, ws_size, (size_t)WS_END); grid_blocks = -1; return; }
        int dev = 0, cus = 0, per_cu = 0;
        hipGetDevice(&dev);
        hipDeviceGetAttribute(&cus, hipDeviceAttributeMultiprocessorCount, dev);
        hipFuncSetAttribute((const void*)fwd_kernel, hipFuncAttributeMaxDynamicSharedMemorySize, LDS_BYTES);
        hipOccupancyMaxActiveBlocksPerMultiprocessor(&per_cu, (const void*)fwd_kernel, NTHREADS, LDS_BYTES);
        (void)hipGetLastError();
        if (per_cu < 1) { fprintf(stderr, "kernel_launch: occupancy query says %d blocks per CU\n", per_cu); per_cu = 1; }
        grid_blocks = cus;
    }
    if (grid_blocks < 0) return;
    Params p{};
    for (int i = 0; i < 16; ++i) p.in[i] = (const float*)d_in[i];
    p.out = (float*)d_out; p.ws = (unsigned char*)d_ws;
    void* args[] = {&p};
    hipError_t e = hipLaunchCooperativeKernel((const void*)fwd_kernel, dim3(grid_blocks), dim3(NTHREADS), args, LDS_BYTES, stream);
    if (e != hipSuccess) fprintf(stderr, "cooperative launch failed: %s (grid %d)\n", hipGetErrorString(e), grid_blocks);
}
```
